# Optimizing an MI355X kernel written in HIP

```python
import math
import jax, jax.numpy as jnp
from jax import lax
import numpy as np

D_MODEL = 1024
BATCH = 4
SEQ = 8192
DEPTH = 4

N_MIXERS = 2
N_MLSTM_LAYERS = (DEPTH + 1) // 2
N_MLA_LAYERS = DEPTH // 2

MLSTM_HEADS = 8
MLSTM_DV = D_MODEL // MLSTM_HEADS
MLSTM_DQK = MLSTM_DV // 2
MLSTM_CHUNK = 64
MLSTM_IN = 2 * MLSTM_HEADS * MLSTM_DQK + 2 * MLSTM_HEADS * MLSTM_DV + 2 * MLSTM_HEADS

MLA_HEADS = 8
MLA_Q_LORA = 384
MLA_KV_LORA = 256
MLA_NOPE = 128
MLA_ROPE = 64
MLA_V = 128
MLA_IN = MLA_Q_LORA + MLA_KV_LORA + MLA_ROPE
ROPE_THETA = 10000.0
ATTN_QBLOCK = 128

N_EXPERTS = 32
TOP_K = 4
D_FF = D_MODEL
SWIGLU_LIMIT = 7.0
SWIGLU_ALPHA = 1.702
MOE_BLOCK = 128

DEEPNORM_ALPHA = (2.0 * DEPTH) ** 0.25
DEEPNORM_BETA = (8.0 * DEPTH) ** -0.25
LN_EPS = 1e-5
RMS_EPS = 1e-6

kernel_name = 'hybrid_mlstm_mla_moe_deepnorm'


def layer_norm(x, g, b):
    xf = x.astype(jnp.float32)
    mu = jnp.mean(xf, axis=-1, keepdims=True)
    var = jnp.mean(jnp.square(xf - mu), axis=-1, keepdims=True)
    return ((xf - mu) * lax.rsqrt(var + LN_EPS) * g + b).astype(x.dtype)


def rms_norm(x, g):
    xf = x.astype(jnp.float32)
    return (xf * lax.rsqrt(jnp.mean(jnp.square(xf), axis=-1, keepdims=True) + RMS_EPS) * g).astype(x.dtype)


def rope_tables(positions):
    inv_freq = ROPE_THETA ** (-jnp.arange(0, MLA_ROPE, 2, dtype=jnp.float32) / MLA_ROPE)
    ang = positions.astype(jnp.float32)[..., None] * inv_freq
    return jnp.cos(ang), jnp.sin(ang)


def apply_rope(x, cos, sin):
    x1, x2 = jnp.split(x, 2, axis=-1)
    return jnp.concatenate([x1 * cos - x2 * sin, x2 * cos + x1 * sin], axis=-1).astype(x.dtype)


def mlstm_cell(q, k, v, ig, lf):
    B, H, S, dk = q.shape
    dv = v.shape[-1]
    L = MLSTM_CHUNK
    nc = S // L
    q = q.reshape(B, H, nc, L, dk)
    k = k.reshape(B, H, nc, L, dk)
    v = v.reshape(B, H, nc, L, dv)
    ig = ig.reshape(B, H, nc, L)
    lf = lf.reshape(B, H, nc, L)
    b = jnp.cumsum(lf, axis=-1)
    g_end = b[..., -1:] - b + ig

    def step(carry, inp):
        C, n, m = carry
        k_c, v_c, g_c, bl_c = inp
        m_new = jnp.maximum(bl_c + m, jnp.max(g_c, axis=-1))
        decay = jnp.exp(bl_c + m - m_new)
        w = jnp.exp(g_c - m_new[..., None])
        C_new = decay[..., None, None] * C + jnp.einsum('bhlv,bhlk->bhvk', w[..., None] * v_c, k_c)
        n_new = decay[..., None] * n + jnp.einsum('bhl,bhlk->bhk', w, k_c)
        return (C_new, n_new, m_new), (C, n, m)

    init = (jnp.zeros((B, H, dv, dk), jnp.float32), jnp.zeros((B, H, dk), jnp.float32),
            jnp.zeros((B, H), jnp.float32))
    xs = (jnp.moveaxis(k, 2, 0), jnp.moveaxis(v, 2, 0), jnp.moveaxis(g_end, 2, 0),
          jnp.moveaxis(b[..., -1], 2, 0))
    _, (C_prev, n_prev, m_prev) = lax.scan(step, init, xs)
    C_prev = jnp.moveaxis(C_prev, 0, 2)
    n_prev = jnp.moveaxis(n_prev, 0, 2)
    m_prev = jnp.moveaxis(m_prev, 0, 2)

    causal = jnp.tril(jnp.ones((L, L), dtype=bool))
    D = jnp.where(causal, b[..., :, None] - b[..., None, :] + ig[..., None, :], -jnp.inf)
    inter = b + m_prev[..., None]
    m_row = jnp.maximum(inter, jnp.max(D, axis=-1))
    s = jnp.einsum('bhcqk,bhcsk->bhcqs', q, k) * jnp.exp(D - m_row[..., None])
    w_inter = jnp.exp(inter - m_row)
    num = (jnp.einsum('bhcqs,bhcsv->bhcqv', s, v)
           + w_inter[..., None] * jnp.einsum('bhcqk,bhcvk->bhcqv', q, C_prev))
    den = jnp.sum(s, axis=-1) + w_inter * jnp.einsum('bhcqk,bhck->bhcq', q, n_prev)
    h = num / jnp.maximum(jnp.abs(den), jnp.exp(-m_row))[..., None]
    return h.reshape(B, H, S, dv)


def mlstm_mixer(x, w_in, b_gates, norm_gain, w_out):
    B, S, _ = x.shape
    H, dk, dv = MLSTM_HEADS, MLSTM_DQK, MLSTM_DV
    proj = x @ w_in
    cuts = [H * dk, 2 * H * dk, 2 * H * dk + H * dv, 2 * H * dk + 2 * H * dv]
    q, k, v, o, g = jnp.split(proj, cuts, axis=-1)

    def heads(t, d):
        return t.reshape(B, S, H, d).transpose(0, 2, 1, 3).astype(jnp.float32)

    gates = (g + b_gates).astype(jnp.float32)
    ig = gates[..., :H].transpose(0, 2, 1)
    lf = jax.nn.log_sigmoid(gates[..., H:]).transpose(0, 2, 1)
    h = mlstm_cell(heads(q, dk) * (dk ** -0.5), heads(k, dk), heads(v, dv), ig, lf)
    h = rms_norm(h.transpose(0, 2, 1, 3), norm_gain.reshape(H, dv)).reshape(B, S, H * dv)
    h = (jax.nn.sigmoid(o.astype(jnp.float32)) * h).astype(x.dtype)
    return h @ w_out


def causal_block_attention(q_nope, q_rope, k_nope, k_rope, v):
    B, S, H, dn = q_nope.shape
    QB = ATTN_QBLOCK
    nqb = S // QB
    scale = (MLA_NOPE + MLA_ROPE) ** -0.5
    qn = q_nope.reshape(B, nqb, QB, H, dn).transpose(1, 0, 3, 2, 4)
    qr = q_rope.reshape(B, nqb, QB, H, MLA_ROPE).transpose(1, 0, 3, 2, 4)
    kn = k_nope.transpose(0, 2, 1, 3)
    vh = v.transpose(0, 2, 1, 3)
    key_pos = jnp.arange(S)

    def block(args):
        qn_b, qr_b, blk = args
        s = jnp.einsum('bhqd,bhkd->bhqk', qn_b, kn) + jnp.einsum('bhqr,bkr->bhqk', qr_b, k_rope)
        s = s.astype(jnp.float32) * scale
        q_pos = blk * QB + jnp.arange(QB)
        mask = key_pos[None, :] <= q_pos[:, None]
        p = jax.nn.softmax(jnp.where(mask, s, -jnp.inf), axis=-1)
        return jnp.einsum('bhqk,bhkv->bhqv', p.astype(vh.dtype), vh)

    o = lax.map(block, (qn, qr, jnp.arange(nqb)))
    return o.transpose(1, 0, 3, 2, 4).reshape(B, S, H, MLA_V)


def mla_mixer(x, cos, sin, w_in, q_norm, kv_norm, w_qb, w_kvb, w_out):
    B, S, _ = x.shape
    H = MLA_HEADS
    a = x @ w_in
    c_q, c_kv, k_r = jnp.split(a, [MLA_Q_LORA, MLA_Q_LORA + MLA_KV_LORA], axis=-1)
    c_q = rms_norm(c_q, q_norm)
    c_kv = rms_norm(c_kv, kv_norm)
    q = (c_q @ w_qb).reshape(B, S, H, MLA_NOPE + MLA_ROPE)
    kv = (c_kv @ w_kvb).reshape(B, S, H, MLA_NOPE + MLA_V)
    q_nope, q_rope = q[..., :MLA_NOPE], q[..., MLA_NOPE:]
    k_nope, v = kv[..., :MLA_NOPE], kv[..., MLA_NOPE:]
    q_rope = apply_rope(q_rope, cos[:, :, None, :], sin[:, :, None, :])
    k_rope = apply_rope(k_r, cos, sin)
    o = causal_block_attention(q_nope, q_rope, k_nope, k_rope, v)
    return o.reshape(B, S, H * MLA_V) @ w_out


def clamped_swiglu(gu):
    g = jnp.minimum(gu[..., ::2], SWIGLU_LIMIT)
    l = jnp.clip(gu[..., 1::2], -SWIGLU_LIMIT, SWIGLU_LIMIT)
    return (l + 1.0) * g * jax.nn.sigmoid(SWIGLU_ALPHA * g)


def moe(x, w_router, b_router, w_gu, b_gu, w_down, b_down):
    B, S, D = x.shape
    T = B * S
    A = T * TOP_K
    xt = x.reshape(T, D)
    logits = (xt @ w_router + b_router).astype(jnp.float32)
    top_val, top_idx = lax.top_k(logits, TOP_K)
    gate = jax.nn.softmax(top_val, axis=-1)
    e_flat = top_idx.reshape(-1)
    tok_flat = jnp.repeat(jnp.arange(T, dtype=jnp.int32), TOP_K)
    order = jnp.argsort(e_flat)
    e_sorted = e_flat[order]
    tok_sorted = tok_flat[order]
    gate_sorted = gate.reshape(-1)[order]
    counts = jnp.bincount(e_flat, length=N_EXPERTS)
    seg_start = jnp.cumsum(counts) - counts
    padded = (counts + MOE_BLOCK - 1) // MOE_BLOCK * MOE_BLOCK
    pad_end = jnp.cumsum(padded)
    pad_start = pad_end - padded
    dest = pad_start[e_sorted] + jnp.arange(A) - seg_start[e_sorted]
    n_blocks = -(-A // MOE_BLOCK) + N_EXPERTS
    P = n_blocks * MOE_BLOCK
    row_tok = jnp.full((P,), T, dtype=jnp.int32).at[dest].set(tok_sorted)
    xpad = jnp.concatenate([xt, jnp.zeros((1, D), xt.dtype)], axis=0)
    x_blocks = xpad[row_tok].reshape(n_blocks, MOE_BLOCK, D)
    block_expert = jnp.minimum(
        jnp.searchsorted(pad_end, jnp.arange(n_blocks) * MOE_BLOCK, side='right'), N_EXPERTS - 1)

    def expert_block(args):
        xb, e = args
        h = clamped_swiglu(xb @ w_gu[e] + b_gu[e])
        return h @ w_down[e] + b_down[e]

    y_blocks = lax.map(expert_block, (x_blocks, block_expert))
    y_sorted = y_blocks.reshape(P, D)[dest]
    y = jax.ops.segment_sum(y_sorted * gate_sorted[:, None].astype(y_sorted.dtype), tok_sorted,
                            num_segments=T)
    return y.reshape(B, S, D).astype(x.dtype)


def setup_inputs(seed: int = 0) -> dict:
    key = jax.random.key(seed)
    ks = jax.random.split(key, 24)

    def nrm(k, shape, scale):
        return jax.random.normal(k, shape, jnp.float32) * scale

    H = MLSTM_HEADS
    x = nrm(ks[0], (BATCH, SEQ, D_MODEL), 1.0)
    positions = (jax.random.randint(ks[1], (BATCH, 1), 0, 4096, dtype=jnp.int32)
                 + jnp.arange(SEQ, dtype=jnp.int32)[None, :])
    ln_gain = 1.0 + nrm(ks[2], (DEPTH, 2, D_MODEL), 0.02)
    ln_bias = nrm(ks[3], (DEPTH, 2, D_MODEL), 0.02)
    mlstm_w_in = nrm(ks[4], (N_MLSTM_LAYERS, D_MODEL, MLSTM_IN), D_MODEL ** -0.5)
    mlstm_b_gates = jnp.concatenate([nrm(ks[5], (N_MLSTM_LAYERS, H), 0.1),
                                     3.0 + nrm(ks[6], (N_MLSTM_LAYERS, H), 0.5)], axis=-1)
    mlstm_norm_gain = 1.0 + nrm(ks[7], (N_MLSTM_LAYERS, H * MLSTM_DV), 0.02)
    mlstm_w_out = nrm(ks[8], (N_MLSTM_LAYERS, H * MLSTM_DV, D_MODEL),
                      (H * MLSTM_DV) ** -0.5 * DEEPNORM_BETA)
    mla_w_in = nrm(ks[9], (N_MLA_LAYERS, D_MODEL, MLA_IN), D_MODEL ** -0.5)
    mla_q_norm = 1.0 + nrm(ks[10], (N_MLA_LAYERS, MLA_Q_LORA), 0.02)
    mla_kv_norm = 1.0 + nrm(ks[11], (N_MLA_LAYERS, MLA_KV_LORA), 0.02)
    mla_w_qb = nrm(ks[12], (N_MLA_LAYERS, MLA_Q_LORA, MLA_HEADS * (MLA_NOPE + MLA_ROPE)), MLA_Q_LORA ** -0.5)
    mla_w_kvb = nrm(ks[13], (N_MLA_LAYERS, MLA_KV_LORA, MLA_HEADS * (MLA_NOPE + MLA_V)), MLA_KV_LORA ** -0.5)
    mla_w_out = nrm(ks[14], (N_MLA_LAYERS, MLA_HEADS * MLA_V, D_MODEL),
                    (MLA_HEADS * MLA_V) ** -0.5 * DEEPNORM_BETA)
    moe_w_router = nrm(ks[15], (DEPTH, D_MODEL, N_EXPERTS), D_MODEL ** -0.5)
    moe_b_router = nrm(ks[16], (DEPTH, N_EXPERTS), 0.01)
    moe_w_gate_up = nrm(ks[17], (DEPTH, N_EXPERTS, D_MODEL, 2 * D_FF), D_MODEL ** -0.5)
    moe_b_gate_up = nrm(ks[18], (DEPTH, N_EXPERTS, 2 * D_FF), 0.02)
    moe_w_down = nrm(ks[19], (DEPTH, N_EXPERTS, D_FF, D_MODEL), D_FF ** -0.5 * DEEPNORM_BETA)
    moe_b_down = nrm(ks[20], (DEPTH, N_EXPERTS, D_MODEL), 0.02)
    return {'x': x, 'positions': positions, 'ln_gain': ln_gain, 'ln_bias': ln_bias,
            'mlstm_w_in': mlstm_w_in, 'mlstm_b_gates': mlstm_b_gates,
            'mlstm_norm_gain': mlstm_norm_gain, 'mlstm_w_out': mlstm_w_out,
            'mla_w_in': mla_w_in, 'mla_q_norm': mla_q_norm, 'mla_kv_norm': mla_kv_norm,
            'mla_w_qb': mla_w_qb, 'mla_w_kvb': mla_w_kvb, 'mla_w_out': mla_w_out,
            'moe_w_router': moe_w_router, 'moe_b_router': moe_b_router,
            'moe_w_gate_up': moe_w_gate_up, 'moe_b_gate_up': moe_b_gate_up,
            'moe_w_down': moe_w_down, 'moe_b_down': moe_b_down}


def reference(x, positions, ln_gain, ln_bias, mlstm_w_in, mlstm_b_gates, mlstm_norm_gain,
              mlstm_w_out, mla_w_in, mla_q_norm, mla_kv_norm, mla_w_qb, mla_w_kvb, mla_w_out,
              moe_w_router, moe_b_router, moe_w_gate_up, moe_b_gate_up, moe_w_down, moe_b_down):
    cos, sin = rope_tables(positions)
    for layer in range(DEPTH):
        j = layer // N_MIXERS
        if layer % N_MIXERS == 0:
            mix = mlstm_mixer(x, mlstm_w_in[j], mlstm_b_gates[j], mlstm_norm_gain[j], mlstm_w_out[j])
        else:
            mix = mla_mixer(x, cos, sin, mla_w_in[j], mla_q_norm[j], mla_kv_norm[j],
                            mla_w_qb[j], mla_w_kvb[j], mla_w_out[j])
        x = layer_norm(DEEPNORM_ALPHA * x + mix, ln_gain[layer, 0], ln_bias[layer, 0])
        ff = moe(x, moe_w_router[layer], moe_b_router[layer], moe_w_gate_up[layer],
                 moe_b_gate_up[layer], moe_w_down[layer], moe_b_down[layer])
        x = layer_norm(DEEPNORM_ALPHA * x + ff, ln_gain[layer, 1], ln_bias[layer, 1])
    return x
```

```cpp
#include <hip/hip_runtime.h>
#include <cstdio>
#include <cstdint>
#include <cstring>

#define LAS __attribute__((address_space(3)))
#define GAS __attribute__((address_space(1)))
typedef unsigned short bf16_t;
typedef short bf16x8 __attribute__((ext_vector_type(8)));
typedef short s16x4 __attribute__((ext_vector_type(4)));
typedef float f32x2 __attribute__((ext_vector_type(2)));
typedef float f32x4 __attribute__((ext_vector_type(4)));
typedef float f32x16 __attribute__((ext_vector_type(16)));
typedef unsigned u32x2 __attribute__((ext_vector_type(2)));
typedef unsigned u32x4 __attribute__((ext_vector_type(4)));

#ifndef MK_PER_PHASE
#define MK_PER_PHASE 1
#endif

constexpr int NB = 4, SEQ = 8192, T = NB * SEQ, D = 1024, DEPTH = 4;
constexpr int MH = 8, MDV = 128, MDK = 64, MCH = 64, MNC = SEQ / MCH, MIN_ = 3088, MUNITS = NB * MH * MNC;
constexpr int AH = 8, AQL = 384, AKL = 256, ANOPE = 128, AROPE = 64, AV = 128, AIN = 704, AINP = 768, AQD = 192;
constexpr int NE = 32, TOPK = 4, DFF = 1024;
constexpr float DN_ALPHA = 1.6817928305074290f;
constexpr float LN_EPS = 1e-5f, RMS_EPS = 1e-6f;
constexpr int MOE_ROWS = 139264;

constexpr size_t MiB = 1ull << 20;
constexpr size_t WS_CTL = 0, CTL_ZERO_BYTES = 1 * MiB;
constexpr size_t WS_COS = 1 * MiB, WS_SIN = 5 * MiB, WS_GATES = 9 * MiB, WS_TOKINFO = 11 * MiB, WS_TOKGATE = 11 * MiB + 512 * 1024, WS_LIST = 12 * MiB;
constexpr size_t WS_MSC = 16 * MiB, WS_NLOC = 17 * MiB, WS_NPREV = 18 * MiB;
constexpr size_t WS_WINM = 20 * MiB, WS_WOUTM = 32 * MiB, WS_WINA = 36 * MiB, WS_WQB = 39 * MiB, WS_WKV = 42 * MiB, WS_WOUTA = 44 * MiB;
constexpr size_t WS_WGU = 64 * MiB, WS_WD = 576 * MiB;
constexpr size_t WS_XF = 832 * MiB, WS_ZF = 960 * MiB, WS_XB = 1088 * MiB, WS_PROJ = 1152 * MiB;
constexpr size_t WS_A32 = WS_PROJ, WS_CQ = WS_PROJ + 96 * MiB, WS_CKV = WS_PROJ + 120 * MiB, WS_KR = WS_PROJ + 136 * MiB;
constexpr size_t WS_QB = 1344 * MiB, WS_CLOC = WS_QB, WS_KN = 1472 * MiB, WS_CPREV = WS_KN, WS_VT = 1536 * MiB, WS_HB = 1600 * MiB;
constexpr size_t WS_HMOE = 1664 * MiB, WS_YMOE = 1936 * MiB, WS_END = 2208 * MiB;
constexpr int CW_BAR = 4096, CW_CNT = 16384;

constexpr int RING_BYTES = 147456;
constexpr int MISC_OFF = RING_BYTES;
constexpr int LDS_BYTES = RING_BYTES + 1024;
constexpr int NWAVES = 8, NTHR = 512;

__device__ __forceinline__ unsigned cvt_pk_bf16(float lo, float hi) { unsigned r; asm("v_cvt_pk_bf16_f32 %0, %1, %2" : "=v"(r) : "v"(lo), "v"(hi)); return r; }
__device__ __forceinline__ float bf_lo(unsigned w) { return __uint_as_float(w << 16); }
__device__ __forceinline__ float bf_hi(unsigned w) { return __uint_as_float(w & 0xffff0000u); }
__device__ __forceinline__ float wave_sum(float v) {
#pragma unroll
    for (int o = 1; o < 64; o <<= 1) v += __shfl_xor(v, o);
    return v;
}
__device__ __forceinline__ float wave_max(float v) {
#pragma unroll
    for (int o = 1; o < 64; o <<= 1) v = fmaxf(v, __shfl_xor(v, o));
    return v;
}
#define LDS_WAIT() asm volatile("s_waitcnt lgkmcnt(0)" ::: "memory")
#define VM_WAIT() asm volatile("s_waitcnt vmcnt(0)" ::: "memory")

#define XB_TMO      128
#define XB_XCNT(j)  (256  + 64 * (j))
#define XB_XSUB(j)  (1280 + 64 * (j))
#define XB_XGEN(j)  (2304 + 64 * (j))
#define XB_TOP      3328
#define XB_TOPGEN   3392
#define XCD_BAR_WORDS 3456
#define XB_SPIN_CAP (1u << 18)
__device__ __forceinline__ unsigned xb_ld(unsigned* p)              { return __hip_atomic_load(p, __ATOMIC_RELAXED, __HIP_MEMORY_SCOPE_AGENT); }
__device__ __forceinline__ unsigned xb_add(unsigned* p, unsigned v) { return __hip_atomic_fetch_add(p, v, __ATOMIC_RELAXED, __HIP_MEMORY_SCOPE_AGENT); }
__device__ __forceinline__ unsigned xb_xcc_id() { return (unsigned)__builtin_amdgcn_s_getreg((3 << 11) | 20) & 0xFu; }
#define XB_SPIN(cond, bar) do { unsigned _sp = 0; while (cond) { __builtin_amdgcn_s_sleep(1); \
    if ((++_sp & 255u) == 0u) { if (xb_ld(&(bar)[XB_TMO])) break; if (_sp > XB_SPIN_CAP) { atomicAdd(&(bar)[XB_TMO], 1u); break; } } } } while (0)
struct XcdBarrier { unsigned* bar; unsigned x; volatile LAS unsigned* st; };
__device__ __forceinline__ XcdBarrier xcd_barrier_post(unsigned* bar, volatile LAS unsigned* st) {
    XcdBarrier b; b.bar = bar; b.x = xb_xcc_id(); b.st = st;
    if (threadIdx.x == 0) (void)xb_add(&bar[XB_XCNT(b.x)], 1u);
    return b;
}
__device__ __forceinline__ void xcd_barrier_complete(unsigned* bar, unsigned x, unsigned& nloc, unsigned& nx) {
    const unsigned G = gridDim.x * gridDim.y * gridDim.z;
    unsigned sum, cnt, mine, sp = 0u;
    for (;;) {
        sum = 0u; cnt = 0u; mine = 0u;
#pragma unroll
        for (unsigned j = 0; j < 16; ++j) { const unsigned c = xb_ld(&bar[XB_XCNT(j)]); sum += c; cnt += (c > 0u) ? 1u : 0u; mine = (j == x) ? c : mine; }
        if (sum == G) break;
        __builtin_amdgcn_s_sleep(1);
        if ((++sp & 255u) == 0u) { if (xb_ld(&bar[XB_TMO])) break; if (sp > XB_SPIN_CAP) { atomicAdd(&bar[XB_TMO], 1u); break; } }
    }
    nloc = mine > 0u ? mine : 1u; nx = cnt > 0u ? cnt : 1u;
}
__device__ __forceinline__ void xcd_barrier(const XcdBarrier& b) {
    asm volatile("s_waitcnt vmcnt(0)" ::: "memory");
    __syncthreads();
    if (threadIdx.x == 0) {
        unsigned* bar = b.bar;
        __builtin_amdgcn_s_waitcnt(0);
        unsigned nloc = b.st[0], nx = b.st[1];
        if (nloc == 0u) { xcd_barrier_complete(bar, b.x, nloc, nx); b.st[0] = nloc; b.st[1] = nx; }
        const unsigned old = xb_add(&bar[XB_XSUB(b.x)], 1u);
        const unsigned gen = old / nloc;
        if (old + 1u == (gen + 1u) * nloc) {
            __builtin_amdgcn_fence(__ATOMIC_RELEASE, "agent");
            asm volatile("s_waitcnt vmcnt(0)" ::: "memory");
            const unsigned og = xb_add(&bar[XB_TOP], 1u);
            const unsigned tg = og / nx;
            if (og + 1u == (tg + 1u) * nx) xb_add(&bar[XB_TOPGEN], 1u);
            else XB_SPIN(xb_ld(&bar[XB_TOPGEN]) == tg, bar);
            __builtin_amdgcn_fence(__ATOMIC_ACQUIRE, "agent");
            xb_add(&bar[XB_XGEN(b.x)], 1u);
            asm volatile("s_waitcnt vmcnt(0)" ::: "memory");
        } else {
            XB_SPIN(xb_ld(&bar[XB_XGEN(b.x)]) == gen, bar);
            __builtin_amdgcn_fence(__ATOMIC_ACQUIRE, "agent");
            asm volatile("s_waitcnt vmcnt(0)" ::: "memory");
        }
    }
    __syncthreads();
}

namespace pg8 {
constexpr int BM = 256, BK = 64, HALF = 128, HTB = HALF * BK * 2, STAGE_BYTES = 8 * HTB;
__host__ __device__ __forceinline__ int lds_byte(int r, int c) { const int st = (r >> 4) * 2 + (c >> 5), rr = r & 15, cc = c & 31, ob = rr * 64 + cc * 2; return st * 1024 + (ob ^ (((ob >> 9) & 1) << 5)); }
__host__ __device__ __forceinline__ void stage_rc(int b, int& R, int& C) { const int st = b / 1024, sb = b % 1024, swz = sb ^ (((sb >> 9) & 1) << 5); R = (st >> 1) * 16 + swz / 64; C = (st & 1) * 32 + (swz % 64) / 2; }
__host__ __device__ __forceinline__ int perm32(int rho) { const int n = rho >> 4, i = rho & 15; return 8 * (i >> 2) + 4 * n + (i & 3); }

struct Unit { int pm, pn, aux, nvalid; const char* A; const char* B; const int* rows; };

template <class Epi, class Sched, bool GATHER>
__device__ __forceinline__ void gemm_phase(LAS unsigned char* lds, const int tid, const int K, const int lda, const int ldb, const Sched& S, const Epi& E) {
    const int wid = __builtin_amdgcn_readfirstlane(tid >> 6), lane = tid & 63, wr = wid >> 2, wc = wid & 3, fr = lane & 15, fq = lane >> 4;
    const int nt = K / BK;
    int Rr[2], Cc[2];
    unsigned offB[2], offA[2], gAc[2][2], gAn[2][2];
#pragma unroll
    for (int i = 0; i < 2; ++i) { int R, C; stage_rc(tid * 16 + i * 8192, R, C); Rr[i] = R; Cc[i] = C; const int Rb = Epi::PERM ? ((R & ~31) + perm32(R & 31)) : R;
        offB[i] = (unsigned)(Rb * ldb + C) * 2u; offA[i] = (unsigned)(R * lda + C) * 2u;
#pragma unroll
        for (int h = 0; h < 2; ++h) { gAc[h][i] = offA[i]; gAn[h][i] = offA[i]; } }
    const size_t hstepA = (size_t)HALF * lda * 2, hstepB = (size_t)HALF * ldb * 2;
    const size_t kstep = (size_t)(BK * 2);
    const unsigned ldsw = (unsigned)wid * 1024u;
    const int aoff = lds_byte(wr * 64 + fr, fq * 8), boff = lds_byte(wc * 32 + fr, fq * 8);
#define PG8_SA(b, h) (((b) * 2 + (h)) * HTB)
#define PG8_SB(b, h) ((4 + (b) * 2 + (h)) * HTB)
#define PG8_STAGE(bufoff, gbase, voff) do { _Pragma("unroll") for (int _i = 0; _i < 2; ++_i) \
        __builtin_amdgcn_global_load_lds((const unsigned*)((const char*)(gbase) + (voff)[_i]), (LAS unsigned*)(lds + (bufoff) + ldsw + _i * 8192), 16, 0, 0); } while (0)
#define PG8_STAGEA(bufoff, gbase, h, G) do { if constexpr (GATHER) { PG8_STAGE(bufoff, gbase, G[h]); } else { PG8_STAGE(bufoff, (gbase) + (h) * hstepA, offA); } } while (0)
#define PG8_STAGEA2(bufoff, gbase, h) do { if constexpr (GATHER) { if (last) { PG8_STAGE(bufoff, gbase, gAn[h]); } else { PG8_STAGE(bufoff, gbase, gAc[h]); } } else { PG8_STAGE(bufoff, (gbase) + (h) * hstepA, offA); } } while (0)
#define PG8_LDA(dst, b, h) do { _Pragma("unroll") for (int m = 0; m < 4; ++m) _Pragma("unroll") for (int k = 0; k < 2; ++k) dst[m][k] = *(const LAS bf16x8*)(lds + PG8_SA(b, h) + aoff + m * 2048 + k * 1024); } while (0)
#define PG8_LDB(dst, b, h) do { _Pragma("unroll") for (int n = 0; n < 2; ++n) _Pragma("unroll") for (int k = 0; k < 2; ++k) dst[n][k] = *(const LAS bf16x8*)(lds + PG8_SB(b, h) + boff + n * 2048 + k * 1024); } while (0)
#define PG8_MMA(ai, bj, At, Bt) do { __builtin_amdgcn_s_setprio(1); _Pragma("unroll") for (int m = 0; m < 4; ++m) _Pragma("unroll") for (int n = 0; n < 2; ++n) _Pragma("unroll") for (int k = 0; k < 2; ++k) \
        acc[ai][bj][m][n] = __builtin_amdgcn_mfma_f32_16x16x32_bf16(Bt[n][k], At[m][k], acc[ai][bj][m][n], 0, 0, 0); __builtin_amdgcn_s_setprio(0); } while (0)
#define PG8_WAIT_V(n) asm volatile("s_waitcnt vmcnt(" #n ")" ::: "memory")
#define PG8_WAIT_L(n) asm volatile("s_waitcnt lgkmcnt(" #n ")" ::: "memory")
#define PG8_BAR __builtin_amdgcn_s_barrier()
#define PG8_SCHED __builtin_amdgcn_sched_barrier(0)
#define PG8_GATHER(U, OFF) do { _Pragma("unroll") for (int _h = 0; _h < 2; ++_h) _Pragma("unroll") for (int _i = 0; _i < 2; ++_i) { const int _r = _h * HALF + Rr[_i]; \
        const int _tok = (U).rows[_r < (U).nvalid ? _r : 0]; OFF[_h][_i] = (unsigned)(_tok * lda + Cc[_i]) * 2u; } } while (0)
    Unit cur, nxt; int ui = 0;
    if (!S.next(0, cur)) return;
    f32x4 acc[2][2][4][2];
#pragma unroll
    for (int a = 0; a < 2; ++a)
#pragma unroll
        for (int b = 0; b < 2; ++b)
#pragma unroll
            for (int m = 0; m < 4; ++m)
#pragma unroll
                for (int n = 0; n < 2; ++n) acc[a][b][m][n] = (f32x4){0.f, 0.f, 0.f, 0.f};
    bf16x8 At[4][2], B0[2][2], B1[2][2];
    const char* cA = cur.A; const char* cB = cur.B;
    if constexpr (GATHER) { PG8_GATHER(cur, gAc); }
    PG8_STAGE(PG8_SB(0, 0), cB, offB); PG8_STAGEA(PG8_SA(0, 0), cA, 0, gAc); PG8_STAGE(PG8_SB(0, 1), cB + hstepB, offB); PG8_STAGEA(PG8_SA(0, 1), cA, 1, gAc);
    if (wr == 1) PG8_BAR;
    PG8_WAIT_V(4); PG8_BAR;
    PG8_STAGE(PG8_SB(1, 0), cB + kstep, offB); PG8_STAGEA(PG8_SA(1, 0), cA + kstep, 0, gAc); PG8_STAGE(PG8_SB(1, 1), cB + kstep + hstepB, offB);
    PG8_WAIT_V(6); PG8_BAR;
    for (;;) {
        const bool has_next = S.next(ui + 1, nxt);
        const char* nA = has_next ? nxt.A : cA; const char* nB = has_next ? nxt.B : cB;
        for (int t = 0; t < nt; t += 2) {
            const bool last = (t == nt - 2);
            const char* a1 = cA + (size_t)(t + 1) * kstep;
            const char* a2 = last ? nA : cA + (size_t)(t + 2) * kstep; const char* b2 = last ? nB : cB + (size_t)(t + 2) * kstep;
            const char* a3 = a2 + kstep; const char* b3 = b2 + kstep;
            if constexpr (GATHER) { if (last && has_next) { PG8_GATHER(nxt, gAn); } }
            PG8_LDB(B0, 0, 0); PG8_SCHED; PG8_LDA(At, 0, 0); PG8_STAGEA(PG8_SA(1, 1), a1, 1, gAc);
            PG8_WAIT_L(8); PG8_BAR; PG8_WAIT_L(0); PG8_MMA(0, 0, At, B0); PG8_BAR; PG8_SCHED;
            PG8_LDB(B1, 0, 1); PG8_STAGE(PG8_SB(0, 0), b2, offB);
            PG8_BAR; PG8_WAIT_L(0); PG8_MMA(0, 1, At, B1); PG8_BAR;
            PG8_LDA(At, 0, 1); PG8_STAGEA2(PG8_SA(0, 0), a2, 0);
            PG8_BAR; PG8_WAIT_L(0); PG8_MMA(1, 0, At, B0); PG8_BAR; PG8_SCHED;
            PG8_STAGE(PG8_SB(0, 1), b2 + hstepB, offB);
            PG8_WAIT_V(6); PG8_BAR; PG8_MMA(1, 1, At, B1); PG8_BAR;
            PG8_LDB(B0, 1, 0); PG8_SCHED; PG8_LDA(At, 1, 0); PG8_STAGEA2(PG8_SA(0, 1), a2, 1);
            PG8_WAIT_L(8); PG8_BAR; PG8_WAIT_L(0); PG8_MMA(0, 0, At, B0); PG8_BAR; PG8_SCHED;
            PG8_LDB(B1, 1, 1); PG8_STAGE(PG8_SB(1, 0), b3, offB);
            PG8_BAR; PG8_WAIT_L(0); PG8_MMA(0, 1, At, B1); PG8_BAR;
            PG8_LDA(At, 1, 1); PG8_STAGEA2(PG8_SA(1, 0), a3, 0);
            PG8_BAR; PG8_WAIT_L(0); PG8_MMA(1, 0, At, B0); PG8_BAR; PG8_SCHED;
            PG8_STAGE(PG8_SB(1, 1), b3 + hstepB, offB);
            PG8_WAIT_V(6); PG8_BAR; PG8_MMA(1, 1, At, B1); PG8_BAR;
        }
        { int l2; asm volatile("v_mbcnt_lo_u32_b32 %0, -1, 0\n\tv_mbcnt_hi_u32_b32 %0, -1, %0" : "=v"(l2)); E(acc, cur, wr, wc, l2 & 15, l2 >> 4); }
        if (!has_next) break;
#pragma unroll
        for (int a = 0; a < 2; ++a)
#pragma unroll
            for (int b = 0; b < 2; ++b)
#pragma unroll
                for (int m = 0; m < 4; ++m)
#pragma unroll
                    for (int n = 0; n < 2; ++n) acc[a][b][m][n] = (f32x4){0.f, 0.f, 0.f, 0.f};
        cur = nxt; cA = nA; cB = nB; ++ui;
        if constexpr (GATHER) {
#pragma unroll
            for (int h = 0; h < 2; ++h) { gAc[h][0] = gAn[h][0]; gAc[h][1] = gAn[h][1]; } }
    }
    PG8_WAIT_V(0);
    if (wr == 0) PG8_BAR;
    PG8_BAR;
#undef PG8_SA
#undef PG8_SB
#undef PG8_STAGE
#undef PG8_LDA
#undef PG8_LDB
#undef PG8_MMA
#undef PG8_WAIT_V
#undef PG8_WAIT_L
#undef PG8_BAR
#undef PG8_SCHED
#undef PG8_GATHER
#undef PG8_STAGEA
#undef PG8_STAGEA2
}
}
namespace pg8 {
struct EpiBf16 {
    static constexpr bool PERM = true;
    bf16_t* O; int ldc; float scale;
    __device__ __forceinline__ void operator()(const f32x4 (&acc)[2][2][4][2], const Unit& u, int wr, int wc, int fr, int fq) const {
        const int row0 = u.pm * BM + wr * 64 + fr, col0 = u.pn * BM + wc * 32 + 8 * fq;
#pragma unroll
        for (int ai = 0; ai < 2; ++ai)
#pragma unroll
            for (int m = 0; m < 4; ++m) { bf16_t* rowp = O + (size_t)(row0 + ai * HALF + m * 16) * ldc + col0;
#pragma unroll
                for (int bj = 0; bj < 2; ++bj) { const f32x4 v0 = acc[ai][bj][m][0] * scale, v1 = acc[ai][bj][m][1] * scale;
                    u32x4 w; w.x = cvt_pk_bf16(v0[0], v0[1]); w.y = cvt_pk_bf16(v0[2], v0[3]); w.z = cvt_pk_bf16(v1[0], v1[1]); w.w = cvt_pk_bf16(v1[2], v1[3]);
                    *(u32x4*)(rowp + bj * HALF) = w; } }
    }
};
struct EpiF32 {
    static constexpr bool PERM = false;
    float* C; int ldc;
    __device__ __forceinline__ void operator()(const f32x4 (&acc)[2][2][4][2], const Unit& u, int wr, int wc, int fr, int fq) const {
        const int row0 = u.pm * BM + wr * 64 + fr, col0 = u.pn * BM + wc * 32 + 4 * fq;
#pragma unroll
        for (int ai = 0; ai < 2; ++ai)
#pragma unroll
            for (int m = 0; m < 4; ++m) { float* rowp = C + (size_t)(row0 + ai * HALF + m * 16) * ldc + col0;
#pragma unroll
                for (int bj = 0; bj < 2; ++bj)
#pragma unroll
                    for (int n = 0; n < 2; ++n) *(f32x4*)(rowp + bj * HALF + n * 16) = acc[ai][bj][m][n]; }
    }
};
struct EpiResid {
    static constexpr bool PERM = false;
    const float* X; float* Z; int ldc; float alpha;
    __device__ __forceinline__ void operator()(const f32x4 (&acc)[2][2][4][2], const Unit& u, int wr, int wc, int fr, int fq) const {
        const int row0 = u.pm * BM + wr * 64 + fr, col0 = u.pn * BM + wc * 32 + 4 * fq;
#pragma unroll
        for (int ai = 0; ai < 2; ++ai)
#pragma unroll
            for (int m = 0; m < 4; ++m) { const size_t off = (size_t)(row0 + ai * HALF + m * 16) * ldc + col0;
#pragma unroll
                for (int bj = 0; bj < 2; ++bj)
#pragma unroll
                    for (int n = 0; n < 2; ++n) { const f32x4 xv = *(const f32x4*)(X + off + bj * HALF + n * 16); *(f32x4*)(Z + off + bj * HALF + n * 16) = xv * alpha + acc[ai][bj][m][n]; }
                asm volatile("" ::: "memory"); }
    }
};
struct EpiQRope {
    static constexpr bool PERM = true;
    bf16_t* O; int ldc; const float* cosT; const float* sinT; float scale;
    __device__ __forceinline__ void operator()(const f32x4 (&acc)[2][2][4][2], const Unit& u, int wr, int wc, int fr, int fq) const {
        const int row0 = u.pm * BM + wr * 64 + fr, col0 = u.pn * BM + wc * 32 + 8 * fq;
#pragma unroll
        for (int ai = 0; ai < 2; ++ai)
#pragma unroll
            for (int m = 0; m < 4; ++m) { const unsigned row = (unsigned)(row0 + ai * HALF + m * 16);
#pragma unroll
                for (int bj = 0; bj < 2; ++bj) { f32x4 v0 = acc[ai][bj][m][0] * scale, v1 = acc[ai][bj][m][1] * scale;
                    const int col = col0 + bj * HALF, rr = col % AQD;
                    if (rr >= ANOPE) { const unsigned tb = (row * 32u + (unsigned)((rr - ANOPE) >> 1)) * 4u;
                        const f32x4 c = *(const f32x4*)((const char*)cosT + tb), s = *(const f32x4*)((const char*)sinT + tb);
                        const f32x4 a0 = v0, a1 = v1;
                        v0[0] = a0[0] * c[0] - a0[1] * s[0]; v0[1] = a0[1] * c[0] + a0[0] * s[0]; v0[2] = a0[2] * c[1] - a0[3] * s[1]; v0[3] = a0[3] * c[1] + a0[2] * s[1];
                        v1[0] = a1[0] * c[2] - a1[1] * s[2]; v1[1] = a1[1] * c[2] + a1[0] * s[2]; v1[2] = a1[2] * c[3] - a1[3] * s[3]; v1[3] = a1[3] * c[3] + a1[2] * s[3]; }
                    u32x4 w; w.x = cvt_pk_bf16(v0[0], v0[1]); w.y = cvt_pk_bf16(v0[2], v0[3]); w.z = cvt_pk_bf16(v1[0], v1[1]); w.w = cvt_pk_bf16(v1[2], v1[3]);
                    *(u32x4*)((char*)O + ((size_t)row * (unsigned)ldc + (unsigned)col) * 2u) = w; }
                asm volatile("" ::: "memory"); }
    }
};
struct EpiSwiglu {
    static constexpr bool PERM = true;
    bf16_t* Hh; const float* bgu;
    __device__ __forceinline__ void operator()(const f32x4 (&acc)[2][2][4][2], const Unit& u, int wr, int wc, int fr, int fq) const {
        const int row0 = u.pm * BM + wr * 64 + fr, j0 = u.pn * HALF + wc * 32 + 8 * fq;
        const float* bp = bgu + (size_t)u.aux * 2048 + 2 * j0;
        const f32x4 b0 = *(const f32x4*)(bp), b1 = *(const f32x4*)(bp + 4), b2 = *(const f32x4*)(bp + 8), b3 = *(const f32x4*)(bp + 12);
        const float bg[8] = {b0[0], b0[2], b1[0], b1[2], b2[0], b2[2], b3[0], b3[2]}, bl[8] = {b0[1], b0[3], b1[1], b1[3], b2[1], b2[3], b3[1], b3[3]};
#pragma unroll
        for (int ai = 0; ai < 2; ++ai)
#pragma unroll
            for (int m = 0; m < 4; ++m) { bf16_t* rowp = Hh + (size_t)(row0 + ai * HALF + m * 16) * DFF + j0;
                float o[8];
#pragma unroll
                for (int q = 0; q < 8; ++q) { float g = acc[ai][0][m][q >> 2][q & 3] + bg[q], l = acc[ai][1][m][q >> 2][q & 3] + bl[q];
                    g = fminf(g, 7.0f); l = fminf(fmaxf(l, -7.0f), 7.0f);
                    const float sg = __builtin_amdgcn_rcpf(1.0f + __builtin_amdgcn_exp2f(-1.702f * 1.4426950408889634f * g));
                    o[q] = (l + 1.0f) * g * sg; }
                u32x4 w; w.x = cvt_pk_bf16(o[0], o[1]); w.y = cvt_pk_bf16(o[2], o[3]); w.z = cvt_pk_bf16(o[4], o[5]); w.w = cvt_pk_bf16(o[6], o[7]);
                *(u32x4*)rowp = w; }
    }
};
struct EpiDown {
    static constexpr bool PERM = true;
    bf16_t* Y; const float* bd;
    __device__ __forceinline__ void operator()(const f32x4 (&acc)[2][2][4][2], const Unit& u, int wr, int wc, int fr, int fq) const {
        const int row0 = u.pm * BM + wr * 64 + fr, col0 = u.pn * BM + wc * 32 + 8 * fq;
        f32x4 bv[2][2];
#pragma unroll
        for (int bj = 0; bj < 2; ++bj)
#pragma unroll
            for (int n = 0; n < 2; ++n) bv[bj][n] = *(const f32x4*)(bd + (size_t)u.aux * D + col0 + bj * HALF + 4 * n);
#pragma unroll
        for (int ai = 0; ai < 2; ++ai)
#pragma unroll
            for (int m = 0; m < 4; ++m) { bf16_t* rowp = Y + (size_t)(row0 + ai * HALF + m * 16) * D + col0;
#pragma unroll
                for (int bj = 0; bj < 2; ++bj) { const f32x4 v0 = acc[ai][bj][m][0] + bv[bj][0], v1 = acc[ai][bj][m][1] + bv[bj][1];
                    u32x4 w; w.x = cvt_pk_bf16(v0[0], v0[1]); w.y = cvt_pk_bf16(v0[2], v0[3]); w.z = cvt_pk_bf16(v1[0], v1[1]); w.w = cvt_pk_bf16(v1[2], v1[3]);
                    *(u32x4*)(rowp + bj * HALF) = w; } }
    }
};

struct DenseOrder {
    const char* A; const char* Bt; int nM, nN, G, c; size_t astep, bstep;
    __device__ __forceinline__ void init(const void* A_, const void* Bt_, int M, int N, int lda, int ldb, int G_, int c_) { A = (const char*)A_; Bt = (const char*)Bt_; nM = M / BM; nN = N / BM; G = G_; c = c_; astep = (size_t)BM * lda * 2; bstep = (size_t)BM * ldb * 2; }
    __device__ __forceinline__ bool next(int i, Unit& u) const {
        const int L = i * G + c; if (L >= nM * nN) return false;
        u.pm = L / nN; u.pn = L - u.pm * nN; u.aux = 0; u.nvalid = 256; u.A = A + (size_t)u.pm * astep; u.B = Bt + (size_t)u.pn * bstep; u.rows = nullptr; return true;
    }
};
struct MoeOrder {
    const volatile LAS int* ntp; const char* A; const char* W; const int* list; const unsigned* cnt; int NC, G, c; size_t wstep_e, astep;
    bool gather;
    __device__ __forceinline__ bool next(int i, Unit& u) const {
        const int L = i * G + c; const int NT = ntp[32]; if (L >= NT * NC) return false;
        const int rt = L / NC, pn = L - rt * NC; int e = 0;
        for (int k = 1; k < 32; ++k) e += (rt >= ntp[k]) ? 1 : 0;
        e = __builtin_amdgcn_readfirstlane(e);
        const int rtl = rt - ntp[e];
        u.pm = rt; u.pn = pn; u.aux = e; u.B = W + (size_t)e * wstep_e + (size_t)pn * astep;
        const int c_e = (int)__hip_atomic_load(cnt + e * 64, __ATOMIC_RELAXED, __HIP_MEMORY_SCOPE_AGENT);
        int nv = c_e - rtl * 256; u.nvalid = __builtin_amdgcn_readfirstlane(nv > 256 ? 256 : nv);
        if (gather) { u.A = A; u.rows = list + (size_t)e * T + (size_t)rtl * 256; } else { u.A = A + (size_t)rt * (size_t)(256 * D * 2); u.rows = nullptr; }
        return true;
    }
};
}
struct Args { const void* in[20]; float* out; unsigned char* ws; int ph_lo, ph_hi; };
struct Frame {
    LAS unsigned char* lds; volatile LAS unsigned* MISC;
    int tid, lane, wave, vcu, G;
    __device__ __forceinline__ const void* ptr(int i) const { const unsigned lo = __builtin_amdgcn_readfirstlane(MISC[128 + 2 * i]), hi = __builtin_amdgcn_readfirstlane(MISC[129 + 2 * i]); return (const void*)(((unsigned long long)hi << 32) | lo); }
    __device__ __forceinline__ unsigned char* ws() const { return (unsigned char*)ptr(21); }
    __device__ __forceinline__ float* out() const { return (float*)ptr(20); }
    __device__ __forceinline__ unsigned* ctl() const { return (unsigned*)ptr(21); }
};
__device__ __forceinline__ Frame refresh(const Frame& F) {
    Frame R = F; int ln, w = F.wave, v = F.vcu, g = F.G;
    asm volatile("v_mbcnt_lo_u32_b32 %0, -1, 0\n\tv_mbcnt_hi_u32_b32 %0, -1, %0" : "=v"(ln));
    asm volatile("" : "+s"(w), "+s"(v), "+s"(g));
    R.tid = w * 64 + ln; R.lane = ln; R.wave = w; R.vcu = v; R.G = g; return R;
}
enum { IN_X = 0, IN_POS, IN_LNG, IN_LNB, IN_MWIN, IN_MBG, IN_MNG, IN_MWOUT, IN_AWIN, IN_AQN, IN_AKVN, IN_AWQB, IN_AWKVB, IN_AWOUT, IN_RW, IN_RB, IN_WGU, IN_BGU, IN_WD, IN_BD };

template <class RowMap>
__device__ __forceinline__ void transpose_item(const float* __restrict__ W, int ldw, int K, bf16_t* __restrict__ WT, LAS float* scr, int kb, int nb, int lane, RowMap rm) {
    const int k0 = 64 * kb, n0 = 32 * nb;
#pragma unroll 8
    for (int i = 0; i < 32; ++i) { const int kk = 2 * i + (lane >> 5); scr[kk * 33 + (lane & 31)] = W[(size_t)(k0 + kk) * ldw + n0 + (lane & 31)]; }
    LDS_WAIT();
    const int c = lane & 7;
#pragma unroll
    for (int j = 0; j < 4; ++j) { const int n = (lane >> 3) + 8 * j; const LAS float* s = scr + (8 * c) * 33 + n;
        u32x4 o; o.x = cvt_pk_bf16(s[0 * 33], s[1 * 33]); o.y = cvt_pk_bf16(s[2 * 33], s[3 * 33]); o.z = cvt_pk_bf16(s[4 * 33], s[5 * 33]); o.w = cvt_pk_bf16(s[6 * 33], s[7 * 33]);
        const int dr = rm(n0 + n);
        *(u32x4*)(WT + (size_t)dr * K + k0 + 8 * c) = o; }
    LDS_WAIT();
}
struct RmId { __device__ __forceinline__ int operator()(int n) const { return n; } };
struct RmQb { __device__ __forceinline__ int operator()(int n) const { const int hh = n / AQD, r = n - hh * AQD; if (r < ANOPE) return n; const int i = r - ANOPE; return hh * AQD + ANOPE + ((i < 32) ? 2 * i : 2 * (i - 32) + 1); } };
struct RmKv { __device__ __forceinline__ int operator()(int n) const { const int hh = n >> 8, r = n & 255; return (r < 128) ? hh * 128 + r : 1024 + hh * 128 + (r - 128); } };
struct RmGu { __device__ __forceinline__ int operator()(int n) const { const int j = n >> 1, l = n & 1; return (j >> 7) * 256 + l * 128 + (j & 127); } };

__device__ __forceinline__ void p0_prologue(const Frame& F) {
    LAS float* scr = (LAS float*)(F.lds + F.wave * 8704);
    const int gw = F.vcu * NWAVES + F.wave, NGW = F.G * NWAVES, lane = F.lane;
    unsigned char* ws = F.ws();
    constexpr int I_MWIN = 16 * 96, I_SQ = 16 * 32, I_AWIN = 16 * 22, I_QB = 6 * 48, I_KV = 4 * 64, I_GU = 16 * 64, I_D = 16 * 32;
    constexpr int N_SMALL = 2 * (I_MWIN + I_SQ + I_AWIN + I_QB + I_KV + I_SQ);
    constexpr int N_GU = 128 * I_GU, N_D = 128 * I_D, NITEMS = N_SMALL + N_GU + N_D;
    for (int it = gw; it < NITEMS; it += NGW) {
        int r = it;
        if (r >= N_SMALL) {
            r -= N_SMALL;
            if (r < N_GU) { const int mtx = r >> 10, q = r & 1023; transpose_item((const float*)F.ptr(IN_WGU) + (size_t)mtx * 1024 * 2048, 2048, 1024, (bf16_t*)(ws + WS_WGU) + (size_t)mtx * 2048 * 1024, scr, q >> 6, q & 63, lane, RmGu()); }
            else { r -= N_GU; const int mtx = r >> 9, q = r & 511; transpose_item((const float*)F.ptr(IN_WD) + (size_t)mtx * 1024 * 1024, 1024, 1024, (bf16_t*)(ws + WS_WD) + (size_t)mtx * 1024 * 1024, scr, q >> 5, q & 31, lane, RmId()); }
            continue;
        }
        const int j = (r >= N_SMALL / 2) ? 1 : 0; r -= j * (N_SMALL / 2);
        if (r < I_MWIN) { transpose_item((const float*)F.ptr(IN_MWIN) + (size_t)j * 1024 * MIN_, MIN_, 1024, (bf16_t*)(ws + WS_WINM) + (size_t)j * 3072 * 1024, scr, r / 96, r % 96, lane, RmId()); continue; } r -= I_MWIN;
        if (r < I_SQ) { transpose_item((const float*)F.ptr(IN_MWOUT) + (size_t)j * 1024 * 1024, 1024, 1024, (bf16_t*)(ws + WS_WOUTM) + (size_t)j * 1024 * 1024, scr, r >> 5, r & 31, lane, RmId()); continue; } r -= I_SQ;
        if (r < I_AWIN) { transpose_item((const float*)F.ptr(IN_AWIN) + (size_t)j * 1024 * AIN, AIN, 1024, (bf16_t*)(ws + WS_WINA) + (size_t)j * AINP * 1024, scr, r / 22, r % 22, lane, RmId()); continue; } r -= I_AWIN;
        if (r < I_QB) { transpose_item((const float*)F.ptr(IN_AWQB) + (size_t)j * AQL * 1536, 1536, AQL, (bf16_t*)(ws + WS_WQB) + (size_t)j * 1536 * AQL, scr, r / 48, r % 48, lane, RmQb()); continue; } r -= I_QB;
        if (r < I_KV) { transpose_item((const float*)F.ptr(IN_AWKVB) + (size_t)j * AKL * 2048, 2048, AKL, (bf16_t*)(ws + WS_WKV) + (size_t)j * 2048 * AKL, scr, r >> 6, r & 63, lane, RmKv()); continue; } r -= I_KV;
        transpose_item((const float*)F.ptr(IN_AWOUT) + (size_t)j * 1024 * 1024, 1024, 1024, (bf16_t*)(ws + WS_WOUTA) + (size_t)j * 1024 * 1024, scr, r >> 5, r & 31, lane, RmId());
    }
    { const int gt = F.vcu * NTHR + F.tid, NGT = F.G * NTHR;
      for (int i = gt; i < 2 * 64 * 1024 / 8; i += NGT) { const int j = i / (64 * 1024 / 8), q = i - j * (64 * 1024 / 8);
          *(u32x4*)((bf16_t*)(ws + WS_WINA) + (size_t)j * AINP * 1024 + (size_t)AIN * 1024 + (size_t)q * 8) = (u32x4){0u, 0u, 0u, 0u}; }
      const float* x = (const float*)F.ptr(IN_X); bf16_t* xb = (bf16_t*)(ws + WS_XB);
      for (size_t i = gt; i < (size_t)T * D / 8; i += NGT) { const f32x4 v0 = *(const f32x4*)(x + i * 8), v1 = *(const f32x4*)(x + i * 8 + 4);
          u32x4 w; w.x = cvt_pk_bf16(v0[0], v0[1]); w.y = cvt_pk_bf16(v0[2], v0[3]); w.z = cvt_pk_bf16(v1[0], v1[1]); w.w = cvt_pk_bf16(v1[2], v1[3]); *(u32x4*)(xb + i * 8) = w; }
      const int* pos = (const int*)F.ptr(IN_POS); float* ct = (float*)(ws + WS_COS); float* st = (float*)(ws + WS_SIN);
      for (int i = gt; i < T * 32; i += NGT) { const int m = i >> 5, k = i & 31;
          const float inv = exp2f(-(float)(2 * k) * (13.287712379549449f / 64.0f));
          const float ang = (float)pos[m] * inv;
          const double rev = (double)ang * 0.15915494309189535; const float fr = (float)(rev - floor(rev));
          ct[i] = __builtin_amdgcn_cosf(fr); st[i] = __builtin_amdgcn_sinf(fr); }
    }
}

template <int NEX>
__device__ __forceinline__ void skinny_fill(const Frame& F, const float* __restrict__ W, int ldw) {
    LAS float* wl = (LAS float*)F.lds;
    for (int idx = F.tid; idx < 1024 * NEX; idx += NTHR) { const int k = idx / NEX, e = idx % NEX; wl[((k >> 2) * NEX + e) * 4 + (k & 3)] = W[(size_t)k * ldw + e]; }
    __syncthreads();
}
__device__ __forceinline__ void gates_phase(const Frame& F, const float* __restrict__ X, const float* __restrict__ bg, float* __restrict__ Gt) {
    const LAS f32x4* wl = (const LAS f32x4*)F.lds;
    const int tok = F.lane & 15, kq = F.lane >> 4;
    const f32x4 bias = *(const f32x4*)(bg + 4 * kq);
    for (int grp = F.vcu * NWAVES + F.wave; grp < T / 16; grp += F.G * NWAVES) {
        const int m0 = grp * 16; const float* xr = X + (size_t)(m0 + tok) * D + 4 * kq;
        f32x4 acc0 = {0.f, 0.f, 0.f, 0.f}, acc1 = {0.f, 0.f, 0.f, 0.f};
#pragma unroll 4
        for (int i = 0; i < 64; i += 2) {
            const f32x4 x0 = *(const f32x4*)(xr + 16 * i), x1 = *(const f32x4*)(xr + 16 * (i + 1));
            const f32x4 w0 = wl[(i * 4 + kq) * 16 + tok], w1 = wl[((i + 1) * 4 + kq) * 16 + tok];
#pragma unroll
            for (int j = 0; j < 4; ++j) { acc0 = __builtin_amdgcn_mfma_f32_16x16x4f32(w0[j], x0[j], acc0, 0, 0, 0); acc1 = __builtin_amdgcn_mfma_f32_16x16x4f32(w1[j], x1[j], acc1, 0, 0, 0); }
        }
        *(f32x4*)(Gt + (size_t)(m0 + tok) * 16 + 4 * kq) = acc0 + acc1 + bias;
    }
}

template <int MODE>
__device__ __forceinline__ void ln_phase(const Frame& F, int layer, bool is_last) {
    unsigned char* ws = F.ws();
    const float* ZF = (const float*)(ws + WS_ZF); float* XF = (float*)(ws + WS_XF); bf16_t* XB = (bf16_t*)(ws + WS_XB);
    const float* lng = (const float*)F.ptr(IN_LNG) + (size_t)(layer * 2 + MODE) * D; const float* lnb = (const float*)F.ptr(IN_LNB) + (size_t)(layer * 2 + MODE) * D;
    const int lane = F.lane, tok = lane & 15, kq = lane >> 4;
    unsigned* cnt = F.ctl() + CW_CNT + layer * 32 * 64;
    const int* tokinfo = (const int*)(ws + WS_TOKINFO); const float* tokgate = (const float*)(ws + WS_TOKGATE);
    volatile LAS int* ntp = (volatile LAS int*)(F.MISC + 16); volatile LAS unsigned* hist = F.MISC + 64; volatile LAS unsigned* hbase = F.MISC + 96;
    if (MODE == 0) { skinny_fill<32>(F, (const float*)F.ptr(IN_RW) + (size_t)layer * D * NE, NE); if (F.tid < 32) hist[F.tid] = 0u; __syncthreads(); }
    f32x4 gv[4], bv[4];
#pragma unroll
    for (int j = 0; j < 4; ++j) { gv[j] = *(const f32x4*)(lng + 4 * lane + 256 * j); bv[j] = *(const f32x4*)(lnb + 4 * lane + 256 * j); }
    float* OUT = is_last ? F.out() : XF;
    for (int grp = F.vcu; grp < T / 128; grp += F.G) {
        const int m0 = grp * 128 + F.wave * 16;
        float mu_l = 0.f, rs_l = 0.f;
        for (int r = 0; r < 16; ++r) {
            const int m = m0 + r; f32x4 v[4];
            if (MODE == 0) {
#pragma unroll
                for (int j = 0; j < 4; ++j) v[j] = *(const f32x4*)(ZF + (size_t)m * D + 4 * lane + 256 * j);
            } else {
#pragma unroll
                for (int j = 0; j < 4; ++j) v[j] = *(const f32x4*)(XF + (size_t)m * D + 4 * lane + 256 * j) * DN_ALPHA;
#pragma unroll
                for (int k = 0; k < 4; ++k) { const int inf = __builtin_amdgcn_readfirstlane(tokinfo[m * 4 + k]); const float g = __uint_as_float(__builtin_amdgcn_readfirstlane(__float_as_uint(tokgate[m * 4 + k])));
                    const int e = inf >> 20, pos = inf & 0xfffff; const size_t prow = (size_t)ntp[e] * 256 + pos; const bf16_t* yr = (const bf16_t*)(ws + WS_YMOE) + prow * D + 4 * lane;
#pragma unroll
                    for (int j = 0; j < 4; ++j) { const u32x2 w = *(const u32x2*)(yr + 256 * j); v[j][0] += g * bf_lo(w.x); v[j][1] += g * bf_hi(w.x); v[j][2] += g * bf_lo(w.y); v[j][3] += g * bf_hi(w.y); } }
            }
            float s = 0.f;
#pragma unroll
            for (int j = 0; j < 4; ++j) s += (v[j][0] + v[j][1]) + (v[j][2] + v[j][3]);
            const float mean = wave_sum(s) * (1.f / D); float s2 = 0.f;
#pragma unroll
            for (int j = 0; j < 4; ++j) { v[j] = v[j] - mean; s2 += (v[j][0] * v[j][0] + v[j][1] * v[j][1]) + (v[j][2] * v[j][2] + v[j][3] * v[j][3]); }
            const float rstd = 1.f / sqrtf(wave_sum(s2) * (1.f / D) + LN_EPS);
            if (tok == r) { mu_l = mean; rs_l = rstd; }
#pragma unroll
            for (int j = 0; j < 4; ++j) { const f32x4 y = v[j] * rstd * gv[j] + bv[j]; *(f32x4*)(OUT + (size_t)m * D + 4 * lane + 256 * j) = y;
                u32x2 w; w.x = cvt_pk_bf16(y[0], y[1]); w.y = cvt_pk_bf16(y[2], y[3]); *(u32x2*)(XB + (size_t)m * D + 4 * lane + 256 * j) = w; }
        }
        if (MODE == 0) {
            const LAS f32x4* wl = (const LAS f32x4*)F.lds;
            const float* zr = ZF + (size_t)(m0 + tok) * D + 4 * kq;
            f32x4 acc0 = {0.f, 0.f, 0.f, 0.f}, acc1 = {0.f, 0.f, 0.f, 0.f};
#pragma unroll 2
            for (int i = 0; i < 64; ++i) {
                const f32x4 z = *(const f32x4*)(zr + 16 * i), g4 = *(const f32x4*)(lng + 16 * i + 4 * kq), b4 = *(const f32x4*)(lnb + 16 * i + 4 * kq);
                const f32x4 xn = (z - mu_l) * rs_l * g4 + b4;
                const f32x4 w0 = wl[(i * 4 + kq) * 32 + tok], w1 = wl[(i * 4 + kq) * 32 + 16 + tok];
#pragma unroll
                for (int j = 0; j < 4; ++j) { acc0 = __builtin_amdgcn_mfma_f32_16x16x4f32(w0[j], xn[j], acc0, 0, 0, 0); acc1 = __builtin_amdgcn_mfma_f32_16x16x4f32(w1[j], xn[j], acc1, 0, 0, 0); }
            }
            const float* rb = (const float*)F.ptr(IN_RB) + layer * NE;
            float lv[8]; int used = 0;
#pragma unroll
            for (int r = 0; r < 4; ++r) { lv[r] = acc0[r] + rb[4 * kq + r]; lv[4 + r] = acc1[r] + rb[16 + 4 * kq + r]; }
            float tv[4]; int ti[4];
#pragma unroll
            for (int k = 0; k < 4; ++k) {
                float bvv = -3.0e38f; int bi = 64, bslot = -1;
#pragma unroll
                for (int q = 0; q < 8; ++q) { const int idx = (q < 4) ? 4 * kq + q : 16 + 4 * kq + (q - 4); const bool ok = !((used >> q) & 1) && (lv[q] > bvv || (lv[q] == bvv && idx < bi)); if (ok) { bvv = lv[q]; bi = idx; bslot = q; } }
                float gvv = bvv; int gi = bi;
#pragma unroll
                for (int o = 16; o <= 32; o <<= 1) { const float ov = __shfl_xor(gvv, o); const int oi = __shfl_xor(gi, o); if (ov > gvv || (ov == gvv && oi < gi)) { gvv = ov; gi = oi; } }
                if (gi == bi && bslot >= 0) used |= (1 << bslot);
                tv[k] = gvv; ti[k] = gi;
            }
            const float e1 = __expf(tv[1] - tv[0]), e2 = __expf(tv[2] - tv[0]), e3 = __expf(tv[3] - tv[0]); const float inv = 1.f / (1.f + e1 + e2 + e3);
            const float myg = (kq == 0 ? 1.f : kq == 1 ? e1 : kq == 2 ? e2 : e3) * inv; const int mye = (kq == 0 ? ti[0] : kq == 1 ? ti[1] : kq == 2 ? ti[2] : ti[3]);
            const unsigned rank = __hip_atomic_fetch_add((LAS unsigned*)(hist + mye), 1u, __ATOMIC_RELAXED, __HIP_MEMORY_SCOPE_WORKGROUP);
            __syncthreads();
            if (F.tid < 32) { const unsigned c = hist[F.tid]; hbase[F.tid] = __hip_atomic_fetch_add(cnt + F.tid * 64, c, __ATOMIC_RELAXED, __HIP_MEMORY_SCOPE_AGENT); hist[F.tid] = 0u; }
            __syncthreads();
            const unsigned pos = hbase[mye] + rank; const int m = m0 + tok;
            ((int*)(ws + WS_TOKINFO))[m * 4 + kq] = (mye << 20) | (int)pos; ((float*)(ws + WS_TOKGATE))[m * 4 + kq] = myg;
            ((int*)(ws + WS_LIST))[(size_t)mye * T + pos] = m;
        }
    }
}

__device__ __forceinline__ void moe_prefix(const Frame& F, int layer) {
    volatile LAS int* ntp = (volatile LAS int*)(F.MISC + 16);
    __syncthreads();
    if (F.tid == 0) { unsigned* cnt = F.ctl() + CW_CNT + layer * 32 * 64; int acc = 0;
        for (int e = 0; e < 32; ++e) { ntp[e] = acc; acc += ((int)__hip_atomic_load(cnt + e * 64, __ATOMIC_RELAXED, __HIP_MEMORY_SCOPE_AGENT) + 255) >> 8; } ntp[32] = acc; }
    __syncthreads();
}

__device__ __forceinline__ void mla_norm_phase(const Frame& F, int j) {
    unsigned char* ws = F.ws(); const float* A32 = (const float*)(ws + WS_A32);
    bf16_t* CQ = (bf16_t*)(ws + WS_CQ); bf16_t* CKV = (bf16_t*)(ws + WS_CKV); bf16_t* KR = (bf16_t*)(ws + WS_KR);
    const float* qn = (const float*)F.ptr(IN_AQN) + j * AQL; const float* kvn = (const float*)F.ptr(IN_AKVN) + j * AKL;
    const float* ct = (const float*)(ws + WS_COS); const float* st = (const float*)(ws + WS_SIN);
    const int lane = F.lane;
    for (int m = F.vcu * NWAVES + F.wave; m < T; m += F.G * NWAVES) {
        const float* ar = A32 + (size_t)m * AINP;
        f32x4 q0 = {0.f, 0.f, 0.f, 0.f}, q1 = q0, k0 = q0, k1 = q0; float sq = 0.f, sk = 0.f;
        if (lane < 48) { q0 = *(const f32x4*)(ar + 8 * lane); q1 = *(const f32x4*)(ar + 8 * lane + 4); sq = (q0[0] * q0[0] + q0[1] * q0[1]) + (q0[2] * q0[2] + q0[3] * q0[3]) + (q1[0] * q1[0] + q1[1] * q1[1]) + (q1[2] * q1[2] + q1[3] * q1[3]); }
        if (lane < 32) { k0 = *(const f32x4*)(ar + AQL + 8 * lane); k1 = *(const f32x4*)(ar + AQL + 8 * lane + 4); sk = (k0[0] * k0[0] + k0[1] * k0[1]) + (k0[2] * k0[2] + k0[3] * k0[3]) + (k1[0] * k1[0] + k1[1] * k1[1]) + (k1[2] * k1[2] + k1[3] * k1[3]); }
        const float rq = 1.f / sqrtf(wave_sum(sq) * (1.f / AQL) + RMS_EPS), rk = 1.f / sqrtf(wave_sum(sk) * (1.f / AKL) + RMS_EPS);
        if (lane < 48) { const f32x4 g0 = *(const f32x4*)(qn + 8 * lane), g1 = *(const f32x4*)(qn + 8 * lane + 4); const f32x4 y0 = q0 * rq * g0, y1 = q1 * rq * g1;
            u32x4 w; w.x = cvt_pk_bf16(y0[0], y0[1]); w.y = cvt_pk_bf16(y0[2], y0[3]); w.z = cvt_pk_bf16(y1[0], y1[1]); w.w = cvt_pk_bf16(y1[2], y1[3]); *(u32x4*)(CQ + (size_t)m * AQL + 8 * lane) = w; }
        if (lane < 32) { const f32x4 g0 = *(const f32x4*)(kvn + 8 * lane), g1 = *(const f32x4*)(kvn + 8 * lane + 4); const f32x4 y0 = k0 * rk * g0, y1 = k1 * rk * g1;
            u32x4 w; w.x = cvt_pk_bf16(y0[0], y0[1]); w.y = cvt_pk_bf16(y0[2], y0[3]); w.z = cvt_pk_bf16(y1[0], y1[1]); w.w = cvt_pk_bf16(y1[2], y1[3]); *(u32x4*)(CKV + (size_t)m * AKL + 8 * lane) = w;
            const float x1 = ar[AQL + AKL + lane], x2 = ar[AQL + AKL + 32 + lane], c = ct[(size_t)m * 32 + lane], s = st[(size_t)m * 32 + lane];
            *(unsigned*)(KR + (size_t)m * AROPE + 2 * lane) = cvt_pk_bf16(x1 * c - x2 * s, x2 * c + x1 * s); }
    }
}
constexpr int MT_STRIDE = 144;
__device__ __forceinline__ float log_sigmoid(float x) { return fminf(x, 0.f) - __logf(1.f + __expf(-fabsf(x))); }
__device__ __forceinline__ float wave_incl_scan_add(float v, int lane) {
#pragma unroll
    for (int o = 1; o < 64; o <<= 1) { const float t = __shfl_up(v, o); if (lane >= o) v += t; }
    return v;
}
__device__ __forceinline__ float wave_incl_scan_max(float v, int lane) {
#pragma unroll
    for (int o = 1; o < 64; o <<= 1) { const float t = __shfl_up(v, o); if (lane >= o) v = fmaxf(v, t); }
    return v;
}
template <int NCH>
__device__ __forceinline__ void stage_transposed(LAS unsigned char* tile, const bf16_t* __restrict__ src, int lane, float scale, bool do_scale) {
#pragma unroll
    for (int c = 0; c < NCH; ++c) { const u32x4 w = *(const u32x4*)(src + 8 * c); const unsigned ww[4] = {w.x, w.y, w.z, w.w};
#pragma unroll
        for (int p = 0; p < 4; ++p) { unsigned lo = ww[p] & 0xffffu, hi = ww[p] >> 16;
            if (do_scale) { const unsigned pk = cvt_pk_bf16(bf_lo(ww[p]) * scale, bf_hi(ww[p]) * scale); lo = pk & 0xffffu; hi = pk >> 16; }
            *(LAS bf16_t*)(tile + (8 * c + 2 * p) * MT_STRIDE + 2 * lane) = (bf16_t)lo; *(LAS bf16_t*)(tile + (8 * c + 2 * p + 1) * MT_STRIDE + 2 * lane) = (bf16_t)hi; } }
}

__device__ __forceinline__ void mlstm_local_phase(const Frame& F) {
    unsigned char* ws = F.ws(); const bf16_t* PROJ = (const bf16_t*)(ws + WS_PROJ); const float* Gt = (const float*)(ws + WS_GATES);
    float* CLOC = (float*)(ws + WS_CLOC); float* NLOC = (float*)(ws + WS_NLOC); float* GMAX = (float*)(ws + WS_MSC); float* BL = GMAX + MUNITS;
    const int lane = F.lane, c32 = lane & 31, hi = lane >> 5;
    LAS unsigned char* kt = F.lds + F.wave * (2 * 64 * MT_STRIDE); LAS unsigned char* vt = kt + 64 * MT_STRIDE;
    for (int it = F.vcu * NWAVES + F.wave; it < MUNITS * 2; it += F.G * NWAVES) {
        const int u = it >> 1, half = it & 1, c = u & (MNC - 1), bh = u >> 7, h = bh & 7, b = bh >> 3, m0 = b * SEQ + c * MCH;
        const int m = m0 + lane;
        const float ig = Gt[(size_t)m * 16 + h], lf = log_sigmoid(Gt[(size_t)m * 16 + 8 + h]);
        const float bc = wave_incl_scan_add(lf, lane), bl = __shfl(bc, 63);
        const float g = bl - bc + ig, gmax = wave_max(g), w = __expf(g - gmax);
        stage_transposed<8>(kt, PROJ + (size_t)m * 3072 + 512 + h * 64, lane, w, true);
        stage_transposed<8>(vt, PROJ + (size_t)m * 3072 + 1024 + h * 128 + half * 64, lane, 1.f, false);
        LDS_WAIT();
        f32x16 acc[2][2];
#pragma unroll
        for (int i = 0; i < 2; ++i)
#pragma unroll
            for (int j = 0; j < 2; ++j)
#pragma unroll
                for (int r = 0; r < 16; ++r) acc[i][j][r] = 0.f;
#pragma unroll
        for (int ks = 0; ks < 4; ++ks) {
            bf16x8 af[2], bfr[2];
#pragma unroll
            for (int i = 0; i < 2; ++i) { af[i] = *(const LAS bf16x8*)(vt + (32 * i + c32) * MT_STRIDE + (16 * ks + 8 * hi) * 2); bfr[i] = *(const LAS bf16x8*)(kt + (32 * i + c32) * MT_STRIDE + (16 * ks + 8 * hi) * 2); }
#pragma unroll
            for (int i = 0; i < 2; ++i)
#pragma unroll
                for (int j = 0; j < 2; ++j) acc[i][j] = __builtin_amdgcn_mfma_f32_32x32x16_bf16(af[i], bfr[j], acc[i][j], 0, 0, 0);
        }
        float* cl = CLOC + (size_t)u * (MDV * MDK);
#pragma unroll
        for (int i = 0; i < 2; ++i)
#pragma unroll
            for (int j = 0; j < 2; ++j)
#pragma unroll
                for (int r = 0; r < 16; ++r) { const int dv = half * 64 + 32 * i + (r & 3) + 8 * (r >> 2) + 4 * hi; cl[dv * MDK + 32 * j + c32] = acc[i][j][r]; }
        if (half == 0) {
            float s = 0.f;
#pragma unroll
            for (int q = 0; q < 8; ++q) { const u32x4 w4 = *(const LAS u32x4*)(kt + lane * MT_STRIDE + 16 * q); s += (bf_lo(w4.x) + bf_hi(w4.x)) + (bf_lo(w4.y) + bf_hi(w4.y)) + (bf_lo(w4.z) + bf_hi(w4.z)) + (bf_lo(w4.w) + bf_hi(w4.w)); }
            NLOC[(size_t)u * MDK + lane] = s;
            if (lane == 0) { GMAX[u] = gmax; BL[u] = bl; }
        }
        LDS_WAIT();
    }
}

__device__ __forceinline__ void mlstm_scan_phase(const Frame& F) {
    unsigned char* ws = F.ws(); const float* __restrict__ CLOC = (const float*)(ws + WS_CLOC); const float* __restrict__ NLOC = (const float*)(ws + WS_NLOC);
    const float* __restrict__ GMAX = (const float*)(ws + WS_MSC); const float* __restrict__ BL = GMAX + MUNITS; float* __restrict__ MPREV = (float*)(ws + WS_MSC) + 2 * MUNITS;
    bf16_t* __restrict__ CPREV = (bf16_t*)(ws + WS_CPREV); float* __restrict__ NPREV = (float*)(ws + WS_NPREV);
    constexpr int PER = MDV * MDK / 2;
    for (int it = F.vcu * NTHR + F.tid; it < NB * MH * PER; it += F.G * NTHR) {
        const int bh = it / PER, e = it - bh * PER; const bool hasn = e < 32; const int eo = e * 2;
        float c0 = 0.f, c1 = 0.f, n0 = 0.f, n1 = 0.f, mm = 0.f;
        for (int cb = 0; cb < MNC; cb += 8) {
            f32x2 loc[8], nl[8]; float gm[8], bl[8];
#pragma unroll
            for (int k = 0; k < 8; ++k) { const int u = bh * MNC + cb + k; loc[k] = *(const f32x2*)(CLOC + (size_t)u * (MDV * MDK) + eo); gm[k] = GMAX[u]; bl[k] = BL[u];
                nl[k] = hasn ? *(const f32x2*)(NLOC + (size_t)u * MDK + eo) : (f32x2){0.f, 0.f}; }
#pragma unroll
            for (int k = 0; k < 8; ++k) { const int u = bh * MNC + cb + k;
                const float mnew = fmaxf(bl[k] + mm, gm[k]), dec = __expf(bl[k] + mm - mnew), sc = __expf(gm[k] - mnew);
                *(unsigned*)(CPREV + (size_t)u * (MDV * MDK) + eo) = cvt_pk_bf16(c0, c1);
                if (hasn) { *(f32x2*)(NPREV + (size_t)u * MDK + eo) = (f32x2){n0, n1}; if (e == 0) MPREV[u] = mm; }
                c0 = dec * c0 + sc * loc[k].x; c1 = dec * c1 + sc * loc[k].y; n0 = dec * n0 + sc * nl[k].x; n1 = dec * n1 + sc * nl[k].y; mm = mnew; }
        }
    }
}

__device__ __forceinline__ void mlstm_out_phase(const Frame& F, const float* __restrict__ gain) {
    unsigned char* ws = F.ws(); const bf16_t* PROJ = (const bf16_t*)(ws + WS_PROJ); const float* Gt = (const float*)(ws + WS_GATES);
    const bf16_t* CPREV = (const bf16_t*)(ws + WS_CPREV); const float* NPREV = (const float*)(ws + WS_NPREV); const float* MPREV = (const float*)(ws + WS_MSC) + 2 * MUNITS;
    bf16_t* HB = (bf16_t*)(ws + WS_HB);
    const int lane = F.lane, c32 = lane & 31, hi = lane >> 5;
    LAS unsigned char* vt = F.lds + F.wave * (128 * MT_STRIDE);
    for (int it = F.vcu * NWAVES + F.wave; it < MUNITS * 2; it += F.G * NWAVES) {
        const int u = it >> 1, tb = it & 1, c = u & (MNC - 1), bh = u >> 7, h = bh & 7, b = bh >> 3, m0 = b * SEQ + c * MCH;
        const int mg = m0 + lane;
        const float ig = Gt[(size_t)mg * 16 + h], lf = log_sigmoid(Gt[(size_t)mg * 16 + 8 + h]);
        const float bc = wave_incl_scan_add(lf, lane), av = ig - bc, pm = wave_incl_scan_max(av, lane);
        const float mprev = MPREV[u];
        const int tl = 32 * tb + c32;
        const float Mt = fmaxf(mprev, __shfl(pm, tl)), bt = __shfl(bc, tl);
        const float winter = __expf(mprev - Mt) * 0.125f;
        stage_transposed<16>(vt, PROJ + (size_t)mg * 3072 + 1024 + h * 128, lane, 1.f, false);
        bf16x8 qf[4];
        const bf16_t* qrow = PROJ + (size_t)(m0 + tl) * 3072 + h * 64 + 8 * hi;
#pragma unroll
        for (int ks = 0; ks < 4; ++ks) qf[ks] = *(const bf16x8*)(qrow + 16 * ks);
        float qn = 0.f;
        { const float* np = NPREV + (size_t)u * MDK + 8 * hi;
#pragma unroll
          for (int ks = 0; ks < 4; ++ks) { const f32x4 n0 = *(const f32x4*)(np + 16 * ks), n1 = *(const f32x4*)(np + 16 * ks + 4); const u32x4 qw = __builtin_bit_cast(u32x4, qf[ks]);
              qn += bf_lo(qw.x) * n0[0] + bf_hi(qw.x) * n0[1] + bf_lo(qw.y) * n0[2] + bf_hi(qw.y) * n0[3] + bf_lo(qw.z) * n1[0] + bf_hi(qw.z) * n1[1] + bf_lo(qw.w) * n1[2] + bf_hi(qw.w) * n1[3]; } }
        qn += __shfl_xor(qn, 32);
        f32x16 acc[4];
#pragma unroll
        for (int i = 0; i < 4; ++i)
#pragma unroll
            for (int r = 0; r < 16; ++r) acc[i][r] = 0.f;
        { const bf16_t* cp = CPREV + (size_t)u * (MDV * MDK) + 8 * hi;
#pragma unroll
          for (int i = 0; i < 4; ++i)
#pragma unroll
              for (int ks = 0; ks < 4; ++ks) { const bf16x8 af = *(const bf16x8*)(cp + (size_t)(32 * i + c32) * MDK + 16 * ks); acc[i] = __builtin_amdgcn_mfma_f32_32x32x16_bf16(af, qf[ks], acc[i], 0, 0, 0); } }
#pragma unroll
        for (int i = 0; i < 4; ++i)
#pragma unroll
            for (int r = 0; r < 16; ++r) acc[i][r] *= winter;
        float den = 0.f;
        LDS_WAIT();
#pragma unroll
        for (int sb = 0; sb < 2; ++sb) {
            if (sb <= tb) {
                f32x16 st;
#pragma unroll
                for (int r = 0; r < 16; ++r) st[r] = 0.f;
                const bf16_t* krow = PROJ + (size_t)(m0 + 32 * sb + c32) * 3072 + 512 + h * 64 + 8 * hi;
#pragma unroll
                for (int ks = 0; ks < 4; ++ks) { const bf16x8 kf = *(const bf16x8*)(krow + 16 * ks); st = __builtin_amdgcn_mfma_f32_32x32x16_bf16(kf, qf[ks], st, 0, 0, 0); }
                unsigned pk[8];
#pragma unroll
                for (int r = 0; r < 16; r += 2) {
                    const int s0 = 32 * sb + (r & 3) + 8 * (r >> 2) + 4 * hi, s1 = s0 + 1;
                    const float a0 = __shfl(av, s0), a1 = __shfl(av, s1);
                    float p0 = st[r] * 0.125f * __expf(a0 - Mt), p1 = st[r + 1] * 0.125f * __expf(a1 - Mt);
                    if (s0 > tl) p0 = 0.f; if (s1 > tl) p1 = 0.f;
                    den += p0 + p1; pk[r >> 1] = cvt_pk_bf16(p0, p1);
                }
#pragma unroll
                for (int s2 = 0; s2 < 2; ++s2) {
                    const bf16x8 pf = __builtin_bit_cast(bf16x8, (u32x4){pk[4 * s2], pk[4 * s2 + 1], pk[4 * s2 + 2], pk[4 * s2 + 3]});
                    const int k0 = 16 * (2 * sb + s2) + 4 * hi;
#pragma unroll
                    for (int i = 0; i < 4; ++i) { const LAS unsigned char* vr = vt + (32 * i + c32) * MT_STRIDE;
                        const u32x2 v0 = *(const LAS u32x2*)(vr + 2 * k0), v1 = *(const LAS u32x2*)(vr + 2 * (k0 + 8));
                        const bf16x8 vf = __builtin_bit_cast(bf16x8, (u32x4){v0.x, v0.y, v1.x, v1.y});
                        acc[i] = __builtin_amdgcn_mfma_f32_32x32x16_bf16(vf, pf, acc[i], 0, 0, 0); }
                }
            }
        }
        den += __shfl_xor(den, 32);
        den += winter * qn;
        const float mrow = bt + Mt, dnm = fmaxf(fabsf(den), __expf(-mrow)), rinv = 1.f / dnm;
        float ss = 0.f;
#pragma unroll
        for (int i = 0; i < 4; ++i)
#pragma unroll
            for (int r = 0; r < 16; ++r) { acc[i][r] *= rinv; ss += acc[i][r] * acc[i][r]; }
        ss += __shfl_xor(ss, 32);
        const float rn = 1.f / sqrtf(ss * (1.f / MDV) + RMS_EPS);
        const size_t mrowi = (size_t)(m0 + tl);
#pragma unroll
        for (int i = 0; i < 4; ++i)
#pragma unroll
            for (int g4 = 0; g4 < 4; ++g4) { const int dv = 32 * i + 8 * g4 + 4 * hi;
                const f32x4 gn = *(const f32x4*)(gain + h * 128 + dv); const u32x2 ow = *(const u32x2*)(PROJ + mrowi * 3072 + 2048 + h * 128 + dv);
                const float o0 = bf_lo(ow.x), o1 = bf_hi(ow.x), o2 = bf_lo(ow.y), o3 = bf_hi(ow.y);
                const float y0 = acc[i][4 * g4 + 0] * rn * gn[0] / (1.f + __expf(-o0)), y1 = acc[i][4 * g4 + 1] * rn * gn[1] / (1.f + __expf(-o1));
                const float y2 = acc[i][4 * g4 + 2] * rn * gn[2] / (1.f + __expf(-o2)), y3 = acc[i][4 * g4 + 3] * rn * gn[3] / (1.f + __expf(-o3));
                u32x2 w; w.x = cvt_pk_bf16(y0, y1); w.y = cvt_pk_bf16(y2, y3); *(u32x2*)(HB + mrowi * D + h * 128 + dv) = w; }
        LDS_WAIT();
    }
}
constexpr int AT_KB = 64 * 384, AT_VB = 128 * 128, AT_STAGE = AT_KB + AT_VB;
__device__ __forceinline__ void attn_phase(const Frame& F) {
    unsigned char* ws = F.ws(); const bf16_t* QB = (const bf16_t*)(ws + WS_QB); const bf16_t* KN = (const bf16_t*)(ws + WS_KN); const bf16_t* KR = (const bf16_t*)(ws + WS_KR); const bf16_t* VT = (const bf16_t*)(ws + WS_VT);
    bf16_t* HB = (bf16_t*)(ws + WS_HB);
    LAS unsigned char* lds = F.lds;
    const int lane = F.lane, w = F.wave, c32 = lane & 31, hi = lane >> 5;
    int k_isr[3]; unsigned k_off[3], v_off[2];
#pragma unroll
    for (int n = 0; n < 3; ++n) { const int P = (n * 8 + w) * 64 + lane, row = P / 24, q = P - row * 24, p = (q & ~7) | ((q & 7) ^ ((row >> 1) & 7));
        k_isr[n] = p >= 16; k_off[n] = (p >= 16) ? (unsigned)(row * AROPE + (p - 16) * 8) * 2u : (unsigned)(row * 1024 + p * 8) * 2u; }
#pragma unroll
    for (int n = 0; n < 2; ++n) { const int P = (n * 8 + w) * 64 + lane, row = P >> 3, q = P & 7, p = q ^ ((row >> 1) & 7); v_off[n] = (unsigned)row * (unsigned)(T * 2) + (unsigned)(p * 16); }
    const int sw = (c32 >> 1) & 7;
    unsigned ko[4];
#pragma unroll
    for (int i = 0; i < 4; ++i) ko[i] = (unsigned)(c32 * 384 + (((2 * i + hi) ^ sw) * 16));
    const unsigned vrow = (unsigned)(c32 * 128 + 8 * hi);

    for (int item = F.vcu; item < NB * AH * 16; item += F.G) {
        const int bh = item >> 4, x = item & 15, b = bh >> 3, hh = bh & 7;
#pragma unroll 1
        for (int sub = 0; sub < 2; ++sub) {
            const int qb = sub ? 31 - x : x, nt = 4 * qb + 4, jmax = 4 * qb + (w >> 1);
            const int qrow = 256 * qb + 32 * w + c32;
            const size_t mq = (size_t)b * SEQ + qrow;
            __syncthreads();
            const bf16_t* knb = KN + (size_t)b * SEQ * 1024 + hh * 128; const bf16_t* krb = KR + (size_t)b * SEQ * AROPE; const bf16_t* vtb = VT + (size_t)(hh * 128) * T + (size_t)b * SEQ;
#define AT_ISSUE(j, stg) do { _Pragma("unroll") for (int _n = 0; _n < 3; ++_n) { \
                const char* _g = k_isr[_n] ? (const char*)(krb + (size_t)(j) * 64 * AROPE) + k_off[_n] : (const char*)(knb + (size_t)(j) * 64 * 1024) + k_off[_n]; \
                __builtin_amdgcn_global_load_lds((const unsigned*)_g, (LAS unsigned*)(lds + (stg) * AT_STAGE + (_n * 8 + w) * 1024), 16, 0, 0); } \
            _Pragma("unroll") for (int _n = 0; _n < 2; ++_n) { const char* _g = (const char*)(vtb + (size_t)(j) * 64) + v_off[_n]; \
                __builtin_amdgcn_global_load_lds((const unsigned*)_g, (LAS unsigned*)(lds + (stg) * AT_STAGE + AT_KB + (_n * 8 + w) * 1024), 16, 0, 0); } } while (0)
            AT_ISSUE(0, 0);
            bf16x8 qf[12];
            { const bf16_t* qr = QB + mq * 1536 + hh * AQD + 8 * hi;
#pragma unroll
              for (int ks = 0; ks < 12; ++ks) qf[ks] = *(const bf16x8*)(qr + 16 * ks); }
            f32x16 O[4];
#pragma unroll
            for (int i = 0; i < 4; ++i)
#pragma unroll
                for (int r = 0; r < 16; ++r) O[i][r] = 0.f;
            float m_run = -1.0e30f, l_run = 0.f;
#pragma unroll 1
            for (int j = 0; j < nt; ++j) {
                asm volatile("s_waitcnt vmcnt(0)" ::: "memory");
                __syncthreads();
                if (j + 1 < nt) AT_ISSUE(j + 1, (j + 1) & 1);
                if (j <= jmax) {
                    const LAS unsigned char* kb_ = lds + (j & 1) * AT_STAGE; const LAS unsigned char* vb_ = kb_ + AT_KB;
                    f32x16 s0, s1;
#pragma unroll
                    for (int r = 0; r < 16; ++r) { s0[r] = 0.f; s1[r] = 0.f; }
#pragma unroll
                    for (int ks = 0; ks < 12; ++ks) {
                        const bf16x8 k0 = *(const LAS bf16x8*)(kb_ + ko[ks & 3] + (ks >> 2) * 128), k1 = *(const LAS bf16x8*)(kb_ + ko[ks & 3] + (ks >> 2) * 128 + 32 * 384);
                        s0 = __builtin_amdgcn_mfma_f32_32x32x16_bf16(k0, qf[ks], s0, 0, 0, 0); s1 = __builtin_amdgcn_mfma_f32_32x32x16_bf16(k1, qf[ks], s1, 0, 0, 0);
                    }
                    if (j == jmax) {
                        const int kbase = 64 * j + 4 * hi;
#pragma unroll
                        for (int r = 0; r < 16; ++r) { const int key = kbase + (r & 3) + 8 * (r >> 2); if (key > qrow) s0[r] = -__builtin_inff(); if (key + 32 > qrow) s1[r] = -__builtin_inff(); }
                    }
                    float mx = fmaxf(s0[0], s1[0]);
#pragma unroll
                    for (int r = 1; r < 16; ++r) mx = fmaxf(mx, fmaxf(s0[r], s1[r]));
                    mx = fmaxf(mx, __shfl_xor(mx, 32));
                    const float mnew = fmaxf(m_run, mx), alpha = __builtin_amdgcn_exp2f(m_run - mnew); m_run = mnew;
                    float ls = 0.f; unsigned pk[16];
#pragma unroll
                    for (int r = 0; r < 16; r += 2) { const float p0 = __builtin_amdgcn_exp2f(s0[r] - mnew), p1 = __builtin_amdgcn_exp2f(s0[r + 1] - mnew), p2 = __builtin_amdgcn_exp2f(s1[r] - mnew), p3 = __builtin_amdgcn_exp2f(s1[r + 1] - mnew);
                        ls += (p0 + p1) + (p2 + p3); pk[r >> 1] = cvt_pk_bf16(p0, p1); pk[8 + (r >> 1)] = cvt_pk_bf16(p2, p3); }
                    l_run = l_run * alpha + ls;
#pragma unroll
                    for (int i = 0; i < 4; ++i)
#pragma unroll
                        for (int r = 0; r < 16; ++r) O[i][r] *= alpha;
#pragma unroll
                    for (int st = 0; st < 4; ++st) {
                        const bf16x8 pf = __builtin_bit_cast(bf16x8, (u32x4){pk[4 * st], pk[4 * st + 1], pk[4 * st + 2], pk[4 * st + 3]});
                        const unsigned p0o = (unsigned)(((2 * st) ^ sw) * 16), p1o = (unsigned)(((2 * st + 1) ^ sw) * 16);
#pragma unroll
                        for (int i = 0; i < 4; ++i) { const LAS unsigned char* vr = vb_ + vrow + i * (32 * 128);
                            const u32x2 v0 = *(const LAS u32x2*)(vr + p0o), v1 = *(const LAS u32x2*)(vr + p1o);
                            const bf16x8 vf = __builtin_bit_cast(bf16x8, (u32x4){v0.x, v0.y, v1.x, v1.y});
                            O[i] = __builtin_amdgcn_mfma_f32_32x32x16_bf16(vf, pf, O[i], 0, 0, 0); }
                    }
                }
            }
            const float lt = l_run + __shfl_xor(l_run, 32), rl = 1.f / lt;
            bf16_t* orow = HB + mq * D + hh * 128 + 4 * hi;
#pragma unroll
            for (int i = 0; i < 4; ++i)
#pragma unroll
                for (int g4 = 0; g4 < 4; ++g4) { u32x2 wv; wv.x = cvt_pk_bf16(O[i][4 * g4] * rl, O[i][4 * g4 + 1] * rl); wv.y = cvt_pk_bf16(O[i][4 * g4 + 2] * rl, O[i][4 * g4 + 3] * rl);
                    *(u32x2*)(orow + 32 * i + 8 * g4) = wv; }
#undef AT_ISSUE
        }
    }
}
#ifndef EN_P0
#define EN_P0 1
#endif
#ifndef EN_M1
#define EN_M1 1
#endif
#ifndef EN_M2
#define EN_M2 1
#endif
#ifndef EN_M3
#define EN_M3 1
#endif
#ifndef EN_M4
#define EN_M4 1
#endif
#ifndef EN_A1
#define EN_A1 1
#endif
#ifndef EN_A2
#define EN_A2 1
#endif
#ifndef EN_A3
#define EN_A3 1
#endif
#ifndef EN_A4
#define EN_A4 1
#endif
#ifndef EN_O5
#define EN_O5 1
#endif
#ifndef EN_L6
#define EN_L6 1
#endif
#ifndef EN_G7
#define EN_G7 1
#endif
#ifndef EN_G8
#define EN_G8 1
#endif
#ifndef EN_L9
#define EN_L9 1
#endif
constexpr int PH_PER_LAYER = 9, N_PHASES = 1 + DEPTH * PH_PER_LAYER;
constexpr float Q_SCALE = 0.07216878364870323f * 1.4426950408889634f;

__global__ void __launch_bounds__(NTHR, 2) fwd_kernel(Args args) {
    extern __shared__ __attribute__((aligned(16))) unsigned char lds_raw[];
    Frame F0; Frame& F = F0;
    F.lds = (LAS unsigned char*)lds_raw; F.MISC = (volatile LAS unsigned*)(F.lds + MISC_OFF);
    F.tid = threadIdx.x; F.lane = F.tid & 63; F.wave = __builtin_amdgcn_readfirstlane(F.tid >> 6);
    F.G = gridDim.x; { const int bx = blockIdx.x; F.vcu = (F.G % 8 == 0) ? (bx % 8) * (F.G / 8) + bx / 8 : bx; }
    if (F.tid < 128) F.MISC[F.tid] = 0u;
    if (F.tid == 128) {
#pragma unroll
        for (int i = 0; i < 20; ++i) { const unsigned long long p = (unsigned long long)args.in[i]; F.MISC[128 + 2 * i] = (unsigned)p; F.MISC[129 + 2 * i] = (unsigned)(p >> 32); }
        { const unsigned long long p = (unsigned long long)args.out; F.MISC[168] = (unsigned)p; F.MISC[169] = (unsigned)(p >> 32); }
        { const unsigned long long p = (unsigned long long)args.ws; F.MISC[170] = (unsigned)p; F.MISC[171] = (unsigned)(p >> 32); }
    }
    __syncthreads();
    XcdBarrier bar = xcd_barrier_post(F.ctl() + CW_BAR, F.MISC);
    const int lo = args.ph_lo, hi = args.ph_hi;
#define IN(k) (lo <= (k) && (k) < hi)
#define SEAM(k) do { if (IN(k) && IN((k) + 1)) xcd_barrier(bar); else __syncthreads(); } while (0)

    if (EN_P0 && IN(0)) { const Frame F = refresh(F0); p0_prologue(F); }
    SEAM(0);

    for (int l = 0; l < DEPTH; ++l) {
        const int pb = 1 + l * PH_PER_LAYER, j = l >> 1;
        if ((l & 1) == 0) {
            if (EN_M1 && IN(pb + 0)) { const Frame F = refresh(F0); unsigned char* ws = F.ws(); const float* xres = (l == 0) ? (const float*)F.ptr(IN_X) : (const float*)(ws + WS_XF);
                pg8::DenseOrder S; S.init(ws + WS_XB, (bf16_t*)(ws + WS_WINM) + (size_t)j * 3072 * 1024, T, 3072, 1024, 1024, F.G, F.vcu);
                pg8::EpiBf16 E{(bf16_t*)(ws + WS_PROJ), 3072, 1.0f};
                pg8::gemm_phase<pg8::EpiBf16, pg8::DenseOrder, false>(F.lds, F.tid, 1024, 1024, 1024, S, E);
                __syncthreads();
                const Frame F2 = refresh(F0);
                skinny_fill<16>(F2, (const float*)F.ptr(IN_MWIN) + (size_t)j * 1024 * MIN_ + 3072, MIN_);
                gates_phase(F2, xres, (const float*)F2.ptr(IN_MBG) + j * 16, (float*)(ws + WS_GATES));
            }
            SEAM(pb + 0);
            if (EN_M2 && IN(pb + 1)) { const Frame F = refresh(F0); mlstm_local_phase(F); }
            SEAM(pb + 1);
            if (EN_M3 && IN(pb + 2)) { const Frame F = refresh(F0); mlstm_scan_phase(F); }
            SEAM(pb + 2);
            if (EN_M4 && IN(pb + 3)) { const Frame F = refresh(F0); mlstm_out_phase(F, (const float*)F.ptr(IN_MNG) + (size_t)j * 1024); }
            SEAM(pb + 3);
        } else {
            if (EN_A1 && IN(pb + 0)) { const Frame F = refresh(F0); unsigned char* ws = F.ws();
                pg8::DenseOrder S; S.init(ws + WS_XB, (bf16_t*)(ws + WS_WINA) + (size_t)j * AINP * 1024, T, AINP, 1024, 1024, F.G, F.vcu);
                pg8::EpiF32 E{(float*)(ws + WS_A32), AINP};
                pg8::gemm_phase<pg8::EpiF32, pg8::DenseOrder, false>(F.lds, F.tid, 1024, 1024, 1024, S, E);
            }
            SEAM(pb + 0);
            if (EN_A2 && IN(pb + 1)) { const Frame F = refresh(F0); mla_norm_phase(F, j); }
            SEAM(pb + 1);
            if (EN_A3 && IN(pb + 2)) { const Frame F = refresh(F0); unsigned char* ws = F.ws();
                { pg8::DenseOrder S; S.init(ws + WS_CQ, (bf16_t*)(ws + WS_WQB) + (size_t)j * 1536 * AQL, T, 1536, AQL, AQL, F.G, F.vcu);
                  pg8::EpiQRope E{(bf16_t*)(ws + WS_QB), 1536, (const float*)(ws + WS_COS), (const float*)(ws + WS_SIN), Q_SCALE};
                  pg8::gemm_phase<pg8::EpiQRope, pg8::DenseOrder, false>(F.lds, F.tid, AQL, AQL, AQL, S, E); }
                __syncthreads();
                { const Frame F = refresh(F0); unsigned char* ws = F.ws();
                  pg8::DenseOrder S; S.init(ws + WS_CKV, (bf16_t*)(ws + WS_WKV) + (size_t)j * 2048 * AKL, T, 1024, AKL, AKL, F.G, F.vcu);
                  pg8::EpiBf16 E{(bf16_t*)(ws + WS_KN), 1024, 1.0f};
                  pg8::gemm_phase<pg8::EpiBf16, pg8::DenseOrder, false>(F.lds, F.tid, AKL, AKL, AKL, S, E); }
                __syncthreads();
                { const Frame F = refresh(F0); unsigned char* ws = F.ws();
                  pg8::DenseOrder S; S.init((bf16_t*)(ws + WS_WKV) + (size_t)j * 2048 * AKL + (size_t)1024 * AKL, ws + WS_CKV, 1024, T, AKL, AKL, F.G, F.vcu);
                  pg8::EpiBf16 E{(bf16_t*)(ws + WS_VT), T, 1.0f};
                  pg8::gemm_phase<pg8::EpiBf16, pg8::DenseOrder, false>(F.lds, F.tid, AKL, AKL, AKL, S, E); }
            }
            SEAM(pb + 2);
            if (EN_A4 && IN(pb + 3)) { const Frame F = refresh(F0); attn_phase(F); }
            SEAM(pb + 3);
        }
        if (EN_O5 && IN(pb + 4)) { const Frame F = refresh(F0); unsigned char* ws = F.ws(); const float* xres = (l == 0) ? (const float*)F.ptr(IN_X) : (const float*)(ws + WS_XF);
            const bf16_t* wo = (l & 1) ? (const bf16_t*)(ws + WS_WOUTA) + (size_t)j * 1024 * 1024 : (const bf16_t*)(ws + WS_WOUTM) + (size_t)j * 1024 * 1024;
            pg8::DenseOrder S; S.init(ws + WS_HB, wo, T, 1024, 1024, 1024, F.G, F.vcu);
            pg8::EpiResid E{xres, (float*)(ws + WS_ZF), 1024, DN_ALPHA};
            pg8::gemm_phase<pg8::EpiResid, pg8::DenseOrder, false>(F.lds, F.tid, 1024, 1024, 1024, S, E);
        }
        SEAM(pb + 4);
        if (EN_L6 && IN(pb + 5)) { const Frame F = refresh(F0); ln_phase<0>(F, l, false); }
        SEAM(pb + 5);
        if (EN_G7 && IN(pb + 6)) { const Frame F = refresh(F0); unsigned char* ws = F.ws();
            moe_prefix(F, l);
            pg8::MoeOrder S{(const volatile LAS int*)(F.MISC + 16), (const char*)(ws + WS_XB), (const char*)(ws + WS_WGU) + (size_t)l * 32 * 2048 * 1024 * 2, (const int*)(ws + WS_LIST), F.ctl() + CW_CNT + l * 32 * 64,
                            8, F.G, F.vcu, (size_t)2048 * 1024 * 2, (size_t)256 * 1024 * 2, true};
            pg8::EpiSwiglu E{(bf16_t*)(ws + WS_HMOE), (const float*)F.ptr(IN_BGU) + (size_t)l * 32 * 2048};
            pg8::gemm_phase<pg8::EpiSwiglu, pg8::MoeOrder, true>(F.lds, F.tid, 1024, 1024, 1024, S, E);
        }
        SEAM(pb + 6);
        if (EN_G8 && IN(pb + 7)) { const Frame F = refresh(F0); unsigned char* ws = F.ws();
            moe_prefix(F, l);
            pg8::MoeOrder S{(const volatile LAS int*)(F.MISC + 16), (const char*)(ws + WS_HMOE), (const char*)(ws + WS_WD) + (size_t)l * 32 * 1024 * 1024 * 2, (const int*)(ws + WS_LIST), F.ctl() + CW_CNT + l * 32 * 64,
                            4, F.G, F.vcu, (size_t)1024 * 1024 * 2, (size_t)256 * 1024 * 2, false};
            pg8::EpiDown E{(bf16_t*)(ws + WS_YMOE), (const float*)F.ptr(IN_BD) + (size_t)l * 32 * 1024};
            pg8::gemm_phase<pg8::EpiDown, pg8::MoeOrder, false>(F.lds, F.tid, 1024, 1024, 1024, S, E);
        }
        SEAM(pb + 7);
        if (EN_L9 && IN(pb + 8)) { const Frame F = refresh(F0); moe_prefix(F, l); ln_phase<1>(F, l, l == DEPTH - 1); }
        SEAM(pb + 8);
    }
#undef IN
#undef SEAM
}

extern "C" void kernel_launch(void* const* d_in, const int* in_sizes, int n_in, void* d_out, int out_size, void* d_ws, size_t ws_size, hipStream_t stream) {
    static int grid = 0;
    if (grid == 0) {
        if (n_in != 20 || out_size != T * D || ws_size < WS_END) { fprintf(stderr, "kernel_launch: unexpected problem (n_in %d out %d ws %zu)\n", n_in, out_size, ws_size); grid = -1; return; }
        int dev = 0, cus = 0, per_cu = 0;
        if (hipGetDevice(&dev) != hipSuccess || hipDeviceGetAttribute(&cus, hipDeviceAttributeMultiprocessorCount, dev) != hipSuccess) { grid = -1; return; }
        if (hipFuncSetAttribute((const void*)fwd_kernel, hipFuncAttributeMaxDynamicSharedMemorySize, LDS_BYTES) != hipSuccess) { fprintf(stderr, "kernel_launch: hipFuncSetAttribute failed\n"); grid = -1; return; }
        if (hipOccupancyMaxActiveBlocksPerMultiprocessor(&per_cu, (const void*)fwd_kernel, NTHR, LDS_BYTES) != hipSuccess || per_cu < 1) fprintf(stderr, "kernel_launch: occupancy query reports %d\n", per_cu);
        (void)hipGetLastError();
        grid = cus;
    }
    if (grid < 0) return;
    (void)hipMemsetAsync((char*)d_ws + WS_CTL, 0, CTL_ZERO_BYTES, stream);
    Args a; memset(&a, 0, sizeof(a));
    for (int i = 0; i < 20; ++i) a.in[i] = d_in[i];
    a.out = (float*)d_out; a.ws = (unsigned char*)d_ws;
#if MK_PER_PHASE
    for (int p = 0; p < N_PHASES; ++p) { a.ph_lo = p; a.ph_hi = p + 1; hipLaunchKernelGGL(fwd_kernel, dim3(grid), dim3(NTHR), LDS_BYTES, stream, a); }
#else
    a.ph_lo = 0; a.ph_hi = N_PHASES;
    hipLaunchKernelGGL(fwd_kernel, dim3(grid), dim3(NTHR), LDS_BYTES, stream, a);
#endif
    const hipError_t le = hipPeekAtLastError();
    if (le != hipSuccess) fprintf(stderr, "kernel_launch: launch failed: %s\n", hipGetErrorName(le));
}
```

```cpp
#include <hip/hip_runtime.h>
#include <cstdio>
#include <cstdint>
#include <cstring>

#define LAS __attribute__((address_space(3)))
#define GAS __attribute__((address_space(1)))
typedef unsigned short bf16_t;
typedef short bf16x8 __attribute__((ext_vector_type(8)));
typedef short s16x4 __attribute__((ext_vector_type(4)));
typedef float f32x2 __attribute__((ext_vector_type(2)));
typedef float f32x4 __attribute__((ext_vector_type(4)));
typedef float f32x16 __attribute__((ext_vector_type(16)));
typedef unsigned u32x2 __attribute__((ext_vector_type(2)));
typedef unsigned u32x4 __attribute__((ext_vector_type(4)));

#ifndef MK_PER_PHASE
#define MK_PER_PHASE 0
#endif

constexpr int NB = 4, SEQ = 8192, T = NB * SEQ, D = 1024, DEPTH = 4;
constexpr int MH = 8, MDV = 128, MDK = 64, MCH = 64, MNC = SEQ / MCH, MIN_ = 3088, MUNITS = NB * MH * MNC;
constexpr int AH = 8, AQL = 384, AKL = 256, ANOPE = 128, AROPE = 64, AV = 128, AIN = 704, AINP = 768, AQD = 192;
constexpr int NE = 32, TOPK = 4, DFF = 1024;
constexpr float DN_ALPHA = 1.6817928305074290f;
constexpr float LN_EPS = 1e-5f, RMS_EPS = 1e-6f;
constexpr int MOE_ROWS = 139264;

constexpr size_t MiB = 1ull << 20;
constexpr size_t WS_CTL = 0, CTL_ZERO_BYTES = 1 * MiB;
constexpr size_t WS_COS = 1 * MiB, WS_SIN = 5 * MiB, WS_GATES = 9 * MiB, WS_TOKINFO = 11 * MiB, WS_TOKGATE = 11 * MiB + 512 * 1024, WS_LIST = 12 * MiB;
constexpr size_t WS_MSC = 16 * MiB, WS_NLOC = 17 * MiB, WS_NPREV = 18 * MiB;
constexpr size_t WS_WINM = 20 * MiB, WS_WOUTM = 32 * MiB, WS_WINA = 36 * MiB, WS_WQB = 39 * MiB, WS_WKV = 42 * MiB, WS_WOUTA = 44 * MiB;
constexpr size_t WS_WGU = 64 * MiB, WS_WD = 576 * MiB;
constexpr size_t WS_XF = 832 * MiB, WS_ZF = 960 * MiB, WS_XB = 1088 * MiB, WS_PROJ = 1152 * MiB;
constexpr size_t WS_A32 = WS_PROJ, WS_CQ = WS_PROJ + 96 * MiB, WS_CKV = WS_PROJ + 120 * MiB, WS_KR = WS_PROJ + 136 * MiB;
constexpr size_t WS_QB = 1344 * MiB, WS_CLOC = WS_QB, WS_KN = 1472 * MiB, WS_CPREV = WS_KN, WS_VT = 1536 * MiB, WS_HB = 1600 * MiB;
constexpr size_t WS_HMOE = 1664 * MiB, WS_YMOE = 1936 * MiB, WS_END = 2208 * MiB;
constexpr int CW_BAR = 4096, CW_CNT = 16384;

constexpr int RING_BYTES = 147456;
constexpr int MISC_OFF = RING_BYTES;
constexpr int LDS_BYTES = RING_BYTES + 1024;
constexpr int NWAVES = 8, NTHR = 512;

__device__ __forceinline__ unsigned cvt_pk_bf16(float lo, float hi) { unsigned r; asm("v_cvt_pk_bf16_f32 %0, %1, %2" : "=v"(r) : "v"(lo), "v"(hi)); return r; }
__device__ __forceinline__ float bf_lo(unsigned w) { return __uint_as_float(w << 16); }
__device__ __forceinline__ float bf_hi(unsigned w) { return __uint_as_float(w & 0xffff0000u); }
__device__ __forceinline__ float wave_sum(float v) {
#pragma unroll
    for (int o = 1; o < 64; o <<= 1) v += __shfl_xor(v, o);
    return v;
}
__device__ __forceinline__ float wave_max(float v) {
#pragma unroll
    for (int o = 1; o < 64; o <<= 1) v = fmaxf(v, __shfl_xor(v, o));
    return v;
}
#define LDS_WAIT() asm volatile("s_waitcnt lgkmcnt(0)" ::: "memory")
#define VM_WAIT() asm volatile("s_waitcnt vmcnt(0)" ::: "memory")

#define XB_TMO      128
#define XB_XCNT(j)  (256  + 64 * (j))
#define XB_XSUB(j)  (1280 + 64 * (j))
#define XB_XGEN(j)  (2304 + 64 * (j))
#define XB_TOP      3328
#define XB_TOPGEN   3392
#define XCD_BAR_WORDS 3456
#define XB_SPIN_CAP (1u << 18)
__device__ __forceinline__ unsigned xb_ld(unsigned* p)              { return __hip_atomic_load(p, __ATOMIC_RELAXED, __HIP_MEMORY_SCOPE_AGENT); }
__device__ __forceinline__ unsigned xb_add(unsigned* p, unsigned v) { return __hip_atomic_fetch_add(p, v, __ATOMIC_RELAXED, __HIP_MEMORY_SCOPE_AGENT); }
__device__ __forceinline__ unsigned xb_xcc_id() { return (unsigned)__builtin_amdgcn_s_getreg((3 << 11) | 20) & 0xFu; }
#define XB_SPIN(cond, bar) do { unsigned _sp = 0; while (cond) { __builtin_amdgcn_s_sleep(1); \
    if ((++_sp & 255u) == 0u) { if (xb_ld(&(bar)[XB_TMO])) break; if (_sp > XB_SPIN_CAP) { atomicAdd(&(bar)[XB_TMO], 1u); break; } } } } while (0)
struct XcdBarrier { unsigned* bar; unsigned x; volatile LAS unsigned* st; };
__device__ __forceinline__ XcdBarrier xcd_barrier_post(unsigned* bar, volatile LAS unsigned* st) {
    XcdBarrier b; b.bar = bar; b.x = xb_xcc_id(); b.st = st;
    if (threadIdx.x == 0) (void)xb_add(&bar[XB_XCNT(b.x)], 1u);
    return b;
}
__device__ __forceinline__ void xcd_barrier_complete(unsigned* bar, unsigned x, unsigned& nloc, unsigned& nx) {
    const unsigned G = gridDim.x * gridDim.y * gridDim.z;
    unsigned sum, cnt, mine, sp = 0u;
    for (;;) {
        sum = 0u; cnt = 0u; mine = 0u;
#pragma unroll
        for (unsigned j = 0; j < 16; ++j) { const unsigned c = xb_ld(&bar[XB_XCNT(j)]); sum += c; cnt += (c > 0u) ? 1u : 0u; mine = (j == x) ? c : mine; }
        if (sum == G) break;
        __builtin_amdgcn_s_sleep(1);
        if ((++sp & 255u) == 0u) { if (xb_ld(&bar[XB_TMO])) break; if (sp > XB_SPIN_CAP) { atomicAdd(&bar[XB_TMO], 1u); break; } }
    }
    nloc = mine > 0u ? mine : 1u; nx = cnt > 0u ? cnt : 1u;
}
__device__ __forceinline__ void xcd_barrier(const XcdBarrier& b) {
    asm volatile("s_waitcnt vmcnt(0)" ::: "memory");
    __syncthreads();
    if (threadIdx.x == 0) {
        unsigned* bar = b.bar;
        __builtin_amdgcn_s_waitcnt(0);
        unsigned nloc = b.st[0], nx = b.st[1];
        if (nloc == 0u) { xcd_barrier_complete(bar, b.x, nloc, nx); b.st[0] = nloc; b.st[1] = nx; }
        const unsigned old = xb_add(&bar[XB_XSUB(b.x)], 1u);
        const unsigned gen = old / nloc;
        if (old + 1u == (gen + 1u) * nloc) {
            __builtin_amdgcn_fence(__ATOMIC_RELEASE, "agent");
            asm volatile("s_waitcnt vmcnt(0)" ::: "memory");
            const unsigned og = xb_add(&bar[XB_TOP], 1u);
            const unsigned tg = og / nx;
            if (og + 1u == (tg + 1u) * nx) xb_add(&bar[XB_TOPGEN], 1u);
            else XB_SPIN(xb_ld(&bar[XB_TOPGEN]) == tg, bar);
            __builtin_amdgcn_fence(__ATOMIC_ACQUIRE, "agent");
            xb_add(&bar[XB_XGEN(b.x)], 1u);
            asm volatile("s_waitcnt vmcnt(0)" ::: "memory");
        } else {
            XB_SPIN(xb_ld(&bar[XB_XGEN(b.x)]) == gen, bar);
            __builtin_amdgcn_fence(__ATOMIC_ACQUIRE, "agent");
            asm volatile("s_waitcnt vmcnt(0)" ::: "memory");
        }
    }
    __syncthreads();
}

namespace pg8 {
constexpr int BM = 256, BK = 64, HALF = 128, HTB = HALF * BK * 2, STAGE_BYTES = 8 * HTB;
__host__ __device__ __forceinline__ int lds_byte(int r, int c) { const int st = (r >> 4) * 2 + (c >> 5), rr = r & 15, cc = c & 31, ob = rr * 64 + cc * 2; return st * 1024 + (ob ^ (((ob >> 9) & 1) << 5)); }
__host__ __device__ __forceinline__ void stage_rc(int b, int& R, int& C) { const int st = b / 1024, sb = b % 1024, swz = sb ^ (((sb >> 9) & 1) << 5); R = (st >> 1) * 16 + swz / 64; C = (st & 1) * 32 + (swz % 64) / 2; }
__host__ __device__ __forceinline__ int perm32(int rho) { const int n = rho >> 4, i = rho & 15; return 8 * (i >> 2) + 4 * n + (i & 3); }

struct Unit { int pm, pn, aux, nvalid; const char* A; const char* B; const int* rows; };

template <class Epi, class Sched, bool GATHER>
__device__ __forceinline__ void gemm_phase(LAS unsigned char* lds, const int tid, const int K, const int lda, const int ldb, const Sched& S, const Epi& E) {
    const int wid = __builtin_amdgcn_readfirstlane(tid >> 6), lane = tid & 63, wr = wid >> 2, wc = wid & 3, fr = lane & 15, fq = lane >> 4;
    const int nt = K / BK;
    int Rr[2], Cc[2];
    unsigned offB[2], offA[2], gAc[2][2], gAn[2][2];
#pragma unroll
    for (int i = 0; i < 2; ++i) { int R, C; stage_rc(tid * 16 + i * 8192, R, C); Rr[i] = R; Cc[i] = C; const int Rb = Epi::PERM ? ((R & ~31) + perm32(R & 31)) : R;
        offB[i] = (unsigned)(Rb * ldb + C) * 2u; offA[i] = (unsigned)(R * lda + C) * 2u;
#pragma unroll
        for (int h = 0; h < 2; ++h) { gAc[h][i] = offA[i]; gAn[h][i] = offA[i]; } }
    const size_t hstepA = (size_t)HALF * lda * 2, hstepB = (size_t)HALF * ldb * 2;
    const size_t kstep = (size_t)(BK * 2);
    const unsigned ldsw = (unsigned)wid * 1024u;
    const int aoff = lds_byte(wr * 64 + fr, fq * 8), boff = lds_byte(wc * 32 + fr, fq * 8);
#define PG8_SA(b, h) (((b) * 2 + (h)) * HTB)
#define PG8_SB(b, h) ((4 + (b) * 2 + (h)) * HTB)
#define PG8_STAGE(bufoff, gbase, voff) do { _Pragma("unroll") for (int _i = 0; _i < 2; ++_i) \
        __builtin_amdgcn_global_load_lds((const unsigned*)((const char*)(gbase) + (voff)[_i]), (LAS unsigned*)(lds + (bufoff) + ldsw + _i * 8192), 16, 0, 0); } while (0)
#define PG8_STAGEA(bufoff, gbase, h, G) do { if constexpr (GATHER) { PG8_STAGE(bufoff, gbase, G[h]); } else { PG8_STAGE(bufoff, (gbase) + (h) * hstepA, offA); } } while (0)
#define PG8_STAGEA2(bufoff, gbase, h) do { if constexpr (GATHER) { if (last) { PG8_STAGE(bufoff, gbase, gAn[h]); } else { PG8_STAGE(bufoff, gbase, gAc[h]); } } else { PG8_STAGE(bufoff, (gbase) + (h) * hstepA, offA); } } while (0)
#define PG8_LDA(dst, b, h) do { _Pragma("unroll") for (int m = 0; m < 4; ++m) _Pragma("unroll") for (int k = 0; k < 2; ++k) dst[m][k] = *(const LAS bf16x8*)(lds + PG8_SA(b, h) + aoff + m * 2048 + k * 1024); } while (0)
#define PG8_LDB(dst, b, h) do { _Pragma("unroll") for (int n = 0; n < 2; ++n) _Pragma("unroll") for (int k = 0; k < 2; ++k) dst[n][k] = *(const LAS bf16x8*)(lds + PG8_SB(b, h) + boff + n * 2048 + k * 1024); } while (0)
#define PG8_MMA(ai, bj, At, Bt) do { __builtin_amdgcn_s_setprio(1); _Pragma("unroll") for (int m = 0; m < 4; ++m) _Pragma("unroll") for (int n = 0; n < 2; ++n) _Pragma("unroll") for (int k = 0; k < 2; ++k) \
        acc[ai][bj][m][n] = __builtin_amdgcn_mfma_f32_16x16x32_bf16(Bt[n][k], At[m][k], acc[ai][bj][m][n], 0, 0, 0); __builtin_amdgcn_s_setprio(0); } while (0)
#define PG8_WAIT_V(n) asm volatile("s_waitcnt vmcnt(" #n ")" ::: "memory")
#define PG8_WAIT_L(n) asm volatile("s_waitcnt lgkmcnt(" #n ")" ::: "memory")
#define PG8_BAR __builtin_amdgcn_s_barrier()
#define PG8_SCHED __builtin_amdgcn_sched_barrier(0)
#define PG8_GATHER(U, OFF) do { _Pragma("unroll") for (int _h = 0; _h < 2; ++_h) _Pragma("unroll") for (int _i = 0; _i < 2; ++_i) { const int _r = _h * HALF + Rr[_i]; \
        const int _tok = (U).rows[_r < (U).nvalid ? _r : 0]; OFF[_h][_i] = (unsigned)(_tok * lda + Cc[_i]) * 2u; } } while (0)
    Unit cur, nxt; int ui = 0;
    if (!S.next(0, cur)) return;
    f32x4 acc[2][2][4][2];
#pragma unroll
    for (int a = 0; a < 2; ++a)
#pragma unroll
        for (int b = 0; b < 2; ++b)
#pragma unroll
            for (int m = 0; m < 4; ++m)
#pragma unroll
                for (int n = 0; n < 2; ++n) acc[a][b][m][n] = (f32x4){0.f, 0.f, 0.f, 0.f};
    bf16x8 At[4][2], B0[2][2], B1[2][2];
    const char* cA = cur.A; const char* cB = cur.B;
    if constexpr (GATHER) { PG8_GATHER(cur, gAc); }
    PG8_STAGE(PG8_SB(0, 0), cB, offB); PG8_STAGEA(PG8_SA(0, 0), cA, 0, gAc); PG8_STAGE(PG8_SB(0, 1), cB + hstepB, offB); PG8_STAGEA(PG8_SA(0, 1), cA, 1, gAc);
    if (wr == 1) PG8_BAR;
    PG8_WAIT_V(4); PG8_BAR;
    PG8_STAGE(PG8_SB(1, 0), cB + kstep, offB); PG8_STAGEA(PG8_SA(1, 0), cA + kstep, 0, gAc); PG8_STAGE(PG8_SB(1, 1), cB + kstep + hstepB, offB);
    PG8_WAIT_V(6); PG8_BAR;
    for (;;) {
        const bool has_next = S.next(ui + 1, nxt);
        const char* nA = has_next ? nxt.A : cA; const char* nB = has_next ? nxt.B : cB;
        for (int t = 0; t < nt; t += 2) {
            const bool last = (t == nt - 2);
            const char* a1 = cA + (size_t)(t + 1) * kstep;
            const char* a2 = last ? nA : cA + (size_t)(t + 2) * kstep; const char* b2 = last ? nB : cB + (size_t)(t + 2) * kstep;
            const char* a3 = a2 + kstep; const char* b3 = b2 + kstep;
            if constexpr (GATHER) { if (last && has_next) { PG8_GATHER(nxt, gAn); } }
            PG8_LDB(B0, 0, 0); PG8_SCHED; PG8_LDA(At, 0, 0); PG8_STAGEA(PG8_SA(1, 1), a1, 1, gAc);
            PG8_WAIT_L(8); PG8_BAR; PG8_WAIT_L(0); PG8_MMA(0, 0, At, B0); PG8_BAR; PG8_SCHED;
            PG8_LDB(B1, 0, 1); PG8_STAGE(PG8_SB(0, 0), b2, offB);
            PG8_BAR; PG8_WAIT_L(0); PG8_MMA(0, 1, At, B1); PG8_BAR;
            PG8_LDA(At, 0, 1); PG8_STAGEA2(PG8_SA(0, 0), a2, 0);
            PG8_BAR; PG8_WAIT_L(0); PG8_MMA(1, 0, At, B0); PG8_BAR; PG8_SCHED;
            PG8_STAGE(PG8_SB(0, 1), b2 + hstepB, offB);
            PG8_WAIT_V(6); PG8_BAR; PG8_MMA(1, 1, At, B1); PG8_BAR;
            PG8_LDB(B0, 1, 0); PG8_SCHED; PG8_LDA(At, 1, 0); PG8_STAGEA2(PG8_SA(0, 1), a2, 1);
            PG8_WAIT_L(8); PG8_BAR; PG8_WAIT_L(0); PG8_MMA(0, 0, At, B0); PG8_BAR; PG8_SCHED;
            PG8_LDB(B1, 1, 1); PG8_STAGE(PG8_SB(1, 0), b3, offB);
            PG8_BAR; PG8_WAIT_L(0); PG8_MMA(0, 1, At, B1); PG8_BAR;
            PG8_LDA(At, 1, 1); PG8_STAGEA2(PG8_SA(1, 0), a3, 0);
            PG8_BAR; PG8_WAIT_L(0); PG8_MMA(1, 0, At, B0); PG8_BAR; PG8_SCHED;
            PG8_STAGE(PG8_SB(1, 1), b3 + hstepB, offB);
            PG8_WAIT_V(6); PG8_BAR; PG8_MMA(1, 1, At, B1); PG8_BAR;
        }
        { int l2; asm volatile("v_mbcnt_lo_u32_b32 %0, -1, 0\n\tv_mbcnt_hi_u32_b32 %0, -1, %0" : "=v"(l2)); E(acc, cur, wr, wc, l2 & 15, l2 >> 4); }
        if (!has_next) break;
#pragma unroll
        for (int a = 0; a < 2; ++a)
#pragma unroll
            for (int b = 0; b < 2; ++b)
#pragma unroll
                for (int m = 0; m < 4; ++m)
#pragma unroll
                    for (int n = 0; n < 2; ++n) acc[a][b][m][n] = (f32x4){0.f, 0.f, 0.f, 0.f};
        cur = nxt; cA = nA; cB = nB; ++ui;
        if constexpr (GATHER) {
#pragma unroll
            for (int h = 0; h < 2; ++h) { gAc[h][0] = gAn[h][0]; gAc[h][1] = gAn[h][1]; } }
    }
    PG8_WAIT_V(0);
    if (wr == 0) PG8_BAR;
    PG8_BAR;
#undef PG8_SA
#undef PG8_SB
#undef PG8_STAGE
#undef PG8_LDA
#undef PG8_LDB
#undef PG8_MMA
#undef PG8_WAIT_V
#undef PG8_WAIT_L
#undef PG8_BAR
#undef PG8_SCHED
#undef PG8_GATHER
#undef PG8_STAGEA
#undef PG8_STAGEA2
}
}
namespace pg8 {
struct EpiBf16 {
    static constexpr bool PERM = true;
    bf16_t* O; int ldc; float scale;
    __device__ __forceinline__ void operator()(const f32x4 (&acc)[2][2][4][2], const Unit& u, int wr, int wc, int fr, int fq) const {
        const int row0 = u.pm * BM + wr * 64 + fr, col0 = u.pn * BM + wc * 32 + 8 * fq;
#pragma unroll
        for (int ai = 0; ai < 2; ++ai)
#pragma unroll
            for (int m = 0; m < 4; ++m) { bf16_t* rowp = O + (size_t)(row0 + ai * HALF + m * 16) * ldc + col0;
#pragma unroll
                for (int bj = 0; bj < 2; ++bj) { const f32x4 v0 = acc[ai][bj][m][0] * scale, v1 = acc[ai][bj][m][1] * scale;
                    u32x4 w; w.x = cvt_pk_bf16(v0[0], v0[1]); w.y = cvt_pk_bf16(v0[2], v0[3]); w.z = cvt_pk_bf16(v1[0], v1[1]); w.w = cvt_pk_bf16(v1[2], v1[3]);
                    *(u32x4*)(rowp + bj * HALF) = w; } }
    }
};
struct EpiF32 {
    static constexpr bool PERM = false;
    float* C; int ldc;
    __device__ __forceinline__ void operator()(const f32x4 (&acc)[2][2][4][2], const Unit& u, int wr, int wc, int fr, int fq) const {
        const int row0 = u.pm * BM + wr * 64 + fr, col0 = u.pn * BM + wc * 32 + 4 * fq;
#pragma unroll
        for (int ai = 0; ai < 2; ++ai)
#pragma unroll
            for (int m = 0; m < 4; ++m) { float* rowp = C + (size_t)(row0 + ai * HALF + m * 16) * ldc + col0;
#pragma unroll
                for (int bj = 0; bj < 2; ++bj)
#pragma unroll
                    for (int n = 0; n < 2; ++n) *(f32x4*)(rowp + bj * HALF + n * 16) = acc[ai][bj][m][n]; }
    }
};
struct EpiResid {
    static constexpr bool PERM = false;
    const float* X; float* Z; int ldc; float alpha;
    __device__ __forceinline__ void operator()(const f32x4 (&acc)[2][2][4][2], const Unit& u, int wr, int wc, int fr, int fq) const {
        const int row0 = u.pm * BM + wr * 64 + fr, col0 = u.pn * BM + wc * 32 + 4 * fq;
#pragma unroll
        for (int ai = 0; ai < 2; ++ai)
#pragma unroll
            for (int m = 0; m < 4; ++m) { const size_t off = (size_t)(row0 + ai * HALF + m * 16) * ldc + col0;
#pragma unroll
                for (int bj = 0; bj < 2; ++bj)
#pragma unroll
                    for (int n = 0; n < 2; ++n) { const f32x4 xv = *(const f32x4*)(X + off + bj * HALF + n * 16); *(f32x4*)(Z + off + bj * HALF + n * 16) = xv * alpha + acc[ai][bj][m][n]; }
                asm volatile("" ::: "memory"); }
    }
};
struct EpiQRope {
    static constexpr bool PERM = true;
    bf16_t* O; int ldc; const float* cosT; const float* sinT; float scale;
    __device__ __forceinline__ void operator()(const f32x4 (&acc)[2][2][4][2], const Unit& u, int wr, int wc, int fr, int fq) const {
        const int row0 = u.pm * BM + wr * 64 + fr, col0 = u.pn * BM + wc * 32 + 8 * fq;
#pragma unroll
        for (int ai = 0; ai < 2; ++ai)
#pragma unroll
            for (int m = 0; m < 4; ++m) { const unsigned row = (unsigned)(row0 + ai * HALF + m * 16);
#pragma unroll
                for (int bj = 0; bj < 2; ++bj) { f32x4 v0 = acc[ai][bj][m][0] * scale, v1 = acc[ai][bj][m][1] * scale;
                    const int col = col0 + bj * HALF, rr = col % AQD;
                    if (rr >= ANOPE) { const unsigned tb = (row * 32u + (unsigned)((rr - ANOPE) >> 1)) * 4u;
                        const f32x4 c = *(const f32x4*)((const char*)cosT + tb), s = *(const f32x4*)((const char*)sinT + tb);
                        const f32x4 a0 = v0, a1 = v1;
                        v0[0] = a0[0] * c[0] - a0[1] * s[0]; v0[1] = a0[1] * c[0] + a0[0] * s[0]; v0[2] = a0[2] * c[1] - a0[3] * s[1]; v0[3] = a0[3] * c[1] + a0[2] * s[1];
                        v1[0] = a1[0] * c[2] - a1[1] * s[2]; v1[1] = a1[1] * c[2] + a1[0] * s[2]; v1[2] = a1[2] * c[3] - a1[3] * s[3]; v1[3] = a1[3] * c[3] + a1[2] * s[3]; }
                    u32x4 w; w.x = cvt_pk_bf16(v0[0], v0[1]); w.y = cvt_pk_bf16(v0[2], v0[3]); w.z = cvt_pk_bf16(v1[0], v1[1]); w.w = cvt_pk_bf16(v1[2], v1[3]);
                    *(u32x4*)((char*)O + ((size_t)row * (unsigned)ldc + (unsigned)col) * 2u) = w; }
                asm volatile("" ::: "memory"); }
    }
};
struct EpiSwiglu {
    static constexpr bool PERM = true;
    bf16_t* Hh; const float* bgu;
    __device__ __forceinline__ void operator()(const f32x4 (&acc)[2][2][4][2], const Unit& u, int wr, int wc, int fr, int fq) const {
        const int row0 = u.pm * BM + wr * 64 + fr, j0 = u.pn * HALF + wc * 32 + 8 * fq;
        const float* bp = bgu + (size_t)u.aux * 2048 + 2 * j0;
        const f32x4 b0 = *(const f32x4*)(bp), b1 = *(const f32x4*)(bp + 4), b2 = *(const f32x4*)(bp + 8), b3 = *(const f32x4*)(bp + 12);
        const float bg[8] = {b0[0], b0[2], b1[0], b1[2], b2[0], b2[2], b3[0], b3[2]}, bl[8] = {b0[1], b0[3], b1[1], b1[3], b2[1], b2[3], b3[1], b3[3]};
#pragma unroll
        for (int ai = 0; ai < 2; ++ai)
#pragma unroll
            for (int m = 0; m < 4; ++m) { bf16_t* rowp = Hh + (size_t)(row0 + ai * HALF + m * 16) * DFF + j0;
                float o[8];
#pragma unroll
                for (int q = 0; q < 8; ++q) { float g = acc[ai][0][m][q >> 2][q & 3] + bg[q], l = acc[ai][1][m][q >> 2][q & 3] + bl[q];
                    g = fminf(g, 7.0f); l = fminf(fmaxf(l, -7.0f), 7.0f);
                    const float sg = __builtin_amdgcn_rcpf(1.0f + __builtin_amdgcn_exp2f(-1.702f * 1.4426950408889634f * g));
                    o[q] = (l + 1.0f) * g * sg; }
                u32x4 w; w.x = cvt_pk_bf16(o[0], o[1]); w.y = cvt_pk_bf16(o[2], o[3]); w.z = cvt_pk_bf16(o[4], o[5]); w.w = cvt_pk_bf16(o[6], o[7]);
                *(u32x4*)rowp = w; }
    }
};
struct EpiDown {
    static constexpr bool PERM = true;
    bf16_t* Y; const float* bd;
    __device__ __forceinline__ void operator()(const f32x4 (&acc)[2][2][4][2], const Unit& u, int wr, int wc, int fr, int fq) const {
        const int row0 = u.pm * BM + wr * 64 + fr, col0 = u.pn * BM + wc * 32 + 8 * fq;
        f32x4 bv[2][2];
#pragma unroll
        for (int bj = 0; bj < 2; ++bj)
#pragma unroll
            for (int n = 0; n < 2; ++n) bv[bj][n] = *(const f32x4*)(bd + (size_t)u.aux * D + col0 + bj * HALF + 4 * n);
#pragma unroll
        for (int ai = 0; ai < 2; ++ai)
#pragma unroll
            for (int m = 0; m < 4; ++m) { bf16_t* rowp = Y + (size_t)(row0 + ai * HALF + m * 16) * D + col0;
#pragma unroll
                for (int bj = 0; bj < 2; ++bj) { const f32x4 v0 = acc[ai][bj][m][0] + bv[bj][0], v1 = acc[ai][bj][m][1] + bv[bj][1];
                    u32x4 w; w.x = cvt_pk_bf16(v0[0], v0[1]); w.y = cvt_pk_bf16(v0[2], v0[3]); w.z = cvt_pk_bf16(v1[0], v1[1]); w.w = cvt_pk_bf16(v1[2], v1[3]);
                    *(u32x4*)(rowp + bj * HALF) = w; } }
    }
};

struct DenseOrder {
    const char* A; const char* Bt; int nM, nN, G, c; size_t astep, bstep;
    __device__ __forceinline__ void init(const void* A_, const void* Bt_, int M, int N, int lda, int ldb, int G_, int c_) { A = (const char*)A_; Bt = (const char*)Bt_; nM = M / BM; nN = N / BM; G = G_; c = c_; astep = (size_t)BM * lda * 2; bstep = (size_t)BM * ldb * 2; }
    __device__ __forceinline__ bool next(int i, Unit& u) const {
        const int L = i * G + c; if (L >= nM * nN) return false;
        u.pm = L / nN; u.pn = L - u.pm * nN; u.aux = 0; u.nvalid = 256; u.A = A + (size_t)u.pm * astep; u.B = Bt + (size_t)u.pn * bstep; u.rows = nullptr; return true;
    }
};
struct MoeOrder {
    const volatile LAS int* ntp; const char* A; const char* W; const int* list; const unsigned* cnt; int NC, G, c; size_t wstep_e, astep;
    bool gather;
    __device__ __forceinline__ bool next(int i, Unit& u) const {
        const int L = i * G + c; const int NT = ntp[32]; if (L >= NT * NC) return false;
        const int rt = L / NC, pn = L - rt * NC; int e = 0;
        for (int k = 1; k < 32; ++k) e += (rt >= ntp[k]) ? 1 : 0;
        e = __builtin_amdgcn_readfirstlane(e);
        const int rtl = rt - ntp[e];
        u.pm = rt; u.pn = pn; u.aux = e; u.B = W + (size_t)e * wstep_e + (size_t)pn * astep;
        const int c_e = (int)__hip_atomic_load(cnt + e * 64, __ATOMIC_RELAXED, __HIP_MEMORY_SCOPE_AGENT);
        int nv = c_e - rtl * 256; u.nvalid = __builtin_amdgcn_readfirstlane(nv > 256 ? 256 : nv);
        if (gather) { u.A = A; u.rows = list + (size_t)e * T + (size_t)rtl * 256; } else { u.A = A + (size_t)rt * (size_t)(256 * D * 2); u.rows = nullptr; }
        return true;
    }
};
}
struct Args { const void* in[20]; float* out; unsigned char* ws; int ph_lo, ph_hi; };
struct Frame {
    LAS unsigned char* lds; volatile LAS unsigned* MISC;
    int tid, lane, wave, vcu, G;
    __device__ __forceinline__ const void* ptr(int i) const { const unsigned lo = __builtin_amdgcn_readfirstlane(MISC[128 + 2 * i]), hi = __builtin_amdgcn_readfirstlane(MISC[129 + 2 * i]); return (const void*)(((unsigned long long)hi << 32) | lo); }
    __device__ __forceinline__ unsigned char* ws() const { return (unsigned char*)ptr(21); }
    __device__ __forceinline__ float* out() const { return (float*)ptr(20); }
    __device__ __forceinline__ unsigned* ctl() const { return (unsigned*)ptr(21); }
};
__device__ __forceinline__ Frame refresh(const Frame& F) {
    Frame R = F; int ln, w = F.wave, v = F.vcu, g = F.G;
    asm volatile("v_mbcnt_lo_u32_b32 %0, -1, 0\n\tv_mbcnt_hi_u32_b32 %0, -1, %0" : "=v"(ln));
    asm volatile("" : "+s"(w), "+s"(v), "+s"(g));
    R.tid = w * 64 + ln; R.lane = ln; R.wave = w; R.vcu = v; R.G = g; return R;
}
enum { IN_X = 0, IN_POS, IN_LNG, IN_LNB, IN_MWIN, IN_MBG, IN_MNG, IN_MWOUT, IN_AWIN, IN_AQN, IN_AKVN, IN_AWQB, IN_AWKVB, IN_AWOUT, IN_RW, IN_RB, IN_WGU, IN_BGU, IN_WD, IN_BD };

template <class RowMap>
__device__ __forceinline__ void transpose_item(const float* __restrict__ W, int ldw, int K, bf16_t* __restrict__ WT, LAS float* scr, int kb, int nb, int lane, RowMap rm) {
    const int k0 = 64 * kb, n0 = 32 * nb;
#pragma unroll 8
    for (int i = 0; i < 32; ++i) { const int kk = 2 * i + (lane >> 5); scr[kk * 33 + (lane & 31)] = W[(size_t)(k0 + kk) * ldw + n0 + (lane & 31)]; }
    LDS_WAIT();
    const int c = lane & 7;
#pragma unroll
    for (int j = 0; j < 4; ++j) { const int n = (lane >> 3) + 8 * j; const LAS float* s = scr + (8 * c) * 33 + n;
        u32x4 o; o.x = cvt_pk_bf16(s[0 * 33], s[1 * 33]); o.y = cvt_pk_bf16(s[2 * 33], s[3 * 33]); o.z = cvt_pk_bf16(s[4 * 33], s[5 * 33]); o.w = cvt_pk_bf16(s[6 * 33], s[7 * 33]);
        const int dr = rm(n0 + n);
        *(u32x4*)(WT + (size_t)dr * K + k0 + 8 * c) = o; }
    LDS_WAIT();
}
struct RmId { __device__ __forceinline__ int operator()(int n) const { return n; } };
struct RmQb { __device__ __forceinline__ int operator()(int n) const { const int hh = n / AQD, r = n - hh * AQD; if (r < ANOPE) return n; const int i = r - ANOPE; return hh * AQD + ANOPE + ((i < 32) ? 2 * i : 2 * (i - 32) + 1); } };
struct RmKv { __device__ __forceinline__ int operator()(int n) const { const int hh = n >> 8, r = n & 255; return (r < 128) ? hh * 128 + r : 1024 + hh * 128 + (r - 128); } };
struct RmGu { __device__ __forceinline__ int operator()(int n) const { const int j = n >> 1, l = n & 1; return (j >> 7) * 256 + l * 128 + (j & 127); } };

__device__ __forceinline__ void p0_prologue(const Frame& F) {
    LAS float* scr = (LAS float*)(F.lds + F.wave * 8704);
    const int gw = F.vcu * NWAVES + F.wave, NGW = F.G * NWAVES, lane = F.lane;
    unsigned char* ws = F.ws();
    constexpr int I_MWIN = 16 * 96, I_SQ = 16 * 32, I_AWIN = 16 * 22, I_QB = 6 * 48, I_KV = 4 * 64, I_GU = 16 * 64, I_D = 16 * 32;
    constexpr int N_SMALL = 2 * (I_MWIN + I_SQ + I_AWIN + I_QB + I_KV + I_SQ);
    constexpr int N_GU = 128 * I_GU, N_D = 128 * I_D, NITEMS = N_SMALL + N_GU + N_D;
    for (int it = gw; it < NITEMS; it += NGW) {
        int r = it;
        if (r >= N_SMALL) {
            r -= N_SMALL;
            if (r < N_GU) { const int mtx = r >> 10, q = r & 1023; transpose_item((const float*)F.ptr(IN_WGU) + (size_t)mtx * 1024 * 2048, 2048, 1024, (bf16_t*)(ws + WS_WGU) + (size_t)mtx * 2048 * 1024, scr, q >> 6, q & 63, lane, RmGu()); }
            else { r -= N_GU; const int mtx = r >> 9, q = r & 511; transpose_item((const float*)F.ptr(IN_WD) + (size_t)mtx * 1024 * 1024, 1024, 1024, (bf16_t*)(ws + WS_WD) + (size_t)mtx * 1024 * 1024, scr, q >> 5, q & 31, lane, RmId()); }
            continue;
        }
        const int j = (r >= N_SMALL / 2) ? 1 : 0; r -= j * (N_SMALL / 2);
        if (r < I_MWIN) { transpose_item((const float*)F.ptr(IN_MWIN) + (size_t)j * 1024 * MIN_, MIN_, 1024, (bf16_t*)(ws + WS_WINM) + (size_t)j * 3072 * 1024, scr, r / 96, r % 96, lane, RmId()); continue; } r -= I_MWIN;
        if (r < I_SQ) { transpose_item((const float*)F.ptr(IN_MWOUT) + (size_t)j * 1024 * 1024, 1024, 1024, (bf16_t*)(ws + WS_WOUTM) + (size_t)j * 1024 * 1024, scr, r >> 5, r & 31, lane, RmId()); continue; } r -= I_SQ;
        if (r < I_AWIN) { transpose_item((const float*)F.ptr(IN_AWIN) + (size_t)j * 1024 * AIN, AIN, 1024, (bf16_t*)(ws + WS_WINA) + (size_t)j * AINP * 1024, scr, r / 22, r % 22, lane, RmId()); continue; } r -= I_AWIN;
        if (r < I_QB) { transpose_item((const float*)F.ptr(IN_AWQB) + (size_t)j * AQL * 1536, 1536, AQL, (bf16_t*)(ws + WS_WQB) + (size_t)j * 1536 * AQL, scr, r / 48, r % 48, lane, RmQb()); continue; } r -= I_QB;
        if (r < I_KV) { transpose_item((const float*)F.ptr(IN_AWKVB) + (size_t)j * AKL * 2048, 2048, AKL, (bf16_t*)(ws + WS_WKV) + (size_t)j * 2048 * AKL, scr, r >> 6, r & 63, lane, RmKv()); continue; } r -= I_KV;
        transpose_item((const float*)F.ptr(IN_AWOUT) + (size_t)j * 1024 * 1024, 1024, 1024, (bf16_t*)(ws + WS_WOUTA) + (size_t)j * 1024 * 1024, scr, r >> 5, r & 31, lane, RmId());
    }
    { const int gt = F.vcu * NTHR + F.tid, NGT = F.G * NTHR;
      for (int i = gt; i < 2 * 64 * 1024 / 8; i += NGT) { const int j = i / (64 * 1024 / 8), q = i - j * (64 * 1024 / 8);
          *(u32x4*)((bf16_t*)(ws + WS_WINA) + (size_t)j * AINP * 1024 + (size_t)AIN * 1024 + (size_t)q * 8) = (u32x4){0u, 0u, 0u, 0u}; }
      const float* x = (const float*)F.ptr(IN_X); bf16_t* xb = (bf16_t*)(ws + WS_XB);
      for (size_t i = gt; i < (size_t)T * D / 8; i += NGT) { const f32x4 v0 = *(const f32x4*)(x + i * 8), v1 = *(const f32x4*)(x + i * 8 + 4);
          u32x4 w; w.x = cvt_pk_bf16(v0[0], v0[1]); w.y = cvt_pk_bf16(v0[2], v0[3]); w.z = cvt_pk_bf16(v1[0], v1[1]); w.w = cvt_pk_bf16(v1[2], v1[3]); *(u32x4*)(xb + i * 8) = w; }
      const int* pos = (const int*)F.ptr(IN_POS); float* ct = (float*)(ws + WS_COS); float* st = (float*)(ws + WS_SIN);
      for (int i = gt; i < T * 32; i += NGT) { const int m = i >> 5, k = i & 31;
          const float inv = exp2f(-(float)(2 * k) * (13.287712379549449f / 64.0f));
          const float ang = (float)pos[m] * inv;
          const double rev = (double)ang * 0.15915494309189535; const float fr = (float)(rev - floor(rev));
          ct[i] = __builtin_amdgcn_cosf(fr); st[i] = __builtin_amdgcn_sinf(fr); }
    }
}

template <int NEX>
__device__ __forceinline__ void skinny_fill(const Frame& F, const float* __restrict__ W, int ldw) {
    LAS float* wl = (LAS float*)F.lds;
    for (int idx = F.tid; idx < 1024 * NEX; idx += NTHR) { const int k = idx / NEX, e = idx % NEX; wl[((k >> 2) * NEX + e) * 4 + (k & 3)] = W[(size_t)k * ldw + e]; }
    __syncthreads();
}
__device__ __forceinline__ void gates_phase(const Frame& F, const float* __restrict__ X, const float* __restrict__ bg, float* __restrict__ Gt) {
    const LAS f32x4* wl = (const LAS f32x4*)F.lds;
    const int tok = F.lane & 15, kq = F.lane >> 4;
    const f32x4 bias = *(const f32x4*)(bg + 4 * kq);
    for (int grp = F.vcu * NWAVES + F.wave; grp < T / 16; grp += F.G * NWAVES) {
        const int m0 = grp * 16; const float* xr = X + (size_t)(m0 + tok) * D + 4 * kq;
        f32x4 acc0 = {0.f, 0.f, 0.f, 0.f}, acc1 = {0.f, 0.f, 0.f, 0.f};
#pragma unroll 4
        for (int i = 0; i < 64; i += 2) {
            const f32x4 x0 = *(const f32x4*)(xr + 16 * i), x1 = *(const f32x4*)(xr + 16 * (i + 1));
            const f32x4 w0 = wl[(i * 4 + kq) * 16 + tok], w1 = wl[((i + 1) * 4 + kq) * 16 + tok];
#pragma unroll
            for (int j = 0; j < 4; ++j) { acc0 = __builtin_amdgcn_mfma_f32_16x16x4f32(w0[j], x0[j], acc0, 0, 0, 0); acc1 = __builtin_amdgcn_mfma_f32_16x16x4f32(w1[j], x1[j], acc1, 0, 0, 0); }
        }
        *(f32x4*)(Gt + (size_t)(m0 + tok) * 16 + 4 * kq) = acc0 + acc1 + bias;
    }
}

template <int MODE>
__device__ __forceinline__ void ln_phase(const Frame& F, int layer, bool is_last) {
    unsigned char* ws = F.ws();
    const float* ZF = (const float*)(ws + WS_ZF); float* XF = (float*)(ws + WS_XF); bf16_t* XB = (bf16_t*)(ws + WS_XB);
    const float* lng = (const float*)F.ptr(IN_LNG) + (size_t)(layer * 2 + MODE) * D; const float* lnb = (const float*)F.ptr(IN_LNB) + (size_t)(layer * 2 + MODE) * D;
    const int lane = F.lane, tok = lane & 15, kq = lane >> 4;
    unsigned* cnt = F.ctl() + CW_CNT + layer * 32 * 64;
    const int* tokinfo = (const int*)(ws + WS_TOKINFO); const float* tokgate = (const float*)(ws + WS_TOKGATE);
    volatile LAS int* ntp = (volatile LAS int*)(F.MISC + 16); volatile LAS unsigned* hist = F.MISC + 64; volatile LAS unsigned* hbase = F.MISC + 96;
    if (MODE == 0) { skinny_fill<32>(F, (const float*)F.ptr(IN_RW) + (size_t)layer * D * NE, NE); if (F.tid < 32) hist[F.tid] = 0u; __syncthreads(); }
    f32x4 gv[4], bv[4];
#pragma unroll
    for (int j = 0; j < 4; ++j) { gv[j] = *(const f32x4*)(lng + 4 * lane + 256 * j); bv[j] = *(const f32x4*)(lnb + 4 * lane + 256 * j); }
    float* OUT = is_last ? F.out() : XF;
    for (int grp = F.vcu; grp < T / 128; grp += F.G) {
        const int m0 = grp * 128 + F.wave * 16;
        float mu_l = 0.f, rs_l = 0.f;
        for (int r = 0; r < 16; ++r) {
            const int m = m0 + r; f32x4 v[4];
            if (MODE == 0) {
#pragma unroll
                for (int j = 0; j < 4; ++j) v[j] = *(const f32x4*)(ZF + (size_t)m * D + 4 * lane + 256 * j);
            } else {
#pragma unroll
                for (int j = 0; j < 4; ++j) v[j] = *(const f32x4*)(XF + (size_t)m * D + 4 * lane + 256 * j) * DN_ALPHA;
#pragma unroll
                for (int k = 0; k < 4; ++k) { const int inf = __builtin_amdgcn_readfirstlane(tokinfo[m * 4 + k]); const float g = __uint_as_float(__builtin_amdgcn_readfirstlane(__float_as_uint(tokgate[m * 4 + k])));
                    const int e = inf >> 20, pos = inf & 0xfffff; const size_t prow = (size_t)ntp[e] * 256 + pos; const bf16_t* yr = (const bf16_t*)(ws + WS_YMOE) + prow * D + 4 * lane;
#pragma unroll
                    for (int j = 0; j < 4; ++j) { const u32x2 w = *(const u32x2*)(yr + 256 * j); v[j][0] += g * bf_lo(w.x); v[j][1] += g * bf_hi(w.x); v[j][2] += g * bf_lo(w.y); v[j][3] += g * bf_hi(w.y); } }
            }
            float s = 0.f;
#pragma unroll
            for (int j = 0; j < 4; ++j) s += (v[j][0] + v[j][1]) + (v[j][2] + v[j][3]);
            const float mean = wave_sum(s) * (1.f / D); float s2 = 0.f;
#pragma unroll
            for (int j = 0; j < 4; ++j) { v[j] = v[j] - mean; s2 += (v[j][0] * v[j][0] + v[j][1] * v[j][1]) + (v[j][2] * v[j][2] + v[j][3] * v[j][3]); }
            const float rstd = 1.f / sqrtf(wave_sum(s2) * (1.f / D) + LN_EPS);
            if (tok == r) { mu_l = mean; rs_l = rstd; }
#pragma unroll
            for (int j = 0; j < 4; ++j) { const f32x4 y = v[j] * rstd * gv[j] + bv[j]; *(f32x4*)(OUT + (size_t)m * D + 4 * lane + 256 * j) = y;
                u32x2 w; w.x = cvt_pk_bf16(y[0], y[1]); w.y = cvt_pk_bf16(y[2], y[3]); *(u32x2*)(XB + (size_t)m * D + 4 * lane + 256 * j) = w; }
        }
        if (MODE == 0) {
            const LAS f32x4* wl = (const LAS f32x4*)F.lds;
            const float* zr = ZF + (size_t)(m0 + tok) * D + 4 * kq;
            f32x4 acc0 = {0.f, 0.f, 0.f, 0.f}, acc1 = {0.f, 0.f, 0.f, 0.f};
#pragma unroll 2
            for (int i = 0; i < 64; ++i) {
                const f32x4 z = *(const f32x4*)(zr + 16 * i), g4 = *(const f32x4*)(lng + 16 * i + 4 * kq), b4 = *(const f32x4*)(lnb + 16 * i + 4 * kq);
                const f32x4 xn = (z - mu_l) * rs_l * g4 + b4;
                const f32x4 w0 = wl[(i * 4 + kq) * 32 + tok], w1 = wl[(i * 4 + kq) * 32 + 16 + tok];
#pragma unroll
                for (int j = 0; j < 4; ++j) { acc0 = __builtin_amdgcn_mfma_f32_16x16x4f32(w0[j], xn[j], acc0, 0, 0, 0); acc1 = __builtin_amdgcn_mfma_f32_16x16x4f32(w1[j], xn[j], acc1, 0, 0, 0); }
            }
            const float* rb = (const float*)F.ptr(IN_RB) + layer * NE;
            float lv[8]; int used = 0;
#pragma unroll
            for (int r = 0; r < 4; ++r) { lv[r] = acc0[r] + rb[4 * kq + r]; lv[4 + r] = acc1[r] + rb[16 + 4 * kq + r]; }
            float tv[4]; int ti[4];
#pragma unroll
            for (int k = 0; k < 4; ++k) {
                float bvv = -3.0e38f; int bi = 64, bslot = -1;
#pragma unroll
                for (int q = 0; q < 8; ++q) { const int idx = (q < 4) ? 4 * kq + q : 16 + 4 * kq + (q - 4); const bool ok = !((used >> q) & 1) && (lv[q] > bvv || (lv[q] == bvv && idx < bi)); if (ok) { bvv = lv[q]; bi = idx; bslot = q; } }
                float gvv = bvv; int gi = bi;
#pragma unroll
                for (int o = 16; o <= 32; o <<= 1) { const float ov = __shfl_xor(gvv, o); const int oi = __shfl_xor(gi, o); if (ov > gvv || (ov == gvv && oi < gi)) { gvv = ov; gi = oi; } }
                if (gi == bi && bslot >= 0) used |= (1 << bslot);
                tv[k] = gvv; ti[k] = gi;
            }
            const float e1 = __expf(tv[1] - tv[0]), e2 = __expf(tv[2] - tv[0]), e3 = __expf(tv[3] - tv[0]); const float inv = 1.f / (1.f + e1 + e2 + e3);
            const float myg = (kq == 0 ? 1.f : kq == 1 ? e1 : kq == 2 ? e2 : e3) * inv; const int mye = (kq == 0 ? ti[0] : kq == 1 ? ti[1] : kq == 2 ? ti[2] : ti[3]);
            const unsigned rank = __hip_atomic_fetch_add((LAS unsigned*)(hist + mye), 1u, __ATOMIC_RELAXED, __HIP_MEMORY_SCOPE_WORKGROUP);
            __syncthreads();
            if (F.tid < 32) { const unsigned c = hist[F.tid]; hbase[F.tid] = __hip_atomic_fetch_add(cnt + F.tid * 64, c, __ATOMIC_RELAXED, __HIP_MEMORY_SCOPE_AGENT); hist[F.tid] = 0u; }
            __syncthreads();
            const unsigned pos = hbase[mye] + rank; const int m = m0 + tok;
            ((int*)(ws + WS_TOKINFO))[m * 4 + kq] = (mye << 20) | (int)pos; ((float*)(ws + WS_TOKGATE))[m * 4 + kq] = myg;
            ((int*)(ws + WS_LIST))[(size_t)mye * T + pos] = m;
        }
    }
}

__device__ __forceinline__ void moe_prefix(const Frame& F, int layer) {
    volatile LAS int* ntp = (volatile LAS int*)(F.MISC + 16);
    __syncthreads();
    if (F.tid == 0) { unsigned* cnt = F.ctl() + CW_CNT + layer * 32 * 64; int acc = 0;
        for (int e = 0; e < 32; ++e) { ntp[e] = acc; acc += ((int)__hip_atomic_load(cnt + e * 64, __ATOMIC_RELAXED, __HIP_MEMORY_SCOPE_AGENT) + 255) >> 8; } ntp[32] = acc; }
    __syncthreads();
}

__device__ __forceinline__ void mla_norm_phase(const Frame& F, int j) {
    unsigned char* ws = F.ws(); const float* A32 = (const float*)(ws + WS_A32);
    bf16_t* CQ = (bf16_t*)(ws + WS_CQ); bf16_t* CKV = (bf16_t*)(ws + WS_CKV); bf16_t* KR = (bf16_t*)(ws + WS_KR);
    const float* qn = (const float*)F.ptr(IN_AQN) + j * AQL; const float* kvn = (const float*)F.ptr(IN_AKVN) + j * AKL;
    const float* ct = (const float*)(ws + WS_COS); const float* st = (const float*)(ws + WS_SIN);
    const int lane = F.lane;
    for (int m = F.vcu * NWAVES + F.wave; m < T; m += F.G * NWAVES) {
        const float* ar = A32 + (size_t)m * AINP;
        f32x4 q0 = {0.f, 0.f, 0.f, 0.f}, q1 = q0, k0 = q0, k1 = q0; float sq = 0.f, sk = 0.f;
        if (lane < 48) { q0 = *(const f32x4*)(ar + 8 * lane); q1 = *(const f32x4*)(ar + 8 * lane + 4); sq = (q0[0] * q0[0] + q0[1] * q0[1]) + (q0[2] * q0[2] + q0[3] * q0[3]) + (q1[0] * q1[0] + q1[1] * q1[1]) + (q1[2] * q1[2] + q1[3] * q1[3]); }
        if (lane < 32) { k0 = *(const f32x4*)(ar + AQL + 8 * lane); k1 = *(const f32x4*)(ar + AQL + 8 * lane + 4); sk = (k0[0] * k0[0] + k0[1] * k0[1]) + (k0[2] * k0[2] + k0[3] * k0[3]) + (k1[0] * k1[0] + k1[1] * k1[1]) + (k1[2] * k1[2] + k1[3] * k1[3]); }
        const float rq = 1.f / sqrtf(wave_sum(sq) * (1.f / AQL) + RMS_EPS), rk = 1.f / sqrtf(wave_sum(sk) * (1.f / AKL) + RMS_EPS);
        if (lane < 48) { const f32x4 g0 = *(const f32x4*)(qn + 8 * lane), g1 = *(const f32x4*)(qn + 8 * lane + 4); const f32x4 y0 = q0 * rq * g0, y1 = q1 * rq * g1;
            u32x4 w; w.x = cvt_pk_bf16(y0[0], y0[1]); w.y = cvt_pk_bf16(y0[2], y0[3]); w.z = cvt_pk_bf16(y1[0], y1[1]); w.w = cvt_pk_bf16(y1[2], y1[3]); *(u32x4*)(CQ + (size_t)m * AQL + 8 * lane) = w; }
        if (lane < 32) { const f32x4 g0 = *(const f32x4*)(kvn + 8 * lane), g1 = *(const f32x4*)(kvn + 8 * lane + 4); const f32x4 y0 = k0 * rk * g0, y1 = k1 * rk * g1;
            u32x4 w; w.x = cvt_pk_bf16(y0[0], y0[1]); w.y = cvt_pk_bf16(y0[2], y0[3]); w.z = cvt_pk_bf16(y1[0], y1[1]); w.w = cvt_pk_bf16(y1[2], y1[3]); *(u32x4*)(CKV + (size_t)m * AKL + 8 * lane) = w;
            const float x1 = ar[AQL + AKL + lane], x2 = ar[AQL + AKL + 32 + lane], c = ct[(size_t)m * 32 + lane], s = st[(size_t)m * 32 + lane];
            *(unsigned*)(KR + (size_t)m * AROPE + 2 * lane) = cvt_pk_bf16(x1 * c - x2 * s, x2 * c + x1 * s); }
    }
}
constexpr int MT_STRIDE = 144;
__device__ __forceinline__ float log_sigmoid(float x) { return fminf(x, 0.f) - __logf(1.f + __expf(-fabsf(x))); }
__device__ __forceinline__ float wave_incl_scan_add(float v, int lane) {
#pragma unroll
    for (int o = 1; o < 64; o <<= 1) { const float t = __shfl_up(v, o); if (lane >= o) v += t; }
    return v;
}
__device__ __forceinline__ float wave_incl_scan_max(float v, int lane) {
#pragma unroll
    for (int o = 1; o < 64; o <<= 1) { const float t = __shfl_up(v, o); if (lane >= o) v = fmaxf(v, t); }
    return v;
}
template <int NCH>
__device__ __forceinline__ void stage_transposed(LAS unsigned char* tile, const bf16_t* __restrict__ src, int lane, float scale, bool do_scale) {
#pragma unroll
    for (int c = 0; c < NCH; ++c) { const u32x4 w = *(const u32x4*)(src + 8 * c); const unsigned ww[4] = {w.x, w.y, w.z, w.w};
#pragma unroll
        for (int p = 0; p < 4; ++p) { unsigned lo = ww[p] & 0xffffu, hi = ww[p] >> 16;
            if (do_scale) { const unsigned pk = cvt_pk_bf16(bf_lo(ww[p]) * scale, bf_hi(ww[p]) * scale); lo = pk & 0xffffu; hi = pk >> 16; }
            *(LAS bf16_t*)(tile + (8 * c + 2 * p) * MT_STRIDE + 2 * lane) = (bf16_t)lo; *(LAS bf16_t*)(tile + (8 * c + 2 * p + 1) * MT_STRIDE + 2 * lane) = (bf16_t)hi; } }
}

__device__ __forceinline__ void mlstm_local_phase(const Frame& F) {
    unsigned char* ws = F.ws(); const bf16_t* PROJ = (const bf16_t*)(ws + WS_PROJ); const float* Gt = (const float*)(ws + WS_GATES);
    float* CLOC = (float*)(ws + WS_CLOC); float* NLOC = (float*)(ws + WS_NLOC); float* GMAX = (float*)(ws + WS_MSC); float* BL = GMAX + MUNITS;
    const int lane = F.lane, c32 = lane & 31, hi = lane >> 5;
    LAS unsigned char* kt = F.lds + F.wave * (2 * 64 * MT_STRIDE); LAS unsigned char* vt = kt + 64 * MT_STRIDE;
    for (int it = F.vcu * NWAVES + F.wave; it < MUNITS * 2; it += F.G * NWAVES) {
        const int u = it >> 1, half = it & 1, c = u & (MNC - 1), bh = u >> 7, h = bh & 7, b = bh >> 3, m0 = b * SEQ + c * MCH;
        const int m = m0 + lane;
        const float ig = Gt[(size_t)m * 16 + h], lf = log_sigmoid(Gt[(size_t)m * 16 + 8 + h]);
        const float bc = wave_incl_scan_add(lf, lane), bl = __shfl(bc, 63);
        const float g = bl - bc + ig, gmax = wave_max(g), w = __expf(g - gmax);
        stage_transposed<8>(kt, PROJ + (size_t)m * 3072 + 512 + h * 64, lane, w, true);
        stage_transposed<8>(vt, PROJ + (size_t)m * 3072 + 1024 + h * 128 + half * 64, lane, 1.f, false);
        LDS_WAIT();
        f32x16 acc[2][2];
#pragma unroll
        for (int i = 0; i < 2; ++i)
#pragma unroll
            for (int j = 0; j < 2; ++j)
#pragma unroll
                for (int r = 0; r < 16; ++r) acc[i][j][r] = 0.f;
#pragma unroll
        for (int ks = 0; ks < 4; ++ks) {
            bf16x8 af[2], bfr[2];
#pragma unroll
            for (int i = 0; i < 2; ++i) { af[i] = *(const LAS bf16x8*)(vt + (32 * i + c32) * MT_STRIDE + (16 * ks + 8 * hi) * 2); bfr[i] = *(const LAS bf16x8*)(kt + (32 * i + c32) * MT_STRIDE + (16 * ks + 8 * hi) * 2); }
#pragma unroll
            for (int i = 0; i < 2; ++i)
#pragma unroll
                for (int j = 0; j < 2; ++j) acc[i][j] = __builtin_amdgcn_mfma_f32_32x32x16_bf16(af[i], bfr[j], acc[i][j], 0, 0, 0);
        }
        float* cl = CLOC + (size_t)u * (MDV * MDK);
#pragma unroll
        for (int i = 0; i < 2; ++i)
#pragma unroll
            for (int j = 0; j < 2; ++j)
#pragma unroll
                for (int r = 0; r < 16; ++r) { const int dv = half * 64 + 32 * i + (r & 3) + 8 * (r >> 2) + 4 * hi; cl[dv * MDK + 32 * j + c32] = acc[i][j][r]; }
        if (half == 0) {
            float s = 0.f;
#pragma unroll
            for (int q = 0; q < 8; ++q) { const u32x4 w4 = *(const LAS u32x4*)(kt + lane * MT_STRIDE + 16 * q); s += (bf_lo(w4.x) + bf_hi(w4.x)) + (bf_lo(w4.y) + bf_hi(w4.y)) + (bf_lo(w4.z) + bf_hi(w4.z)) + (bf_lo(w4.w) + bf_hi(w4.w)); }
            NLOC[(size_t)u * MDK + lane] = s;
            if (lane == 0) { GMAX[u] = gmax; BL[u] = bl; }
        }
        LDS_WAIT();
    }
}

__device__ __forceinline__ void mlstm_scan_phase(const Frame& F) {
    unsigned char* ws = F.ws(); const float* __restrict__ CLOC = (const float*)(ws + WS_CLOC); const float* __restrict__ NLOC = (const float*)(ws + WS_NLOC);
    const float* __restrict__ GMAX = (const float*)(ws + WS_MSC); const float* __restrict__ BL = GMAX + MUNITS; float* __restrict__ MPREV = (float*)(ws + WS_MSC) + 2 * MUNITS;
    bf16_t* __restrict__ CPREV = (bf16_t*)(ws + WS_CPREV); float* __restrict__ NPREV = (float*)(ws + WS_NPREV);
    constexpr int PER = MDV * MDK / 2;
    for (int it = F.vcu * NTHR + F.tid; it < NB * MH * PER; it += F.G * NTHR) {
        const int bh = it / PER, e = it - bh * PER; const bool hasn = e < 32; const int eo = e * 2;
        float c0 = 0.f, c1 = 0.f, n0 = 0.f, n1 = 0.f, mm = 0.f;
        for (int cb = 0; cb < MNC; cb += 8) {
            f32x2 loc[8], nl[8]; float gm[8], bl[8];
#pragma unroll
            for (int k = 0; k < 8; ++k) { const int u = bh * MNC + cb + k; loc[k] = *(const f32x2*)(CLOC + (size_t)u * (MDV * MDK) + eo); gm[k] = GMAX[u]; bl[k] = BL[u];
                nl[k] = hasn ? *(const f32x2*)(NLOC + (size_t)u * MDK + eo) : (f32x2){0.f, 0.f}; }
#pragma unroll
            for (int k = 0; k < 8; ++k) { const int u = bh * MNC + cb + k;
                const float mnew = fmaxf(bl[k] + mm, gm[k]), dec = __expf(bl[k] + mm - mnew), sc = __expf(gm[k] - mnew);
                *(unsigned*)(CPREV + (size_t)u * (MDV * MDK) + eo) = cvt_pk_bf16(c0, c1);
                if (hasn) { *(f32x2*)(NPREV + (size_t)u * MDK + eo) = (f32x2){n0, n1}; if (e == 0) MPREV[u] = mm; }
                c0 = dec * c0 + sc * loc[k].x; c1 = dec * c1 + sc * loc[k].y; n0 = dec * n0 + sc * nl[k].x; n1 = dec * n1 + sc * nl[k].y; mm = mnew; }
        }
    }
}

__device__ __forceinline__ void mlstm_out_phase(const Frame& F, const float* __restrict__ gain) {
    unsigned char* ws = F.ws(); const bf16_t* PROJ = (const bf16_t*)(ws + WS_PROJ); const float* Gt = (const float*)(ws + WS_GATES);
    const bf16_t* CPREV = (const bf16_t*)(ws + WS_CPREV); const float* NPREV = (const float*)(ws + WS_NPREV); const float* MPREV = (const float*)(ws + WS_MSC) + 2 * MUNITS;
    bf16_t* HB = (bf16_t*)(ws + WS_HB);
    const int lane = F.lane, c32 = lane & 31, hi = lane >> 5;
    LAS unsigned char* vt = F.lds + F.wave * (128 * MT_STRIDE);
    for (int it = F.vcu * NWAVES + F.wave; it < MUNITS * 2; it += F.G * NWAVES) {
        const int u = it >> 1, tb = it & 1, c = u & (MNC - 1), bh = u >> 7, h = bh & 7, b = bh >> 3, m0 = b * SEQ + c * MCH;
        const int mg = m0 + lane;
        const float ig = Gt[(size_t)mg * 16 + h], lf = log_sigmoid(Gt[(size_t)mg * 16 + 8 + h]);
        const float bc = wave_incl_scan_add(lf, lane), av = ig - bc, pm = wave_incl_scan_max(av, lane);
        const float mprev = MPREV[u];
        const int tl = 32 * tb + c32;
        const float Mt = fmaxf(mprev, __shfl(pm, tl)), bt = __shfl(bc, tl);
        const float winter = __expf(mprev - Mt) * 0.125f;
        stage_transposed<16>(vt, PROJ + (size_t)mg * 3072 + 1024 + h * 128, lane, 1.f, false);
        bf16x8 qf[4];
        const bf16_t* qrow = PROJ + (size_t)(m0 + tl) * 3072 + h * 64 + 8 * hi;
#pragma unroll
        for (int ks = 0; ks < 4; ++ks) qf[ks] = *(const bf16x8*)(qrow + 16 * ks);
        float qn = 0.f;
        { const float* np = NPREV + (size_t)u * MDK + 8 * hi;
#pragma unroll
          for (int ks = 0; ks < 4; ++ks) { const f32x4 n0 = *(const f32x4*)(np + 16 * ks), n1 = *(const f32x4*)(np + 16 * ks + 4); const u32x4 qw = __builtin_bit_cast(u32x4, qf[ks]);
              qn += bf_lo(qw.x) * n0[0] + bf_hi(qw.x) * n0[1] + bf_lo(qw.y) * n0[2] + bf_hi(qw.y) * n0[3] + bf_lo(qw.z) * n1[0] + bf_hi(qw.z) * n1[1] + bf_lo(qw.w) * n1[2] + bf_hi(qw.w) * n1[3]; } }
        qn += __shfl_xor(qn, 32);
        f32x16 acc[4];
#pragma unroll
        for (int i = 0; i < 4; ++i)
#pragma unroll
            for (int r = 0; r < 16; ++r) acc[i][r] = 0.f;
        { const bf16_t* cp = CPREV + (size_t)u * (MDV * MDK) + 8 * hi;
#pragma unroll
          for (int i = 0; i < 4; ++i)
#pragma unroll
              for (int ks = 0; ks < 4; ++ks) { const bf16x8 af = *(const bf16x8*)(cp + (size_t)(32 * i + c32) * MDK + 16 * ks); acc[i] = __builtin_amdgcn_mfma_f32_32x32x16_bf16(af, qf[ks], acc[i], 0, 0, 0); } }
#pragma unroll
        for (int i = 0; i < 4; ++i)
#pragma unroll
            for (int r = 0; r < 16; ++r) acc[i][r] *= winter;
        float den = 0.f;
        LDS_WAIT();
#pragma unroll
        for (int sb = 0; sb < 2; ++sb) {
            if (sb <= tb) {
                f32x16 st;
#pragma unroll
                for (int r = 0; r < 16; ++r) st[r] = 0.f;
                const bf16_t* krow = PROJ + (size_t)(m0 + 32 * sb + c32) * 3072 + 512 + h * 64 + 8 * hi;
#pragma unroll
                for (int ks = 0; ks < 4; ++ks) { const bf16x8 kf = *(const bf16x8*)(krow + 16 * ks); st = __builtin_amdgcn_mfma_f32_32x32x16_bf16(kf, qf[ks], st, 0, 0, 0); }
                unsigned pk[8];
#pragma unroll
                for (int r = 0; r < 16; r += 2) {
                    const int s0 = 32 * sb + (r & 3) + 8 * (r >> 2) + 4 * hi, s1 = s0 + 1;
                    const float a0 = __shfl(av, s0), a1 = __shfl(av, s1);
                    float p0 = st[r] * 0.125f * __expf(a0 - Mt), p1 = st[r + 1] * 0.125f * __expf(a1 - Mt);
                    if (s0 > tl) p0 = 0.f; if (s1 > tl) p1 = 0.f;
                    den += p0 + p1; pk[r >> 1] = cvt_pk_bf16(p0, p1);
                }
#pragma unroll
                for (int s2 = 0; s2 < 2; ++s2) {
                    const bf16x8 pf = __builtin_bit_cast(bf16x8, (u32x4){pk[4 * s2], pk[4 * s2 + 1], pk[4 * s2 + 2], pk[4 * s2 + 3]});
                    const int k0 = 16 * (2 * sb + s2) + 4 * hi;
#pragma unroll
                    for (int i = 0; i < 4; ++i) { const LAS unsigned char* vr = vt + (32 * i + c32) * MT_STRIDE;
                        const u32x2 v0 = *(const LAS u32x2*)(vr + 2 * k0), v1 = *(const LAS u32x2*)(vr + 2 * (k0 + 8));
                        const bf16x8 vf = __builtin_bit_cast(bf16x8, (u32x4){v0.x, v0.y, v1.x, v1.y});
                        acc[i] = __builtin_amdgcn_mfma_f32_32x32x16_bf16(vf, pf, acc[i], 0, 0, 0); }
                }
            }
        }
        den += __shfl_xor(den, 32);
        den += winter * qn;
        const float mrow = bt + Mt, dnm = fmaxf(fabsf(den), __expf(-mrow)), rinv = 1.f / dnm;
        float ss = 0.f;
#pragma unroll
        for (int i = 0; i < 4; ++i)
#pragma unroll
            for (int r = 0; r < 16; ++r) { acc[i][r] *= rinv; ss += acc[i][r] * acc[i][r]; }
        ss += __shfl_xor(ss, 32);
        const float rn = 1.f / sqrtf(ss * (1.f / MDV) + RMS_EPS);
        const size_t mrowi = (size_t)(m0 + tl);
#pragma unroll
        for (int i = 0; i < 4; ++i)
#pragma unroll
            for (int g4 = 0; g4 < 4; ++g4) { const int dv = 32 * i + 8 * g4 + 4 * hi;
                const f32x4 gn = *(const f32x4*)(gain + h * 128 + dv); const u32x2 ow = *(const u32x2*)(PROJ + mrowi * 3072 + 2048 + h * 128 + dv);
                const float o0 = bf_lo(ow.x), o1 = bf_hi(ow.x), o2 = bf_lo(ow.y), o3 = bf_hi(ow.y);
                const float y0 = acc[i][4 * g4 + 0] * rn * gn[0] / (1.f + __expf(-o0)), y1 = acc[i][4 * g4 + 1] * rn * gn[1] / (1.f + __expf(-o1));
                const float y2 = acc[i][4 * g4 + 2] * rn * gn[2] / (1.f + __expf(-o2)), y3 = acc[i][4 * g4 + 3] * rn * gn[3] / (1.f + __expf(-o3));
                u32x2 w; w.x = cvt_pk_bf16(y0, y1); w.y = cvt_pk_bf16(y2, y3); *(u32x2*)(HB + mrowi * D + h * 128 + dv) = w; }
        LDS_WAIT();
    }
}
constexpr int AT_KB = 64 * 384, AT_VB = 128 * 128, AT_STAGE = AT_KB + AT_VB;
__device__ __forceinline__ void attn_phase(const Frame& F) {
    unsigned char* ws = F.ws(); const bf16_t* QB = (const bf16_t*)(ws + WS_QB); const bf16_t* KN = (const bf16_t*)(ws + WS_KN); const bf16_t* KR = (const bf16_t*)(ws + WS_KR); const bf16_t* VT = (const bf16_t*)(ws + WS_VT);
    bf16_t* HB = (bf16_t*)(ws + WS_HB);
    LAS unsigned char* lds = F.lds;
    const int lane = F.lane, w = F.wave, c32 = lane & 31, hi = lane >> 5;
    int k_isr[3]; unsigned k_off[3], v_off[2];
#pragma unroll
    for (int n = 0; n < 3; ++n) { const int P = (n * 8 + w) * 64 + lane, row = P / 24, q = P - row * 24, p = (q & ~7) | ((q & 7) ^ ((row >> 1) & 7));
        k_isr[n] = p >= 16; k_off[n] = (p >= 16) ? (unsigned)(row * AROPE + (p - 16) * 8) * 2u : (unsigned)(row * 1024 + p * 8) * 2u; }
#pragma unroll
    for (int n = 0; n < 2; ++n) { const int P = (n * 8 + w) * 64 + lane, row = P >> 3, q = P & 7, p = q ^ ((row >> 1) & 7); v_off[n] = (unsigned)row * (unsigned)(T * 2) + (unsigned)(p * 16); }
    const int sw = (c32 >> 1) & 7;
    unsigned ko[4];
#pragma unroll
    for (int i = 0; i < 4; ++i) ko[i] = (unsigned)(c32 * 384 + (((2 * i + hi) ^ sw) * 16));
    const unsigned vrow = (unsigned)(c32 * 128 + 8 * hi);

    for (int item = F.vcu; item < NB * AH * 16; item += F.G) {
        const int bh = item >> 4, x = item & 15, b = bh >> 3, hh = bh & 7;
#pragma unroll 1
        for (int sub = 0; sub < 2; ++sub) {
            const int qb = sub ? 31 - x : x, nt = 4 * qb + 4, jmax = 4 * qb + (w >> 1);
            const int qrow = 256 * qb + 32 * w + c32;
            const size_t mq = (size_t)b * SEQ + qrow;
            __syncthreads();
            const bf16_t* knb = KN + (size_t)b * SEQ * 1024 + hh * 128; const bf16_t* krb = KR + (size_t)b * SEQ * AROPE; const bf16_t* vtb = VT + (size_t)(hh * 128) * T + (size_t)b * SEQ;
#define AT_ISSUE(j, stg) do { _Pragma("unroll") for (int _n = 0; _n < 3; ++_n) { \
                const char* _g = k_isr[_n] ? (const char*)(krb + (size_t)(j) * 64 * AROPE) + k_off[_n] : (const char*)(knb + (size_t)(j) * 64 * 1024) + k_off[_n]; \
                __builtin_amdgcn_global_load_lds((const unsigned*)_g, (LAS unsigned*)(lds + (stg) * AT_STAGE + (_n * 8 + w) * 1024), 16, 0, 0); } \
            _Pragma("unroll") for (int _n = 0; _n < 2; ++_n) { const char* _g = (const char*)(vtb + (size_t)(j) * 64) + v_off[_n]; \
                __builtin_amdgcn_global_load_lds((const unsigned*)_g, (LAS unsigned*)(lds + (stg) * AT_STAGE + AT_KB + (_n * 8 + w) * 1024), 16, 0, 0); } } while (0)
            AT_ISSUE(0, 0);
            bf16x8 qf[12];
            { const bf16_t* qr = QB + mq * 1536 + hh * AQD + 8 * hi;
#pragma unroll
              for (int ks = 0; ks < 12; ++ks) qf[ks] = *(const bf16x8*)(qr + 16 * ks); }
            f32x16 O[4];
#pragma unroll
            for (int i = 0; i < 4; ++i)
#pragma unroll
                for (int r = 0; r < 16; ++r) O[i][r] = 0.f;
            float m_run = -1.0e30f, l_run = 0.f;
#pragma unroll 1
            for (int j = 0; j < nt; ++j) {
                asm volatile("s_waitcnt vmcnt(0)" ::: "memory");
                __syncthreads();
                if (j + 1 < nt) AT_ISSUE(j + 1, (j + 1) & 1);
                if (j <= jmax) {
                    const LAS unsigned char* kb_ = lds + (j & 1) * AT_STAGE; const LAS unsigned char* vb_ = kb_ + AT_KB;
                    f32x16 s0, s1;
#pragma unroll
                    for (int r = 0; r < 16; ++r) { s0[r] = 0.f; s1[r] = 0.f; }
#pragma unroll
                    for (int ks = 0; ks < 12; ++ks) {
                        const bf16x8 k0 = *(const LAS bf16x8*)(kb_ + ko[ks & 3] + (ks >> 2) * 128), k1 = *(const LAS bf16x8*)(kb_ + ko[ks & 3] + (ks >> 2) * 128 + 32 * 384);
                        s0 = __builtin_amdgcn_mfma_f32_32x32x16_bf16(k0, qf[ks], s0, 0, 0, 0); s1 = __builtin_amdgcn_mfma_f32_32x32x16_bf16(k1, qf[ks], s1, 0, 0, 0);
                    }
                    if (j == jmax) {
                        const int kbase = 64 * j + 4 * hi;
#pragma unroll
                        for (int r = 0; r < 16; ++r) { const int key = kbase + (r & 3) + 8 * (r >> 2); if (key > qrow) s0[r] = -__builtin_inff(); if (key + 32 > qrow) s1[r] = -__builtin_inff(); }
                    }
                    float mx = fmaxf(s0[0], s1[0]);
#pragma unroll
                    for (int r = 1; r < 16; ++r) mx = fmaxf(mx, fmaxf(s0[r], s1[r]));
                    mx = fmaxf(mx, __shfl_xor(mx, 32));
                    const float mnew = fmaxf(m_run, mx), alpha = __builtin_amdgcn_exp2f(m_run - mnew); m_run = mnew;
                    float ls = 0.f; unsigned pk[16];
#pragma unroll
                    for (int r = 0; r < 16; r += 2) { const float p0 = __builtin_amdgcn_exp2f(s0[r] - mnew), p1 = __builtin_amdgcn_exp2f(s0[r + 1] - mnew), p2 = __builtin_amdgcn_exp2f(s1[r] - mnew), p3 = __builtin_amdgcn_exp2f(s1[r + 1] - mnew);
                        ls += (p0 + p1) + (p2 + p3); pk[r >> 1] = cvt_pk_bf16(p0, p1); pk[8 + (r >> 1)] = cvt_pk_bf16(p2, p3); }
                    l_run = l_run * alpha + ls;
#pragma unroll
                    for (int i = 0; i < 4; ++i)
#pragma unroll
                        for (int r = 0; r < 16; ++r) O[i][r] *= alpha;
#pragma unroll
                    for (int st = 0; st < 4; ++st) {
                        const bf16x8 pf = __builtin_bit_cast(bf16x8, (u32x4){pk[4 * st], pk[4 * st + 1], pk[4 * st + 2], pk[4 * st + 3]});
                        const unsigned p0o = (unsigned)(((2 * st) ^ sw) * 16), p1o = (unsigned)(((2 * st + 1) ^ sw) * 16);
#pragma unroll
                        for (int i = 0; i < 4; ++i) { const LAS unsigned char* vr = vb_ + vrow + i * (32 * 128);
                            const u32x2 v0 = *(const LAS u32x2*)(vr + p0o), v1 = *(const LAS u32x2*)(vr + p1o);
                            const bf16x8 vf = __builtin_bit_cast(bf16x8, (u32x4){v0.x, v0.y, v1.x, v1.y});
                            O[i] = __builtin_amdgcn_mfma_f32_32x32x16_bf16(vf, pf, O[i], 0, 0, 0); }
                    }
                }
            }
            const float lt = l_run + __shfl_xor(l_run, 32), rl = 1.f / lt;
            bf16_t* orow = HB + mq * D + hh * 128 + 4 * hi;
#pragma unroll
            for (int i = 0; i < 4; ++i)
#pragma unroll
                for (int g4 = 0; g4 < 4; ++g4) { u32x2 wv; wv.x = cvt_pk_bf16(O[i][4 * g4] * rl, O[i][4 * g4 + 1] * rl); wv.y = cvt_pk_bf16(O[i][4 * g4 + 2] * rl, O[i][4 * g4 + 3] * rl);
                    *(u32x2*)(orow + 32 * i + 8 * g4) = wv; }
#undef AT_ISSUE
        }
    }
}
#ifndef EN_P0
#define EN_P0 1
#endif
#ifndef EN_M1
#define EN_M1 1
#endif
#ifndef EN_M2
#define EN_M2 1
#endif
#ifndef EN_M3
#define EN_M3 1
#endif
#ifndef EN_M4
#define EN_M4 1
#endif
#ifndef EN_A1
#define EN_A1 1
#endif
#ifndef EN_A2
#define EN_A2 1
#endif
#ifndef EN_A3
#define EN_A3 1
#endif
#ifndef EN_A4
#define EN_A4 1
#endif
#ifndef EN_O5
#define EN_O5 1
#endif
#ifndef EN_L6
#define EN_L6 1
#endif
#ifndef EN_G7
#define EN_G7 1
#endif
#ifndef EN_G8
#define EN_G8 1
#endif
#ifndef EN_L9
#define EN_L9 1
#endif
constexpr int PH_PER_LAYER = 9, N_PHASES = 1 + DEPTH * PH_PER_LAYER;
constexpr float Q_SCALE = 0.07216878364870323f * 1.4426950408889634f;

__global__ void __launch_bounds__(NTHR, 2) fwd_kernel(Args args) {
    extern __shared__ __attribute__((aligned(16))) unsigned char lds_raw[];
    Frame F0; Frame& F = F0;
    F.lds = (LAS unsigned char*)lds_raw; F.MISC = (volatile LAS unsigned*)(F.lds + MISC_OFF);
    F.tid = threadIdx.x; F.lane = F.tid & 63; F.wave = __builtin_amdgcn_readfirstlane(F.tid >> 6);
    F.G = gridDim.x; { const int bx = blockIdx.x; F.vcu = (F.G % 8 == 0) ? (bx % 8) * (F.G / 8) + bx / 8 : bx; }
    if (F.tid < 128) F.MISC[F.tid] = 0u;
    if (F.tid == 128) {
#pragma unroll
        for (int i = 0; i < 20; ++i) { const unsigned long long p = (unsigned long long)args.in[i]; F.MISC[128 + 2 * i] = (unsigned)p; F.MISC[129 + 2 * i] = (unsigned)(p >> 32); }
        { const unsigned long long p = (unsigned long long)args.out; F.MISC[168] = (unsigned)p; F.MISC[169] = (unsigned)(p >> 32); }
        { const unsigned long long p = (unsigned long long)args.ws; F.MISC[170] = (unsigned)p; F.MISC[171] = (unsigned)(p >> 32); }
    }
    __syncthreads();
    XcdBarrier bar = xcd_barrier_post(F.ctl() + CW_BAR, F.MISC);
    const int lo = args.ph_lo, hi = args.ph_hi;
#define IN(k) (lo <= (k) && (k) < hi)
#define SEAM(k) do { if (IN(k) && IN((k) + 1)) xcd_barrier(bar); else __syncthreads(); } while (0)

    if (EN_P0 && IN(0)) { const Frame F = refresh(F0); p0_prologue(F); }
    SEAM(0);

    for (int l = 0; l < DEPTH; ++l) {
        const int pb = 1 + l * PH_PER_LAYER, j = l >> 1;
        if ((l & 1) == 0) {
            if (EN_M1 && IN(pb + 0)) { const Frame F = refresh(F0); unsigned char* ws = F.ws(); const float* xres = (l == 0) ? (const float*)F.ptr(IN_X) : (const float*)(ws + WS_XF);
                pg8::DenseOrder S; S.init(ws + WS_XB, (bf16_t*)(ws + WS_WINM) + (size_t)j * 3072 * 1024, T, 3072, 1024, 1024, F.G, F.vcu);
                pg8::EpiBf16 E{(bf16_t*)(ws + WS_PROJ), 3072, 1.0f};
                pg8::gemm_phase<pg8::EpiBf16, pg8::DenseOrder, false>(F.lds, F.tid, 1024, 1024, 1024, S, E);
                __syncthreads();
                const Frame F2 = refresh(F0);
                skinny_fill<16>(F2, (const float*)F.ptr(IN_MWIN) + (size_t)j * 1024 * MIN_ + 3072, MIN_);
                gates_phase(F2, xres, (const float*)F2.ptr(IN_MBG) + j * 16, (float*)(ws + WS_GATES));
            }
            SEAM(pb + 0);
            if (EN_M2 && IN(pb + 1)) { const Frame F = refresh(F0); mlstm_local_phase(F); }
            SEAM(pb + 1);
            if (EN_M3 && IN(pb + 2)) { const Frame F = refresh(F0); mlstm_scan_phase(F); }
            SEAM(pb + 2);
            if (EN_M4 && IN(pb + 3)) { const Frame F = refresh(F0); mlstm_out_phase(F, (const float*)F.ptr(IN_MNG) + (size_t)j * 1024); }
            SEAM(pb + 3);
        } else {
            if (EN_A1 && IN(pb + 0)) { const Frame F = refresh(F0); unsigned char* ws = F.ws();
                pg8::DenseOrder S; S.init(ws + WS_XB, (bf16_t*)(ws + WS_WINA) + (size_t)j * AINP * 1024, T, AINP, 1024, 1024, F.G, F.vcu);
                pg8::EpiF32 E{(float*)(ws + WS_A32), AINP};
                pg8::gemm_phase<pg8::EpiF32, pg8::DenseOrder, false>(F.lds, F.tid, 1024, 1024, 1024, S, E);
            }
            SEAM(pb + 0);
            if (EN_A2 && IN(pb + 1)) { const Frame F = refresh(F0); mla_norm_phase(F, j); }
            SEAM(pb + 1);
            if (EN_A3 && IN(pb + 2)) { const Frame F = refresh(F0); unsigned char* ws = F.ws();
                { pg8::DenseOrder S; S.init(ws + WS_CQ, (bf16_t*)(ws + WS_WQB) + (size_t)j * 1536 * AQL, T, 1536, AQL, AQL, F.G, F.vcu);
                  pg8::EpiQRope E{(bf16_t*)(ws + WS_QB), 1536, (const float*)(ws + WS_COS), (const float*)(ws + WS_SIN), Q_SCALE};
                  pg8::gemm_phase<pg8::EpiQRope, pg8::DenseOrder, false>(F.lds, F.tid, AQL, AQL, AQL, S, E); }
                __syncthreads();
                { const Frame F = refresh(F0); unsigned char* ws = F.ws();
                  pg8::DenseOrder S; S.init(ws + WS_CKV, (bf16_t*)(ws + WS_WKV) + (size_t)j * 2048 * AKL, T, 1024, AKL, AKL, F.G, F.vcu);
                  pg8::EpiBf16 E{(bf16_t*)(ws + WS_KN), 1024, 1.0f};
                  pg8::gemm_phase<pg8::EpiBf16, pg8::DenseOrder, false>(F.lds, F.tid, AKL, AKL, AKL, S, E); }
                __syncthreads();
                { const Frame F = refresh(F0); unsigned char* ws = F.ws();
                  pg8::DenseOrder S; S.init((bf16_t*)(ws + WS_WKV) + (size_t)j * 2048 * AKL + (size_t)1024 * AKL, ws + WS_CKV, 1024, T, AKL, AKL, F.G, F.vcu);
                  pg8::EpiBf16 E{(bf16_t*)(ws + WS_VT), T, 1.0f};
                  pg8::gemm_phase<pg8::EpiBf16, pg8::DenseOrder, false>(F.lds, F.tid, AKL, AKL, AKL, S, E); }
            }
            SEAM(pb + 2);
            if (EN_A4 && IN(pb + 3)) { const Frame F = refresh(F0); attn_phase(F); }
            SEAM(pb + 3);
        }
        if (EN_O5 && IN(pb + 4)) { const Frame F = refresh(F0); unsigned char* ws = F.ws(); const float* xres = (l == 0) ? (const float*)F.ptr(IN_X) : (const float*)(ws + WS_XF);
            const bf16_t* wo = (l & 1) ? (const bf16_t*)(ws + WS_WOUTA) + (size_t)j * 1024 * 1024 : (const bf16_t*)(ws + WS_WOUTM) + (size_t)j * 1024 * 1024;
            pg8::DenseOrder S; S.init(ws + WS_HB, wo, T, 1024, 1024, 1024, F.G, F.vcu);
            pg8::EpiResid E{xres, (float*)(ws + WS_ZF), 1024, DN_ALPHA};
            pg8::gemm_phase<pg8::EpiResid, pg8::DenseOrder, false>(F.lds, F.tid, 1024, 1024, 1024, S, E);
        }
        SEAM(pb + 4);
        if (EN_L6 && IN(pb + 5)) { const Frame F = refresh(F0); ln_phase<0>(F, l, false); }
        SEAM(pb + 5);
        if (EN_G7 && IN(pb + 6)) { const Frame F = refresh(F0); unsigned char* ws = F.ws();
            moe_prefix(F, l);
            pg8::MoeOrder S{(const volatile LAS int*)(F.MISC + 16), (const char*)(ws + WS_XB), (const char*)(ws + WS_WGU) + (size_t)l * 32 * 2048 * 1024 * 2, (const int*)(ws + WS_LIST), F.ctl() + CW_CNT + l * 32 * 64,
                            8, F.G, F.vcu, (size_t)2048 * 1024 * 2, (size_t)256 * 1024 * 2, true};
            pg8::EpiSwiglu E{(bf16_t*)(ws + WS_HMOE), (const float*)F.ptr(IN_BGU) + (size_t)l * 32 * 2048};
            pg8::gemm_phase<pg8::EpiSwiglu, pg8::MoeOrder, true>(F.lds, F.tid, 1024, 1024, 1024, S, E);
        }
        SEAM(pb + 6);
        if (EN_G8 && IN(pb + 7)) { const Frame F = refresh(F0); unsigned char* ws = F.ws();
            moe_prefix(F, l);
            pg8::MoeOrder S{(const volatile LAS int*)(F.MISC + 16), (const char*)(ws + WS_HMOE), (const char*)(ws + WS_WD) + (size_t)l * 32 * 1024 * 1024 * 2, (const int*)(ws + WS_LIST), F.ctl() + CW_CNT + l * 32 * 64,
                            4, F.G, F.vcu, (size_t)1024 * 1024 * 2, (size_t)256 * 1024 * 2, false};
            pg8::EpiDown E{(bf16_t*)(ws + WS_YMOE), (const float*)F.ptr(IN_BD) + (size_t)l * 32 * 1024};
            pg8::gemm_phase<pg8::EpiDown, pg8::MoeOrder, false>(F.lds, F.tid, 1024, 1024, 1024, S, E);
        }
        SEAM(pb + 7);
        if (EN_L9 && IN(pb + 8)) { const Frame F = refresh(F0); moe_prefix(F, l); ln_phase<1>(F, l, l == DEPTH - 1); }
        SEAM(pb + 8);
    }
#undef IN
#undef SEAM
}

extern "C" void kernel_launch(void* const* d_in, const int* in_sizes, int n_in, void* d_out, int out_size, void* d_ws, size_t ws_size, hipStream_t stream) {
    static int grid = 0;
    if (grid == 0) {
        if (n_in != 20 || out_size != T * D || ws_size < WS_END) { fprintf(stderr, "kernel_launch: unexpected problem (n_in %d out %d ws %zu)\n", n_in, out_size, ws_size); grid = -1; return; }
        int dev = 0, cus = 0, per_cu = 0;
        if (hipGetDevice(&dev) != hipSuccess || hipDeviceGetAttribute(&cus, hipDeviceAttributeMultiprocessorCount, dev) != hipSuccess) { grid = -1; return; }
        if (hipFuncSetAttribute((const void*)fwd_kernel, hipFuncAttributeMaxDynamicSharedMemorySize, LDS_BYTES) != hipSuccess) { fprintf(stderr, "kernel_launch: hipFuncSetAttribute failed\n"); grid = -1; return; }
        if (hipOccupancyMaxActiveBlocksPerMultiprocessor(&per_cu, (const void*)fwd_kernel, NTHR, LDS_BYTES) != hipSuccess || per_cu < 1) fprintf(stderr, "kernel_launch: occupancy query reports %d\n", per_cu);
        (void)hipGetLastError();
        grid = cus;
    }
    if (grid < 0) return;
    (void)hipMemsetAsync((char*)d_ws + WS_CTL, 0, CTL_ZERO_BYTES, stream);
    Args a; memset(&a, 0, sizeof(a));
    for (int i = 0; i < 20; ++i) a.in[i] = d_in[i];
    a.out = (float*)d_out; a.ws = (unsigned char*)d_ws;
#if MK_PER_PHASE
    for (int p = 0; p < N_PHASES; ++p) { a.ph_lo = p; a.ph_hi = p + 1; hipLaunchKernelGGL(fwd_kernel, dim3(grid), dim3(NTHR), LDS_BYTES, stream, a); }
#else
    a.ph_lo = 0; a.ph_hi = N_PHASES;
    hipLaunchKernelGGL(fwd_kernel, dim3(grid), dim3(NTHR), LDS_BYTES, stream, a);
#endif
    const hipError_t le = hipPeekAtLastError();
    if (le != hipSuccess) fprintf(stderr, "kernel_launch: launch failed: %s\n", hipGetErrorName(le));
}
```

```cpp
#include <hip/hip_runtime.h>
#include <cstdio>
#include <cstdint>
#include <cstring>

#define LAS __attribute__((address_space(3)))
#define GAS __attribute__((address_space(1)))
typedef unsigned short bf16_t;
typedef short bf16x8 __attribute__((ext_vector_type(8)));
typedef short s16x4 __attribute__((ext_vector_type(4)));
typedef float f32x2 __attribute__((ext_vector_type(2)));
typedef float f32x4 __attribute__((ext_vector_type(4)));
typedef float f32x16 __attribute__((ext_vector_type(16)));
typedef unsigned u32x2 __attribute__((ext_vector_type(2)));
typedef unsigned u32x4 __attribute__((ext_vector_type(4)));
typedef int i32x4 __attribute__((ext_vector_type(4)));
typedef int i32x8 __attribute__((ext_vector_type(8)));

#ifndef MK_PER_PHASE
#define MK_PER_PHASE 0
#endif

constexpr int NB = 4, SEQ = 8192, T = NB * SEQ, D = 1024, DEPTH = 4;
constexpr int MH = 8, MDV = 128, MDK = 64, MCH = 64, MNC = SEQ / MCH, MIN_ = 3088, MUNITS = NB * MH * MNC;
constexpr int AH = 8, AQL = 384, AKL = 256, ANOPE = 128, AROPE = 64, AV = 128, AIN = 704, AINP = 768, AQD = 192;
constexpr int NE = 32, TOPK = 4, DFF = 1024;
constexpr float DN_ALPHA = 1.6817928305074290f;
constexpr float LN_EPS = 1e-5f, RMS_EPS = 1e-6f;
constexpr int MOE_ROWS = 139264;

constexpr size_t MiB = 1ull << 20;
constexpr size_t WS_CTL = 0, CTL_ZERO_BYTES = 1 * MiB;
constexpr size_t WS_COS = 1 * MiB, WS_SIN = 5 * MiB, WS_GATES = 9 * MiB, WS_TOKINFO = 11 * MiB, WS_TOKGATE = 11 * MiB + 512 * 1024, WS_LIST = 12 * MiB;
constexpr size_t WS_MSC = 16 * MiB, WS_NLOC = 17 * MiB, WS_NPREV = 18 * MiB;
constexpr size_t WS_WINM = 20 * MiB, WS_WOUTM = 32 * MiB, WS_WINA = 36 * MiB, WS_WQB = 39 * MiB, WS_WKV = 42 * MiB, WS_WOUTA = 44 * MiB;
constexpr size_t WS_WGU = 64 * MiB, WS_WD = 576 * MiB;
constexpr size_t WS_XF = 832 * MiB, WS_ZF = 960 * MiB, WS_XB = 1088 * MiB, WS_PROJ = 1152 * MiB;
constexpr size_t WS_A32 = WS_PROJ, WS_CQ = WS_PROJ + 96 * MiB, WS_CKV = WS_PROJ + 120 * MiB, WS_KR = WS_PROJ + 136 * MiB;
constexpr size_t WS_QB = 1344 * MiB, WS_CLOC = WS_QB, WS_KN = 1472 * MiB, WS_CPREV = WS_KN, WS_VT = 1536 * MiB, WS_HB = 1600 * MiB;
constexpr size_t WS_HMOE = 1664 * MiB, WS_YMOE = 1936 * MiB, WS_XB8 = 2208 * MiB, WS_END = 2240 * MiB;
constexpr int CW_BAR = 4096, CW_CNT = 16384;

constexpr int RING_BYTES = 147456;
constexpr int MISC_OFF = RING_BYTES;
constexpr int LDS_BYTES = RING_BYTES + 1024;
constexpr int NWAVES = 8, NTHR = 512;

__device__ __forceinline__ unsigned cvt_pk_bf16(float lo, float hi) { unsigned r; asm("v_cvt_pk_bf16_f32 %0, %1, %2" : "=v"(r) : "v"(lo), "v"(hi)); return r; }
__device__ __forceinline__ float bf_lo(unsigned w) { return __uint_as_float(w << 16); }
__device__ __forceinline__ float bf_hi(unsigned w) { return __uint_as_float(w & 0xffff0000u); }
__device__ __forceinline__ float wave_sum(float v) {
#pragma unroll
    for (int o = 1; o < 64; o <<= 1) v += __shfl_xor(v, o);
    return v;
}
__device__ __forceinline__ float wave_max(float v) {
#pragma unroll
    for (int o = 1; o < 64; o <<= 1) v = fmaxf(v, __shfl_xor(v, o));
    return v;
}
#ifndef MOE_FP8
#define MOE_FP8 1
#endif
constexpr float F8_SX = 16.f, F8_SWG = 256.f, F8_SH = 4.f, F8_SWD = 512.f;
#ifndef F8_SWCVT
#define F8_SWCVT 0
#endif
__device__ __forceinline__ unsigned f32_to_e4m3_sw(float x) {
    const unsigned b = __float_as_uint(x), sgn = (b >> 24) & 0x80u; const float ax = fabsf(x);
    if (ax < 0.015625f) return sgn | (unsigned)__builtin_rintf(ax * 512.0f);
    unsigned u = b & 0x7fffffffu; u += 0x7ffffu + ((u >> 20) & 1u);
    const unsigned e8 = (u >> 23) - 120u, m = (u >> 20) & 7u; unsigned enc = (e8 << 3) | m; enc = enc > 0x7eu ? 0x7eu : enc;
    return sgn | enc;
}
__device__ __forceinline__ unsigned cvt4_fp8(float a, float b, float c, float d) {
#if F8_SWCVT
    return f32_to_e4m3_sw(a) | (f32_to_e4m3_sw(b) << 8) | (f32_to_e4m3_sw(c) << 16) | (f32_to_e4m3_sw(d) << 24);
#else
    int w = 0; w = __builtin_amdgcn_cvt_pk_fp8_f32(a, b, w, false); w = __builtin_amdgcn_cvt_pk_fp8_f32(c, d, w, true); return (unsigned)w;
#endif
}
#define LDS_WAIT() asm volatile("s_waitcnt lgkmcnt(0)" ::: "memory")
#define VM_WAIT() asm volatile("s_waitcnt vmcnt(0)" ::: "memory")

#define XB_TMO      128
#define XB_XCNT(j)  (256  + 64 * (j))
#define XB_XSUB(j)  (1280 + 64 * (j))
#define XB_XGEN(j)  (2304 + 64 * (j))
#define XB_TOP      3328
#define XB_TOPGEN   3392
#define XCD_BAR_WORDS 3456
#define XB_SPIN_CAP (1u << 18)
__device__ __forceinline__ unsigned xb_ld(unsigned* p)              { return __hip_atomic_load(p, __ATOMIC_RELAXED, __HIP_MEMORY_SCOPE_AGENT); }
__device__ __forceinline__ unsigned xb_add(unsigned* p, unsigned v) { return __hip_atomic_fetch_add(p, v, __ATOMIC_RELAXED, __HIP_MEMORY_SCOPE_AGENT); }
__device__ __forceinline__ unsigned xb_xcc_id() { return (unsigned)__builtin_amdgcn_s_getreg((3 << 11) | 20) & 0xFu; }
#define XB_SPIN(cond, bar) do { unsigned _sp = 0; while (cond) { __builtin_amdgcn_s_sleep(1); \
    if ((++_sp & 255u) == 0u) { if (xb_ld(&(bar)[XB_TMO])) break; if (_sp > XB_SPIN_CAP) { atomicAdd(&(bar)[XB_TMO], 1u); break; } } } } while (0)
struct XcdBarrier { unsigned* bar; unsigned x; volatile LAS unsigned* st; };
__device__ __forceinline__ XcdBarrier xcd_barrier_post(unsigned* bar, volatile LAS unsigned* st) {
    XcdBarrier b; b.bar = bar; b.x = xb_xcc_id(); b.st = st;
    if (threadIdx.x == 0) (void)xb_add(&bar[XB_XCNT(b.x)], 1u);
    return b;
}
__device__ __forceinline__ void xcd_barrier_complete(unsigned* bar, unsigned x, unsigned& nloc, unsigned& nx) {
    const unsigned G = gridDim.x * gridDim.y * gridDim.z;
    unsigned sum, cnt, mine, sp = 0u;
    for (;;) {
        sum = 0u; cnt = 0u; mine = 0u;
#pragma unroll
        for (unsigned j = 0; j < 16; ++j) { const unsigned c = xb_ld(&bar[XB_XCNT(j)]); sum += c; cnt += (c > 0u) ? 1u : 0u; mine = (j == x) ? c : mine; }
        if (sum == G) break;
        __builtin_amdgcn_s_sleep(1);
        if ((++sp & 255u) == 0u) { if (xb_ld(&bar[XB_TMO])) break; if (sp > XB_SPIN_CAP) { atomicAdd(&bar[XB_TMO], 1u); break; } }
    }
    nloc = mine > 0u ? mine : 1u; nx = cnt > 0u ? cnt : 1u;
}
__device__ __forceinline__ void xcd_barrier(const XcdBarrier& b) {
    asm volatile("s_waitcnt vmcnt(0)" ::: "memory");
    __syncthreads();
    if (threadIdx.x == 0) {
        unsigned* bar = b.bar;
        __builtin_amdgcn_s_waitcnt(0);
        unsigned nloc = b.st[0], nx = b.st[1];
        if (nloc == 0u) { xcd_barrier_complete(bar, b.x, nloc, nx); b.st[0] = nloc; b.st[1] = nx; }
        const unsigned old = xb_add(&bar[XB_XSUB(b.x)], 1u);
        const unsigned gen = old / nloc;
        if (old + 1u == (gen + 1u) * nloc) {
            __builtin_amdgcn_fence(__ATOMIC_RELEASE, "agent");
            asm volatile("s_waitcnt vmcnt(0)" ::: "memory");
            const unsigned og = xb_add(&bar[XB_TOP], 1u);
            const unsigned tg = og / nx;
            if (og + 1u == (tg + 1u) * nx) xb_add(&bar[XB_TOPGEN], 1u);
            else XB_SPIN(xb_ld(&bar[XB_TOPGEN]) == tg, bar);
            __builtin_amdgcn_fence(__ATOMIC_ACQUIRE, "agent");
            xb_add(&bar[XB_XGEN(b.x)], 1u);
            asm volatile("s_waitcnt vmcnt(0)" ::: "memory");
        } else {
            XB_SPIN(xb_ld(&bar[XB_XGEN(b.x)]) == gen, bar);
            __builtin_amdgcn_fence(__ATOMIC_ACQUIRE, "agent");
            asm volatile("s_waitcnt vmcnt(0)" ::: "memory");
        }
    }
    __syncthreads();
}

namespace pg8 {
constexpr int BM = 256, BK = 64, HALF = 128, HTB = HALF * BK * 2, STAGE_BYTES = 8 * HTB;
__host__ __device__ __forceinline__ int lds_byte(int r, int c) { const int st = (r >> 4) * 2 + (c >> 5), rr = r & 15, cc = c & 31, ob = rr * 64 + cc * 2; return st * 1024 + (ob ^ (((ob >> 9) & 1) << 5)); }
__host__ __device__ __forceinline__ void stage_rc(int b, int& R, int& C) { const int st = b / 1024, sb = b % 1024, swz = sb ^ (((sb >> 9) & 1) << 5); R = (st >> 1) * 16 + swz / 64; C = (st & 1) * 32 + (swz % 64) / 2; }
__host__ __device__ __forceinline__ int perm32(int rho) { const int n = rho >> 4, i = rho & 15; return 8 * (i >> 2) + 4 * n + (i & 3); }

struct Unit { int pm, pn, aux, nvalid; const char* A; const char* B; const int* rows; };

template <class Epi, class Sched, bool GATHER, bool FP8 = false>
__device__ __forceinline__ void gemm_phase(LAS unsigned char* lds, const int tid, const int K, const int lda, const int ldb, const Sched& S, const Epi& E) {
    const int wid = __builtin_amdgcn_readfirstlane(tid >> 6), lane = tid & 63, wr = wid >> 2, wc = wid & 3, fr = lane & 15, fq = lane >> 4;
    constexpr int ESZ = FP8 ? 1 : 2;
    const int nt = K * ESZ / (BK * 2);
    int Rr[2], Cc[2];
    unsigned offB[2], offA[2], gAc[2][2], gAn[2][2];
#pragma unroll
    for (int i = 0; i < 2; ++i) { int R, C; stage_rc(tid * 16 + i * 8192, R, C); Rr[i] = R; Cc[i] = C; const int Rb = Epi::PERM ? ((R & ~31) + perm32(R & 31)) : R;
        offB[i] = (unsigned)(Rb * ldb * ESZ + C * 2); offA[i] = (unsigned)(R * lda * ESZ + C * 2);
#pragma unroll
        for (int h = 0; h < 2; ++h) { gAc[h][i] = offA[i]; gAn[h][i] = offA[i]; } }
    const size_t hstepA = (size_t)HALF * lda * ESZ, hstepB = (size_t)HALF * ldb * ESZ;
    const size_t kstep = (size_t)(BK * 2);
    const unsigned ldsw = (unsigned)wid * 1024u;
    const int aoff = lds_byte(wr * 64 + fr, fq * 8), boff = lds_byte(wc * 32 + fr, fq * 8);
#define PG8_SA(b, h) (((b) * 2 + (h)) * HTB)
#define PG8_SB(b, h) ((4 + (b) * 2 + (h)) * HTB)
#define PG8_STAGE(bufoff, gbase, voff) do { _Pragma("unroll") for (int _i = 0; _i < 2; ++_i) \
        __builtin_amdgcn_global_load_lds((const unsigned*)((const char*)(gbase) + (voff)[_i]), (LAS unsigned*)(lds + (bufoff) + ldsw + _i * 8192), 16, 0, 0); } while (0)
#define PG8_STAGEA(bufoff, gbase, h, G) do { if constexpr (GATHER) { PG8_STAGE(bufoff, gbase, G[h]); } else { PG8_STAGE(bufoff, (gbase) + (h) * hstepA, offA); } } while (0)
#define PG8_STAGEA2(bufoff, gbase, h) do { if constexpr (GATHER) { if (last) { PG8_STAGE(bufoff, gbase, gAn[h]); } else { PG8_STAGE(bufoff, gbase, gAc[h]); } } else { PG8_STAGE(bufoff, (gbase) + (h) * hstepA, offA); } } while (0)
#define PG8_LDA(dst, b, h) do { _Pragma("unroll") for (int m = 0; m < 4; ++m) { dst[m].lo = *(const LAS i32x4*)(lds + PG8_SA(b, h) + aoff + m * 2048); dst[m].hi = *(const LAS i32x4*)(lds + PG8_SA(b, h) + aoff + m * 2048 + 1024); } } while (0)
#define PG8_LDB(dst, b, h) do { _Pragma("unroll") for (int n = 0; n < 2; ++n) { dst[n].lo = *(const LAS i32x4*)(lds + PG8_SB(b, h) + boff + n * 2048); dst[n].hi = *(const LAS i32x4*)(lds + PG8_SB(b, h) + boff + n * 2048 + 1024); } } while (0)
#define PG8_MMA(ai, bj, At, Bt) do { __builtin_amdgcn_s_setprio(1); _Pragma("unroll") for (int m = 0; m < 4; ++m) _Pragma("unroll") for (int n = 0; n < 2; ++n) { \
        if constexpr (FP8) { asm volatile("v_mfma_f32_16x16x128_f8f6f4 %0, %1, %2, %0" : "+v"(acc[ai][bj][m][n]) : "v"(Bt[n]), "v"(At[m])); }     \
        else { const i32x4 _bl = Bt[n].lo, _bh = Bt[n].hi, _al = At[m].lo, _ah = At[m].hi;     \
               acc[ai][bj][m][n] = __builtin_amdgcn_mfma_f32_16x16x32_bf16(__builtin_bit_cast(bf16x8, _bl), __builtin_bit_cast(bf16x8, _al), acc[ai][bj][m][n], 0, 0, 0); \
               acc[ai][bj][m][n] = __builtin_amdgcn_mfma_f32_16x16x32_bf16(__builtin_bit_cast(bf16x8, _bh), __builtin_bit_cast(bf16x8, _ah), acc[ai][bj][m][n], 0, 0, 0); } } \
        __builtin_amdgcn_s_setprio(0); } while (0)
#define PG8_WAIT_V(n) asm volatile("s_waitcnt vmcnt(" #n ")" ::: "memory")
#define PG8_WAIT_L(n) asm volatile("s_waitcnt lgkmcnt(" #n ")" ::: "memory")
#define PG8_BAR __builtin_amdgcn_s_barrier()
#define PG8_SCHED __builtin_amdgcn_sched_barrier(0)
#define PG8_GATHER(U, OFF) do { _Pragma("unroll") for (int _h = 0; _h < 2; ++_h) _Pragma("unroll") for (int _i = 0; _i < 2; ++_i) { const int _r = _h * HALF + Rr[_i]; \
        const int _tok = ((const GAS int*)(U).rows)[_r < (U).nvalid ? _r : 0]; OFF[_h][_i] = (unsigned)(_tok * lda * ESZ + Cc[_i] * 2); } } while (0)
    Unit cur, nxt; int ui = 0;
    if (!S.next(0, cur)) return;
    f32x4 acc[2][2][4][2];
#pragma unroll
    for (int a = 0; a < 2; ++a)
#pragma unroll
        for (int b = 0; b < 2; ++b)
#pragma unroll
            for (int m = 0; m < 4; ++m)
#pragma unroll
                for (int n = 0; n < 2; ++n) acc[a][b][m][n] = (f32x4){0.f, 0.f, 0.f, 0.f};
    i32x8 At[4], B0[2], B1[2];
    const char* cA = cur.A; const char* cB = cur.B;
    if constexpr (GATHER) { PG8_GATHER(cur, gAc); }
    PG8_STAGE(PG8_SB(0, 0), cB, offB); PG8_STAGEA(PG8_SA(0, 0), cA, 0, gAc); PG8_STAGE(PG8_SB(0, 1), cB + hstepB, offB); PG8_STAGEA(PG8_SA(0, 1), cA, 1, gAc);
    if (wr == 1) PG8_BAR;
    PG8_WAIT_V(4); PG8_BAR;
    PG8_STAGE(PG8_SB(1, 0), cB + kstep, offB); PG8_STAGEA(PG8_SA(1, 0), cA + kstep, 0, gAc); PG8_STAGE(PG8_SB(1, 1), cB + kstep + hstepB, offB);
    PG8_WAIT_V(6); PG8_BAR;
    for (;;) {
        const bool has_next = S.next(ui + 1, nxt);
        const char* nA = has_next ? nxt.A : cA; const char* nB = has_next ? nxt.B : cB;
#pragma unroll 1
        for (int t = 0; t < nt; t += 2) {
            const bool last = (t == nt - 2);
            const char* a1 = cA + (size_t)(t + 1) * kstep;
            const char* a2 = last ? nA : cA + (size_t)(t + 2) * kstep; const char* b2 = last ? nB : cB + (size_t)(t + 2) * kstep;
            const char* a3 = a2 + kstep; const char* b3 = b2 + kstep;
            if constexpr (GATHER) { if (last && has_next) { PG8_GATHER(nxt, gAn); } }
            PG8_LDB(B0, 0, 0); PG8_SCHED; PG8_LDA(At, 0, 0); PG8_STAGEA(PG8_SA(1, 1), a1, 1, gAc);
            PG8_WAIT_L(8); PG8_BAR; PG8_WAIT_L(0); PG8_MMA(0, 0, At, B0); PG8_BAR; PG8_SCHED;
            PG8_LDB(B1, 0, 1); PG8_STAGE(PG8_SB(0, 0), b2, offB);
            PG8_BAR; PG8_WAIT_L(0); PG8_MMA(0, 1, At, B1); PG8_BAR;
            PG8_LDA(At, 0, 1); PG8_STAGEA2(PG8_SA(0, 0), a2, 0);
            PG8_BAR; PG8_WAIT_L(0); PG8_MMA(1, 0, At, B0); PG8_BAR; PG8_SCHED;
            PG8_STAGE(PG8_SB(0, 1), b2 + hstepB, offB);
            PG8_WAIT_V(6); PG8_BAR; PG8_MMA(1, 1, At, B1); PG8_BAR;
            PG8_LDB(B0, 1, 0); PG8_SCHED; PG8_LDA(At, 1, 0); PG8_STAGEA2(PG8_SA(0, 1), a2, 1);
            PG8_WAIT_L(8); PG8_BAR; PG8_WAIT_L(0); PG8_MMA(0, 0, At, B0); PG8_BAR; PG8_SCHED;
            PG8_LDB(B1, 1, 1); PG8_STAGE(PG8_SB(1, 0), b3, offB);
            PG8_BAR; PG8_WAIT_L(0); PG8_MMA(0, 1, At, B1); PG8_BAR;
            PG8_LDA(At, 1, 1); PG8_STAGEA2(PG8_SA(1, 0), a3, 0);
            PG8_BAR; PG8_WAIT_L(0); PG8_MMA(1, 0, At, B0); PG8_BAR; PG8_SCHED;
            PG8_STAGE(PG8_SB(1, 1), b3 + hstepB, offB);
            PG8_WAIT_V(6); PG8_BAR; PG8_MMA(1, 1, At, B1); PG8_BAR;
        }
        if constexpr (FP8) asm volatile("s_nop 15" ::: "memory");
        { int l2; asm volatile("v_mbcnt_lo_u32_b32 %0, -1, 0\n\tv_mbcnt_hi_u32_b32 %0, -1, %0" : "=v"(l2)); E(acc, cur, wr, wc, l2 & 15, l2 >> 4); }
        if (!has_next) break;
#pragma unroll
        for (int a = 0; a < 2; ++a)
#pragma unroll
            for (int b = 0; b < 2; ++b)
#pragma unroll
                for (int m = 0; m < 4; ++m)
#pragma unroll
                    for (int n = 0; n < 2; ++n) acc[a][b][m][n] = (f32x4){0.f, 0.f, 0.f, 0.f};
        cur = nxt; cA = nA; cB = nB; ++ui;
        if constexpr (GATHER) {
#pragma unroll
            for (int h = 0; h < 2; ++h) { gAc[h][0] = gAn[h][0]; gAc[h][1] = gAn[h][1]; } }
    }
    PG8_WAIT_V(0);
    if (wr == 0) PG8_BAR;
    PG8_BAR;
#undef PG8_SA
#undef PG8_SB
#undef PG8_STAGE
#undef PG8_LDA
#undef PG8_LDB
#undef PG8_MMA
#undef PG8_WAIT_V
#undef PG8_WAIT_L
#undef PG8_BAR
#undef PG8_SCHED
#undef PG8_GATHER
#undef PG8_STAGEA
#undef PG8_STAGEA2
}
}
namespace pg8 {
struct EpiBf16 {
    static constexpr bool PERM = true;
    bf16_t* O; int ldc; float scale;
    __device__ __forceinline__ void operator()(const f32x4 (&acc)[2][2][4][2], const Unit& u, int wr, int wc, int fr, int fq) const {
        const int row0 = u.pm * BM + wr * 64 + fr, col0 = u.pn * BM + wc * 32 + 8 * fq;
#pragma unroll
        for (int ai = 0; ai < 2; ++ai)
#pragma unroll
            for (int m = 0; m < 4; ++m) { bf16_t* rowp = O + (size_t)(row0 + ai * HALF + m * 16) * ldc + col0;
#pragma unroll
                for (int bj = 0; bj < 2; ++bj) { const f32x4 v0 = acc[ai][bj][m][0] * scale, v1 = acc[ai][bj][m][1] * scale;
                    u32x4 w; w.x = cvt_pk_bf16(v0[0], v0[1]); w.y = cvt_pk_bf16(v0[2], v0[3]); w.z = cvt_pk_bf16(v1[0], v1[1]); w.w = cvt_pk_bf16(v1[2], v1[3]);
                    *(u32x4*)(rowp + bj * HALF) = w; } }
    }
};
struct EpiF32 {
    static constexpr bool PERM = false;
    float* C; int ldc;
    __device__ __forceinline__ void operator()(const f32x4 (&acc)[2][2][4][2], const Unit& u, int wr, int wc, int fr, int fq) const {
        const int row0 = u.pm * BM + wr * 64 + fr, col0 = u.pn * BM + wc * 32 + 4 * fq;
#pragma unroll
        for (int ai = 0; ai < 2; ++ai)
#pragma unroll
            for (int m = 0; m < 4; ++m) { float* rowp = C + (size_t)(row0 + ai * HALF + m * 16) * ldc + col0;
#pragma unroll
                for (int bj = 0; bj < 2; ++bj)
#pragma unroll
                    for (int n = 0; n < 2; ++n) *(f32x4*)(rowp + bj * HALF + n * 16) = acc[ai][bj][m][n]; }
    }
};
struct EpiResid {
    static constexpr bool PERM = false;
    const float* X; float* Z; int ldc; float alpha;
    __device__ __forceinline__ void operator()(const f32x4 (&acc)[2][2][4][2], const Unit& u, int wr, int wc, int fr, int fq) const {
        const int row0 = u.pm * BM + wr * 64 + fr, col0 = u.pn * BM + wc * 32 + 4 * fq;
#pragma unroll
        for (int ai = 0; ai < 2; ++ai)
#pragma unroll
            for (int m = 0; m < 4; ++m) { const size_t off = (size_t)(row0 + ai * HALF + m * 16) * ldc + col0;
#pragma unroll
                for (int bj = 0; bj < 2; ++bj)
#pragma unroll
                    for (int n = 0; n < 2; ++n) { const f32x4 xv = *(const f32x4*)(X + off + bj * HALF + n * 16); *(f32x4*)(Z + off + bj * HALF + n * 16) = xv * alpha + acc[ai][bj][m][n]; }
                asm volatile("" ::: "memory"); }
    }
};
struct EpiQRope {
    static constexpr bool PERM = true;
    bf16_t* O; int ldc; const float* cosT; const float* sinT; float scale;
    __device__ __forceinline__ void operator()(const f32x4 (&acc)[2][2][4][2], const Unit& u, int wr, int wc, int fr, int fq) const {
        const int row0 = u.pm * BM + wr * 64 + fr, col0 = u.pn * BM + wc * 32 + 8 * fq;
#pragma unroll
        for (int ai = 0; ai < 2; ++ai)
#pragma unroll
            for (int m = 0; m < 4; ++m) { const unsigned row = (unsigned)(row0 + ai * HALF + m * 16);
#pragma unroll
                for (int bj = 0; bj < 2; ++bj) { f32x4 v0 = acc[ai][bj][m][0] * scale, v1 = acc[ai][bj][m][1] * scale;
                    const int col = col0 + bj * HALF, rr = col % AQD;
                    if (rr >= ANOPE) { const unsigned tb = (row * 32u + (unsigned)((rr - ANOPE) >> 1)) * 4u;
                        const f32x4 c = *(const f32x4*)((const char*)cosT + tb), s = *(const f32x4*)((const char*)sinT + tb);
                        const f32x4 a0 = v0, a1 = v1;
                        v0[0] = a0[0] * c[0] - a0[1] * s[0]; v0[1] = a0[1] * c[0] + a0[0] * s[0]; v0[2] = a0[2] * c[1] - a0[3] * s[1]; v0[3] = a0[3] * c[1] + a0[2] * s[1];
                        v1[0] = a1[0] * c[2] - a1[1] * s[2]; v1[1] = a1[1] * c[2] + a1[0] * s[2]; v1[2] = a1[2] * c[3] - a1[3] * s[3]; v1[3] = a1[3] * c[3] + a1[2] * s[3]; }
                    u32x4 w; w.x = cvt_pk_bf16(v0[0], v0[1]); w.y = cvt_pk_bf16(v0[2], v0[3]); w.z = cvt_pk_bf16(v1[0], v1[1]); w.w = cvt_pk_bf16(v1[2], v1[3]);
                    *(u32x4*)((char*)O + ((size_t)row * (unsigned)ldc + (unsigned)col) * 2u) = w; }
                asm volatile("" ::: "memory"); }
    }
};
struct EpiSwiglu {
    static constexpr bool PERM = true;
    unsigned char* Hh; const float* bgu;
    __device__ __forceinline__ void operator()(const f32x4 (&acc)[2][2][4][2], const Unit& u, int wr, int wc, int fr, int fq) const {
        const int row0 = u.pm * BM + wr * 64 + fr, j0 = u.pn * HALF + wc * 32 + 8 * fq;
        const float* bp = bgu + (size_t)u.aux * 2048 + 2 * j0;
        const f32x4 b0 = *(const f32x4*)(bp), b1 = *(const f32x4*)(bp + 4), b2 = *(const f32x4*)(bp + 8), b3 = *(const f32x4*)(bp + 12);
        const float bg[8] = {b0[0], b0[2], b1[0], b1[2], b2[0], b2[2], b3[0], b3[2]}, bl[8] = {b0[1], b0[3], b1[1], b1[3], b2[1], b2[3], b3[1], b3[3]};
        constexpr float inv = MOE_FP8 ? 1.0f / (F8_SX * F8_SWG) : 1.0f;
#pragma unroll
        for (int ai = 0; ai < 2; ++ai)
#pragma unroll
            for (int m = 0; m < 4; ++m) { unsigned char* rowp = Hh + ((size_t)(row0 + ai * HALF + m * 16) * DFF + j0) * (MOE_FP8 ? 1 : 2);
                float o[8];
#pragma unroll
                for (int q = 0; q < 8; ++q) { float g = acc[ai][0][m][q >> 2][q & 3] * inv + bg[q], l = acc[ai][1][m][q >> 2][q & 3] * inv + bl[q];
                    g = fminf(g, 7.0f); l = fminf(fmaxf(l, -7.0f), 7.0f);
                    const float sg = __builtin_amdgcn_rcpf(1.0f + __builtin_amdgcn_exp2f(-1.702f * 1.4426950408889634f * g));
                    o[q] = (l + 1.0f) * g * sg * (MOE_FP8 ? F8_SH : 1.0f); }
                if (MOE_FP8) { u32x2 w; w.x = cvt4_fp8(o[0], o[1], o[2], o[3]); w.y = cvt4_fp8(o[4], o[5], o[6], o[7]); *(u32x2*)rowp = w; }
                else { u32x4 w; w.x = cvt_pk_bf16(o[0], o[1]); w.y = cvt_pk_bf16(o[2], o[3]); w.z = cvt_pk_bf16(o[4], o[5]); w.w = cvt_pk_bf16(o[6], o[7]); *(u32x4*)rowp = w; } }
    }
};
struct EpiDown {
    static constexpr bool PERM = true;
    bf16_t* Y; const float* bd;
    __device__ __forceinline__ void operator()(const f32x4 (&acc)[2][2][4][2], const Unit& u, int wr, int wc, int fr, int fq) const {
        const int row0 = u.pm * BM + wr * 64 + fr, col0 = u.pn * BM + wc * 32 + 8 * fq;
        const float* bp = bd + (size_t)u.aux * D + col0;
        constexpr float inv = MOE_FP8 ? 1.0f / (F8_SH * F8_SWD) : 1.0f;
#pragma unroll
        for (int bj = 0; bj < 2; ++bj) {
            const f32x4 b0 = *(const f32x4*)(bp + bj * HALF), b1 = *(const f32x4*)(bp + bj * HALF + 4);
#pragma unroll
            for (int ai = 0; ai < 2; ++ai)
#pragma unroll
                for (int m = 0; m < 4; ++m) { const f32x4 v0 = acc[ai][bj][m][0] * inv + b0, v1 = acc[ai][bj][m][1] * inv + b1;
                    u32x4 w; w.x = cvt_pk_bf16(v0[0], v0[1]); w.y = cvt_pk_bf16(v0[2], v0[3]); w.z = cvt_pk_bf16(v1[0], v1[1]); w.w = cvt_pk_bf16(v1[2], v1[3]);
                    *(u32x4*)((char*)Y + ((size_t)(unsigned)(row0 + ai * HALF + m * 16) * D + (unsigned)(col0 + bj * HALF)) * 2u) = w; }
            asm volatile("" ::: "memory"); }
    }
};

struct DenseOrder {
    const char* A; const char* Bt; int nM, nN, G, c; size_t astep, bstep;
    __device__ __forceinline__ void init(const void* A_, const void* Bt_, int M, int N, int lda, int ldb, int G_, int c_) { A = (const char*)A_; Bt = (const char*)Bt_; nM = M / BM; nN = N / BM; G = G_; c = c_; astep = (size_t)BM * lda * 2; bstep = (size_t)BM * ldb * 2; }
    __device__ __forceinline__ bool next(int i, Unit& u) const {
        const int L = i * G + c; if (L >= nM * nN) return false;
        u.pm = L / nN; u.pn = L - u.pm * nN; u.aux = 0; u.nvalid = 256; u.A = A + (size_t)u.pm * astep; u.B = Bt + (size_t)u.pn * bstep; u.rows = nullptr; return true;
    }
};
struct MoeOrder {
    const volatile LAS int* ntp; const char* A; const char* W; const int* list; const unsigned* cnt; int NC, G, c; size_t wstep_e, astep;
    bool gather; size_t arow_step;
    __device__ __forceinline__ bool next(int i, Unit& u) const {
        const int L = i * G + c; const int NT = ntp[32]; if (L >= NT * NC) return false;
        const int rt = L / NC, pn = L - rt * NC; int e = 0;
        for (int k = 1; k < 32; ++k) e += (rt >= ntp[k]) ? 1 : 0;
        e = __builtin_amdgcn_readfirstlane(e);
        const int rtl = rt - ntp[e];
        u.pm = rt; u.pn = pn; u.aux = e; u.B = W + (size_t)e * wstep_e + (size_t)pn * astep;
        const int c_e = (int)__hip_atomic_load(cnt + e * 64, __ATOMIC_RELAXED, __HIP_MEMORY_SCOPE_AGENT);
        int nv = c_e - rtl * 256; u.nvalid = __builtin_amdgcn_readfirstlane(nv > 256 ? 256 : nv);
        if (gather) { u.A = A; u.rows = list + (size_t)e * T + (size_t)rtl * 256; } else { u.A = A + (size_t)rt * arow_step; u.rows = nullptr; }
        return true;
    }
};
}
struct Args { const void* in[20]; float* out; unsigned char* ws; int ph_lo, ph_hi; };
struct Frame {
    LAS unsigned char* lds; volatile LAS unsigned* MISC;
    int tid, lane, wave, vcu, G;
    __device__ __forceinline__ const void* ptr(int i) const { const unsigned lo = __builtin_amdgcn_readfirstlane(MISC[128 + 2 * i]), hi = __builtin_amdgcn_readfirstlane(MISC[129 + 2 * i]); return (const void*)(((unsigned long long)hi << 32) | lo); }
    __device__ __forceinline__ unsigned char* ws() const { return (unsigned char*)ptr(21); }
    __device__ __forceinline__ float* out() const { return (float*)ptr(20); }
    __device__ __forceinline__ unsigned* ctl() const { return (unsigned*)ptr(21); }
};
__device__ __forceinline__ Frame refresh(const Frame& F) {
    Frame R = F; int ln, w = F.wave, v = F.vcu, g = F.G;
    asm volatile("v_mbcnt_lo_u32_b32 %0, -1, 0\n\tv_mbcnt_hi_u32_b32 %0, -1, %0" : "=v"(ln));
    asm volatile("" : "+s"(w), "+s"(v), "+s"(g));
    R.tid = w * 64 + ln; R.lane = ln; R.wave = w; R.vcu = v; R.G = g; return R;
}
enum { IN_X = 0, IN_POS, IN_LNG, IN_LNB, IN_MWIN, IN_MBG, IN_MNG, IN_MWOUT, IN_AWIN, IN_AQN, IN_AKVN, IN_AWQB, IN_AWKVB, IN_AWOUT, IN_RW, IN_RB, IN_WGU, IN_BGU, IN_WD, IN_BD };

template <class RowMap>
__device__ __forceinline__ void transpose_item(const float* __restrict__ W, int ldw, int K, bf16_t* __restrict__ WT, LAS float* scr, int kb, int nb, int lane, RowMap rm) {
    const int k0 = 64 * kb, n0 = 32 * nb;
#pragma unroll 8
    for (int i = 0; i < 32; ++i) { const int kk = 2 * i + (lane >> 5); scr[kk * 33 + (lane & 31)] = W[(size_t)(k0 + kk) * ldw + n0 + (lane & 31)]; }
    LDS_WAIT();
    const int c = lane & 7;
#pragma unroll
    for (int j = 0; j < 4; ++j) { const int n = (lane >> 3) + 8 * j; const LAS float* s = scr + (8 * c) * 33 + n;
        u32x4 o; o.x = cvt_pk_bf16(s[0 * 33], s[1 * 33]); o.y = cvt_pk_bf16(s[2 * 33], s[3 * 33]); o.z = cvt_pk_bf16(s[4 * 33], s[5 * 33]); o.w = cvt_pk_bf16(s[6 * 33], s[7 * 33]);
        const int dr = rm(n0 + n);
        *(u32x4*)(WT + (size_t)dr * K + k0 + 8 * c) = o; }
    LDS_WAIT();
}
template <class RowMap>
__device__ __forceinline__ void transpose_item_f8(const float* __restrict__ W, int ldw, int K, unsigned char* __restrict__ WT, LAS float* scr, int kb, int nb, int lane, RowMap rm, float scale) {
    const int k0 = 64 * kb, n0 = 32 * nb;
#pragma unroll 8
    for (int i = 0; i < 32; ++i) { const int kk = 2 * i + (lane >> 5); scr[kk * 33 + (lane & 31)] = W[(size_t)(k0 + kk) * ldw + n0 + (lane & 31)] * scale; }
    LDS_WAIT();
    const int c = lane & 3;
#pragma unroll
    for (int j = 0; j < 2; ++j) { const int n = (lane >> 2) + 16 * j; const LAS float* s = scr + (16 * c) * 33 + n;
        u32x4 o; o.x = cvt4_fp8(s[0 * 33], s[1 * 33], s[2 * 33], s[3 * 33]); o.y = cvt4_fp8(s[4 * 33], s[5 * 33], s[6 * 33], s[7 * 33]);
        o.z = cvt4_fp8(s[8 * 33], s[9 * 33], s[10 * 33], s[11 * 33]); o.w = cvt4_fp8(s[12 * 33], s[13 * 33], s[14 * 33], s[15 * 33]);
        const int dr = rm(n0 + n);
        *(u32x4*)(WT + (size_t)dr * K + k0 + 16 * c) = o; }
    LDS_WAIT();
}
struct RmId { __device__ __forceinline__ int operator()(int n) const { return n; } };
struct RmQb { __device__ __forceinline__ int operator()(int n) const { const int hh = n / AQD, r = n - hh * AQD; if (r < ANOPE) return n; const int i = r - ANOPE; return hh * AQD + ANOPE + ((i < 32) ? 2 * i : 2 * (i - 32) + 1); } };
struct RmKv { __device__ __forceinline__ int operator()(int n) const { const int hh = n >> 8, r = n & 255; return (r < 128) ? hh * 128 + r : 1024 + hh * 128 + (r - 128); } };
struct RmGu { __device__ __forceinline__ int operator()(int n) const { const int j = n >> 1, l = n & 1; return (j >> 7) * 256 + l * 128 + (j & 127); } };

__device__ __forceinline__ void p0_prologue(const Frame& F) {
    LAS float* scr = (LAS float*)(F.lds + F.wave * 8704);
    const int gw = F.vcu * NWAVES + F.wave, NGW = F.G * NWAVES, lane = F.lane;
    unsigned char* ws = F.ws();
    constexpr int I_MWIN = 16 * 96, I_SQ = 16 * 32, I_AWIN = 16 * 22, I_QB = 6 * 48, I_KV = 4 * 64, I_GU = 16 * 64, I_D = 16 * 32;
    constexpr int N_SMALL = 2 * (I_MWIN + I_SQ + I_AWIN + I_QB + I_KV + I_SQ);
    constexpr int N_GU = 128 * I_GU, N_D = 128 * I_D, NITEMS = N_SMALL + N_GU + N_D;
    for (int it = gw; it < NITEMS; it += NGW) {
        int r = it;
        if (r >= N_SMALL) {
            r -= N_SMALL;
            if (r < N_GU) { const int mtx = r >> 10, q = r & 1023;
                if (MOE_FP8) transpose_item_f8((const float*)F.ptr(IN_WGU) + (size_t)mtx * 1024 * 2048, 2048, 1024, (unsigned char*)(ws + WS_WGU) + (size_t)mtx * 2048 * 1024, scr, q >> 6, q & 63, lane, RmGu(), F8_SWG);
                else transpose_item((const float*)F.ptr(IN_WGU) + (size_t)mtx * 1024 * 2048, 2048, 1024, (bf16_t*)(ws + WS_WGU) + (size_t)mtx * 2048 * 1024, scr, q >> 6, q & 63, lane, RmGu()); }
            else { r -= N_GU; const int mtx = r >> 9, q = r & 511;
                if (MOE_FP8) transpose_item_f8((const float*)F.ptr(IN_WD) + (size_t)mtx * 1024 * 1024, 1024, 1024, (unsigned char*)(ws + WS_WD) + (size_t)mtx * 1024 * 1024, scr, q >> 5, q & 31, lane, RmId(), F8_SWD);
                else transpose_item((const float*)F.ptr(IN_WD) + (size_t)mtx * 1024 * 1024, 1024, 1024, (bf16_t*)(ws + WS_WD) + (size_t)mtx * 1024 * 1024, scr, q >> 5, q & 31, lane, RmId()); }
            continue;
        }
        const int j = (r >= N_SMALL / 2) ? 1 : 0; r -= j * (N_SMALL / 2);
        if (r < I_MWIN) { transpose_item((const float*)F.ptr(IN_MWIN) + (size_t)j * 1024 * MIN_, MIN_, 1024, (bf16_t*)(ws + WS_WINM) + (size_t)j * 3072 * 1024, scr, r / 96, r % 96, lane, RmId()); continue; } r -= I_MWIN;
        if (r < I_SQ) { transpose_item((const float*)F.ptr(IN_MWOUT) + (size_t)j * 1024 * 1024, 1024, 1024, (bf16_t*)(ws + WS_WOUTM) + (size_t)j * 1024 * 1024, scr, r >> 5, r & 31, lane, RmId()); continue; } r -= I_SQ;
        if (r < I_AWIN) { transpose_item((const float*)F.ptr(IN_AWIN) + (size_t)j * 1024 * AIN, AIN, 1024, (bf16_t*)(ws + WS_WINA) + (size_t)j * AINP * 1024, scr, r / 22, r % 22, lane, RmId()); continue; } r -= I_AWIN;
        if (r < I_QB) { transpose_item((const float*)F.ptr(IN_AWQB) + (size_t)j * AQL * 1536, 1536, AQL, (bf16_t*)(ws + WS_WQB) + (size_t)j * 1536 * AQL, scr, r / 48, r % 48, lane, RmQb()); continue; } r -= I_QB;
        if (r < I_KV) { transpose_item((const float*)F.ptr(IN_AWKVB) + (size_t)j * AKL * 2048, 2048, AKL, (bf16_t*)(ws + WS_WKV) + (size_t)j * 2048 * AKL, scr, r >> 6, r & 63, lane, RmKv()); continue; } r -= I_KV;
        transpose_item((const float*)F.ptr(IN_AWOUT) + (size_t)j * 1024 * 1024, 1024, 1024, (bf16_t*)(ws + WS_WOUTA) + (size_t)j * 1024 * 1024, scr, r >> 5, r & 31, lane, RmId());
    }
    { const int gt = F.vcu * NTHR + F.tid, NGT = F.G * NTHR;
      for (int i = gt; i < 2 * 64 * 1024 / 8; i += NGT) { const int j = i / (64 * 1024 / 8), q = i - j * (64 * 1024 / 8);
          *(u32x4*)((bf16_t*)(ws + WS_WINA) + (size_t)j * AINP * 1024 + (size_t)AIN * 1024 + (size_t)q * 8) = (u32x4){0u, 0u, 0u, 0u}; }
      const float* x = (const float*)F.ptr(IN_X); bf16_t* xb = (bf16_t*)(ws + WS_XB);
      for (size_t i = gt; i < (size_t)T * D / 8; i += NGT) { const f32x4 v0 = *(const f32x4*)(x + i * 8), v1 = *(const f32x4*)(x + i * 8 + 4);
          u32x4 w; w.x = cvt_pk_bf16(v0[0], v0[1]); w.y = cvt_pk_bf16(v0[2], v0[3]); w.z = cvt_pk_bf16(v1[0], v1[1]); w.w = cvt_pk_bf16(v1[2], v1[3]); *(u32x4*)(xb + i * 8) = w; }
      const int* pos = (const int*)F.ptr(IN_POS); float* ct = (float*)(ws + WS_COS); float* st = (float*)(ws + WS_SIN);
      for (int i = gt; i < T * 32; i += NGT) { const int m = i >> 5, k = i & 31;
          const float inv = exp2f(-(float)(2 * k) * (13.287712379549449f / 64.0f));
          const float ang = (float)pos[m] * inv;
          const double rev = (double)ang * 0.15915494309189535; const float fr = (float)(rev - floor(rev));
          ct[i] = __builtin_amdgcn_cosf(fr); st[i] = __builtin_amdgcn_sinf(fr); }
    }
}

template <int NEX>
__device__ __forceinline__ void skinny_fill(const Frame& F, const float* __restrict__ W, int ldw) {
    LAS float* wl = (LAS float*)F.lds;
    for (int idx = F.tid; idx < 1024 * NEX; idx += NTHR) { const int k = idx / NEX, e = idx % NEX; wl[((k >> 2) * NEX + e) * 4 + (k & 3)] = W[(size_t)k * ldw + e]; }
    __syncthreads();
}
__device__ __forceinline__ void gates_phase(const Frame& F, const float* __restrict__ X, const float* __restrict__ bg, float* __restrict__ Gt) {
    const LAS f32x4* wl = (const LAS f32x4*)F.lds;
    const int tok = F.lane & 15, kq = F.lane >> 4;
    const f32x4 bias = *(const f32x4*)(bg + 4 * kq);
    for (int grp = F.vcu * NWAVES + F.wave; grp < T / 16; grp += F.G * NWAVES) {
        const int m0 = grp * 16; const float* xr = X + (size_t)(m0 + tok) * D + 4 * kq;
        f32x4 acc0 = {0.f, 0.f, 0.f, 0.f}, acc1 = {0.f, 0.f, 0.f, 0.f};
#pragma unroll 4
        for (int i = 0; i < 64; i += 2) {
            const f32x4 x0 = *(const f32x4*)(xr + 16 * i), x1 = *(const f32x4*)(xr + 16 * (i + 1));
            const f32x4 w0 = wl[(i * 4 + kq) * 16 + tok], w1 = wl[((i + 1) * 4 + kq) * 16 + tok];
#pragma unroll
            for (int j = 0; j < 4; ++j) { acc0 = __builtin_amdgcn_mfma_f32_16x16x4f32(w0[j], x0[j], acc0, 0, 0, 0); acc1 = __builtin_amdgcn_mfma_f32_16x16x4f32(w1[j], x1[j], acc1, 0, 0, 0); }
        }
        *(f32x4*)(Gt + (size_t)(m0 + tok) * 16 + 4 * kq) = acc0 + acc1 + bias;
    }
}

__device__ __forceinline__ void ln_router_phase(const Frame& F, int layer, int cnt_layer) {
    unsigned char* ws = F.ws();
    const float* __restrict__ ZF = (const float*)(ws + WS_ZF); float* __restrict__ XF = (float*)(ws + WS_XF); unsigned char* __restrict__ XB8 = (unsigned char*)(ws + WS_XB8);
    const float* lng = (const float*)F.ptr(IN_LNG) + (size_t)(layer * 2) * D; const float* lnb = (const float*)F.ptr(IN_LNB) + (size_t)(layer * 2) * D;
    const int lane = F.lane, tok = lane & 15, kq = lane >> 4;
    unsigned* cnt = F.ctl() + CW_CNT + cnt_layer * 32 * 64;
    volatile LAS unsigned* hist = F.MISC + 64; volatile LAS unsigned* hbase = F.MISC + 96; volatile LAS float* cvec = (volatile LAS float*)(F.MISC + 192);
    LAS float* wl = (LAS float*)F.lds; LAS float* part = (LAS float*)(F.lds + 131072);
    {
        const float* Wr = (const float*)F.ptr(IN_RW) + (size_t)layer * D * NE; const int e = F.tid & 31; float cp = 0.f;
#pragma unroll 8
        for (int it = 0; it < 64; ++it) { const int k = (F.tid >> 5) + 16 * it; const float w = Wr[(size_t)k * NE + e]; wl[((k >> 2) * 32 + e) * 4 + (k & 3)] = w * lng[k]; cp += w * lnb[k]; }
        part[(F.tid >> 5) * 32 + e] = cp;
        if (F.tid < 32) hist[F.tid] = 0u;
        __syncthreads();
        if (F.tid < 32) { float c = ((const float*)F.ptr(IN_RB))[layer * NE + F.tid];
#pragma unroll
            for (int q = 0; q < 16; ++q) c += part[q * 32 + F.tid];
            cvec[F.tid] = c; }
        __syncthreads();
    }
    f32x4 gv[4], bv[4];
#pragma unroll
    for (int j = 0; j < 4; ++j) { gv[j] = *(const f32x4*)(lng + 4 * lane + 256 * j); bv[j] = *(const f32x4*)(lnb + 4 * lane + 256 * j); }
    for (int grp = F.vcu; grp < T / 128; grp += F.G) {
        const int m0 = grp * 128 + F.wave * 16;
        float mu_l = 0.f, rs_l = 0.f;
        f32x4 nx[4];
#pragma unroll
        for (int j = 0; j < 4; ++j) nx[j] = *(const f32x4*)(ZF + (size_t)m0 * D + 4 * lane + 256 * j);
#pragma unroll 2
        for (int r = 0; r < 16; ++r) {
            const int m = m0 + r; f32x4 v[4];
#pragma unroll
            for (int j = 0; j < 4; ++j) v[j] = nx[j];
            if (r < 15) {
#pragma unroll
                for (int j = 0; j < 4; ++j) nx[j] = *(const f32x4*)(ZF + (size_t)(m + 1) * D + 4 * lane + 256 * j); }
            float s = 0.f;
#pragma unroll
            for (int j = 0; j < 4; ++j) s += (v[j][0] + v[j][1]) + (v[j][2] + v[j][3]);
            const float mean = wave_sum(s) * (1.f / D); float s2 = 0.f;
#pragma unroll
            for (int j = 0; j < 4; ++j) { v[j] = v[j] - mean; s2 += (v[j][0] * v[j][0] + v[j][1] * v[j][1]) + (v[j][2] * v[j][2] + v[j][3] * v[j][3]); }
            const float rstd = 1.f / sqrtf(wave_sum(s2) * (1.f / D) + LN_EPS);
            if (tok == r) { mu_l = mean; rs_l = rstd; }
#pragma unroll
            for (int j = 0; j < 4; ++j) { const f32x4 y = v[j] * rstd * gv[j] + bv[j]; *(f32x4*)(XF + (size_t)m * D + 4 * lane + 256 * j) = y;
                if (MOE_FP8) *(unsigned*)(XB8 + (size_t)m * D + 4 * lane + 256 * j) = cvt4_fp8(y[0] * F8_SX, y[1] * F8_SX, y[2] * F8_SX, y[3] * F8_SX);
                else { u32x2 w; w.x = cvt_pk_bf16(y[0], y[1]); w.y = cvt_pk_bf16(y[2], y[3]); *(u32x2*)((bf16_t*)(ws + WS_XB) + (size_t)m * D + 4 * lane + 256 * j) = w; } }
        }
        const LAS f32x4* wl4 = (const LAS f32x4*)F.lds;
        const float* zr = ZF + (size_t)(m0 + tok) * D + 4 * kq;
        f32x4 acc0 = {0.f, 0.f, 0.f, 0.f}, acc1 = {0.f, 0.f, 0.f, 0.f};
#pragma unroll 1
        for (int c = 0; c < 4; ++c) {
            f32x4 zb[16];
#pragma unroll
            for (int i = 0; i < 16; ++i) zb[i] = *(const f32x4*)(zr + 16 * (16 * c + i));
#pragma unroll
            for (int i = 0; i < 16; ++i) { const f32x4 xn = zb[i] - mu_l; const int ii = 16 * c + i;
                const f32x4 w0 = wl4[(ii * 4 + kq) * 32 + tok], w1 = wl4[(ii * 4 + kq) * 32 + 16 + tok];
#pragma unroll
                for (int j = 0; j < 4; ++j) { acc0 = __builtin_amdgcn_mfma_f32_16x16x4f32(w0[j], xn[j], acc0, 0, 0, 0); acc1 = __builtin_amdgcn_mfma_f32_16x16x4f32(w1[j], xn[j], acc1, 0, 0, 0); } }
        }
        float lv[8]; int used = 0;
#pragma unroll
        for (int r = 0; r < 4; ++r) { lv[r] = acc0[r] * rs_l + cvec[4 * kq + r]; lv[4 + r] = acc1[r] * rs_l + cvec[16 + 4 * kq + r]; }
        float tv[4]; int ti[4];
#pragma unroll
        for (int k = 0; k < 4; ++k) {
            float bvv = -3.0e38f; int bi = 64, bslot = -1;
#pragma unroll
            for (int q = 0; q < 8; ++q) { const int idx = (q < 4) ? 4 * kq + q : 16 + 4 * kq + (q - 4); const bool ok = !((used >> q) & 1) && (lv[q] > bvv || (lv[q] == bvv && idx < bi)); if (ok) { bvv = lv[q]; bi = idx; bslot = q; } }
            float gvv = bvv; int gi = bi;
#pragma unroll
            for (int o = 16; o <= 32; o <<= 1) { const float ov = __shfl_xor(gvv, o); const int oi = __shfl_xor(gi, o); if (ov > gvv || (ov == gvv && oi < gi)) { gvv = ov; gi = oi; } }
            if (gi == bi && bslot >= 0) used |= (1 << bslot);
            tv[k] = gvv; ti[k] = gi;
        }
        const float e1 = __expf(tv[1] - tv[0]), e2 = __expf(tv[2] - tv[0]), e3 = __expf(tv[3] - tv[0]); const float inv = 1.f / (1.f + e1 + e2 + e3);
        const float myg = (kq == 0 ? 1.f : kq == 1 ? e1 : kq == 2 ? e2 : e3) * inv; const int mye = (kq == 0 ? ti[0] : kq == 1 ? ti[1] : kq == 2 ? ti[2] : ti[3]);
        const unsigned rank = __hip_atomic_fetch_add((LAS unsigned*)(hist + mye), 1u, __ATOMIC_RELAXED, __HIP_MEMORY_SCOPE_WORKGROUP);
        __syncthreads();
        if (F.tid < 32) { const unsigned c = hist[F.tid]; hbase[F.tid] = __hip_atomic_fetch_add(cnt + F.tid * 64, c, __ATOMIC_RELAXED, __HIP_MEMORY_SCOPE_AGENT); hist[F.tid] = 0u; }
        __syncthreads();
        const unsigned pos = hbase[mye] + rank; const int m = m0 + tok;
        ((int*)(ws + WS_TOKINFO))[m * 4 + kq] = (mye << 20) | (int)pos; ((float*)(ws + WS_TOKGATE))[m * 4 + kq] = myg;
        ((int*)(ws + WS_LIST))[(size_t)mye * T + pos] = m;
    }
}

__device__ __forceinline__ void ln_combine_phase(const Frame& F, int layer, bool is_last, bool dummy) {
    unsigned char* ws = F.ws();
    float* __restrict__ XF = (float*)(ws + WS_XF); bf16_t* __restrict__ XB = (bf16_t*)(ws + WS_XB); const bf16_t* __restrict__ YM = (const bf16_t*)(ws + WS_YMOE);
    const float* lng = (const float*)F.ptr(IN_LNG) + (size_t)(layer * 2 + 1) * D; const float* lnb = (const float*)F.ptr(IN_LNB) + (size_t)(layer * 2 + 1) * D;
    const int lane = F.lane;
    const int* tokinfo = (const int*)(ws + WS_TOKINFO); const float* tokgate = (const float*)(ws + WS_TOKGATE);
    volatile LAS int* ntp = (volatile LAS int*)(F.MISC + 16);
    f32x4 gv[4], bv[4];
#pragma unroll
    for (int j = 0; j < 4; ++j) { gv[j] = *(const f32x4*)(lng + 4 * lane + 256 * j); bv[j] = *(const f32x4*)(lnb + 4 * lane + 256 * j); }
    float* OUT = is_last ? F.out() : XF;
    bf16_t* XBo = XB; if (dummy) { OUT = (float*)(ws + WS_ZF); XBo = (bf16_t*)(ws + WS_HB); }
    for (int grp = F.vcu * NWAVES + F.wave; grp < T / 16; grp += F.G * NWAVES) {
        const int m0 = grp * 16;
        const int inf = tokinfo[m0 * 4 + lane]; const float gl = tokgate[m0 * 4 + lane];
        const unsigned prl = (unsigned)(ntp[inf >> 20] * 256 + (inf & 0xfffff));
        f32x4 nx[4]; u32x2 ny[4][4]; float ng[4];
#define LNC_LOAD(r) do { _Pragma("unroll") for (int j = 0; j < 4; ++j) nx[j] = *(const f32x4*)(XF + (size_t)(m0 + (r)) * D + 4 * lane + 256 * j); \
            _Pragma("unroll") for (int k = 0; k < 4; ++k) { const unsigned pr = (unsigned)__builtin_amdgcn_readlane((int)prl, 4 * (r) + k); ng[k] = __uint_as_float((unsigned)__builtin_amdgcn_readlane((int)__float_as_uint(gl), 4 * (r) + k)); \
                const bf16_t* yr = YM + (size_t)pr * D + 4 * lane; _Pragma("unroll") for (int j = 0; j < 4; ++j) ny[k][j] = *(const u32x2*)(yr + 256 * j); } } while (0)
        LNC_LOAD(0);
#pragma unroll 1
        for (int r = 0; r < 16; ++r) {
            const int m = m0 + r; f32x4 v[4];
#pragma unroll
            for (int j = 0; j < 4; ++j) v[j] = nx[j] * DN_ALPHA;
#pragma unroll
            for (int k = 0; k < 4; ++k) { const float g = ng[k];
#pragma unroll
                for (int j = 0; j < 4; ++j) { const u32x2 w = ny[k][j]; v[j][0] += g * bf_lo(w.x); v[j][1] += g * bf_hi(w.x); v[j][2] += g * bf_lo(w.y); v[j][3] += g * bf_hi(w.y); } }
            if (r < 15) LNC_LOAD(r + 1);
            float s = 0.f;
#pragma unroll
            for (int j = 0; j < 4; ++j) s += (v[j][0] + v[j][1]) + (v[j][2] + v[j][3]);
            const float mean = wave_sum(s) * (1.f / D); float s2 = 0.f;
#pragma unroll
            for (int j = 0; j < 4; ++j) { v[j] = v[j] - mean; s2 += (v[j][0] * v[j][0] + v[j][1] * v[j][1]) + (v[j][2] * v[j][2] + v[j][3] * v[j][3]); }
            const float rstd = 1.f / sqrtf(wave_sum(s2) * (1.f / D) + LN_EPS);
#pragma unroll
            for (int j = 0; j < 4; ++j) { const f32x4 y = v[j] * rstd * gv[j] + bv[j]; *(f32x4*)(OUT + (size_t)m * D + 4 * lane + 256 * j) = y;
                u32x2 w; w.x = cvt_pk_bf16(y[0], y[1]); w.y = cvt_pk_bf16(y[2], y[3]); *(u32x2*)(XBo + (size_t)m * D + 4 * lane + 256 * j) = w; }
        }
#undef LNC_LOAD
    }
}

__device__ __forceinline__ void moe_prefix(const Frame& F, int layer) {
    volatile LAS int* ntp = (volatile LAS int*)(F.MISC + 16);
    __syncthreads();
    if (F.tid == 0) { unsigned* cnt = F.ctl() + CW_CNT + layer * 32 * 64; int acc = 0;
        for (int e = 0; e < 32; ++e) { ntp[e] = acc; acc += ((int)__hip_atomic_load(cnt + e * 64, __ATOMIC_RELAXED, __HIP_MEMORY_SCOPE_AGENT) + 255) >> 8; } ntp[32] = acc; }
    __syncthreads();
}

__device__ __forceinline__ void mla_norm_phase(const Frame& F, int j) {
    unsigned char* ws = F.ws(); const float* A32 = (const float*)(ws + WS_A32);
    bf16_t* CQ = (bf16_t*)(ws + WS_CQ); bf16_t* CKV = (bf16_t*)(ws + WS_CKV); bf16_t* KR = (bf16_t*)(ws + WS_KR);
    const float* qn = (const float*)F.ptr(IN_AQN) + j * AQL; const float* kvn = (const float*)F.ptr(IN_AKVN) + j * AKL;
    const float* ct = (const float*)(ws + WS_COS); const float* st = (const float*)(ws + WS_SIN);
    const int lane = F.lane;
    for (int m = F.vcu * NWAVES + F.wave; m < T; m += F.G * NWAVES) {
        const float* ar = A32 + (size_t)m * AINP;
        f32x4 q0 = {0.f, 0.f, 0.f, 0.f}, q1 = q0, k0 = q0, k1 = q0; float sq = 0.f, sk = 0.f;
        if (lane < 48) { q0 = *(const f32x4*)(ar + 8 * lane); q1 = *(const f32x4*)(ar + 8 * lane + 4); sq = (q0[0] * q0[0] + q0[1] * q0[1]) + (q0[2] * q0[2] + q0[3] * q0[3]) + (q1[0] * q1[0] + q1[1] * q1[1]) + (q1[2] * q1[2] + q1[3] * q1[3]); }
        if (lane < 32) { k0 = *(const f32x4*)(ar + AQL + 8 * lane); k1 = *(const f32x4*)(ar + AQL + 8 * lane + 4); sk = (k0[0] * k0[0] + k0[1] * k0[1]) + (k0[2] * k0[2] + k0[3] * k0[3]) + (k1[0] * k1[0] + k1[1] * k1[1]) + (k1[2] * k1[2] + k1[3] * k1[3]); }
        const float rq = 1.f / sqrtf(wave_sum(sq) * (1.f / AQL) + RMS_EPS), rk = 1.f / sqrtf(wave_sum(sk) * (1.f / AKL) + RMS_EPS);
        if (lane < 48) { const f32x4 g0 = *(const f32x4*)(qn + 8 * lane), g1 = *(const f32x4*)(qn + 8 * lane + 4); const f32x4 y0 = q0 * rq * g0, y1 = q1 * rq * g1;
            u32x4 w; w.x = cvt_pk_bf16(y0[0], y0[1]); w.y = cvt_pk_bf16(y0[2], y0[3]); w.z = cvt_pk_bf16(y1[0], y1[1]); w.w = cvt_pk_bf16(y1[2], y1[3]); *(u32x4*)(CQ + (size_t)m * AQL + 8 * lane) = w; }
        if (lane < 32) { const f32x4 g0 = *(const f32x4*)(kvn + 8 * lane), g1 = *(const f32x4*)(kvn + 8 * lane + 4); const f32x4 y0 = k0 * rk * g0, y1 = k1 * rk * g1;
            u32x4 w; w.x = cvt_pk_bf16(y0[0], y0[1]); w.y = cvt_pk_bf16(y0[2], y0[3]); w.z = cvt_pk_bf16(y1[0], y1[1]); w.w = cvt_pk_bf16(y1[2], y1[3]); *(u32x4*)(CKV + (size_t)m * AKL + 8 * lane) = w;
            const float x1 = ar[AQL + AKL + lane], x2 = ar[AQL + AKL + 32 + lane], c = ct[(size_t)m * 32 + lane], s = st[(size_t)m * 32 + lane];
            *(unsigned*)(KR + (size_t)m * AROPE + 2 * lane) = cvt_pk_bf16(x1 * c - x2 * s, x2 * c + x1 * s); }
    }
}
constexpr int MT_STRIDE = 144;
__device__ __forceinline__ float log_sigmoid(float x) { return fminf(x, 0.f) - __logf(1.f + __expf(-fabsf(x))); }
__device__ __forceinline__ float wave_incl_scan_add(float v, int lane) {
#pragma unroll
    for (int o = 1; o < 64; o <<= 1) { const float t = __shfl_up(v, o); if (lane >= o) v += t; }
    return v;
}
__device__ __forceinline__ float wave_incl_scan_max(float v, int lane) {
#pragma unroll
    for (int o = 1; o < 64; o <<= 1) { const float t = __shfl_up(v, o); if (lane >= o) v = fmaxf(v, t); }
    return v;
}
template <int NCH>
__device__ __forceinline__ void stage_transposed(LAS unsigned char* tile, const bf16_t* __restrict__ src, int lane, float scale, bool do_scale) {
#pragma unroll
    for (int c = 0; c < NCH; ++c) { const u32x4 w = *(const u32x4*)(src + 8 * c); const unsigned ww[4] = {w.x, w.y, w.z, w.w};
#pragma unroll
        for (int p = 0; p < 4; ++p) { unsigned lo = ww[p] & 0xffffu, hi = ww[p] >> 16;
            if (do_scale) { const unsigned pk = cvt_pk_bf16(bf_lo(ww[p]) * scale, bf_hi(ww[p]) * scale); lo = pk & 0xffffu; hi = pk >> 16; }
            *(LAS bf16_t*)(tile + (8 * c + 2 * p) * MT_STRIDE + 2 * lane) = (bf16_t)lo; *(LAS bf16_t*)(tile + (8 * c + 2 * p + 1) * MT_STRIDE + 2 * lane) = (bf16_t)hi; } }
}

__device__ __forceinline__ void mlstm_local_phase(const Frame& F) {
    unsigned char* ws = F.ws(); const bf16_t* PROJ = (const bf16_t*)(ws + WS_PROJ); const float* Gt = (const float*)(ws + WS_GATES);
    float* CLOC = (float*)(ws + WS_CLOC); float* NLOC = (float*)(ws + WS_NLOC); float* GMAX = (float*)(ws + WS_MSC); float* BL = GMAX + MUNITS;
    const int lane = F.lane, c32 = lane & 31, hi = lane >> 5;
    LAS unsigned char* kt = F.lds + F.wave * (2 * 64 * MT_STRIDE); LAS unsigned char* vt = kt + 64 * MT_STRIDE;
    for (int it = F.vcu * NWAVES + F.wave; it < MUNITS * 2; it += F.G * NWAVES) {
        const int u = it >> 1, half = it & 1, c = u & (MNC - 1), bh = u >> 7, h = bh & 7, b = bh >> 3, m0 = b * SEQ + c * MCH;
        const int m = m0 + lane;
        const float ig = Gt[(size_t)m * 16 + h], lf = log_sigmoid(Gt[(size_t)m * 16 + 8 + h]);
        const float bc = wave_incl_scan_add(lf, lane), bl = __shfl(bc, 63);
        const float g = bl - bc + ig, gmax = wave_max(g), w = __expf(g - gmax);
        stage_transposed<8>(kt, PROJ + (size_t)m * 3072 + 512 + h * 64, lane, w, true);
        stage_transposed<8>(vt, PROJ + (size_t)m * 3072 + 1024 + h * 128 + half * 64, lane, 1.f, false);
        LDS_WAIT();
        f32x16 acc[2][2];
#pragma unroll
        for (int i = 0; i < 2; ++i)
#pragma unroll
            for (int j = 0; j < 2; ++j)
#pragma unroll
                for (int r = 0; r < 16; ++r) acc[i][j][r] = 0.f;
#pragma unroll
        for (int ks = 0; ks < 4; ++ks) {
            bf16x8 af[2], bfr[2];
#pragma unroll
            for (int i = 0; i < 2; ++i) { af[i] = *(const LAS bf16x8*)(vt + (32 * i + c32) * MT_STRIDE + (16 * ks + 8 * hi) * 2); bfr[i] = *(const LAS bf16x8*)(kt + (32 * i + c32) * MT_STRIDE + (16 * ks + 8 * hi) * 2); }
#pragma unroll
            for (int i = 0; i < 2; ++i)
#pragma unroll
                for (int j = 0; j < 2; ++j) acc[i][j] = __builtin_amdgcn_mfma_f32_32x32x16_bf16(af[i], bfr[j], acc[i][j], 0, 0, 0);
        }
        float* cl = CLOC + (size_t)u * (MDV * MDK);
#pragma unroll
        for (int i = 0; i < 2; ++i)
#pragma unroll
            for (int j = 0; j < 2; ++j)
#pragma unroll
                for (int r = 0; r < 16; ++r) { const int dv = half * 64 + 32 * i + (r & 3) + 8 * (r >> 2) + 4 * hi; cl[dv * MDK + 32 * j + c32] = acc[i][j][r]; }
        if (half == 0) {
            float s = 0.f;
#pragma unroll
            for (int q = 0; q < 8; ++q) { const u32x4 w4 = *(const LAS u32x4*)(kt + lane * MT_STRIDE + 16 * q); s += (bf_lo(w4.x) + bf_hi(w4.x)) + (bf_lo(w4.y) + bf_hi(w4.y)) + (bf_lo(w4.z) + bf_hi(w4.z)) + (bf_lo(w4.w) + bf_hi(w4.w)); }
            NLOC[(size_t)u * MDK + lane] = s;
            if (lane == 0) { GMAX[u] = gmax; BL[u] = bl; }
        }
        LDS_WAIT();
    }
}

__device__ __forceinline__ void mlstm_scan_phase(const Frame& F) {
    unsigned char* ws = F.ws(); const float* __restrict__ CLOC = (const float*)(ws + WS_CLOC); const float* __restrict__ NLOC = (const float*)(ws + WS_NLOC);
    const float* __restrict__ GMAX = (const float*)(ws + WS_MSC); const float* __restrict__ BL = GMAX + MUNITS; float* __restrict__ MPREV = (float*)(ws + WS_MSC) + 2 * MUNITS;
    bf16_t* __restrict__ CPREV = (bf16_t*)(ws + WS_CPREV); float* __restrict__ NPREV = (float*)(ws + WS_NPREV);
    constexpr int PER = MDV * MDK / 2;
    for (int it = F.vcu * NTHR + F.tid; it < NB * MH * PER; it += F.G * NTHR) {
        const int bh = it / PER, e = it - bh * PER; const bool hasn = e < 32; const int eo = e * 2;
        float c0 = 0.f, c1 = 0.f, n0 = 0.f, n1 = 0.f, mm = 0.f;
        for (int cb = 0; cb < MNC; cb += 8) {
            f32x2 loc[8], nl[8]; float gm[8], bl[8];
#pragma unroll
            for (int k = 0; k < 8; ++k) { const int u = bh * MNC + cb + k; loc[k] = *(const f32x2*)(CLOC + (size_t)u * (MDV * MDK) + eo); gm[k] = GMAX[u]; bl[k] = BL[u];
                nl[k] = hasn ? *(const f32x2*)(NLOC + (size_t)u * MDK + eo) : (f32x2){0.f, 0.f}; }
#pragma unroll
            for (int k = 0; k < 8; ++k) { const int u = bh * MNC + cb + k;
                const float mnew = fmaxf(bl[k] + mm, gm[k]), dec = __expf(bl[k] + mm - mnew), sc = __expf(gm[k] - mnew);
                *(unsigned*)(CPREV + (size_t)u * (MDV * MDK) + eo) = cvt_pk_bf16(c0, c1);
                if (hasn) { *(f32x2*)(NPREV + (size_t)u * MDK + eo) = (f32x2){n0, n1}; if (e == 0) MPREV[u] = mm; }
                c0 = dec * c0 + sc * loc[k].x; c1 = dec * c1 + sc * loc[k].y; n0 = dec * n0 + sc * nl[k].x; n1 = dec * n1 + sc * nl[k].y; mm = mnew; }
        }
    }
}

__device__ __forceinline__ void mlstm_out_phase(const Frame& F, const float* __restrict__ gain) {
    unsigned char* ws = F.ws(); const bf16_t* PROJ = (const bf16_t*)(ws + WS_PROJ); const float* Gt = (const float*)(ws + WS_GATES);
    const bf16_t* CPREV = (const bf16_t*)(ws + WS_CPREV); const float* NPREV = (const float*)(ws + WS_NPREV); const float* MPREV = (const float*)(ws + WS_MSC) + 2 * MUNITS;
    bf16_t* HB = (bf16_t*)(ws + WS_HB);
    const int lane = F.lane, c32 = lane & 31, hi = lane >> 5;
    LAS unsigned char* vt = F.lds + F.wave * (128 * MT_STRIDE);
    for (int it = F.vcu * NWAVES + F.wave; it < MUNITS * 2; it += F.G * NWAVES) {
        const int u = it >> 1, tb = it & 1, c = u & (MNC - 1), bh = u >> 7, h = bh & 7, b = bh >> 3, m0 = b * SEQ + c * MCH;
        const int mg = m0 + lane;
        const float ig = Gt[(size_t)mg * 16 + h], lf = log_sigmoid(Gt[(size_t)mg * 16 + 8 + h]);
        const float bc = wave_incl_scan_add(lf, lane), av = ig - bc, pm = wave_incl_scan_max(av, lane);
        const float mprev = MPREV[u];
        const int tl = 32 * tb + c32;
        const float Mt = fmaxf(mprev, __shfl(pm, tl)), bt = __shfl(bc, tl);
        const float winter = __expf(mprev - Mt) * 0.125f;
        stage_transposed<16>(vt, PROJ + (size_t)mg * 3072 + 1024 + h * 128, lane, 1.f, false);
        bf16x8 qf[4];
        const bf16_t* qrow = PROJ + (size_t)(m0 + tl) * 3072 + h * 64 + 8 * hi;
#pragma unroll
        for (int ks = 0; ks < 4; ++ks) qf[ks] = *(const bf16x8*)(qrow + 16 * ks);
        float qn = 0.f;
        { const float* np = NPREV + (size_t)u * MDK + 8 * hi;
#pragma unroll
          for (int ks = 0; ks < 4; ++ks) { const f32x4 n0 = *(const f32x4*)(np + 16 * ks), n1 = *(const f32x4*)(np + 16 * ks + 4); const u32x4 qw = __builtin_bit_cast(u32x4, qf[ks]);
              qn += bf_lo(qw.x) * n0[0] + bf_hi(qw.x) * n0[1] + bf_lo(qw.y) * n0[2] + bf_hi(qw.y) * n0[3] + bf_lo(qw.z) * n1[0] + bf_hi(qw.z) * n1[1] + bf_lo(qw.w) * n1[2] + bf_hi(qw.w) * n1[3]; } }
        qn += __shfl_xor(qn, 32);
        f32x16 acc[4];
#pragma unroll
        for (int i = 0; i < 4; ++i)
#pragma unroll
            for (int r = 0; r < 16; ++r) acc[i][r] = 0.f;
        { const bf16_t* cp = CPREV + (size_t)u * (MDV * MDK) + 8 * hi;
#pragma unroll
          for (int i = 0; i < 4; ++i)
#pragma unroll
              for (int ks = 0; ks < 4; ++ks) { const bf16x8 af = *(const bf16x8*)(cp + (size_t)(32 * i + c32) * MDK + 16 * ks); acc[i] = __builtin_amdgcn_mfma_f32_32x32x16_bf16(af, qf[ks], acc[i], 0, 0, 0); } }
#pragma unroll
        for (int i = 0; i < 4; ++i)
#pragma unroll
            for (int r = 0; r < 16; ++r) acc[i][r] *= winter;
        float den = 0.f;
        LDS_WAIT();
#pragma unroll
        for (int sb = 0; sb < 2; ++sb) {
            if (sb <= tb) {
                f32x16 st;
#pragma unroll
                for (int r = 0; r < 16; ++r) st[r] = 0.f;
                const bf16_t* krow = PROJ + (size_t)(m0 + 32 * sb + c32) * 3072 + 512 + h * 64 + 8 * hi;
#pragma unroll
                for (int ks = 0; ks < 4; ++ks) { const bf16x8 kf = *(const bf16x8*)(krow + 16 * ks); st = __builtin_amdgcn_mfma_f32_32x32x16_bf16(kf, qf[ks], st, 0, 0, 0); }
                unsigned pk[8];
#pragma unroll
                for (int r = 0; r < 16; r += 2) {
                    const int s0 = 32 * sb + (r & 3) + 8 * (r >> 2) + 4 * hi, s1 = s0 + 1;
                    const float a0 = __shfl(av, s0), a1 = __shfl(av, s1);
                    float p0 = st[r] * 0.125f * __expf(a0 - Mt), p1 = st[r + 1] * 0.125f * __expf(a1 - Mt);
                    if (s0 > tl) p0 = 0.f; if (s1 > tl) p1 = 0.f;
                    den += p0 + p1; pk[r >> 1] = cvt_pk_bf16(p0, p1);
                }
#pragma unroll
                for (int s2 = 0; s2 < 2; ++s2) {
                    const bf16x8 pf = __builtin_bit_cast(bf16x8, (u32x4){pk[4 * s2], pk[4 * s2 + 1], pk[4 * s2 + 2], pk[4 * s2 + 3]});
                    const int k0 = 16 * (2 * sb + s2) + 4 * hi;
#pragma unroll
                    for (int i = 0; i < 4; ++i) { const LAS unsigned char* vr = vt + (32 * i + c32) * MT_STRIDE;
                        const u32x2 v0 = *(const LAS u32x2*)(vr + 2 * k0), v1 = *(const LAS u32x2*)(vr + 2 * (k0 + 8));
                        const bf16x8 vf = __builtin_bit_cast(bf16x8, (u32x4){v0.x, v0.y, v1.x, v1.y});
                        acc[i] = __builtin_amdgcn_mfma_f32_32x32x16_bf16(vf, pf, acc[i], 0, 0, 0); }
                }
            }
        }
        den += __shfl_xor(den, 32);
        den += winter * qn;
        const float mrow = bt + Mt, dnm = fmaxf(fabsf(den), __expf(-mrow)), rinv = 1.f / dnm;
        float ss = 0.f;
#pragma unroll
        for (int i = 0; i < 4; ++i)
#pragma unroll
            for (int r = 0; r < 16; ++r) { acc[i][r] *= rinv; ss += acc[i][r] * acc[i][r]; }
        ss += __shfl_xor(ss, 32);
        const float rn = 1.f / sqrtf(ss * (1.f / MDV) + RMS_EPS);
        const size_t mrowi = (size_t)(m0 + tl);
#pragma unroll
        for (int i = 0; i < 4; ++i)
#pragma unroll
            for (int g4 = 0; g4 < 4; ++g4) { const int dv = 32 * i + 8 * g4 + 4 * hi;
                const f32x4 gn = *(const f32x4*)(gain + h * 128 + dv); const u32x2 ow = *(const u32x2*)(PROJ + mrowi * 3072 + 2048 + h * 128 + dv);
                const float o0 = bf_lo(ow.x), o1 = bf_hi(ow.x), o2 = bf_lo(ow.y), o3 = bf_hi(ow.y);
                const float y0 = acc[i][4 * g4 + 0] * rn * gn[0] / (1.f + __expf(-o0)), y1 = acc[i][4 * g4 + 1] * rn * gn[1] / (1.f + __expf(-o1));
                const float y2 = acc[i][4 * g4 + 2] * rn * gn[2] / (1.f + __expf(-o2)), y3 = acc[i][4 * g4 + 3] * rn * gn[3] / (1.f + __expf(-o3));
                u32x2 w; w.x = cvt_pk_bf16(y0, y1); w.y = cvt_pk_bf16(y2, y3); *(u32x2*)(HB + mrowi * D + h * 128 + dv) = w; }
        LDS_WAIT();
    }
}
__device__ __forceinline__ float max3f(float a, float b, float c) { return fmaxf(fmaxf(a, b), c); }
constexpr int AT_KB = 64 * 384, AT_VB = 128 * 128, AT_STAGE = AT_KB + AT_VB;
__device__ __forceinline__ void attn_phase(const Frame& F) {
    unsigned char* ws = F.ws(); const bf16_t* QB = (const bf16_t*)(ws + WS_QB); const bf16_t* KN = (const bf16_t*)(ws + WS_KN); const bf16_t* KR = (const bf16_t*)(ws + WS_KR); const bf16_t* VT = (const bf16_t*)(ws + WS_VT);
    bf16_t* HB = (bf16_t*)(ws + WS_HB);
    LAS unsigned char* lds = F.lds;
    const int lane = F.lane, w = F.wave, c32 = lane & 31, hi = lane >> 5;
    int k_isr[3]; unsigned k_off[3], v_off[2];
#pragma unroll
    for (int n = 0; n < 3; ++n) { const int P = (n * 8 + w) * 64 + lane, row = P / 24, q = P - row * 24, p = (q & ~7) | ((q & 7) ^ ((row >> 1) & 7));
        k_isr[n] = p >= 16; k_off[n] = (p >= 16) ? (unsigned)(row * AROPE + (p - 16) * 8) * 2u : (unsigned)(row * 1024 + p * 8) * 2u; }
#pragma unroll
    for (int n = 0; n < 2; ++n) { const int P = (n * 8 + w) * 64 + lane, row = P >> 3, q = P & 7, p = q ^ ((row >> 1) & 7); v_off[n] = (unsigned)row * (unsigned)(T * 2) + (unsigned)(p * 16); }
    const int sw = (c32 >> 1) & 7;
    unsigned ko[4];
#pragma unroll
    for (int i = 0; i < 4; ++i) ko[i] = (unsigned)(c32 * 384 + (((2 * i + hi) ^ sw) * 16));
    const unsigned vrow = (unsigned)(c32 * 128 + 8 * hi);

    for (int item = F.vcu; item < NB * AH * 16; item += F.G) {
        const int bh = item >> 4, x = item & 15, b = bh >> 3, hh = bh & 7;
#pragma unroll 1
        for (int sub = 0; sub < 2; ++sub) {
            const int qb = sub ? 31 - x : x, nt = 4 * qb + 4, jmax = 4 * qb + (w >> 1);
            const int qrow = 256 * qb + 32 * w + c32;
            const size_t mq = (size_t)b * SEQ + qrow;
            __syncthreads();
            const bf16_t* knb = KN + (size_t)b * SEQ * 1024 + hh * 128; const bf16_t* krb = KR + (size_t)b * SEQ * AROPE; const bf16_t* vtb = VT + (size_t)(hh * 128) * T + (size_t)b * SEQ;
#define AT_ISSUE(j, stg) do { _Pragma("unroll") for (int _n = 0; _n < 3; ++_n) { \
                const char* _g = k_isr[_n] ? (const char*)(krb + (size_t)(j) * 64 * AROPE) + k_off[_n] : (const char*)(knb + (size_t)(j) * 64 * 1024) + k_off[_n]; \
                __builtin_amdgcn_global_load_lds((const unsigned*)_g, (LAS unsigned*)(lds + (stg) * AT_STAGE + (_n * 8 + w) * 1024), 16, 0, 0); } \
            _Pragma("unroll") for (int _n = 0; _n < 2; ++_n) { const char* _g = (const char*)(vtb + (size_t)(j) * 64) + v_off[_n]; \
                __builtin_amdgcn_global_load_lds((const unsigned*)_g, (LAS unsigned*)(lds + (stg) * AT_STAGE + AT_KB + (_n * 8 + w) * 1024), 16, 0, 0); } } while (0)
            AT_ISSUE(0, 0);
            bf16x8 qf[12];
            { const bf16_t* qr = QB + mq * 1536 + hh * AQD + 8 * hi;
#pragma unroll
              for (int ks = 0; ks < 12; ++ks) qf[ks] = *(const bf16x8*)(qr + 16 * ks); }
            f32x16 O[4];
#pragma unroll
            for (int i = 0; i < 4; ++i)
#pragma unroll
                for (int r = 0; r < 16; ++r) O[i][r] = 0.f;
            float m_run = -1.0e30f, l_run = 0.f;
            unsigned pk[16];
#pragma unroll
            for (int r = 0; r < 16; ++r) pk[r] = 0u;
#define AT_QK_SM(jj, sg) do { const LAS unsigned char* kb_ = lds + (sg) * AT_STAGE; \
                f32x16 s0, s1; _Pragma("unroll") for (int r = 0; r < 16; ++r) { s0[r] = 0.f; s1[r] = 0.f; } \
                bf16x8 kf[2][4]; \
                _Pragma("unroll") for (int _q = 0; _q < 2; ++_q) { kf[0][2 * _q] = *(const LAS bf16x8*)(kb_ + ko[_q & 3]); kf[0][2 * _q + 1] = *(const LAS bf16x8*)(kb_ + ko[_q & 3] + 32 * 384); } \
                _Pragma("unroll") for (int g = 0; g < 6; ++g) { \
                    if (g + 1 < 6) { _Pragma("unroll") for (int _q = 0; _q < 2; ++_q) { const int _ks = 2 * (g + 1) + _q; \
                        kf[(g + 1) & 1][2 * _q] = *(const LAS bf16x8*)(kb_ + ko[_ks & 3] + (_ks >> 2) * 128); kf[(g + 1) & 1][2 * _q + 1] = *(const LAS bf16x8*)(kb_ + ko[_ks & 3] + (_ks >> 2) * 128 + 32 * 384); } } \
                    __builtin_amdgcn_sched_barrier(0); \
                    _Pragma("unroll") for (int q = 0; q < 2; ++q) { s0 = __builtin_amdgcn_mfma_f32_32x32x16_bf16(kf[g & 1][2 * q], qf[2 * g + q], s0, 0, 0, 0); s1 = __builtin_amdgcn_mfma_f32_32x32x16_bf16(kf[g & 1][2 * q + 1], qf[2 * g + q], s1, 0, 0, 0); } \
                    __builtin_amdgcn_sched_barrier(0); } \
                if ((jj) == jmax) { const int kbase = 64 * (jj) + 4 * hi; \
                    _Pragma("unroll") for (int r = 0; r < 16; ++r) { const int key = kbase + (r & 3) + 8 * (r >> 2); if (key > qrow) s0[r] = -__builtin_inff(); if (key + 32 > qrow) s1[r] = -__builtin_inff(); } } \
                float mx = max3f(s0[0], s1[0], s0[1]); \
                _Pragma("unroll") for (int r = 2; r < 16; r += 2) mx = max3f(mx, s0[r], s0[r + 1]); \
                _Pragma("unroll") for (int r = 1; r < 15; r += 2) mx = max3f(mx, s1[r], s1[r + 1]); \
                mx = fmaxf(mx, s1[15]); mx = fmaxf(mx, __shfl_xor(mx, 32)); \
                const float mnew = fmaxf(m_run, mx), alpha = __builtin_amdgcn_exp2f(m_run - mnew); m_run = mnew; \
                float ls = 0.f; \
                _Pragma("unroll") for (int r = 0; r < 16; r += 2) { const float p0 = __builtin_amdgcn_exp2f(s0[r] - mnew), p1 = __builtin_amdgcn_exp2f(s0[r + 1] - mnew), p2 = __builtin_amdgcn_exp2f(s1[r] - mnew), p3 = __builtin_amdgcn_exp2f(s1[r + 1] - mnew); \
                    ls += (p0 + p1) + (p2 + p3); pk[r >> 1] = cvt_pk_bf16(p0, p1); pk[8 + (r >> 1)] = cvt_pk_bf16(p2, p3); } \
                l_run = l_run * alpha + ls; \
                _Pragma("unroll") for (int i = 0; i < 4; ++i) _Pragma("unroll") for (int r = 0; r < 16; ++r) O[i][r] *= alpha; } while (0)
#define AT_PV(sg) do { const LAS unsigned char* vb_ = lds + (sg) * AT_STAGE + AT_KB; \
                _Pragma("unroll") for (int st = 0; st < 4; ++st) { \
                    const bf16x8 pf = __builtin_bit_cast(bf16x8, (u32x4){pk[4 * st], pk[4 * st + 1], pk[4 * st + 2], pk[4 * st + 3]}); \
                    const unsigned p0o = (unsigned)(((2 * st) ^ sw) * 16), p1o = (unsigned)(((2 * st + 1) ^ sw) * 16); \
                    _Pragma("unroll") for (int i = 0; i < 4; ++i) { const LAS unsigned char* vr = vb_ + vrow + i * (32 * 128); \
                        const u32x2 v0 = *(const LAS u32x2*)(vr + p0o), v1 = *(const LAS u32x2*)(vr + p1o); \
                        const bf16x8 vf = __builtin_bit_cast(bf16x8, (u32x4){v0.x, v0.y, v1.x, v1.y}); \
                        O[i] = __builtin_amdgcn_mfma_f32_32x32x16_bf16(vf, pf, O[i], 0, 0, 0); } } } while (0)
            const bool grpB = w >= 4;
            int sj = 0; bool pending = false;
#pragma unroll 1
            for (int j = 0; j <= nt; ++j) {
                const int sn = (sj == 2) ? 0 : sj + 1, sp = (sj == 0) ? 2 : sj - 1;
                if (grpB) { asm volatile("s_waitcnt vmcnt(0)" ::: "memory"); __syncthreads(); if (j + 1 < nt) AT_ISSUE(j + 1, sn); }
                if (pending) AT_PV(sp);
                if (!grpB) { asm volatile("s_waitcnt vmcnt(0)" ::: "memory"); __syncthreads(); if (j + 1 < nt) AT_ISSUE(j + 1, sn); }
                pending = (j < nt && j <= jmax);
                if (pending) AT_QK_SM(j, sj);
                sj = sn;
            }
#undef AT_QK_SM
#undef AT_PV
            const float lt = l_run + __shfl_xor(l_run, 32), rl = 1.f / lt;
            bf16_t* orow = HB + mq * D + hh * 128 + 4 * hi;
#pragma unroll
            for (int i = 0; i < 4; ++i)
#pragma unroll
                for (int g4 = 0; g4 < 4; ++g4) { u32x2 wv; wv.x = cvt_pk_bf16(O[i][4 * g4] * rl, O[i][4 * g4 + 1] * rl); wv.y = cvt_pk_bf16(O[i][4 * g4 + 2] * rl, O[i][4 * g4 + 3] * rl);
                    *(u32x2*)(orow + 32 * i + 8 * g4) = wv; }
#undef AT_ISSUE
        }
    }
}
#ifndef DUP_L6
#define DUP_L6 0
#endif
#ifndef DUP_L9
#define DUP_L9 0
#endif
#ifndef DUP_BAR
#define DUP_BAR 0
#endif
#ifndef DUP_P0
#define DUP_P0 0
#endif
#ifndef DUP_A4
#define DUP_A4 0
#endif
#ifndef DUP_G7
#define DUP_G7 0
#endif
#ifndef DUP_G8
#define DUP_G8 0
#endif
#ifndef DUP_M1
#define DUP_M1 0
#endif
#ifndef DUP_O5
#define DUP_O5 0
#endif
#ifndef DUP_M2
#define DUP_M2 0
#endif
#ifndef DUP_M3
#define DUP_M3 0
#endif
#ifndef DUP_M4
#define DUP_M4 0
#endif
#ifndef DUP_A1
#define DUP_A1 0
#endif
#ifndef DUP_A2
#define DUP_A2 0
#endif
#ifndef DUP_A3
#define DUP_A3 0
#endif
#ifndef EN_P0
#define EN_P0 1
#endif
#ifndef EN_M1
#define EN_M1 1
#endif
#ifndef EN_M2
#define EN_M2 1
#endif
#ifndef EN_M3
#define EN_M3 1
#endif
#ifndef EN_M4
#define EN_M4 1
#endif
#ifndef EN_A1
#define EN_A1 1
#endif
#ifndef EN_A2
#define EN_A2 1
#endif
#ifndef EN_A3
#define EN_A3 1
#endif
#ifndef EN_A4
#define EN_A4 1
#endif
#ifndef EN_O5
#define EN_O5 1
#endif
#ifndef EN_L6
#define EN_L6 1
#endif
#ifndef EN_G7
#define EN_G7 1
#endif
#ifndef EN_G8
#define EN_G8 1
#endif
#ifndef EN_L9
#define EN_L9 1
#endif
constexpr int PH_PER_LAYER = 9, N_PHASES = 1 + DEPTH * PH_PER_LAYER;
constexpr float Q_SCALE = 0.07216878364870323f * 1.4426950408889634f;

__global__ void __launch_bounds__(NTHR, 2) fwd_kernel(Args args) {
    extern __shared__ __attribute__((aligned(16))) unsigned char lds_raw[];
    Frame F0; Frame& F = F0;
    F.lds = (LAS unsigned char*)lds_raw; F.MISC = (volatile LAS unsigned*)(F.lds + MISC_OFF);
    F.tid = threadIdx.x; F.lane = F.tid & 63; F.wave = __builtin_amdgcn_readfirstlane(F.tid >> 6);
    F.G = gridDim.x; { const int bx = blockIdx.x; F.vcu = (F.G % 8 == 0) ? (bx % 8) * (F.G / 8) + bx / 8 : bx; }
    if (F.tid < 128) F.MISC[F.tid] = 0u;
    if (F.tid == 128) {
#pragma unroll
        for (int i = 0; i < 20; ++i) { const unsigned long long p = (unsigned long long)args.in[i]; F.MISC[128 + 2 * i] = (unsigned)p; F.MISC[129 + 2 * i] = (unsigned)(p >> 32); }
        { const unsigned long long p = (unsigned long long)args.out; F.MISC[168] = (unsigned)p; F.MISC[169] = (unsigned)(p >> 32); }
        { const unsigned long long p = (unsigned long long)args.ws; F.MISC[170] = (unsigned)p; F.MISC[171] = (unsigned)(p >> 32); }
    }
    __syncthreads();
    XcdBarrier bar = xcd_barrier_post(F.ctl() + CW_BAR, F.MISC);
    const int lo = args.ph_lo, hi = args.ph_hi;
#define IN(k) (lo <= (k) && (k) < hi)
#define SEAM(k) do { if (IN(k) && IN((k) + 1)) { xcd_barrier(bar); if (DUP_BAR) xcd_barrier(bar); } else __syncthreads(); } while (0)

    if (EN_P0 && IN(0)) { for (int rep = 0; rep <= DUP_P0; ++rep) { const Frame F = refresh(F0); p0_prologue(F); __syncthreads(); } }
    SEAM(0);

    for (int l = 0; l < DEPTH; ++l) {
        const int pb = 1 + l * PH_PER_LAYER, j = l >> 1;
        if ((l & 1) == 0) {
            if (EN_M1 && IN(pb + 0)) for (int rep = 0; rep <= DUP_M1; ++rep) { const Frame F = refresh(F0); unsigned char* ws = F.ws(); const float* xres = (l == 0) ? (const float*)F.ptr(IN_X) : (const float*)(ws + WS_XF);
                pg8::DenseOrder S; S.init(ws + WS_XB, (bf16_t*)(ws + WS_WINM) + (size_t)j * 3072 * 1024, T, 3072, 1024, 1024, F.G, F.vcu);
                pg8::EpiBf16 E{(bf16_t*)(ws + WS_PROJ), 3072, 1.0f};
                pg8::gemm_phase<pg8::EpiBf16, pg8::DenseOrder, false>(F.lds, F.tid, 1024, 1024, 1024, S, E);
                __syncthreads();
                const Frame F2 = refresh(F0);
                skinny_fill<16>(F2, (const float*)F.ptr(IN_MWIN) + (size_t)j * 1024 * MIN_ + 3072, MIN_);
                gates_phase(F2, xres, (const float*)F2.ptr(IN_MBG) + j * 16, (float*)(ws + WS_GATES));
            }
            SEAM(pb + 0);
            if (EN_M2 && IN(pb + 1)) for (int rep = 0; rep <= DUP_M2; ++rep) { const Frame F = refresh(F0); mlstm_local_phase(F); __syncthreads(); }
            SEAM(pb + 1);
            if (EN_M3 && IN(pb + 2)) for (int rep = 0; rep <= DUP_M3; ++rep) { const Frame F = refresh(F0); mlstm_scan_phase(F); __syncthreads(); }
            SEAM(pb + 2);
            if (EN_M4 && IN(pb + 3)) for (int rep = 0; rep <= DUP_M4; ++rep) { const Frame F = refresh(F0); __syncthreads(); mlstm_out_phase(F, (const float*)F.ptr(IN_MNG) + (size_t)j * 1024); }
            SEAM(pb + 3);
        } else {
            if (EN_A1 && IN(pb + 0)) for (int rep = 0; rep <= DUP_A1; ++rep) { const Frame F = refresh(F0); unsigned char* ws = F.ws();
                pg8::DenseOrder S; S.init(ws + WS_XB, (bf16_t*)(ws + WS_WINA) + (size_t)j * AINP * 1024, T, AINP, 1024, 1024, F.G, F.vcu);
                pg8::EpiF32 E{(float*)(ws + WS_A32), AINP};
                pg8::gemm_phase<pg8::EpiF32, pg8::DenseOrder, false>(F.lds, F.tid, 1024, 1024, 1024, S, E);
            }
            SEAM(pb + 0);
            if (EN_A2 && IN(pb + 1)) { const Frame F = refresh(F0); mla_norm_phase(F, j); }
            SEAM(pb + 1);
            if (EN_A3 && IN(pb + 2)) for (int rep = 0; rep <= DUP_A3; ++rep) { const Frame F = refresh(F0); unsigned char* ws = F.ws();
                { pg8::DenseOrder S; S.init(ws + WS_CQ, (bf16_t*)(ws + WS_WQB) + (size_t)j * 1536 * AQL, T, 1536, AQL, AQL, F.G, F.vcu);
                  pg8::EpiQRope E{(bf16_t*)(ws + WS_QB), 1536, (const float*)(ws + WS_COS), (const float*)(ws + WS_SIN), Q_SCALE};
                  pg8::gemm_phase<pg8::EpiQRope, pg8::DenseOrder, false>(F.lds, F.tid, AQL, AQL, AQL, S, E); }
                __syncthreads();
                { const Frame F = refresh(F0); unsigned char* ws = F.ws();
                  pg8::DenseOrder S; S.init(ws + WS_CKV, (bf16_t*)(ws + WS_WKV) + (size_t)j * 2048 * AKL, T, 1024, AKL, AKL, F.G, F.vcu);
                  pg8::EpiBf16 E{(bf16_t*)(ws + WS_KN), 1024, 1.0f};
                  pg8::gemm_phase<pg8::EpiBf16, pg8::DenseOrder, false>(F.lds, F.tid, AKL, AKL, AKL, S, E); }
                __syncthreads();
                { const Frame F = refresh(F0); unsigned char* ws = F.ws();
                  pg8::DenseOrder S; S.init((bf16_t*)(ws + WS_WKV) + (size_t)j * 2048 * AKL + (size_t)1024 * AKL, ws + WS_CKV, 1024, T, AKL, AKL, F.G, F.vcu);
                  pg8::EpiBf16 E{(bf16_t*)(ws + WS_VT), T, 1.0f};
                  pg8::gemm_phase<pg8::EpiBf16, pg8::DenseOrder, false>(F.lds, F.tid, AKL, AKL, AKL, S, E); }
            }
            SEAM(pb + 2);
            if (EN_A4 && IN(pb + 3)) { for (int rep = 0; rep <= DUP_A4; ++rep) { const Frame F = refresh(F0); attn_phase(F); __syncthreads(); } }
            SEAM(pb + 3);
        }
        if (EN_O5 && IN(pb + 4)) for (int rep = 0; rep <= DUP_O5; ++rep) { const Frame F = refresh(F0); unsigned char* ws = F.ws(); const float* xres = (l == 0) ? (const float*)F.ptr(IN_X) : (const float*)(ws + WS_XF);
            const bf16_t* wo = (l & 1) ? (const bf16_t*)(ws + WS_WOUTA) + (size_t)j * 1024 * 1024 : (const bf16_t*)(ws + WS_WOUTM) + (size_t)j * 1024 * 1024;
            pg8::DenseOrder S; S.init(ws + WS_HB, wo, T, 1024, 1024, 1024, F.G, F.vcu);
            pg8::EpiResid E{xres, (float*)(ws + WS_ZF), 1024, DN_ALPHA};
            pg8::gemm_phase<pg8::EpiResid, pg8::DenseOrder, false>(F.lds, F.tid, 1024, 1024, 1024, S, E);
        }
        SEAM(pb + 4);
        if (EN_L6 && IN(pb + 5)) { if (DUP_L6) { const Frame F = refresh(F0); ln_router_phase(F, l, l + 4); __syncthreads(); } const Frame F = refresh(F0); ln_router_phase(F, l, l); }
        SEAM(pb + 5);
        if (EN_G7 && IN(pb + 6)) for (int rep = 0; rep <= DUP_G7; ++rep) { const Frame F = refresh(F0); unsigned char* ws = F.ws();
            moe_prefix(F, l);
            constexpr size_t EB = MOE_FP8 ? 1 : 2;
            pg8::MoeOrder S{(const volatile LAS int*)(F.MISC + 16), (const char*)(ws + (MOE_FP8 ? WS_XB8 : WS_XB)), (const char*)(ws + WS_WGU) + (size_t)l * 32 * 2048 * 1024 * EB, (const int*)(ws + WS_LIST), F.ctl() + CW_CNT + l * 32 * 64,
                            8, F.G, F.vcu, (size_t)2048 * 1024 * EB, (size_t)256 * 1024 * EB, true, 0};
            pg8::EpiSwiglu E{(unsigned char*)(ws + WS_HMOE), (const float*)F.ptr(IN_BGU) + (size_t)l * 32 * 2048};
            pg8::gemm_phase<pg8::EpiSwiglu, pg8::MoeOrder, true, MOE_FP8 != 0>(F.lds, F.tid, 1024, 1024, 1024, S, E);
        }
        SEAM(pb + 6);
        if (EN_G8 && IN(pb + 7)) for (int rep = 0; rep <= DUP_G8; ++rep) { const Frame F = refresh(F0); unsigned char* ws = F.ws();
            moe_prefix(F, l);
            constexpr size_t EB = MOE_FP8 ? 1 : 2;
            pg8::MoeOrder S{(const volatile LAS int*)(F.MISC + 16), (const char*)(ws + WS_HMOE), (const char*)(ws + WS_WD) + (size_t)l * 32 * 1024 * 1024 * EB, (const int*)(ws + WS_LIST), F.ctl() + CW_CNT + l * 32 * 64,
                            4, F.G, F.vcu, (size_t)1024 * 1024 * EB, (size_t)256 * 1024 * EB, false, (size_t)256 * 1024 * EB};
            pg8::EpiDown E{(bf16_t*)(ws + WS_YMOE), (const float*)F.ptr(IN_BD) + (size_t)l * 32 * 1024};
            pg8::gemm_phase<pg8::EpiDown, pg8::MoeOrder, false, MOE_FP8 != 0>(F.lds, F.tid, 1024, 1024, 1024, S, E);
        }
        SEAM(pb + 7);
        if (EN_L9 && IN(pb + 8)) { if (DUP_L9) { const Frame F = refresh(F0); moe_prefix(F, l); ln_combine_phase(F, l, false, true); __syncthreads(); } const Frame F = refresh(F0); moe_prefix(F, l); ln_combine_phase(F, l, l == DEPTH - 1, false); }
        SEAM(pb + 8);
    }
#undef IN
#undef SEAM
}

extern "C" void kernel_launch(void* const* d_in, const int* in_sizes, int n_in, void* d_out, int out_size, void* d_ws, size_t ws_size, hipStream_t stream) {
    static int grid = 0;
    if (grid == 0) {
        if (n_in != 20 || out_size != T * D || ws_size < WS_END) { fprintf(stderr, "kernel_launch: unexpected problem (n_in %d out %d ws %zu)\n", n_in, out_size, ws_size); grid = -1; return; }
        int dev = 0, cus = 0, per_cu = 0;
        if (hipGetDevice(&dev) != hipSuccess || hipDeviceGetAttribute(&cus, hipDeviceAttributeMultiprocessorCount, dev) != hipSuccess) { grid = -1; return; }
        if (hipFuncSetAttribute((const void*)fwd_kernel, hipFuncAttributeMaxDynamicSharedMemorySize, LDS_BYTES) != hipSuccess) { fprintf(stderr, "kernel_launch: hipFuncSetAttribute failed\n"); grid = -1; return; }
        if (hipOccupancyMaxActiveBlocksPerMultiprocessor(&per_cu, (const void*)fwd_kernel, NTHR, LDS_BYTES) != hipSuccess || per_cu < 1) fprintf(stderr, "kernel_launch: occupancy query reports %d\n", per_cu);
        (void)hipGetLastError();
        grid = cus;
    }
    if (grid < 0) return;
    (void)hipMemsetAsync((char*)d_ws + WS_CTL, 0, CTL_ZERO_BYTES, stream);
    Args a; memset(&a, 0, sizeof(a));
    for (int i = 0; i < 20; ++i) a.in[i] = d_in[i];
    a.out = (float*)d_out; a.ws = (unsigned char*)d_ws;
#if MK_PER_PHASE
    for (int p = 0; p < N_PHASES; ++p) { a.ph_lo = p; a.ph_hi = p + 1; hipLaunchKernelGGL(fwd_kernel, dim3(grid), dim3(NTHR), LDS_BYTES, stream, a); }
#else
    a.ph_lo = 0; a.ph_hi = N_PHASES;
    hipLaunchKernelGGL(fwd_kernel, dim3(grid), dim3(NTHR), LDS_BYTES, stream, a);
#endif
    const hipError_t le = hipPeekAtLastError();
    if (le != hipSuccess) fprintf(stderr, "kernel_launch: launch failed: %s\n", hipGetErrorName(le));
}
```

```cpp
#include <hip/hip_runtime.h>
#include <cstdio>
#include <cstdint>
#include <cstring>

#define LAS __attribute__((address_space(3)))
#define GAS __attribute__((address_space(1)))
typedef unsigned short bf16_t;
typedef short bf16x8 __attribute__((ext_vector_type(8)));
typedef short s16x4 __attribute__((ext_vector_type(4)));
typedef float f32x2 __attribute__((ext_vector_type(2)));
typedef float f32x4 __attribute__((ext_vector_type(4)));
typedef float f32x16 __attribute__((ext_vector_type(16)));
typedef unsigned u32x2 __attribute__((ext_vector_type(2)));
typedef unsigned u32x4 __attribute__((ext_vector_type(4)));
typedef int i32x4 __attribute__((ext_vector_type(4)));
typedef int i32x8 __attribute__((ext_vector_type(8)));

#ifndef MK_PER_PHASE
#define MK_PER_PHASE 0
#endif

constexpr int NB = 4, SEQ = 8192, T = NB * SEQ, D = 1024, DEPTH = 4;
constexpr int MH = 8, MDV = 128, MDK = 64, MCH = 64, MNC = SEQ / MCH, MIN_ = 3088, MUNITS = NB * MH * MNC;
constexpr int AH = 8, AQL = 384, AKL = 256, ANOPE = 128, AROPE = 64, AV = 128, AIN = 704, AINP = 768, AQD = 192;
constexpr int NE = 32, TOPK = 4, DFF = 1024;
constexpr float DN_ALPHA = 1.6817928305074290f;
constexpr float LN_EPS = 1e-5f, RMS_EPS = 1e-6f;
constexpr int MOE_ROWS = 139264;

constexpr size_t MiB = 1ull << 20;
constexpr size_t WS_CTL = 0, CTL_ZERO_BYTES = 128 * 1024;
constexpr size_t WS_COS = 1 * MiB, WS_SIN = 5 * MiB, WS_GATES = 9 * MiB, WS_TOKINFO = 11 * MiB, WS_TOKGATE = 11 * MiB + 512 * 1024, WS_LIST = 12 * MiB;
constexpr size_t WS_GIMG = 16 * MiB + 128 * 1024  , WS_RIMG = 16 * MiB + 256 * 1024  , WS_RCV = 16 * MiB + 768 * 1024  , WS_MSC = 16 * MiB, WS_NLOC = 17 * MiB, WS_NPREV = 18 * MiB;
constexpr size_t WS_WINM = 20 * MiB, WS_WOUTM = 32 * MiB, WS_WINA = 36 * MiB, WS_WQB = 39 * MiB, WS_WKV = 42 * MiB, WS_WOUTA = 44 * MiB;
constexpr size_t WS_WINM8 = 48 * MiB  ;
constexpr size_t WS_WGU = 64 * MiB, WS_WD = 576 * MiB;
constexpr size_t WS_XM = 832 * MiB, WS_XF = 832 * MiB, WS_ZF = 960 * MiB, WS_XB = 1088 * MiB, WS_PROJ = 1152 * MiB;
constexpr size_t WS_A32 = WS_PROJ, WS_CQ = WS_PROJ + 96 * MiB, WS_CKV = WS_PROJ + 120 * MiB, WS_KR = WS_PROJ + 136 * MiB;
constexpr size_t WS_QB = 1344 * MiB, WS_CLOC = WS_QB, WS_KN = 1472 * MiB, WS_CPREV = WS_KN, WS_VT = 1536 * MiB, WS_HB = 1600 * MiB;
constexpr size_t WS_HMOE = 1664 * MiB, WS_YMOE = 1936 * MiB, WS_XB8 = 2208 * MiB, WS_END = 2240 * MiB;
constexpr int CW_BAR = 4096, CW_CNT = 16384;

constexpr int RING_BYTES = 147456;
constexpr int MISC_OFF = RING_BYTES;
constexpr int LDS_BYTES = RING_BYTES + 1024;
constexpr int NWAVES = 8, NTHR = 512;

__device__ __forceinline__ unsigned cvt_pk_bf16(float lo, float hi) { unsigned r; asm("v_cvt_pk_bf16_f32 %0, %1, %2" : "=v"(r) : "v"(lo), "v"(hi)); return r; }
__device__ __forceinline__ float bf_lo(unsigned w) { return __uint_as_float(w << 16); }
__device__ __forceinline__ float bf_hi(unsigned w) { return __uint_as_float(w & 0xffff0000u); }
template <int CTRL> __device__ __forceinline__ float dpp_mov(float v) { return __int_as_float(__builtin_amdgcn_update_dpp(0, __float_as_int(v), CTRL, 0xf, 0xf, true)); }
__device__ __forceinline__ float xor16(float v, float& other) { const u32x2 r = __builtin_amdgcn_permlane16_swap(__float_as_uint(v), __float_as_uint(v), false, false); other = __uint_as_float(r.y); return __uint_as_float(r.x); }
__device__ __forceinline__ float xor32(float v, float& other) { const u32x2 r = __builtin_amdgcn_permlane32_swap(__float_as_uint(v), __float_as_uint(v), false, false); other = __uint_as_float(r.y); return __uint_as_float(r.x); }
__device__ __forceinline__ float wave_sum(float v) {
    v += dpp_mov<0xB1>(v); v += dpp_mov<0x4E>(v); v += dpp_mov<0x141>(v); v += dpp_mov<0x140>(v);
    float o; v = xor16(v, o) + o; v = xor32(v, o) + o;
    return v;
}
__device__ __forceinline__ float wave_max(float v) {
    v = fmaxf(v, dpp_mov<0xB1>(v)); v = fmaxf(v, dpp_mov<0x4E>(v)); v = fmaxf(v, dpp_mov<0x141>(v)); v = fmaxf(v, dpp_mov<0x140>(v));
    float o; v = xor16(v, o); v = fmaxf(v, o); v = xor32(v, o); v = fmaxf(v, o);
    return v;
}
__device__ __forceinline__ float max_x32(float v) { float o; const float a = xor32(v, o); return fmaxf(a, o); }
__device__ __forceinline__ float sum_x32(float v) { float o; const float a = xor32(v, o); return a + o; }
#ifndef DUP_EPI
#define DUP_EPI 0
#endif
#ifndef PG8_SP2
#define PG8_SP2 0
#endif
#ifndef MOE_FP8
#define MOE_FP8 1
#endif
constexpr float F8_SX = 16.f, F8_SWG = 256.f, F8_SH = 4.f, F8_SWD = 512.f;
#ifndef DF8_M1
#define DF8_M1 0
#endif
#ifndef DF8_A1
#define DF8_A1 1
#endif
#ifndef DF8_O5
#define DF8_O5 1
#endif
#ifndef DF8_MV
#define DF8_MV 1
#endif
#ifndef DENSE_FP8
#define DENSE_FP8 (DF8_M1 || DF8_MV || DF8_A1)
#endif
constexpr float F8_SHB = 16.f, F8_SWI = 256.f, F8_SWO = 512.f;
#ifndef MVT
#define MVT 1
#endif
static_assert(!(DF8_MV && (DF8_M1 || !MVT)), "DF8_MV: the split in-projection needs MVT and a bf16 q/k part");
#ifndef RT_BF16
#define RT_BF16 1
#endif
#ifndef ZF_BF16
#define ZF_BF16 1
#endif
static_assert(!(RT_BF16 && !ZF_BF16), "RT_BF16 reads z as bf16");
#ifndef CV_IN_ATTN
#define CV_IN_ATTN 1
#endif
#ifndef ATT_FP8
#define ATT_FP8 1
#endif
#ifndef Y_FP8
#define Y_FP8 1
#endif
constexpr float F8_SY = 64.f;
constexpr float F8_SQ = 64.f, F8_SK = 16.f, F8_SV = 16.f, F8_SP = 128.f;
#ifndef F8_SWCVT
#define F8_SWCVT 0
#endif
__device__ __forceinline__ unsigned f32_to_e4m3_sw(float x) {
    const unsigned b = __float_as_uint(x), sgn = (b >> 24) & 0x80u; const float ax = fabsf(x);
    if (ax < 0.015625f) return sgn | (unsigned)__builtin_rintf(ax * 512.0f);
    unsigned u = b & 0x7fffffffu; u += 0x7ffffu + ((u >> 20) & 1u);
    const unsigned e8 = (u >> 23) - 120u, m = (u >> 20) & 7u; unsigned enc = (e8 << 3) | m; enc = enc > 0x7eu ? 0x7eu : enc;
    return sgn | enc;
}
__device__ __forceinline__ unsigned cvt4_fp8(float a, float b, float c, float d) {
#if F8_SWCVT
    return f32_to_e4m3_sw(a) | (f32_to_e4m3_sw(b) << 8) | (f32_to_e4m3_sw(c) << 16) | (f32_to_e4m3_sw(d) << 24);
#else
    int w = __float_as_int(a);
    w = __builtin_amdgcn_cvt_pk_fp8_f32(a, b, w, false); w = __builtin_amdgcn_cvt_pk_fp8_f32(c, d, w, true); return (unsigned)w;
#endif
}
#define LDS_WAIT() asm volatile("s_waitcnt lgkmcnt(0)" ::: "memory")
#define VM_WAIT() asm volatile("s_waitcnt vmcnt(0)" ::: "memory")

#define XB_TMO      128
#define XB_XCNT(j)  (256  + 64 * (j))
#define XB_XSUB(j)  (1280 + 64 * (j))
#define XB_XGEN(j)  (2304 + 64 * (j))
#define XB_TOP      3328
#define XB_TOPGEN   3392
#define XCD_BAR_WORDS 3456
#define XB_SPIN_CAP (1u << 18)
__device__ __forceinline__ unsigned xb_ld(unsigned* p)              { return __hip_atomic_load(p, __ATOMIC_RELAXED, __HIP_MEMORY_SCOPE_AGENT); }
__device__ __forceinline__ unsigned xb_add(unsigned* p, unsigned v) { return __hip_atomic_fetch_add(p, v, __ATOMIC_RELAXED, __HIP_MEMORY_SCOPE_AGENT); }
__device__ __forceinline__ unsigned xb_xcc_id() { return (unsigned)__builtin_amdgcn_s_getreg((3 << 11) | 20) & 0xFu; }
#define XB_SPIN(cond, bar) do { unsigned _sp = 0; while (cond) { __builtin_amdgcn_s_sleep(1); \
    if ((++_sp & 255u) == 0u) { if (xb_ld(&(bar)[XB_TMO])) break; if (_sp > XB_SPIN_CAP) { atomicAdd(&(bar)[XB_TMO], 1u); break; } } } } while (0)
struct XcdBarrier { unsigned* bar; unsigned x; volatile LAS unsigned* st; };
__device__ __forceinline__ XcdBarrier xcd_barrier_post(unsigned* bar, volatile LAS unsigned* st) {
    XcdBarrier b; b.bar = bar; b.x = xb_xcc_id(); b.st = st;
    if (threadIdx.x == 0) (void)xb_add(&bar[XB_XCNT(b.x)], 1u);
    return b;
}
__device__ __forceinline__ void xcd_barrier_complete(unsigned* bar, unsigned x, unsigned& nloc, unsigned& nx) {
    const unsigned G = gridDim.x * gridDim.y * gridDim.z;
    unsigned sum, cnt, mine, sp = 0u;
    for (;;) {
        sum = 0u; cnt = 0u; mine = 0u;
#pragma unroll
        for (unsigned j = 0; j < 16; ++j) { const unsigned c = xb_ld(&bar[XB_XCNT(j)]); sum += c; cnt += (c > 0u) ? 1u : 0u; mine = (j == x) ? c : mine; }
        if (sum == G) break;
        __builtin_amdgcn_s_sleep(1);
        if ((++sp & 255u) == 0u) { if (xb_ld(&bar[XB_TMO])) break; if (sp > XB_SPIN_CAP) { atomicAdd(&bar[XB_TMO], 1u); break; } }
    }
    nloc = mine > 0u ? mine : 1u; nx = cnt > 0u ? cnt : 1u;
}
__device__ __forceinline__ void xcd_barrier(const XcdBarrier& b) {
    asm volatile("s_waitcnt vmcnt(0)" ::: "memory");
    __syncthreads();
    if (threadIdx.x == 0) {
        unsigned* bar = b.bar;
        __builtin_amdgcn_s_waitcnt(0);
        unsigned nloc = b.st[0], nx = b.st[1];
        if (nloc == 0u) { xcd_barrier_complete(bar, b.x, nloc, nx); b.st[0] = nloc; b.st[1] = nx; }
        const unsigned old = xb_add(&bar[XB_XSUB(b.x)], 1u);
        const unsigned gen = old / nloc;
        if (old + 1u == (gen + 1u) * nloc) {
            __builtin_amdgcn_fence(__ATOMIC_RELEASE, "agent");
            asm volatile("s_waitcnt vmcnt(0)" ::: "memory");
            const unsigned og = xb_add(&bar[XB_TOP], 1u);
            const unsigned tg = og / nx;
            if (og + 1u == (tg + 1u) * nx) xb_add(&bar[XB_TOPGEN], 1u);
            else XB_SPIN(xb_ld(&bar[XB_TOPGEN]) == tg, bar);
            __builtin_amdgcn_fence(__ATOMIC_ACQUIRE, "agent");
            xb_add(&bar[XB_XGEN(b.x)], 1u);
            asm volatile("s_waitcnt vmcnt(0)" ::: "memory");
        } else {
            XB_SPIN(xb_ld(&bar[XB_XGEN(b.x)]) == gen, bar);
            __builtin_amdgcn_fence(__ATOMIC_ACQUIRE, "agent");
            asm volatile("s_waitcnt vmcnt(0)" ::: "memory");
        }
    }
    __syncthreads();
}

namespace pg8 {
constexpr int BM = 256, BK = 64, HALF = 128, HTB = HALF * BK * 2, STAGE_BYTES = 8 * HTB;
__host__ __device__ __forceinline__ int lds_byte(int r, int c) { const int st = (r >> 4) * 2 + (c >> 5), rr = r & 15, cc = c & 31, ob = rr * 64 + cc * 2; return st * 1024 + (ob ^ (((ob >> 9) & 1) << 5)); }
__host__ __device__ __forceinline__ void stage_rc(int b, int& R, int& C) { const int st = b / 1024, sb = b % 1024, swz = sb ^ (((sb >> 9) & 1) << 5); R = (st >> 1) * 16 + swz / 64; C = (st & 1) * 32 + (swz % 64) / 2; }
__host__ __device__ __forceinline__ int perm32(int rho) { const int n = rho >> 4, i = rho & 15; return 8 * (i >> 2) + 4 * n + (i & 3); }

constexpr int BIAS_LDS_OFF = 131072 + 2048;
struct Unit { int pm, pn, aux, nvalid; const char* A; const char* B; const int* rows; int par = 0; };

template <class Epi, class Sched, bool GATHER, bool FP8 = false, bool SP2 = (PG8_SP2 != 0)>
__device__ __forceinline__ void gemm_phase(LAS unsigned char* lds, const int tid, const int K, const int lda, const int ldb, const Sched& S, const Epi& E) {
    const int wid = __builtin_amdgcn_readfirstlane(tid >> 6), lane = tid & 63, wr = wid >> 2, wc = wid & 3, fr = lane & 15, fq = lane >> 4;
    constexpr int ESZ = FP8 ? 1 : 2;
    const int nt = K * ESZ / (BK * 2);
    int RC[2];
    unsigned offB[2], offA[2], gAc[2][2];
#pragma unroll
    for (int i = 0; i < 2; ++i) { int R, C; stage_rc(tid * 16 + i * 8192, R, C); RC[i] = (R << 8) | (2 * C); const int Rb = Epi::PERM ? ((R & ~31) + perm32(R & 31)) : R;
        offB[i] = (unsigned)(Rb * ldb * ESZ + C * 2); offA[i] = (unsigned)(R * lda * ESZ + C * 2);
#pragma unroll
        for (int h = 0; h < 2; ++h) gAc[h][i] = offA[i]; }
    const size_t hstepA = (size_t)HALF * lda * ESZ, hstepB = (size_t)HALF * ldb * ESZ;
    const size_t kstep = (size_t)(BK * 2);
    const unsigned ldsw = (unsigned)wid * 1024u;
    const int aoff = lds_byte(wr * 64 + fr, fq * 8), boff = lds_byte(wc * 32 + fr, fq * 8);
#define PG8_SA(b, h) (((b) * 2 + (h)) * HTB)
#define PG8_SB(b, h) ((4 + (b) * 2 + (h)) * HTB)
#define PG8_STAGE(bufoff, gbase, voff) do { _Pragma("unroll") for (int _i = 0; _i < 2; ++_i) \
        __builtin_amdgcn_global_load_lds((const unsigned*)((const char*)(gbase) + (voff)[_i]), (LAS unsigned*)(lds + (bufoff) + ldsw + _i * 8192), 16, 0, 0); } while (0)
#define PG8_STAGEA(bufoff, gbase, h, G) do { if constexpr (GATHER) { PG8_STAGE(bufoff, gbase, G[h]); } else { PG8_STAGE(bufoff, (gbase) + (h) * hstepA, offA); } } while (0)
#define PG8_STAGEA2(bufoff, gbase, h) PG8_STAGEA(bufoff, gbase, h, gAc)
#define PG8_LDA(dst, b, h) do { _Pragma("unroll") for (int m = 0; m < 4; ++m) { dst[m].lo = *(const LAS i32x4*)(lds + PG8_SA(b, h) + aoff + m * 2048); dst[m].hi = *(const LAS i32x4*)(lds + PG8_SA(b, h) + aoff + m * 2048 + 1024); } } while (0)
#define PG8_LDB(dst, b, h) do { _Pragma("unroll") for (int n = 0; n < 2; ++n) { dst[n].lo = *(const LAS i32x4*)(lds + PG8_SB(b, h) + boff + n * 2048); dst[n].hi = *(const LAS i32x4*)(lds + PG8_SB(b, h) + boff + n * 2048 + 1024); } } while (0)
#define PG8_MMA(ai, bj, At, Bt) do { __builtin_amdgcn_s_setprio(1); _Pragma("unroll") for (int m = 0; m < 4; ++m) _Pragma("unroll") for (int n = 0; n < 2; ++n) { \
        if constexpr (FP8) { asm volatile("v_mfma_f32_16x16x128_f8f6f4 %0, %1, %2, %0" : "+v"(acc[ai][bj][m][n]) : "v"(Bt[n]), "v"(At[m])); }     \
        else { const i32x4 _bl = Bt[n].lo, _bh = Bt[n].hi, _al = At[m].lo, _ah = At[m].hi;     \
               acc[ai][bj][m][n] = __builtin_amdgcn_mfma_f32_16x16x32_bf16(__builtin_bit_cast(bf16x8, _bl), __builtin_bit_cast(bf16x8, _al), acc[ai][bj][m][n], 0, 0, 0); \
               acc[ai][bj][m][n] = __builtin_amdgcn_mfma_f32_16x16x32_bf16(__builtin_bit_cast(bf16x8, _bh), __builtin_bit_cast(bf16x8, _ah), acc[ai][bj][m][n], 0, 0, 0); } } \
        __builtin_amdgcn_s_setprio(0); } while (0)
#define PG8_WAIT_V(n) asm volatile("s_waitcnt vmcnt(" #n ")" ::: "memory")
#define PG8_WAIT_L(n) asm volatile("s_waitcnt lgkmcnt(" #n ")" ::: "memory")
#define PG8_BAR __builtin_amdgcn_s_barrier()
#define PG8_SCHED __builtin_amdgcn_sched_barrier(0)
#define PG8_GATHER_LD(U, TOK) do { _Pragma("unroll") for (int _h = 0; _h < 2; ++_h) _Pragma("unroll") for (int _i = 0; _i < 2; ++_i) { const int _r = _h * HALF + (RC[_i] >> 8); \
        TOK[_h][_i] = ((const GAS int*)(U).rows)[_r < (U).nvalid ? _r : 0]; } } while (0)
#define PG8_GATHER_CV(TOK, OFF) do { _Pragma("unroll") for (int _h = 0; _h < 2; ++_h) _Pragma("unroll") for (int _i = 0; _i < 2; ++_i) OFF[_h][_i] = (unsigned)(TOK[_h][_i] * lda * ESZ + (RC[_i] & 0xff)); } while (0)
#define PG8_GATHER(U, OFF) do { _Pragma("unroll") for (int _h = 0; _h < 2; ++_h) _Pragma("unroll") for (int _i = 0; _i < 2; ++_i) { const int _r = _h * HALF + (RC[_i] >> 8); \
        const int _tok = ((const GAS int*)(U).rows)[_r < (U).nvalid ? _r : 0]; OFF[_h][_i] = (unsigned)(_tok * lda * ESZ + (RC[_i] & 0xff)); } } while (0)
    Unit cur, nxt; int ui = 0;
    if (!S.next(0, cur)) return;
    f32x4 acc[2][2][4][2];
#pragma unroll
    for (int a = 0; a < 2; ++a)
#pragma unroll
        for (int b = 0; b < 2; ++b)
#pragma unroll
            for (int m = 0; m < 4; ++m)
#pragma unroll
                for (int n = 0; n < 2; ++n) acc[a][b][m][n] = (f32x4){0.f, 0.f, 0.f, 0.f};
    i32x8 At[4], B0[2], B1[2];
    const char* cA = cur.A; const char* cB = cur.B;
    if constexpr (GATHER) { PG8_GATHER(cur, gAc); }
    if constexpr (SP2) {
        PG8_STAGE(PG8_SB(0, 0), cB, offB); PG8_STAGE(PG8_SB(0, 1), cB + hstepB, offB); PG8_STAGEA(PG8_SA(0, 0), cA, 0, gAc); PG8_STAGEA(PG8_SA(0, 1), cA, 1, gAc);
        if (wr == 1) PG8_BAR;
        PG8_WAIT_V(2); PG8_BAR;
        PG8_STAGE(PG8_SB(1, 0), cB + kstep, offB); PG8_STAGEA(PG8_SA(1, 0), cA + kstep, 0, gAc); PG8_STAGE(PG8_SB(1, 1), cB + kstep + hstepB, offB);
        PG8_WAIT_V(6); PG8_BAR;
    } else {
    PG8_STAGE(PG8_SB(0, 0), cB, offB); PG8_STAGEA(PG8_SA(0, 0), cA, 0, gAc); PG8_STAGE(PG8_SB(0, 1), cB + hstepB, offB); PG8_STAGEA(PG8_SA(0, 1), cA, 1, gAc);
    if (wr == 1) PG8_BAR;
    PG8_WAIT_V(4); PG8_BAR;
    PG8_STAGE(PG8_SB(1, 0), cB + kstep, offB); PG8_STAGEA(PG8_SA(1, 0), cA + kstep, 0, gAc); PG8_STAGE(PG8_SB(1, 1), cB + kstep + hstepB, offB);
    PG8_WAIT_V(6); PG8_BAR;
    }
    for (;;) {
        const bool has_next = S.next(ui + 1, nxt);
        cur.par = ui & 1;
        if constexpr (Epi::BIASLDS) { if (wid == 0) { int l2; asm volatile("v_mbcnt_lo_u32_b32 %0, -1, 0\n\tv_mbcnt_hi_u32_b32 %0, -1, %0" : "=v"(l2)); E.prefetch(cur, ui & 1, l2); } }
        const char* nA = has_next ? nxt.A : cA; const char* nB = has_next ? nxt.B : cB;
#pragma unroll 1
        for (int t = 0; t < nt; t += 2) {
            const bool last = (t == nt - 2);
            const char* a1 = cA + (size_t)(t + 1) * kstep;
            const char* a2 = last ? nA : cA + (size_t)(t + 2) * kstep; const char* b2 = last ? nB : cB + (size_t)(t + 2) * kstep;
            const char* a3 = a2 + kstep; const char* b3 = b2 + kstep;
            int tokn[2][2];
            if constexpr (GATHER) { if (last && has_next) { PG8_GATHER_LD(nxt, tokn); } }
            if constexpr (SP2) {
            PG8_LDB(B0, 0, 0); PG8_LDB(B1, 0, 1); PG8_SCHED; PG8_LDA(At, 0, 0); PG8_STAGEA(PG8_SA(1, 1), a1, 1, gAc);
            PG8_WAIT_V(8); PG8_WAIT_L(0); PG8_BAR; PG8_MMA(0, 0, At, B0); PG8_MMA(0, 1, At, B1); PG8_BAR; PG8_SCHED;
            if constexpr (GATHER) { if (last && has_next) { PG8_GATHER_CV(tokn, gAc); } }
            PG8_LDA(At, 0, 1); PG8_STAGE(PG8_SB(0, 0), b2, offB); PG8_STAGE(PG8_SB(0, 1), b2 + hstepB, offB); PG8_STAGEA2(PG8_SA(0, 0), a2, 0);
            PG8_WAIT_V(8); PG8_WAIT_L(0); PG8_BAR; PG8_MMA(1, 0, At, B0); PG8_MMA(1, 1, At, B1); PG8_BAR; PG8_SCHED;
            PG8_LDB(B0, 1, 0); PG8_LDB(B1, 1, 1); PG8_SCHED; PG8_LDA(At, 1, 0); PG8_STAGEA2(PG8_SA(0, 1), a2, 1);
            PG8_WAIT_V(8); PG8_WAIT_L(0); PG8_BAR; PG8_MMA(0, 0, At, B0); PG8_MMA(0, 1, At, B1); PG8_BAR; PG8_SCHED;
            PG8_LDA(At, 1, 1); PG8_STAGE(PG8_SB(1, 0), b3, offB); PG8_STAGE(PG8_SB(1, 1), b3 + hstepB, offB); PG8_STAGEA2(PG8_SA(1, 0), a3, 0);
            PG8_WAIT_V(8); PG8_WAIT_L(0); PG8_BAR; PG8_MMA(1, 0, At, B0); PG8_MMA(1, 1, At, B1); PG8_BAR; PG8_SCHED;
            } else {
            PG8_LDB(B0, 0, 0); PG8_SCHED; PG8_LDA(At, 0, 0); PG8_STAGEA(PG8_SA(1, 1), a1, 1, gAc);
            PG8_WAIT_L(8); PG8_BAR; PG8_WAIT_L(0); PG8_MMA(0, 0, At, B0); PG8_BAR; PG8_SCHED;
            if constexpr (GATHER) { if (last && has_next) { PG8_GATHER_CV(tokn, gAc); } }
            PG8_LDB(B1, 0, 1); PG8_STAGE(PG8_SB(0, 0), b2, offB);
            PG8_BAR; PG8_WAIT_L(0); PG8_MMA(0, 1, At, B1); PG8_BAR;
            PG8_LDA(At, 0, 1); PG8_STAGEA2(PG8_SA(0, 0), a2, 0);
            PG8_BAR; PG8_WAIT_L(0); PG8_MMA(1, 0, At, B0); PG8_BAR; PG8_SCHED;
            PG8_STAGE(PG8_SB(0, 1), b2 + hstepB, offB);
            PG8_WAIT_V(6); PG8_BAR; PG8_MMA(1, 1, At, B1); PG8_BAR;
            PG8_LDB(B0, 1, 0); PG8_SCHED; PG8_LDA(At, 1, 0); PG8_STAGEA2(PG8_SA(0, 1), a2, 1);
            PG8_WAIT_L(8); PG8_BAR; PG8_WAIT_L(0); PG8_MMA(0, 0, At, B0); PG8_BAR; PG8_SCHED;
            PG8_LDB(B1, 1, 1); PG8_STAGE(PG8_SB(1, 0), b3, offB);
            PG8_BAR; PG8_WAIT_L(0); PG8_MMA(0, 1, At, B1); PG8_BAR;
            PG8_LDA(At, 1, 1); PG8_STAGEA2(PG8_SA(1, 0), a3, 0);
            PG8_BAR; PG8_WAIT_L(0); PG8_MMA(1, 0, At, B0); PG8_BAR; PG8_SCHED;
            PG8_STAGE(PG8_SB(1, 1), b3 + hstepB, offB);
            PG8_WAIT_V(6); PG8_BAR; PG8_MMA(1, 1, At, B1); PG8_BAR;
            }
        }
        if constexpr (FP8) asm volatile("s_nop 15" ::: "memory");
        { int l2; asm volatile("v_mbcnt_lo_u32_b32 %0, -1, 0\n\tv_mbcnt_hi_u32_b32 %0, -1, %0" : "=v"(l2)); E(acc, cur, wr, wc, l2 & 15, l2 >> 4); if (DUP_EPI && FP8) { asm volatile("" ::: "memory"); E(acc, cur, wr, wc, l2 & 15, l2 >> 4); } }
        if (!has_next) break;
#pragma unroll
        for (int a = 0; a < 2; ++a)
#pragma unroll
            for (int b = 0; b < 2; ++b)
#pragma unroll
                for (int m = 0; m < 4; ++m)
#pragma unroll
                    for (int n = 0; n < 2; ++n) acc[a][b][m][n] = (f32x4){0.f, 0.f, 0.f, 0.f};
        cur = nxt; cA = nA; cB = nB; ++ui;
    }
    PG8_WAIT_V(0);
    if (wr == 0) PG8_BAR;
    PG8_BAR;
#undef PG8_SA
#undef PG8_SB
#undef PG8_STAGE
#undef PG8_LDA
#undef PG8_LDB
#undef PG8_MMA
#undef PG8_WAIT_V
#undef PG8_WAIT_L
#undef PG8_BAR
#undef PG8_SCHED
#undef PG8_GATHER
#undef PG8_GATHER_LD
#undef PG8_GATHER_CV
#undef PG8_STAGEA
#undef PG8_STAGEA2
}
}
namespace pg8 {
__device__ __forceinline__ u32x4 widen16(u32x2 we, u32x2 wo) {
    const u32x2 r0 = __builtin_amdgcn_permlane16_swap(we.x, wo.x, false, false), r1 = __builtin_amdgcn_permlane16_swap(we.y, wo.y, false, false);
    return (u32x4){r0.x, r1.x, r0.y, r1.y};
}
struct EpiBf16 {
    static constexpr bool PERM = true; static constexpr bool BIASLDS = false;
    bf16_t* O; int ldc; float scale;
    __device__ __forceinline__ void operator()(const f32x4 (&acc)[2][2][4][2], const Unit& u, int wr, int wc, int fr, int fq) const {
        const int row0 = u.pm * BM + wr * 64 + fr, col0 = u.pn * BM + wc * 32 + 8 * fq;
#pragma unroll
        for (int ai = 0; ai < 2; ++ai)
#pragma unroll
            for (int m = 0; m < 4; ++m) { bf16_t* rowp = O + (size_t)(row0 + ai * HALF + m * 16) * ldc + col0;
#pragma unroll
                for (int bj = 0; bj < 2; ++bj) { const f32x4 v0 = acc[ai][bj][m][0] * scale, v1 = acc[ai][bj][m][1] * scale;
                    u32x4 w; w.x = cvt_pk_bf16(v0[0], v0[1]); w.y = cvt_pk_bf16(v0[2], v0[3]); w.z = cvt_pk_bf16(v1[0], v1[1]); w.w = cvt_pk_bf16(v1[2], v1[3]);
                    *(u32x4*)(rowp + bj * HALF) = w; } }
    }
};
struct EpiVT {
    static constexpr bool PERM = true; static constexpr bool BIASLDS = false;
    bf16_t* O; int ldc; float scale = 1.0f;
    __device__ __forceinline__ void operator()(const f32x4 (&acc)[2][2][4][2], const Unit& u, int wr, int wc, int fr, int fq) const {
        const int row0 = u.pm * BM + wr * 64 + fr, col0 = u.pn * BM + wc * 32 + 8 * fq;
        const int cb = col0 & ~15, g = (col0 >> 2) & 3;
        const int s0 = cb + ((g == 0) ? 0 : 4), s1 = cb + ((g == 0) ? 8 : 12);
#pragma unroll
        for (int ai = 0; ai < 2; ++ai)
#pragma unroll
            for (int m = 0; m < 4; ++m) { bf16_t* rowp = O + (size_t)(row0 + ai * HALF + m * 16) * ldc;
#pragma unroll
                for (int bj = 0; bj < 2; ++bj) { const f32x4 v0 = acc[ai][bj][m][0] * scale, v1 = acc[ai][bj][m][1] * scale;
                    u32x2 w0, w1; w0.x = cvt_pk_bf16(v0[0], v0[1]); w0.y = cvt_pk_bf16(v0[2], v0[3]); w1.x = cvt_pk_bf16(v1[0], v1[1]); w1.y = cvt_pk_bf16(v1[2], v1[3]);
                    *(u32x2*)(rowp + bj * HALF + s0) = w0; *(u32x2*)(rowp + bj * HALF + s1) = w1; } }
    }
};
struct EpiF8 {
    static constexpr bool PERM = true; static constexpr bool BIASLDS = false;
    unsigned char* O; int ldc; float scale;
    __device__ __forceinline__ void operator()(const f32x4 (&acc)[2][2][4][2], const Unit& u, int wr, int wc, int fr, int fq) const {
        const int row0 = u.pm * BM + wr * 64 + fr, col0 = u.pn * BM + wc * 32 + 8 * fq;
#pragma unroll
        for (int ai = 0; ai < 2; ++ai)
#pragma unroll
            for (int m = 0; m < 4; ++m) { unsigned char* rowp = O + (size_t)(row0 + ai * HALF + m * 16) * ldc + col0;
#pragma unroll
                for (int bj = 0; bj < 2; ++bj) { const f32x4 v0 = acc[ai][bj][m][0] * scale, v1 = acc[ai][bj][m][1] * scale;
                    u32x2 w; w.x = cvt4_fp8(v0[0], v0[1], v0[2], v0[3]); w.y = cvt4_fp8(v1[0], v1[1], v1[2], v1[3]); *(u32x2*)(rowp + bj * HALF) = w; } }
    }
};
struct EpiVT8 {
    static constexpr bool PERM = true; static constexpr bool BIASLDS = false;
    unsigned char* O; int ldc; float scale;
    __device__ __forceinline__ void operator()(const f32x4 (&acc)[2][2][4][2], const Unit& u, int wr, int wc, int fr, int fq) const {
        const int row0 = u.pm * BM + wr * 64 + fr, col0 = u.pn * BM + wc * 32 + 8 * fq;
#pragma unroll
        for (int ai = 0; ai < 2; ++ai)
#pragma unroll
            for (int m = 0; m < 4; ++m) { unsigned char* rowp = O + (size_t)(row0 + ai * HALF + m * 16) * ldc;
#pragma unroll
                for (int bj = 0; bj < 2; ++bj) { const int c = col0 + bj * HALF, p0 = (c & ~63) + 16 * ((c >> 5) & 1) + 4 * ((c & 31) >> 3);
                    const f32x4 v0 = acc[ai][bj][m][0] * scale, v1 = acc[ai][bj][m][1] * scale;
                    *(unsigned*)(rowp + p0) = cvt4_fp8(v0[0], v0[1], v0[2], v0[3]); *(unsigned*)(rowp + p0 + 32) = cvt4_fp8(v1[0], v1[1], v1[2], v1[3]); } }
    }
};
struct EpiF32 {
    static constexpr bool PERM = false; static constexpr bool BIASLDS = false;
    float* C; int ldc; float scale;
    __device__ __forceinline__ void operator()(const f32x4 (&acc)[2][2][4][2], const Unit& u, int wr, int wc, int fr, int fq) const {
        const int row0 = u.pm * BM + wr * 64 + fr, col0 = u.pn * BM + wc * 32 + 4 * fq;
#pragma unroll
        for (int ai = 0; ai < 2; ++ai)
#pragma unroll
            for (int m = 0; m < 4; ++m) { float* rowp = C + (size_t)(row0 + ai * HALF + m * 16) * ldc + col0;
#pragma unroll
                for (int bj = 0; bj < 2; ++bj)
#pragma unroll
                    for (int n = 0; n < 2; ++n) *(f32x4*)(rowp + bj * HALF + n * 16) = acc[ai][bj][m][n] * scale; }
    }
};
struct EpiResid {
    static constexpr bool PERM = true; static constexpr bool BIASLDS = false;
    const bf16_t* X; float* Z; int ldc; float alpha, ascale;
    __device__ __forceinline__ void operator()(const f32x4 (&acc)[2][2][4][2], const Unit& u, int wr, int wc, int fr, int fq) const {
        const int row0 = u.pm * BM + wr * 64 + fr, col0 = u.pn * BM + wc * 32 + 8 * fq;
        u32x4 xw[2][2];
#define ER_LOAD(g) do { const size_t off_ = (size_t)(row0 + ((g) >> 2) * HALF + ((g) & 3) * 16) * ldc + col0; \
            _Pragma("unroll") for (int bj = 0; bj < 2; ++bj) xw[(g) & 1][bj] = *(const u32x4*)(X + off_ + bj * HALF); } while (0)
        ER_LOAD(0);
#pragma unroll
        for (int g = 0; g < 8; ++g) { const int ai = g >> 2, m = g & 3; const size_t off = (size_t)(row0 + ai * HALF + m * 16) * ldc + col0;
            if (g + 1 < 8) ER_LOAD(g + 1);
            __builtin_amdgcn_sched_barrier(0);
#pragma unroll
            for (int bj = 0; bj < 2; ++bj) { const u32x4 x = xw[g & 1][bj];
                const f32x4 x0 = {bf_lo(x.x), bf_hi(x.x), bf_lo(x.y), bf_hi(x.y)}, x1 = {bf_lo(x.z), bf_hi(x.z), bf_lo(x.w), bf_hi(x.w)};
                const f32x4 z0 = x0 * alpha + acc[ai][bj][m][0] * ascale, z1 = x1 * alpha + acc[ai][bj][m][1] * ascale;
                if (ZF_BF16) { u32x4 w; w.x = cvt_pk_bf16(z0[0], z0[1]); w.y = cvt_pk_bf16(z0[2], z0[3]); w.z = cvt_pk_bf16(z1[0], z1[1]); w.w = cvt_pk_bf16(z1[2], z1[3]); *(u32x4*)((bf16_t*)Z + off + bj * HALF) = w; }
                else { *(f32x4*)(Z + off + bj * HALF) = z0; *(f32x4*)(Z + off + bj * HALF + 4) = z1; } }
            __builtin_amdgcn_sched_barrier(0); }
#undef ER_LOAD
    }
};
struct EpiQRope {
    static constexpr bool PERM = true; static constexpr bool BIASLDS = false;
    bf16_t* O; int ldc; const float* cosT; const float* sinT; float scale;
    __device__ __forceinline__ void operator()(const f32x4 (&acc)[2][2][4][2], const Unit& u, int wr, int wc, int fr, int fq) const {
        const int row0 = u.pm * BM + wr * 64 + fr, col0 = u.pn * BM + wc * 32 + 8 * fq;
        f32x4 cc[2][2], ss[2][2];
        const int rr0 = col0 % AQD, rr1 = (col0 + HALF) % AQD;
#define QR_LOAD(g) do { const unsigned row_ = (unsigned)(row0 + ((g) >> 2) * HALF + ((g) & 3) * 16); \
            _Pragma("unroll") for (int bj = 0; bj < 2; ++bj) { const int rr_ = bj ? rr1 : rr0; \
                if (rr_ >= ANOPE) { const unsigned tb_ = (row_ * 32u + (unsigned)((rr_ - ANOPE) >> 1)) * 4u; cc[(g) & 1][bj] = *(const f32x4*)((const char*)cosT + tb_); ss[(g) & 1][bj] = *(const f32x4*)((const char*)sinT + tb_); } } } while (0)
        QR_LOAD(0);
#pragma unroll
        for (int g = 0; g < 8; ++g) { const int ai = g >> 2, m = g & 3; const unsigned row = (unsigned)(row0 + ai * HALF + m * 16);
            if (g + 1 < 8) QR_LOAD(g + 1);
            __builtin_amdgcn_sched_barrier(0);
#pragma unroll
            for (int bj = 0; bj < 2; ++bj) { f32x4 v0 = acc[ai][bj][m][0] * scale, v1 = acc[ai][bj][m][1] * scale;
                const int col = col0 + bj * HALF, rr = bj ? rr1 : rr0;
                if (rr >= ANOPE) { const f32x4 c = cc[g & 1][bj], s = ss[g & 1][bj];
                    const f32x4 a0 = v0, a1 = v1;
                    v0[0] = a0[0] * c[0] - a0[1] * s[0]; v0[1] = a0[1] * c[0] + a0[0] * s[0]; v0[2] = a0[2] * c[1] - a0[3] * s[1]; v0[3] = a0[3] * c[1] + a0[2] * s[1];
                    v1[0] = a1[0] * c[2] - a1[1] * s[2]; v1[1] = a1[1] * c[2] + a1[0] * s[2]; v1[2] = a1[2] * c[3] - a1[3] * s[3]; v1[3] = a1[3] * c[3] + a1[2] * s[3]; }
                if (ATT_FP8) { u32x2 w; w.x = cvt4_fp8(v0[0], v0[1], v0[2], v0[3]); w.y = cvt4_fp8(v1[0], v1[1], v1[2], v1[3]); *(u32x2*)((char*)O + ((size_t)row * (unsigned)ldc + (unsigned)col)) = w; }
                else { u32x4 w; w.x = cvt_pk_bf16(v0[0], v0[1]); w.y = cvt_pk_bf16(v0[2], v0[3]); w.z = cvt_pk_bf16(v1[0], v1[1]); w.w = cvt_pk_bf16(v1[2], v1[3]);
                    *(u32x4*)((char*)O + ((size_t)row * (unsigned)ldc + (unsigned)col) * 2u) = w; } }
            __builtin_amdgcn_sched_barrier(0); }
#undef QR_LOAD
    }
};
struct EpiSwiglu {
    static constexpr bool PERM = true; static constexpr bool BIASLDS = true;
    unsigned char* Hh; const float* bgu; LAS unsigned char* lds;
    __device__ __forceinline__ void prefetch(const Unit& u, int par, int lane) const {
        __builtin_amdgcn_global_load_lds((const unsigned*)(bgu + (size_t)u.aux * 2048 + 2 * (u.pn * HALF) + 4 * lane), (LAS unsigned*)(lds + BIAS_LDS_OFF + par * 1024), 16, 0, 0); }
    __device__ __forceinline__ void operator()(const f32x4 (&acc)[2][2][4][2], const Unit& u, int wr, int wc, int fr, int fq) const {
        const int row0 = u.pm * BM + wr * 64 + fr, j0 = u.pn * HALF + wc * 32 + 8 * fq;
        const LAS f32x4* bp = (const LAS f32x4*)(lds + BIAS_LDS_OFF + u.par * 1024 + (64 * wc + 16 * fq) * 4);
        const f32x4 b0 = bp[0], b1 = bp[1], b2 = bp[2], b3 = bp[3];
        const float bg[8] = {b0[0], b0[2], b1[0], b1[2], b2[0], b2[2], b3[0], b3[2]}, bl[8] = {b0[1], b0[3], b1[1], b1[3], b2[1], b2[3], b3[1], b3[3]};
        constexpr float inv = MOE_FP8 ? 1.0f / (F8_SX * F8_SWG) : 1.0f;
#pragma unroll
        for (int ai = 0; ai < 2; ++ai)
#pragma unroll
            for (int mp = 0; mp < 2; ++mp) { u32x2 w8[2];
#pragma unroll
                for (int mo = 0; mo < 2; ++mo) { const int m = 2 * mp + mo; unsigned char* rowp = Hh + ((size_t)(row0 + ai * HALF + m * 16) * DFF + j0) * (MOE_FP8 ? 1 : 2);
                float o[8];
#pragma unroll
                for (int q = 0; q < 8; ++q) { float g = acc[ai][0][m][q >> 2][q & 3] * inv + bg[q], l = acc[ai][1][m][q >> 2][q & 3] * inv + bl[q];
                    g = fminf(g, 7.0f); l = fminf(fmaxf(l, -7.0f), 7.0f);
                    const float sg = __builtin_amdgcn_rcpf(1.0f + __builtin_amdgcn_exp2f(-1.702f * 1.4426950408889634f * g));
                    o[q] = (l + 1.0f) * g * sg * (MOE_FP8 ? F8_SH : 1.0f); }
                if (MOE_FP8) { w8[mo].x = cvt4_fp8(o[0], o[1], o[2], o[3]); w8[mo].y = cvt4_fp8(o[4], o[5], o[6], o[7]); }
                else { u32x4 w; w.x = cvt_pk_bf16(o[0], o[1]); w.y = cvt_pk_bf16(o[2], o[3]); w.z = cvt_pk_bf16(o[4], o[5]); w.w = cvt_pk_bf16(o[6], o[7]); *(u32x4*)rowp = w; } }
                if (MOE_FP8) { const u32x4 w16 = widen16(w8[0], w8[1]);
                    *(u32x4*)(Hh + (size_t)(row0 + ai * HALF + (2 * mp + (fq & 1)) * 16) * DFF + (j0 - 8 * fq) + 16 * (fq >> 1)) = w16; } }
    }
};
struct EpiDown {
    static constexpr bool PERM = true; static constexpr bool BIASLDS = true;
    bf16_t* Y; const float* bd; LAS unsigned char* lds;
    __device__ __forceinline__ void prefetch(const Unit& u, int par, int lane) const {
        __builtin_amdgcn_global_load_lds((const unsigned*)(bd + (size_t)u.aux * D + u.pn * BM + 4 * lane), (LAS unsigned*)(lds + BIAS_LDS_OFF + par * 1024), 16, 0, 0); }
    __device__ __forceinline__ void operator()(const f32x4 (&acc)[2][2][4][2], const Unit& u, int wr, int wc, int fr, int fq) const {
        const int row0 = u.pm * BM + wr * 64 + fr, col0 = u.pn * BM + wc * 32 + 8 * fq;
        const LAS f32x4* bp = (const LAS f32x4*)(lds + BIAS_LDS_OFF + u.par * 1024 + (wc * 32 + 8 * fq) * 4);
        constexpr float inv = MOE_FP8 ? 1.0f / (F8_SH * F8_SWD) : 1.0f;
#pragma unroll
        for (int bj = 0; bj < 2; ++bj) {
            const f32x4 b0 = bp[bj * (HALF / 4)], b1 = bp[bj * (HALF / 4) + 1];
#pragma unroll
            for (int ai = 0; ai < 2; ++ai)
#pragma unroll
                for (int mp = 0; mp < 2; ++mp) { u32x2 w8[2];
#pragma unroll
                    for (int mo = 0; mo < 2; ++mo) { const int m = 2 * mp + mo; const f32x4 v0 = acc[ai][bj][m][0] * inv + b0, v1 = acc[ai][bj][m][1] * inv + b1;
                    if (Y_FP8) { w8[mo].x = cvt4_fp8(v0[0] * F8_SY, v0[1] * F8_SY, v0[2] * F8_SY, v0[3] * F8_SY); w8[mo].y = cvt4_fp8(v1[0] * F8_SY, v1[1] * F8_SY, v1[2] * F8_SY, v1[3] * F8_SY); }
                    else { u32x4 w; w.x = cvt_pk_bf16(v0[0], v0[1]); w.y = cvt_pk_bf16(v0[2], v0[3]); w.z = cvt_pk_bf16(v1[0], v1[1]); w.w = cvt_pk_bf16(v1[2], v1[3]);
                        *(u32x4*)((char*)Y + ((size_t)(unsigned)(row0 + ai * HALF + m * 16) * D + (unsigned)(col0 + bj * HALF)) * 2u) = w; } }
                    if (Y_FP8) { const u32x4 w16 = widen16(w8[0], w8[1]);
                        *(u32x4*)((char*)Y + ((size_t)(unsigned)(row0 + ai * HALF + (2 * mp + (fq & 1)) * 16) * D + (unsigned)(col0 - 8 * fq + 16 * (fq >> 1) + bj * HALF))) = w16; } }
            asm volatile("" ::: "memory"); }
    }
};

struct DenseOrder {
    const char* A; const char* Bt; int nM, nN, G, c; size_t astep, bstep;
    int skip_at = 1 << 30, skip_n = 0;
    __device__ __forceinline__ void init(const void* A_, const void* Bt_, int M, int N, int lda, int ldb, int G_, int c_, int esz = 2) { A = (const char*)A_; Bt = (const char*)Bt_; nM = M / BM; nN = N / BM; G = G_; c = c_; astep = (size_t)BM * lda * esz; bstep = (size_t)BM * ldb * esz; }
    __device__ __forceinline__ bool next(int i, Unit& u) const {
        const int L = i * G + c; if (L >= nM * nN) return false;
        u.pm = L / nN; u.pn = L - u.pm * nN; if (u.pn >= skip_at) u.pn += skip_n;
        u.aux = 0; u.nvalid = 256; u.A = A + (size_t)u.pm * astep; u.B = Bt + (size_t)u.pn * bstep; u.rows = nullptr; return true;
    }
};
constexpr int MOE_UTAB_OFF = 131072;
struct MoeOrder {
    const volatile LAS int* utab; const char* A; const char* W; const int* list; int nunits; size_t wstep_e, astep;
    bool gather; size_t arow_step;
    __device__ __forceinline__ bool next(int i, Unit& u) const {
        if (i >= nunits) return false;
        const i32x4 ut = *(const LAS i32x4*)((const LAS int*)utab + 4 * i);
        const int rt = __builtin_amdgcn_readfirstlane(ut.x), pn = __builtin_amdgcn_readfirstlane(ut.y), er = __builtin_amdgcn_readfirstlane(ut.z), nv = __builtin_amdgcn_readfirstlane(ut.w);
        const int e = er & 0xff, rtl = er >> 8;
        u.pm = rt; u.pn = pn; u.aux = e; u.nvalid = nv; u.B = W + (size_t)e * wstep_e + (size_t)pn * astep;
        if (gather) { u.A = A; u.rows = list + (size_t)e * T + (size_t)rtl * 256; } else { u.A = A + (size_t)rt * arow_step; u.rows = nullptr; }
        return true;
    }
};
}
struct Args { const void* in[20]; float* out; unsigned char* ws; int ph_lo, ph_hi; };
struct Frame {
    LAS unsigned char* lds; volatile LAS unsigned* MISC;
    int tid, lane, wave, vcu, G;
    __device__ __forceinline__ const void* ptr(int i) const { const unsigned lo = __builtin_amdgcn_readfirstlane(MISC[128 + 2 * i]), hi = __builtin_amdgcn_readfirstlane(MISC[129 + 2 * i]);
        return (const void*)(const GAS char*)(((unsigned long long)hi << 32) | lo); }
    __device__ __forceinline__ unsigned char* ws() const { return (unsigned char*)ptr(21); }
    __device__ __forceinline__ float* out() const { return (float*)ptr(20); }
    __device__ __forceinline__ unsigned* ctl() const { return (unsigned*)ptr(21); }
};
__device__ __forceinline__ Frame refresh(const Frame& F) {
    Frame R = F; int ln, w = F.wave, v = F.vcu, g = F.G;
    asm volatile("v_mbcnt_lo_u32_b32 %0, -1, 0\n\tv_mbcnt_hi_u32_b32 %0, -1, %0" : "=v"(ln));
    asm volatile("" : "+s"(w), "+s"(v), "+s"(g));
    R.tid = w * 64 + ln; R.lane = ln; R.wave = w; R.vcu = v; R.G = g; return R;
}
enum { IN_X = 0, IN_POS, IN_LNG, IN_LNB, IN_MWIN, IN_MBG, IN_MNG, IN_MWOUT, IN_AWIN, IN_AQN, IN_AKVN, IN_AWQB, IN_AWKVB, IN_AWOUT, IN_RW, IN_RB, IN_WGU, IN_BGU, IN_WD, IN_BD };

template <class RowMap>
__device__ __forceinline__ void transpose_item(const float* __restrict__ W, int ldw, int K, bf16_t* __restrict__ WT, LAS float*, int kb, int nb, int lane, RowMap rm) {
    const int n4 = lane & 7, kg = lane >> 3, k0 = 64 * kb + 8 * kg, n0 = 32 * nb + 4 * n4;
    f32x4 v[8];
#pragma unroll
    for (int i = 0; i < 8; ++i) v[i] = *(const f32x4*)(W + (size_t)(k0 + i) * ldw + n0);
#pragma unroll
    for (int jn = 0; jn < 4; ++jn) { u32x4 o; o.x = cvt_pk_bf16(v[0][jn], v[1][jn]); o.y = cvt_pk_bf16(v[2][jn], v[3][jn]); o.z = cvt_pk_bf16(v[4][jn], v[5][jn]); o.w = cvt_pk_bf16(v[6][jn], v[7][jn]);
        *(u32x4*)(WT + (size_t)rm(n0 + jn) * K + k0) = o; }
}
template <class RowMap>
__device__ __forceinline__ void transpose_item_f8(const float* __restrict__ W, int ldw, int K, unsigned char* __restrict__ WT, LAS float*, int kb, int nb, int lane, RowMap rm, float scale) {
    const int n4 = lane & 7, kg = lane >> 3, k0 = 64 * kb + 8 * kg, n0 = 32 * nb + 4 * n4;
    f32x4 v[8];
#pragma unroll
    for (int i = 0; i < 8; ++i) v[i] = *(const f32x4*)(W + (size_t)(k0 + i) * ldw + n0) * scale;
#pragma unroll
    for (int jn = 0; jn < 4; ++jn) { u32x2 o; o.x = cvt4_fp8(v[0][jn], v[1][jn], v[2][jn], v[3][jn]); o.y = cvt4_fp8(v[4][jn], v[5][jn], v[6][jn], v[7][jn]);
        *(u32x2*)(WT + (size_t)rm(n0 + jn) * K + k0) = o; }
}
template <class RowMap>
__device__ __forceinline__ void transpose_item_f8w(const float* __restrict__ W, int ldw, int K, unsigned char* __restrict__ WT, int kb, int nb, int lane, RowMap rm, float scale) {
    const int n4 = lane & 15, kg = lane >> 4, k0 = 64 * kb + 16 * kg, n0 = 64 * nb + 4 * n4;
    f32x4 v[16];
#pragma unroll
    for (int i = 0; i < 16; ++i) v[i] = *(const f32x4*)(W + (size_t)(k0 + i) * ldw + n0) * scale;
#pragma unroll
    for (int jn = 0; jn < 4; ++jn) { u32x4 o; o.x = cvt4_fp8(v[0][jn], v[1][jn], v[2][jn], v[3][jn]); o.y = cvt4_fp8(v[4][jn], v[5][jn], v[6][jn], v[7][jn]);
        o.z = cvt4_fp8(v[8][jn], v[9][jn], v[10][jn], v[11][jn]); o.w = cvt4_fp8(v[12][jn], v[13][jn], v[14][jn], v[15][jn]);
        *(u32x4*)(WT + (size_t)rm(n0 + jn) * K + k0) = o; }
}
struct RmId { __device__ __forceinline__ int operator()(int n) const { return n; } };
struct RmQb { __device__ __forceinline__ int operator()(int n) const { const int hh = n / AQD, r = n - hh * AQD; if (r < ANOPE) return n; const int i = r - ANOPE; return hh * AQD + ANOPE + ((i < 32) ? 2 * i : 2 * (i - 32) + 1); } };
struct RmKv { __device__ __forceinline__ int operator()(int n) const { const int hh = n >> 8, r = n & 255; return (r < 128) ? hh * 128 + r : 1024 + hh * 128 + (r - 128); } };
struct RmGu { __device__ __forceinline__ int operator()(int n) const { const int j = n >> 1, l = n & 1; return (j >> 7) * 256 + l * 128 + (j & 127); } };

__device__ __forceinline__ void p0_prologue(const Frame& F) {
    LAS float* scr = (LAS float*)(F.lds + F.wave * 8704);
    const int gw = F.vcu * NWAVES + F.wave, NGW = F.G * NWAVES, lane = F.lane;
    unsigned char* ws = F.ws();
    constexpr int I_MWIN = 16 * 96, I_SQ = 16 * 32, I_AWIN = 16 * 22, I_QB = 6 * 48, I_KV = 4 * 64, I_GU = MOE_FP8 ? 16 * 32 : 16 * 64, I_D = MOE_FP8 ? 16 * 16 : 16 * 32;
    constexpr int N_SMALL = 2 * (I_MWIN + I_SQ + I_AWIN + I_QB + I_KV + I_SQ);
    constexpr int P0_LAYERS = (CV_IN_ATTN && MOE_FP8 && ATT_FP8) ? 1 : 4;
    constexpr int NITEMS = N_SMALL + P0_LAYERS * 32 * (I_GU + I_D);
    constexpr int N_LAYER = 32 * (I_GU + I_D);
    for (int it = gw; it < NITEMS; it += NGW) {
        int r = it;
        if (r < P0_LAYERS * N_LAYER) {
            const int l = (P0_LAYERS - 1) - r / N_LAYER; r -= (P0_LAYERS - 1 - l) * N_LAYER;
            if (r < 32 * I_GU) { const int mtx = l * 32 + r / I_GU, q = r % I_GU;
                if (MOE_FP8) transpose_item_f8w((const float*)F.ptr(IN_WGU) + (size_t)mtx * 1024 * 2048, 2048, 1024, (unsigned char*)(ws + WS_WGU) + (size_t)mtx * 2048 * 1024, q >> 5, q & 31, lane, RmGu(), F8_SWG);
                else transpose_item((const float*)F.ptr(IN_WGU) + (size_t)mtx * 1024 * 2048, 2048, 1024, (bf16_t*)(ws + WS_WGU) + (size_t)mtx * 2048 * 1024, scr, q >> 6, q & 63, lane, RmGu()); }
            else { r -= 32 * I_GU; const int mtx = l * 32 + r / I_D, q = r % I_D;
                if (MOE_FP8) transpose_item_f8w((const float*)F.ptr(IN_WD) + (size_t)mtx * 1024 * 1024, 1024, 1024, (unsigned char*)(ws + WS_WD) + (size_t)mtx * 1024 * 1024, q >> 4, q & 15, lane, RmId(), F8_SWD);
                else transpose_item((const float*)F.ptr(IN_WD) + (size_t)mtx * 1024 * 1024, 1024, 1024, (bf16_t*)(ws + WS_WD) + (size_t)mtx * 1024 * 1024, scr, q >> 5, q & 31, lane, RmId()); }
            continue;
        }
        r -= P0_LAYERS * N_LAYER;
        const int j = (r >= N_SMALL / 2) ? 1 : 0; r -= j * (N_SMALL / 2);
        if (r < I_MWIN) { if (DF8_MV && (r % 96) >= 32) transpose_item_f8((const float*)F.ptr(IN_MWIN) + (size_t)j * 1024 * MIN_, MIN_, 1024, (unsigned char*)(ws + WS_WINM8) + (size_t)j * 2048 * 1024 - (size_t)1024 * 1024, scr, r / 96, r % 96, lane, RmId(), F8_SWI);
            else if (DF8_M1) transpose_item_f8((const float*)F.ptr(IN_MWIN) + (size_t)j * 1024 * MIN_, MIN_, 1024, (unsigned char*)(ws + WS_WINM) + (size_t)j * 3072 * 1024, scr, r / 96, r % 96, lane, RmId(), F8_SWI);
            else transpose_item((const float*)F.ptr(IN_MWIN) + (size_t)j * 1024 * MIN_, MIN_, 1024, (bf16_t*)(ws + WS_WINM) + (size_t)j * 3072 * 1024, scr, r / 96, r % 96, lane, RmId()); continue; } r -= I_MWIN;
        if (r < I_SQ) { if (DF8_O5) transpose_item_f8((const float*)F.ptr(IN_MWOUT) + (size_t)j * 1024 * 1024, 1024, 1024, (unsigned char*)(ws + WS_WOUTM) + (size_t)j * 1024 * 1024, scr, r >> 5, r & 31, lane, RmId(), F8_SWO);
            else transpose_item((const float*)F.ptr(IN_MWOUT) + (size_t)j * 1024 * 1024, 1024, 1024, (bf16_t*)(ws + WS_WOUTM) + (size_t)j * 1024 * 1024, scr, r >> 5, r & 31, lane, RmId()); continue; } r -= I_SQ;
        if (r < I_AWIN) { if (DF8_A1) transpose_item_f8((const float*)F.ptr(IN_AWIN) + (size_t)j * 1024 * AIN, AIN, 1024, (unsigned char*)(ws + WS_WINA) + (size_t)j * AINP * 1024, scr, r / 22, r % 22, lane, RmId(), F8_SWI);
            else transpose_item((const float*)F.ptr(IN_AWIN) + (size_t)j * 1024 * AIN, AIN, 1024, (bf16_t*)(ws + WS_WINA) + (size_t)j * AINP * 1024, scr, r / 22, r % 22, lane, RmId()); continue; } r -= I_AWIN;
        if (r < I_QB) { transpose_item((const float*)F.ptr(IN_AWQB) + (size_t)j * AQL * 1536, 1536, AQL, (bf16_t*)(ws + WS_WQB) + (size_t)j * 1536 * AQL, scr, r / 48, r % 48, lane, RmQb()); continue; } r -= I_QB;
        if (r < I_KV) { transpose_item((const float*)F.ptr(IN_AWKVB) + (size_t)j * AKL * 2048, 2048, AKL, (bf16_t*)(ws + WS_WKV) + (size_t)j * 2048 * AKL, scr, r >> 6, r & 63, lane, RmKv()); continue; } r -= I_KV;
        if (DF8_O5) transpose_item_f8((const float*)F.ptr(IN_AWOUT) + (size_t)j * 1024 * 1024, 1024, 1024, (unsigned char*)(ws + WS_WOUTA) + (size_t)j * 1024 * 1024, scr, r >> 5, r & 31, lane, RmId(), F8_SWO);
        else transpose_item((const float*)F.ptr(IN_AWOUT) + (size_t)j * 1024 * 1024, 1024, 1024, (bf16_t*)(ws + WS_WOUTA) + (size_t)j * 1024 * 1024, scr, r >> 5, r & 31, lane, RmId());
    }
    { const int gt = F.vcu * NTHR + F.tid, NGT = F.G * NTHR;
      for (int i = gt; i < 2 * 64 * 1024 / 8; i += NGT) { const int j = i / (64 * 1024 / 8), q = i - j * (64 * 1024 / 8);
          if (DF8_A1) { if (q < 64 * 1024 / 16) *(u32x4*)((unsigned char*)(ws + WS_WINA) + (size_t)j * AINP * 1024 + (size_t)AIN * 1024 + (size_t)q * 16) = (u32x4){0u, 0u, 0u, 0u}; }
          else *(u32x4*)((bf16_t*)(ws + WS_WINA) + (size_t)j * AINP * 1024 + (size_t)AIN * 1024 + (size_t)q * 8) = (u32x4){0u, 0u, 0u, 0u}; }
      const float* x = (const float*)F.ptr(IN_X); bf16_t* xb = (bf16_t*)(ws + WS_XB);
      for (size_t i = gt; i < (size_t)T * D / 8; i += NGT) { const f32x4 v0 = *(const f32x4*)(x + i * 8), v1 = *(const f32x4*)(x + i * 8 + 4);
          u32x4 w; w.x = cvt_pk_bf16(v0[0], v0[1]); w.y = cvt_pk_bf16(v0[2], v0[3]); w.z = cvt_pk_bf16(v1[0], v1[1]); w.w = cvt_pk_bf16(v1[2], v1[3]); *(u32x4*)(xb + i * 8) = w;
          if (DF8_M1 || DF8_MV) { u32x2 w8; w8.x = cvt4_fp8(v0[0] * F8_SX, v0[1] * F8_SX, v0[2] * F8_SX, v0[3] * F8_SX); w8.y = cvt4_fp8(v1[0] * F8_SX, v1[1] * F8_SX, v1[2] * F8_SX, v1[3] * F8_SX); *(u32x2*)((unsigned char*)(ws + WS_XB8) + i * 8) = w8; } }
      { float* gimg = (float*)(ws + WS_GIMG); const float* Wi = (const float*)F.ptr(IN_MWIN);
        for (int i = gt; i < 2 * D * 16; i += NGT) { const int j = i >> 14, r = i & 16383, k = r >> 4, e = r & 15; gimg[(size_t)j * (D * 16) + ((k >> 2) * 16 + e) * 4 + (k & 3)] = Wi[(size_t)j * D * MIN_ + (size_t)k * MIN_ + 3072 + e]; } }
      { float* rimg = (float*)(ws + WS_RIMG); const float* Wr = (const float*)F.ptr(IN_RW); const float* lg = (const float*)F.ptr(IN_LNG);
        for (int i = gt; i < DEPTH * D * NE; i += NGT) { const int l = i >> 15, r = i & 32767, k = r >> 5, e = r & 31; const float wv = Wr[i] * lg[(size_t)(l * 2) * D + k];
            if (RT_BF16) ((bf16_t*)rimg)[(size_t)l * (D * NE) + ((((k >> 5) * 2 + (e >> 4)) * 64 + (((k >> 3) & 3) * 16 + (e & 15))) * 8 + (k & 7))] = (bf16_t)(cvt_pk_bf16(wv, 0.f) & 0xffffu);
            else rimg[(size_t)l * (D * NE) + ((k >> 2) * 32 + e) * 4 + (k & 3)] = wv; }
        const int gwv = F.vcu * NWAVES + F.wave;
        if (gwv < DEPTH * NE) { const int l = gwv >> 5, e = gwv & 31; const float* lb = (const float*)F.ptr(IN_LNB) + (size_t)(l * 2) * D; float c = 0.f;
            float cs = 0.f;
            for (int k = lane; k < D; k += 64) { const float wr = Wr[(size_t)l * D * NE + (size_t)k * NE + e]; c += wr * lb[k]; cs += bf_lo(cvt_pk_bf16(wr * lg[(size_t)(l * 2) * D + k], 0.f)); }
            c = wave_sum(c); cs = wave_sum(cs); if (lane == 0) { ((float*)(ws + WS_RCV))[gwv] = c + ((const float*)F.ptr(IN_RB))[gwv]; ((float*)(ws + WS_RCV))[DEPTH * NE + gwv] = cs; } } }
      const int* pos = (const int*)F.ptr(IN_POS); float* ct = (float*)(ws + WS_COS); float* st = (float*)(ws + WS_SIN);
      for (int i = gt; i < T * 32; i += NGT) { const int m = i >> 5, k = i & 31;
          const float inv = exp2f(-(float)(2 * k) * (13.287712379549449f / 64.0f));
          const float ang = (float)pos[m] * inv;
          const double rev = (double)ang * 0.15915494309189535; const float fr = (float)(rev - floor(rev));
          ct[i] = __builtin_amdgcn_cosf(fr); st[i] = __builtin_amdgcn_sinf(fr); }
    }
}

constexpr int CV_PER_LAYER = 32 * (16 * 64 + 16 * 32);
struct CvItem { const float* src; unsigned char* dst; int ldw, gu; };
__device__ __forceinline__ CvItem cv_decode(const Frame& F, int l, int r, int lane) {
    int q = r; CvItem c;
    const int n4 = lane & 7, kg = lane >> 3;
    if (q < 32 * 1024) { const int mtx = l * 32 + (q >> 10), kb = (q >> 6) & 15, nb = q & 63; c.gu = 1; c.ldw = 2048;
        c.src = (const float*)F.ptr(IN_WGU) + (size_t)mtx * 1024 * 2048 + (size_t)(64 * kb + 8 * kg) * 2048 + 32 * nb + 4 * n4;
        c.dst = (unsigned char*)(F.ws() + WS_WGU) + (size_t)mtx * 2048 * 1024 + 64 * kb + 8 * kg; }
    else { q -= 32 * 1024; const int mtx = l * 32 + (q >> 9), kb = (q >> 5) & 15, nb = q & 31; c.gu = 0; c.ldw = 1024;
        c.src = (const float*)F.ptr(IN_WD) + (size_t)mtx * 1024 * 1024 + (size_t)(64 * kb + 8 * kg) * 1024 + 32 * nb + 4 * n4;
        c.dst = (unsigned char*)(F.ws() + WS_WD) + (size_t)mtx * 1024 * 1024 + 64 * kb + 8 * kg; }
    return c;
}
__device__ __forceinline__ void cv_issue(const CvItem& c, LAS unsigned char* buf) {
#pragma unroll
    for (int i = 0; i < 8; ++i) __builtin_amdgcn_global_load_lds((const unsigned*)(c.src + (size_t)i * c.ldw), (LAS unsigned*)(buf + i * 1024), 16, 0, 2);
}
__device__ __forceinline__ void cv_finish(const CvItem& c, const LAS unsigned char* buf, int r, int lane) {
    f32x4 v[8];
#pragma unroll
    for (int i = 0; i < 8; ++i) v[i] = *(const LAS f32x4*)(buf + i * 1024 + lane * 16);
    int q = r; const int n4 = lane & 7; const int nb = c.gu ? (q & 63) : ((q - 32 * 1024) & 31); const int n0 = 32 * nb + 4 * n4; const float sc = c.gu ? F8_SWG : F8_SWD;
#pragma unroll
    for (int jn = 0; jn < 4; ++jn) { u32x2 o; o.x = cvt4_fp8(v[0][jn] * sc, v[1][jn] * sc, v[2][jn] * sc, v[3][jn] * sc); o.y = cvt4_fp8(v[4][jn] * sc, v[5][jn] * sc, v[6][jn] * sc, v[7][jn] * sc);
        const int n = n0 + jn, row = c.gu ? RmGu()(n) : n;
        __builtin_nontemporal_store(o, (u32x2*)(c.dst + (size_t)row * 1024)); }
}

template <int NEX>
__device__ __forceinline__ void skinny_fill(const Frame& F, const float* __restrict__ W, int ldw) {
    LAS float* wl = (LAS float*)F.lds;
    for (int idx = F.tid; idx < 1024 * NEX; idx += NTHR) { const int k = idx / NEX, e = idx % NEX; wl[((k >> 2) * NEX + e) * 4 + (k & 3)] = W[(size_t)k * ldw + e]; }
    __syncthreads();
}
__device__ __forceinline__ void gates_phase(const Frame& F, const bf16_t* __restrict__ X, const float* __restrict__ bg, float* __restrict__ Gt) {
    const LAS f32x4* wl = (const LAS f32x4*)F.lds;
    const int tok = F.lane & 15, kq = F.lane >> 4;
    const f32x4 bias = *(const f32x4*)(bg + 4 * kq);
    for (int grp = F.vcu * NWAVES + F.wave; grp < T / 16; grp += F.G * NWAVES) {
        const int m0 = grp * 16; const bf16_t* xr = X + (size_t)(m0 + tok) * D + 4 * kq;
        f32x4 acc0 = {0.f, 0.f, 0.f, 0.f}, acc1 = {0.f, 0.f, 0.f, 0.f};
        u32x2 xa[16], xb[16];
#define GP_LOAD(dst, q) do { _Pragma("unroll") for (int t = 0; t < 16; ++t) dst[t] = *(const u32x2*)(xr + 16 * (16 * (q) + t)); } while (0)
#define GP_MMA(src, q) do { _Pragma("unroll") for (int t = 0; t < 16; t += 2) { const int i = 16 * (q) + t; const u32x2 r0 = src[t], r1 = src[t + 1]; \
            const f32x4 x0 = {bf_lo(r0.x), bf_hi(r0.x), bf_lo(r0.y), bf_hi(r0.y)}, x1 = {bf_lo(r1.x), bf_hi(r1.x), bf_lo(r1.y), bf_hi(r1.y)}; \
            const f32x4 w0 = wl[(i * 4 + kq) * 16 + tok], w1 = wl[((i + 1) * 4 + kq) * 16 + tok]; \
            _Pragma("unroll") for (int j = 0; j < 4; ++j) { acc0 = __builtin_amdgcn_mfma_f32_16x16x4f32(w0[j], x0[j], acc0, 0, 0, 0); acc1 = __builtin_amdgcn_mfma_f32_16x16x4f32(w1[j], x1[j], acc1, 0, 0, 0); } } } while (0)
        GP_LOAD(xa, 0);
#pragma unroll 1
        for (int p = 0; p < 2; ++p) {
            GP_LOAD(xb, 2 * p + 1); __builtin_amdgcn_sched_barrier(0);
            GP_MMA(xa, 2 * p); __builtin_amdgcn_sched_barrier(0);
            if (p == 0) GP_LOAD(xa, 2);
            __builtin_amdgcn_sched_barrier(0);
            GP_MMA(xb, 2 * p + 1); __builtin_amdgcn_sched_barrier(0);
        }
#undef GP_LOAD
#undef GP_MMA
        *(f32x4*)(Gt + (size_t)(m0 + tok) * 16 + 4 * kq) = acc0 + acc1 + bias;
    }
}

__device__ __forceinline__ void ln_router_phase(const Frame& F, int layer, int cnt_layer) {
    unsigned char* ws = F.ws();
    const float* __restrict__ ZF = (const float*)(ws + WS_ZF); bf16_t* __restrict__ XM = (bf16_t*)(ws + WS_XM); unsigned char* __restrict__ XB8 = (unsigned char*)(ws + WS_XB8);
    const float* lng = (const float*)F.ptr(IN_LNG) + (size_t)(layer * 2) * D; const float* lnb = (const float*)F.ptr(IN_LNB) + (size_t)(layer * 2) * D;
    const int lane = F.lane, tok = lane & 15, kq = lane >> 4;
    unsigned* cnt = F.ctl() + CW_CNT + cnt_layer * 32 * 64;
    volatile LAS unsigned* hist = F.MISC + 64; volatile LAS unsigned* hbase = F.MISC + 96; volatile LAS float* cvec = (volatile LAS float*)(F.MISC + 192); volatile LAS float* scol = (volatile LAS float*)(F.MISC + 224);
    LAS float* wl = (LAS float*)F.lds; LAS float* part = (LAS float*)(F.lds + 131072);
    {
        const f32x4* src = (const f32x4*)((const char*)(ws + WS_RIMG) + (size_t)layer * (D * NE) * (RT_BF16 ? 2 : 4));
#pragma unroll 4
        for (int it = 0; it < (RT_BF16 ? 8 : 16); ++it) ((LAS f32x4*)wl)[F.tid + NTHR * it] = src[F.tid + NTHR * it];
        if (F.tid < 32) { hist[F.tid] = 0u; cvec[F.tid] = ((const float*)(ws + WS_RCV))[layer * NE + F.tid]; scol[F.tid] = ((const float*)(ws + WS_RCV))[DEPTH * NE + layer * NE + F.tid]; }
        __syncthreads();
    }
    f32x4 gv[4], bv[4];
#pragma unroll
    for (int j = 0; j < 4; ++j) { gv[j] = *(const f32x4*)(lng + 4 * lane + 256 * j); bv[j] = *(const f32x4*)(lnb + 4 * lane + 256 * j); }
#define LZ4(idx) (ZF_BF16 ? ({ const u32x2 w_ = *(const u32x2*)((const bf16_t*)ZF + (idx)); (f32x4){bf_lo(w_.x), bf_hi(w_.x), bf_lo(w_.y), bf_hi(w_.y)}; }) : *(const f32x4*)(ZF + (idx)))
    for (int grp = F.vcu; grp < T / 128; grp += F.G) {
        const int m0 = grp * 128 + F.wave * 16;
        float mu_l = 0.f, rs_l = 0.f;
        f32x4 nx[4];
#pragma unroll
        for (int j = 0; j < 4; ++j) nx[j] = LZ4((size_t)m0 * D + 4 * lane + 256 * j);
#pragma unroll 2
        for (int r = 0; r < 16; ++r) {
            const int m = m0 + r; f32x4 v[4];
#pragma unroll
            for (int j = 0; j < 4; ++j) v[j] = nx[j];
            if (r < 15) {
#pragma unroll
                for (int j = 0; j < 4; ++j) nx[j] = LZ4((size_t)(m + 1) * D + 4 * lane + 256 * j); }
            float s = 0.f;
#pragma unroll
            for (int j = 0; j < 4; ++j) s += (v[j][0] + v[j][1]) + (v[j][2] + v[j][3]);
            const float mean = wave_sum(s) * (1.f / D); float s2 = 0.f;
#pragma unroll
            for (int j = 0; j < 4; ++j) { v[j] = v[j] - mean; s2 += (v[j][0] * v[j][0] + v[j][1] * v[j][1]) + (v[j][2] * v[j][2] + v[j][3] * v[j][3]); }
            const float rstd = 1.f / sqrtf(wave_sum(s2) * (1.f / D) + LN_EPS);
            if (tok == r) { mu_l = mean; rs_l = rstd; }
#pragma unroll
            for (int j = 0; j < 4; ++j) { const f32x4 y = v[j] * rstd * gv[j] + bv[j];
                { u32x2 w; w.x = cvt_pk_bf16(y[0], y[1]); w.y = cvt_pk_bf16(y[2], y[3]); *(u32x2*)(XM + (size_t)m * D + 4 * lane + 256 * j) = w; }
                if (MOE_FP8) *(unsigned*)(XB8 + (size_t)m * D + 4 * lane + 256 * j) = cvt4_fp8(y[0] * F8_SX, y[1] * F8_SX, y[2] * F8_SX, y[3] * F8_SX);
                else { u32x2 w; w.x = cvt_pk_bf16(y[0], y[1]); w.y = cvt_pk_bf16(y[2], y[3]); *(u32x2*)((bf16_t*)(ws + WS_XB) + (size_t)m * D + 4 * lane + 256 * j) = w; } }
        }
        f32x4 acc0 = {0.f, 0.f, 0.f, 0.f}, acc1 = {0.f, 0.f, 0.f, 0.f};
        float lv[8]; int used = 0;
        if constexpr (RT_BF16 != 0) {
            const LAS bf16x8* wl8 = (const LAS bf16x8*)F.lds;
            const bf16_t* zq = (const bf16_t*)ZF + (size_t)(m0 + tok) * D + 8 * kq;
            bf16x8 za[16], zc[16];
#pragma unroll
            for (int i = 0; i < 16; ++i) za[i] = *(const bf16x8*)(zq + 32 * i);
#pragma unroll
            for (int i = 0; i < 16; ++i) zc[i] = *(const bf16x8*)(zq + 32 * (16 + i));
            __builtin_amdgcn_sched_barrier(0);
#pragma unroll
            for (int i = 0; i < 16; ++i) { acc0 = __builtin_amdgcn_mfma_f32_16x16x32_bf16(wl8[(i * 2) * 64 + lane], za[i], acc0, 0, 0, 0); acc1 = __builtin_amdgcn_mfma_f32_16x16x32_bf16(wl8[(i * 2 + 1) * 64 + lane], za[i], acc1, 0, 0, 0); }
#pragma unroll
            for (int i = 0; i < 16; ++i) { acc0 = __builtin_amdgcn_mfma_f32_16x16x32_bf16(wl8[((16 + i) * 2) * 64 + lane], zc[i], acc0, 0, 0, 0); acc1 = __builtin_amdgcn_mfma_f32_16x16x32_bf16(wl8[((16 + i) * 2 + 1) * 64 + lane], zc[i], acc1, 0, 0, 0); }
#pragma unroll
            for (int r = 0; r < 4; ++r) { lv[r] = (acc0[r] - mu_l * scol[4 * kq + r]) * rs_l + cvec[4 * kq + r]; lv[4 + r] = (acc1[r] - mu_l * scol[16 + 4 * kq + r]) * rs_l + cvec[16 + 4 * kq + r]; }
        } else {
        const LAS f32x4* wl4 = (const LAS f32x4*)F.lds;
        const size_t zr = (size_t)(m0 + tok) * D + 4 * kq;
        f32x4 za[16], zc[16];
#define LR_LOAD(dst, c) do { _Pragma("unroll") for (int i = 0; i < 16; ++i) dst[i] = LZ4(zr + 16 * (16 * (c) + i)); } while (0)
#define LR_MMA(src, c) do { _Pragma("unroll") for (int i = 0; i < 16; ++i) { const f32x4 xn = src[i] - mu_l; const int ii = 16 * (c) + i; \
                const f32x4 w0 = wl4[(ii * 4 + kq) * 32 + tok], w1 = wl4[(ii * 4 + kq) * 32 + 16 + tok]; \
                _Pragma("unroll") for (int j = 0; j < 4; ++j) { acc0 = __builtin_amdgcn_mfma_f32_16x16x4f32(w0[j], xn[j], acc0, 0, 0, 0); acc1 = __builtin_amdgcn_mfma_f32_16x16x4f32(w1[j], xn[j], acc1, 0, 0, 0); } } } while (0)
        LR_LOAD(za, 0);
#pragma unroll 1
        for (int p = 0; p < 2; ++p) {
            LR_LOAD(zc, 2 * p + 1); __builtin_amdgcn_sched_barrier(0);
            LR_MMA(za, 2 * p); __builtin_amdgcn_sched_barrier(0);
            if (p == 0) LR_LOAD(za, 2);
            __builtin_amdgcn_sched_barrier(0);
            LR_MMA(zc, 2 * p + 1); __builtin_amdgcn_sched_barrier(0);
        }
#undef LR_LOAD
#undef LR_MMA
#pragma unroll
        for (int r = 0; r < 4; ++r) { lv[r] = acc0[r] * rs_l + cvec[4 * kq + r]; lv[4 + r] = acc1[r] * rs_l + cvec[16 + 4 * kq + r]; }
        }
        float tv[4]; int ti[4];
#pragma unroll
        for (int k = 0; k < 4; ++k) {
            float bvv = -3.0e38f; int bi = 64, bslot = -1;
#pragma unroll
            for (int q = 0; q < 8; ++q) { const int idx = (q < 4) ? 4 * kq + q : 16 + 4 * kq + (q - 4); const bool ok = !((used >> q) & 1) && (lv[q] > bvv || (lv[q] == bvv && idx < bi)); if (ok) { bvv = lv[q]; bi = idx; bslot = q; } }
            float gvv = bvv; int gi = bi;
#pragma unroll
            for (int o = 16; o <= 32; o <<= 1) { const float ov = __shfl_xor(gvv, o); const int oi = __shfl_xor(gi, o); if (ov > gvv || (ov == gvv && oi < gi)) { gvv = ov; gi = oi; } }
            if (gi == bi && bslot >= 0) used |= (1 << bslot);
            tv[k] = gvv; ti[k] = gi;
        }
        const float e1 = __expf(tv[1] - tv[0]), e2 = __expf(tv[2] - tv[0]), e3 = __expf(tv[3] - tv[0]); const float inv = 1.f / (1.f + e1 + e2 + e3);
        const float myg = (kq == 0 ? 1.f : kq == 1 ? e1 : kq == 2 ? e2 : e3) * inv; const int mye = (kq == 0 ? ti[0] : kq == 1 ? ti[1] : kq == 2 ? ti[2] : ti[3]);
        const unsigned rank = __hip_atomic_fetch_add((LAS unsigned*)(hist + mye), 1u, __ATOMIC_RELAXED, __HIP_MEMORY_SCOPE_WORKGROUP);
        __syncthreads();
        if (F.tid < 32) { const unsigned c = hist[F.tid]; hbase[F.tid] = __hip_atomic_fetch_add(cnt + F.tid * 64, c, __ATOMIC_RELAXED, __HIP_MEMORY_SCOPE_AGENT); hist[F.tid] = 0u; }
        __syncthreads();
        const unsigned pos = hbase[mye] + rank; const int m = m0 + tok;
        ((int*)(ws + WS_TOKINFO))[m * 4 + kq] = (mye << 20) | (int)pos; ((float*)(ws + WS_TOKGATE))[m * 4 + kq] = myg;
        ((int*)(ws + WS_LIST))[(size_t)mye * T + pos] = m;
    }
}

__device__ __forceinline__ void ln_combine_phase(const Frame& F, int layer, bool is_last, bool dummy) {
    unsigned char* ws = F.ws();
    const bf16_t* __restrict__ XM = (const bf16_t*)(ws + WS_XM); bf16_t* __restrict__ XB = (bf16_t*)(ws + WS_XB); const bf16_t* __restrict__ YM = (const bf16_t*)(ws + WS_YMOE);
    const float* lng = (const float*)F.ptr(IN_LNG) + (size_t)(layer * 2 + 1) * D; const float* lnb = (const float*)F.ptr(IN_LNB) + (size_t)(layer * 2 + 1) * D;
    const int lane = F.lane;
    const int* tokinfo = (const int*)(ws + WS_TOKINFO); const float* tokgate = (const float*)(ws + WS_TOKGATE);
    volatile LAS int* ntp = (volatile LAS int*)(F.MISC + 16);
    f32x4 gv[4], bv[4];
#pragma unroll
    for (int j = 0; j < 4; ++j) { gv[j] = *(const f32x4*)(lng + 4 * lane + 256 * j); bv[j] = *(const f32x4*)(lnb + 4 * lane + 256 * j); }
    float* OUT = F.out();
    bf16_t* XBo = XB; if (dummy) { OUT = (float*)(ws + WS_ZF); XBo = (bf16_t*)(ws + WS_HB); }
    for (int grp = F.vcu * NWAVES + F.wave; grp < T / 16; grp += F.G * NWAVES) {
        const int m0 = grp * 16;
        const int inf = tokinfo[m0 * 4 + lane]; const float gl = tokgate[m0 * 4 + lane];
        const unsigned prl = (unsigned)(ntp[inf >> 20] * 256 + (inf & 0xfffff));
        u32x2 nx[4]; u32x2 ny[4][4]; float ng[4];
#define LNC_LOAD(r) do { _Pragma("unroll") for (int j = 0; j < 4; ++j) nx[j] = *(const u32x2*)(XM + (size_t)(m0 + (r)) * D + 4 * lane + 256 * j); \
            _Pragma("unroll") for (int k = 0; k < 4; ++k) { const unsigned pr = (unsigned)__builtin_amdgcn_readlane((int)prl, 4 * (r) + k); ng[k] = __uint_as_float((unsigned)__builtin_amdgcn_readlane((int)__float_as_uint(gl), 4 * (r) + k)); \
                if (Y_FP8) { const unsigned char* yr = (const unsigned char*)YM + (size_t)pr * D + 4 * lane; _Pragma("unroll") for (int j = 0; j < 4; ++j) { ny[k][j].x = *(const unsigned*)(yr + 256 * j); ny[k][j].y = 0u; } } \
                else { const bf16_t* yr = YM + (size_t)pr * D + 4 * lane; _Pragma("unroll") for (int j = 0; j < 4; ++j) ny[k][j] = *(const u32x2*)(yr + 256 * j); } } } while (0)
        LNC_LOAD(0);
#pragma unroll 1
        for (int r = 0; r < 16; ++r) {
            const int m = m0 + r; f32x4 v[4];
#pragma unroll
            for (int j = 0; j < 4; ++j) v[j] = (f32x4){bf_lo(nx[j].x), bf_hi(nx[j].x), bf_lo(nx[j].y), bf_hi(nx[j].y)} * DN_ALPHA;
#pragma unroll
            for (int k = 0; k < 4; ++k) { const float g = Y_FP8 ? ng[k] * (1.0f / F8_SY) : ng[k];
#pragma unroll
                for (int j = 0; j < 4; ++j) { const u32x2 w = ny[k][j];
                    if (Y_FP8) { const f32x2 lo2 = __builtin_amdgcn_cvt_pk_f32_fp8((int)w.x, false), hi2 = __builtin_amdgcn_cvt_pk_f32_fp8((int)w.x, true); v[j][0] += g * lo2[0]; v[j][1] += g * lo2[1]; v[j][2] += g * hi2[0]; v[j][3] += g * hi2[1]; }
                    else { v[j][0] += g * bf_lo(w.x); v[j][1] += g * bf_hi(w.x); v[j][2] += g * bf_lo(w.y); v[j][3] += g * bf_hi(w.y); } } }
            if (r < 15) LNC_LOAD(r + 1);
            float s = 0.f;
#pragma unroll
            for (int j = 0; j < 4; ++j) s += (v[j][0] + v[j][1]) + (v[j][2] + v[j][3]);
            const float mean = wave_sum(s) * (1.f / D); float s2 = 0.f;
#pragma unroll
            for (int j = 0; j < 4; ++j) { v[j] = v[j] - mean; s2 += (v[j][0] * v[j][0] + v[j][1] * v[j][1]) + (v[j][2] * v[j][2] + v[j][3] * v[j][3]); }
            const float rstd = 1.f / sqrtf(wave_sum(s2) * (1.f / D) + LN_EPS);
#pragma unroll
            for (int j = 0; j < 4; ++j) { const f32x4 y = v[j] * rstd * gv[j] + bv[j];
                if (is_last || dummy) *(f32x4*)(OUT + (size_t)m * D + 4 * lane + 256 * j) = y;
                if (!is_last) { u32x2 w; w.x = cvt_pk_bf16(y[0], y[1]); w.y = cvt_pk_bf16(y[2], y[3]); *(u32x2*)(XBo + (size_t)m * D + 4 * lane + 256 * j) = w;
                    if (DF8_M1 || DF8_MV || (DF8_A1 && (layer & 1) == 0)) *(unsigned*)((unsigned char*)(ws + WS_XB8) + (size_t)m * D + 4 * lane + 256 * j) = cvt4_fp8(y[0] * F8_SX, y[1] * F8_SX, y[2] * F8_SX, y[3] * F8_SX); } }
        }
#undef LNC_LOAD
    }
}

__device__ __forceinline__ void moe_prefix(const Frame& F, int layer) {
    volatile LAS int* ntp = (volatile LAS int*)(F.MISC + 16); volatile LAS int* cnte = (volatile LAS int*)(F.MISC + 224);
    __syncthreads();
    if (F.tid < 64) { const int ln = F.tid; unsigned* cnt = F.ctl() + CW_CNT + layer * 32 * 64;
        const int c = ln < 32 ? (int)__hip_atomic_load(cnt + ln * 64, __ATOMIC_RELAXED, __HIP_MEMORY_SCOPE_AGENT) : 0; const int tiles = (c + 255) >> 8;
        int incl = tiles;
#pragma unroll
        for (int o = 1; o < 32; o <<= 1) { const int t = __shfl_up(incl, o); if (ln >= o) incl += t; }
        if (ln < 32) { ntp[ln] = incl - tiles; cnte[ln] = c; }
        if (ln == 31) ntp[32] = incl; }
    __syncthreads();
}

__device__ __forceinline__ int moe_units(const Frame& F, int layer, int NC) {
    volatile LAS int* ntp = (volatile LAS int*)(F.MISC + 16); volatile LAS int* utab = (volatile LAS int*)(F.lds + pg8::MOE_UTAB_OFF);
    const int total = ntp[32] * NC;
    if (F.tid < 32) { const int L = F.tid * F.G + F.vcu;
        if (L < total) { const int rt = L / NC, pn = L - rt * NC; int e = 0;
            { const LAS int* ntq = (const LAS int*)(F.MISC + 16);
#pragma unroll
              for (int k = 1; k < 32; ++k) e += (rt >= ntq[k]) ? 1 : 0; }
            const int rtl = rt - ntp[e]; const int c_e = ((volatile LAS int*)(F.MISC + 224))[e];
            int nv = c_e - rtl * 256; nv = nv > 256 ? 256 : nv;
            utab[4 * F.tid] = rt; utab[4 * F.tid + 1] = pn; utab[4 * F.tid + 2] = e | (rtl << 8); utab[4 * F.tid + 3] = nv; } }
    __syncthreads();
    const int mine = (total - F.vcu + F.G - 1) / F.G;
    return total > F.vcu ? (mine > 32 ? 32 : mine) : 0;
}

__device__ __forceinline__ void mla_norm_phase(const Frame& F, int j) {
    unsigned char* ws = F.ws(); const float* A32 = (const float*)(ws + WS_A32);
    bf16_t* CQ = (bf16_t*)(ws + WS_CQ); bf16_t* CKV = (bf16_t*)(ws + WS_CKV); bf16_t* KR = (bf16_t*)(ws + WS_KR);
    const float* qn = (const float*)F.ptr(IN_AQN) + j * AQL; const float* kvn = (const float*)F.ptr(IN_AKVN) + j * AKL;
    const float* ct = (const float*)(ws + WS_COS); const float* st = (const float*)(ws + WS_SIN);
    const int lane = F.lane;
    f32x4 gq0 = {0.f, 0.f, 0.f, 0.f}, gq1 = gq0, gk0 = gq0, gk1 = gq0;
    if (lane < 48) { gq0 = *(const f32x4*)(qn + 8 * lane); gq1 = *(const f32x4*)(qn + 8 * lane + 4); }
    if (lane < 32) { gk0 = *(const f32x4*)(kvn + 8 * lane); gk1 = *(const f32x4*)(kvn + 8 * lane + 4); }
    const int mstep = F.G * NWAVES;
    f32x4 nq0 = {0.f, 0.f, 0.f, 0.f}, nq1 = nq0, nk0 = nq0, nk1 = nq0; float nx1 = 0.f, nx2 = 0.f, nc = 0.f, ns = 0.f;
#define MN_LOAD(mm) do { const float* ar_ = A32 + (size_t)(mm) * AINP; \
        if (lane < 48) { nq0 = *(const f32x4*)(ar_ + 8 * lane); nq1 = *(const f32x4*)(ar_ + 8 * lane + 4); } \
        if (lane < 32) { nk0 = *(const f32x4*)(ar_ + AQL + 8 * lane); nk1 = *(const f32x4*)(ar_ + AQL + 8 * lane + 4); nx1 = ar_[AQL + AKL + lane]; nx2 = ar_[AQL + AKL + 32 + lane]; nc = ct[(size_t)(mm) * 32 + lane]; ns = st[(size_t)(mm) * 32 + lane]; } } while (0)
    int m = F.vcu * NWAVES + F.wave;
    if (m < T) MN_LOAD(m);
    for (; m < T; m += mstep) {
        const f32x4 q0 = nq0, q1 = nq1, k0 = nk0, k1 = nk1; const float x1 = nx1, x2 = nx2, c = nc, s = ns;
        if (m + mstep < T) MN_LOAD(m + mstep);
        float sq = 0.f, sk = 0.f;
        if (lane < 48) sq = (q0[0] * q0[0] + q0[1] * q0[1]) + (q0[2] * q0[2] + q0[3] * q0[3]) + (q1[0] * q1[0] + q1[1] * q1[1]) + (q1[2] * q1[2] + q1[3] * q1[3]);
        if (lane < 32) sk = (k0[0] * k0[0] + k0[1] * k0[1]) + (k0[2] * k0[2] + k0[3] * k0[3]) + (k1[0] * k1[0] + k1[1] * k1[1]) + (k1[2] * k1[2] + k1[3] * k1[3]);
        const float rq = 1.f / sqrtf(wave_sum(sq) * (1.f / AQL) + RMS_EPS), rk = 1.f / sqrtf(wave_sum(sk) * (1.f / AKL) + RMS_EPS);
        if (lane < 48) { const f32x4 y0 = q0 * rq * gq0, y1 = q1 * rq * gq1;
            u32x4 w; w.x = cvt_pk_bf16(y0[0], y0[1]); w.y = cvt_pk_bf16(y0[2], y0[3]); w.z = cvt_pk_bf16(y1[0], y1[1]); w.w = cvt_pk_bf16(y1[2], y1[3]); *(u32x4*)(CQ + (size_t)m * AQL + 8 * lane) = w; }
        if (lane < 32) { const f32x4 y0 = k0 * rk * gk0, y1 = k1 * rk * gk1;
            u32x4 w; w.x = cvt_pk_bf16(y0[0], y0[1]); w.y = cvt_pk_bf16(y0[2], y0[3]); w.z = cvt_pk_bf16(y1[0], y1[1]); w.w = cvt_pk_bf16(y1[2], y1[3]); *(u32x4*)(CKV + (size_t)m * AKL + 8 * lane) = w;
            const float r1 = x1 * c - x2 * s, r2 = x2 * c + x1 * s;
            if (ATT_FP8) *(unsigned short*)((unsigned char*)KR + (size_t)m * AROPE + 2 * lane) = (unsigned short)(cvt4_fp8(r1 * F8_SK, r2 * F8_SK, 0.f, 0.f) & 0xffffu);
            else *(unsigned*)(KR + (size_t)m * AROPE + 2 * lane) = cvt_pk_bf16(r1, r2); }
    }
#undef MN_LOAD
}
constexpr int MT_STRIDE = 144;
__device__ __forceinline__ float log_sigmoid(float x) { return fminf(x, 0.f) - __logf(1.f + __expf(-fabsf(x))); }
__device__ __forceinline__ float wave_incl_scan_add(float v, int lane) {
#pragma unroll
    for (int o = 1; o < 64; o <<= 1) { const float t = __shfl_up(v, o); if (lane >= o) v += t; }
    return v;
}
__device__ __forceinline__ float wave_incl_scan_max(float v, int lane) {
#pragma unroll
    for (int o = 1; o < 64; o <<= 1) { const float t = __shfl_up(v, o); if (lane >= o) v = fmaxf(v, t); }
    return v;
}
template <int NCH>
__device__ __forceinline__ void stage_transposed(LAS unsigned char* tile, const bf16_t* __restrict__ src, int lane, float scale, bool do_scale) {
#pragma unroll
    for (int c = 0; c < NCH; ++c) { const u32x4 w = *(const u32x4*)(src + 8 * c); const unsigned ww[4] = {w.x, w.y, w.z, w.w};
#pragma unroll
        for (int p = 0; p < 4; ++p) { unsigned lo = ww[p] & 0xffffu, hi = ww[p] >> 16;
            if (do_scale) { const unsigned pk = cvt_pk_bf16(bf_lo(ww[p]) * scale, bf_hi(ww[p]) * scale); lo = pk & 0xffffu; hi = pk >> 16; }
            *(LAS bf16_t*)(tile + (8 * c + 2 * p) * MT_STRIDE + 2 * lane) = (bf16_t)lo; *(LAS bf16_t*)(tile + (8 * c + 2 * p + 1) * MT_STRIDE + 2 * lane) = (bf16_t)hi; } }
}

__device__ __forceinline__ void mlstm_local_phase(const Frame& F) {
    unsigned char* ws = F.ws(); const bf16_t* PROJ = (const bf16_t*)(ws + WS_PROJ); const float* Gt = (const float*)(ws + WS_GATES);
    bf16_t* CLOC = (bf16_t*)(ws + WS_CLOC); float* NLOC = (float*)(ws + WS_NLOC); float* GMAX = (float*)(ws + WS_MSC); float* BL = GMAX + MUNITS;
    const bf16_t* VTg = (const bf16_t*)(ws + WS_VT);
    const int lane = F.lane, c32 = lane & 31, hi = lane >> 5;
    const int plane = (lane & ~12) | ((lane & 4) << 1) | ((lane & 8) >> 1);
    LAS unsigned char* kt = F.lds + F.wave * (2 * 64 * MT_STRIDE); LAS unsigned char* vt = kt + 64 * MT_STRIDE;
    for (int it = F.vcu * NWAVES + F.wave; it < MUNITS * 2; it += F.G * NWAVES) {
        const int u = it >> 1, half = it & 1, c = u & (MNC - 1), bh = u >> 7, h = bh & 7, b = bh >> 3, m0 = b * SEQ + c * MCH;
        const int m = m0 + lane;
        const float ig = Gt[(size_t)m * 16 + h], lf = log_sigmoid(Gt[(size_t)m * 16 + 8 + h]);
        const float bc = wave_incl_scan_add(lf, lane), bl = __shfl(bc, 63);
        const float g = bl - bc + ig, gmax = wave_max(g), w = __expf(g - gmax);
        stage_transposed<8>(kt, PROJ + (size_t)m * 3072 + 512 + h * 64, MVT ? plane : lane, w, true);
        if (!MVT) stage_transposed<8>(vt, PROJ + (size_t)m * 3072 + 1024 + h * 128 + half * 64, lane, 1.f, false);
        const bf16_t* vg = VTg + (size_t)(h * 128 + half * 64 + c32) * T + m0 + 8 * hi;
        bf16x8 vgf[4][2];
        if (MVT) {
#pragma unroll
            for (int ks = 0; ks < 4; ++ks)
#pragma unroll
                for (int i = 0; i < 2; ++i) vgf[ks][i] = *(const bf16x8*)(vg + (size_t)(32 * i) * T + 16 * ks);
        }
        LDS_WAIT();
        f32x16 acc[2][2];
#pragma unroll
        for (int i = 0; i < 2; ++i)
#pragma unroll
            for (int j = 0; j < 2; ++j)
#pragma unroll
                for (int r = 0; r < 16; ++r) acc[i][j][r] = 0.f;
#pragma unroll
        for (int ks = 0; ks < 4; ++ks) {
            bf16x8 af[2], bfr[2];
#pragma unroll
            for (int i = 0; i < 2; ++i) { if (MVT) af[i] = vgf[ks][i]; else af[i] = *(const LAS bf16x8*)(vt + (32 * i + c32) * MT_STRIDE + (16 * ks + 8 * hi) * 2); bfr[i] = *(const LAS bf16x8*)(kt + (32 * i + c32) * MT_STRIDE + (16 * ks + 8 * hi) * 2); }
#pragma unroll
            for (int i = 0; i < 2; ++i)
#pragma unroll
                for (int j = 0; j < 2; ++j) acc[i][j] = __builtin_amdgcn_mfma_f32_32x32x16_bf16(bfr[j], af[i], acc[i][j], 0, 0, 0);
        }
        asm volatile("s_nop 15\n\ts_nop 3" : "+v"(acc[0][0]), "+v"(acc[0][1]), "+v"(acc[1][0]), "+v"(acc[1][1]));
        bf16_t* cl = CLOC + (size_t)u * (MDV * MDK) + (size_t)(half * 64 + c32) * MDK + 4 * hi;
#pragma unroll
        for (int i = 0; i < 2; ++i)
#pragma unroll
            for (int j = 0; j < 2; ++j)
#pragma unroll
                for (int g = 0; g < 4; ++g) { u32x2 w; w.x = cvt_pk_bf16(acc[i][j][4 * g], acc[i][j][4 * g + 1]); w.y = cvt_pk_bf16(acc[i][j][4 * g + 2], acc[i][j][4 * g + 3]);
                    *(u32x2*)(cl + (size_t)(32 * i) * MDK + 32 * j + 8 * g) = w; }
        if (half == 0) {
            float s = 0.f;
#pragma unroll
            for (int q = 0; q < 8; ++q) { const u32x4 w4 = *(const LAS u32x4*)(kt + lane * MT_STRIDE + 16 * q); s += (bf_lo(w4.x) + bf_hi(w4.x)) + (bf_lo(w4.y) + bf_hi(w4.y)) + (bf_lo(w4.z) + bf_hi(w4.z)) + (bf_lo(w4.w) + bf_hi(w4.w)); }
            NLOC[(size_t)u * MDK + lane] = s;
            if (lane == 0) { GMAX[u] = gmax; BL[u] = bl; }
        }
        LDS_WAIT();
    }
}

__device__ __forceinline__ void mlstm_scan_phase(const Frame& F) {
    unsigned char* ws = F.ws(); const bf16_t* __restrict__ CLOC = (const bf16_t*)(ws + WS_CLOC); const float* __restrict__ NLOC = (const float*)(ws + WS_NLOC);
    const float* __restrict__ GMAX = (const float*)(ws + WS_MSC); const float* __restrict__ BL = GMAX + MUNITS; float* __restrict__ MPREV = (float*)(ws + WS_MSC) + 2 * MUNITS;
    bf16_t* __restrict__ CPREV = (bf16_t*)(ws + WS_CPREV); float* __restrict__ NPREV = (float*)(ws + WS_NPREV);
    constexpr int PER = MDV * MDK / 2;
    for (int it = F.vcu * NTHR + F.tid; it < NB * MH * PER; it += F.G * NTHR) {
        const int bh = it / PER, e = it - bh * PER; const bool hasn = e < 32; const int eo = e * 2;
        float c0 = 0.f, c1 = 0.f, n0 = 0.f, n1 = 0.f, mm = 0.f;
        for (int cb = 0; cb < MNC; cb += 16) {
            f32x2 loc[16], nl[16]; float gm[16], bl[16];
#pragma unroll
            for (int k = 0; k < 16; ++k) { const int u = bh * MNC + cb + k; { const unsigned cw = *(const unsigned*)(CLOC + (size_t)u * (MDV * MDK) + eo); loc[k] = (f32x2){bf_lo(cw), bf_hi(cw)}; } gm[k] = GMAX[u]; bl[k] = BL[u];
                nl[k] = hasn ? *(const f32x2*)(NLOC + (size_t)u * MDK + eo) : (f32x2){0.f, 0.f}; }
#pragma unroll
            for (int k = 0; k < 16; ++k) { const int u = bh * MNC + cb + k;
                const float mnew = fmaxf(bl[k] + mm, gm[k]), dec = __expf(bl[k] + mm - mnew), sc = __expf(gm[k] - mnew);
                *(unsigned*)(CPREV + (size_t)u * (MDV * MDK) + eo) = cvt_pk_bf16(c0, c1);
                if (hasn) { *(f32x2*)(NPREV + (size_t)u * MDK + eo) = (f32x2){n0, n1}; if (e == 0) MPREV[u] = mm; }
                c0 = dec * c0 + sc * loc[k].x; c1 = dec * c1 + sc * loc[k].y; n0 = dec * n0 + sc * nl[k].x; n1 = dec * n1 + sc * nl[k].y; mm = mnew; }
        }
    }
}

static_assert(MVT, "mlstm_out_phase reads V^T from WS_VT");
#ifndef DUP_M4I
#define DUP_M4I 0
#endif
__device__ __forceinline__ void mlstm_out_phase(const Frame& F, const float* __restrict__ gain) {
    unsigned char* ws = F.ws(); const bf16_t* PROJ = (const bf16_t*)(ws + WS_PROJ); const float* Gt = (const float*)(ws + WS_GATES);
    const bf16_t* CPREV = (const bf16_t*)(ws + WS_CPREV); const float* NPREV = (const float*)(ws + WS_NPREV); const float* MPREV = (const float*)(ws + WS_MSC) + 2 * MUNITS;
    bf16_t* HB = (bf16_t*)(ws + WS_HB); const bf16_t* VTg = (const bf16_t*)(ws + WS_VT);
    const int lane = F.lane, c32 = lane & 31, hi = lane >> 5;
    LAS unsigned char* cpl = F.lds + F.wave * 18432; LAS unsigned char* stg = cpl + 16384;
    const int ckey = (c32 >> 1) & 7, row8 = lane >> 3, sl8 = lane & 7;
    const unsigned cpoff = (unsigned)(row8 * 128 + ((sl8 ^ (row8 >> 1)) * 16));
    for (int u0 = F.vcu * NWAVES + F.wave; u0 < MUNITS * (1 + DUP_M4I); u0 += F.G * NWAVES) {
        const int u = u0 & (MUNITS - 1), c = u & (MNC - 1), bh = u >> 7, h = bh & 7, b = bh >> 3, m0 = b * SEQ + c * MCH;
        { const unsigned char* cg = (const unsigned char*)(CPREV + (size_t)u * (MDV * MDK));
          asm volatile("" ::: "memory");
#pragma unroll
          for (int n = 0; n < 16; ++n) __builtin_amdgcn_global_load_lds((const unsigned*)(cg + n * 1024 + ((n & 1) ? (cpoff ^ 64u) : cpoff)), (LAS unsigned*)(cpl + n * 1024), 16, 0, 0); }
        const int mg = m0 + lane;
        const float ig = Gt[(size_t)mg * 16 + h], lf = log_sigmoid(Gt[(size_t)mg * 16 + 8 + h]);
        const bf16_t* vg = VTg + (size_t)(h * 128 + c32) * T + m0 + 8 * hi;
        const float bc = wave_incl_scan_add(lf, lane), av = ig - bc, pm = wave_incl_scan_max(av, lane);
        const float mprev = MPREV[u];
        f32x4 gn[4];
#pragma unroll
        for (int q = 0; q < 4; ++q) gn[q] = *(const f32x4*)(gain + h * 128 + 64 * (q >> 1) + 8 * sl8 + 4 * (q & 1));
        asm volatile("s_waitcnt vmcnt(0)" ::: "memory");
#pragma unroll 1
        for (int tb = 0; tb < 2; ++tb) {
        const int tl = 32 * tb + c32;
        int hi16 = 16 * hi; asm volatile("" : "+v"(hi16));
        const float Mt = fmaxf(mprev, __shfl(pm, tl)), bt = __shfl(bc, tl);
        const float winter = __expf(mprev - Mt) * 0.125f;
        bf16x8 qf[4];
        const bf16_t* qrow = PROJ + (size_t)(m0 + tl) * 3072 + h * 64 + 8 * hi;
#pragma unroll
        for (int ks = 0; ks < 4; ++ks) qf[ks] = *(const bf16x8*)(qrow + 16 * ks);
        float qn = 0.f;
        { const float* np = NPREV + (size_t)u * MDK + 8 * hi;
#pragma unroll
          for (int ks = 0; ks < 4; ++ks) { const f32x4 n0 = *(const f32x4*)(np + 16 * ks), n1 = *(const f32x4*)(np + 16 * ks + 4); const u32x4 qw = __builtin_bit_cast(u32x4, qf[ks]);
              qn += bf_lo(qw.x) * n0[0] + bf_hi(qw.x) * n0[1] + bf_lo(qw.y) * n0[2] + bf_hi(qw.y) * n0[3] + bf_lo(qw.z) * n1[0] + bf_hi(qw.z) * n1[1] + bf_lo(qw.w) * n1[2] + bf_hi(qw.w) * n1[3]; } }
        qn = sum_x32(qn);
        f32x16 acc[4];
#pragma unroll
        for (int i = 0; i < 4; ++i)
#pragma unroll
            for (int r = 0; r < 16; ++r) acc[i][r] = 0.f;
#pragma unroll
        for (int i = 0; i < 4; ++i)
#pragma unroll
            for (int ks = 0; ks < 4; ++ks) { const bf16x8 af = *(const LAS bf16x8*)(cpl + (32 * i + c32) * 128 + (((2 * ks + hi) ^ ckey) * 16)); acc[i] = __builtin_amdgcn_mfma_f32_32x32x16_bf16(af, qf[ks], acc[i], 0, 0, 0); }
#pragma unroll
        for (int i = 0; i < 4; ++i)
#pragma unroll
            for (int r = 0; r < 16; ++r) acc[i][r] *= winter;
        float den = 0.f;
#pragma unroll
        for (int sb = 0; sb < 2; ++sb) {
            if (sb <= tb) {
                f32x16 st;
#pragma unroll
                for (int r = 0; r < 16; ++r) st[r] = 0.f;
                const bf16_t* krow = PROJ + (size_t)(m0 + 32 * sb + c32) * 3072 + 512 + h * 64 + 8 * hi;
#pragma unroll
                for (int ks = 0; ks < 4; ++ks) { const bf16x8 kf = *(const bf16x8*)(krow + 16 * ks); st = __builtin_amdgcn_mfma_f32_32x32x16_bf16(kf, qf[ks], st, 0, 0, 0); }
                unsigned pk[8];
#pragma unroll
                for (int r = 0; r < 16; r += 2) {
                    const int s0 = 32 * sb + (r & 3) + 8 * (r >> 2) + 4 * hi, s1 = s0 + 1;
                    const float a0 = __int_as_float(__builtin_amdgcn_ds_bpermute(hi16 + 4 * (32 * sb + (r & 3) + 8 * (r >> 2)), __float_as_int(av))),
                                a1 = __int_as_float(__builtin_amdgcn_ds_bpermute(hi16 + 4 * (32 * sb + (r & 3) + 8 * (r >> 2) + 1), __float_as_int(av)));
                    float p0 = st[r] * 0.125f * __expf(a0 - Mt), p1 = st[r + 1] * 0.125f * __expf(a1 - Mt);
                    if (s0 > tl) p0 = 0.f; if (s1 > tl) p1 = 0.f;
                    den += p0 + p1; pk[r >> 1] = cvt_pk_bf16(p0, p1);
                }
#pragma unroll
                for (int s2 = 0; s2 < 2; ++s2) {
                    const bf16x8 pf = __builtin_bit_cast(bf16x8, (u32x4){pk[4 * s2], pk[4 * s2 + 1], pk[4 * s2 + 2], pk[4 * s2 + 3]});
#pragma unroll
                    for (int i = 0; i < 4; ++i) { const bf16x8 vf = *(const bf16x8*)(vg + (size_t)(32 * i) * T + 16 * (2 * sb + s2));
                        acc[i] = __builtin_amdgcn_mfma_f32_32x32x16_bf16(vf, pf, acc[i], 0, 0, 0); }
                }
            }
        }
        den = sum_x32(den);
        den += winter * qn;
        const float mrow = bt + Mt, dnm = fmaxf(fabsf(den), __expf(-mrow)), rinv = 1.f / dnm;
        float ss = 0.f;
#pragma unroll
        for (int i = 0; i < 4; ++i)
#pragma unroll
            for (int r = 0; r < 16; ++r) { acc[i][r] *= rinv; ss += acc[i][r] * acc[i][r]; }
        ss = sum_x32(ss);
        const float rn = 1.f / sqrtf(ss * (1.f / MDV) + RMS_EPS);
        u32x4 ow[4][2];
        { const bf16_t* orow = PROJ + (size_t)(m0 + 32 * tb + row8) * 3072 + 2048 + h * 128 + 8 * sl8;
#pragma unroll
          for (int rr = 0; rr < 4; ++rr) { ow[rr][0] = *(const u32x4*)(orow + (size_t)(8 * rr) * 3072); ow[rr][1] = *(const u32x4*)(orow + (size_t)(8 * rr) * 3072 + 64); } }
#pragma unroll
        for (int rr = 0; rr < 4; ++rr) {
            if ((c32 >> 3) == rr) {
#pragma unroll
                for (int i = 0; i < 4; ++i)
#pragma unroll
                    for (int g = 0; g < 4; ++g) { u32x2 w; w.x = cvt_pk_bf16(acc[i][4 * g] * rn, acc[i][4 * g + 1] * rn); w.y = cvt_pk_bf16(acc[i][4 * g + 2] * rn, acc[i][4 * g + 3] * rn);
                        *(LAS u32x2*)(stg + (c32 & 7) * 256 + (((4 * i + g) ^ (c32 & 7)) * 16) + 8 * hi) = w; }
            }
            asm volatile("" ::: "memory");
            const u32x4 y0 = *(const LAS u32x4*)(stg + row8 * 256 + ((sl8 ^ row8) * 16)), y1 = *(const LAS u32x4*)(stg + row8 * 256 + (((8 + sl8) ^ row8) * 16));
            asm volatile("" ::: "memory");
            const size_t mrowi = (size_t)(m0 + 32 * tb + 8 * rr + row8);
#pragma unroll
            for (int hf = 0; hf < 2; ++hf) { const u32x4 yw = hf ? y1 : y0, o4 = ow[rr][hf]; const unsigned yv[4] = {yw.x, yw.y, yw.z, yw.w}, ov[4] = {o4.x, o4.y, o4.z, o4.w};
                float z[8];
#pragma unroll
                for (int e = 0; e < 4; ++e) { const f32x4 gg = gn[2 * hf + (e >> 1)];
                    z[2 * e] = bf_lo(yv[e]) * gg[2 * (e & 1)] * __builtin_amdgcn_rcpf(1.f + __expf(-bf_lo(ov[e]))); z[2 * e + 1] = bf_hi(yv[e]) * gg[2 * (e & 1) + 1] * __builtin_amdgcn_rcpf(1.f + __expf(-bf_hi(ov[e]))); }
                if (DF8_O5) { u32x2 w; w.x = cvt4_fp8(z[0] * F8_SHB, z[1] * F8_SHB, z[2] * F8_SHB, z[3] * F8_SHB); w.y = cvt4_fp8(z[4] * F8_SHB, z[5] * F8_SHB, z[6] * F8_SHB, z[7] * F8_SHB);
                    *(u32x2*)((unsigned char*)HB + mrowi * D + h * 128 + 64 * hf + 8 * sl8) = w; }
                else { u32x4 w; w.x = cvt_pk_bf16(z[0], z[1]); w.y = cvt_pk_bf16(z[2], z[3]); w.z = cvt_pk_bf16(z[4], z[5]); w.w = cvt_pk_bf16(z[6], z[7]); *(u32x4*)(HB + mrowi * D + h * 128 + 64 * hf + 8 * sl8) = w; } }
        }
        }
        LDS_WAIT();
    }
}
__device__ __forceinline__ float max3f(float a, float b, float c) { return fmaxf(fmaxf(a, b), c); }
constexpr int AT_KB = 64 * 384, AT_VB = 128 * 128, AT_STAGE = AT_KB + AT_VB;
__device__ __forceinline__ void attn_phase(const Frame& F) {
    unsigned char* ws = F.ws(); const bf16_t* QB = (const bf16_t*)(ws + WS_QB); const bf16_t* KN = (const bf16_t*)(ws + WS_KN); const bf16_t* KR = (const bf16_t*)(ws + WS_KR); const bf16_t* VT = (const bf16_t*)(ws + WS_VT);
    bf16_t* HB = (bf16_t*)(ws + WS_HB);
    LAS unsigned char* lds = F.lds;
    const int lane = F.lane, w = F.wave, c32 = lane & 31, hi = lane >> 5;
    int k_isr[3]; unsigned k_off[3], v_off[2];
#pragma unroll
    for (int n = 0; n < 3; ++n) { const int P = (n * 8 + w) * 64 + lane, row = P / 24, q = P - row * 24, p = (q & ~7) | ((q & 7) ^ ((row >> 1) & 7));
        k_isr[n] = p >= 16; k_off[n] = (p >= 16) ? (unsigned)(row * AROPE + (p - 16) * 8) * 2u : (unsigned)(row * 1024 + p * 8) * 2u; }
#pragma unroll
    for (int n = 0; n < 2; ++n) { const int P = (n * 8 + w) * 64 + lane, row = P >> 3, q = P & 7, p = q ^ ((row >> 1) & 7); v_off[n] = (unsigned)row * (unsigned)(T * 2) + (unsigned)(p * 16); }
    const int sw = (c32 >> 1) & 7;
    unsigned ko[4];
#pragma unroll
    for (int i = 0; i < 4; ++i) ko[i] = (unsigned)(c32 * 384 + (((2 * i + hi) ^ sw) * 16));
    const unsigned vrow = (unsigned)(c32 * 128);

    for (int item = F.vcu; item < NB * AH * 16; item += F.G) {
        const int bh = item >> 4, x = item & 15, b = bh >> 3, hh = bh & 7;
#pragma unroll 1
        for (int sub = 0; sub < 2; ++sub) {
            const int qb = sub ? 31 - x : x, nt = 4 * qb + 4, jmax = 4 * qb + (w >> 1);
            const int qrow = 256 * qb + 32 * w + c32;
            const size_t mq = (size_t)b * SEQ + qrow;
            __syncthreads();
            const bf16_t* knb = KN + (size_t)b * SEQ * 1024 + hh * 128; const bf16_t* krb = KR + (size_t)b * SEQ * AROPE; const bf16_t* vtb = VT + (size_t)(hh * 128) * T + (size_t)b * SEQ;
#define AT_ISSUE(j, stg) do { _Pragma("unroll") for (int _n = 0; _n < 3; ++_n) { \
                const char* _g = k_isr[_n] ? (const char*)(krb + (size_t)(j) * 64 * AROPE) + k_off[_n] : (const char*)(knb + (size_t)(j) * 64 * 1024) + k_off[_n]; \
                __builtin_amdgcn_global_load_lds((const unsigned*)_g, (LAS unsigned*)(lds + (stg) * AT_STAGE + (_n * 8 + w) * 1024), 16, 0, 0); } \
            _Pragma("unroll") for (int _n = 0; _n < 2; ++_n) { const char* _g = (const char*)(vtb + (size_t)(j) * 64) + v_off[_n]; \
                __builtin_amdgcn_global_load_lds((const unsigned*)_g, (LAS unsigned*)(lds + (stg) * AT_STAGE + AT_KB + (_n * 8 + w) * 1024), 16, 0, 0); } } while (0)
            AT_ISSUE(0, 0);
            bf16x8 qf[12];
            { const bf16_t* qr = QB + mq * 1536 + hh * AQD + 8 * hi;
#pragma unroll
              for (int ks = 0; ks < 12; ++ks) qf[ks] = *(const bf16x8*)(qr + 16 * ks); }
            f32x16 O[4];
#pragma unroll
            for (int i = 0; i < 4; ++i)
#pragma unroll
                for (int r = 0; r < 16; ++r) O[i][r] = 0.f;
            float m_run = -1.0e30f, l_run = 0.f;
            unsigned pk[16];
#pragma unroll
            for (int r = 0; r < 16; ++r) pk[r] = 0u;
#define AT_QK_SM(jj, sg) do { const LAS unsigned char* kb_ = lds + (sg) * AT_STAGE; \
                f32x16 s0, s1; _Pragma("unroll") for (int r = 0; r < 16; ++r) { s0[r] = 0.f; s1[r] = 0.f; } \
                bf16x8 kf[2][4]; \
                _Pragma("unroll") for (int _q = 0; _q < 2; ++_q) { kf[0][2 * _q] = *(const LAS bf16x8*)(kb_ + ko[_q & 3]); kf[0][2 * _q + 1] = *(const LAS bf16x8*)(kb_ + ko[_q & 3] + 32 * 384); } \
                _Pragma("unroll") for (int g = 0; g < 6; ++g) { \
                    if (g + 1 < 6) { _Pragma("unroll") for (int _q = 0; _q < 2; ++_q) { const int _ks = 2 * (g + 1) + _q; \
                        kf[(g + 1) & 1][2 * _q] = *(const LAS bf16x8*)(kb_ + ko[_ks & 3] + (_ks >> 2) * 128); kf[(g + 1) & 1][2 * _q + 1] = *(const LAS bf16x8*)(kb_ + ko[_ks & 3] + (_ks >> 2) * 128 + 32 * 384); } } \
                    __builtin_amdgcn_sched_barrier(0); \
                    _Pragma("unroll") for (int q = 0; q < 2; ++q) { s0 = __builtin_amdgcn_mfma_f32_32x32x16_bf16(kf[g & 1][2 * q], qf[2 * g + q], s0, 0, 0, 0); s1 = __builtin_amdgcn_mfma_f32_32x32x16_bf16(kf[g & 1][2 * q + 1], qf[2 * g + q], s1, 0, 0, 0); } \
                    __builtin_amdgcn_sched_barrier(0); } \
                if ((jj) == jmax) { const int kbase = 64 * (jj) + 4 * hi; \
                    _Pragma("unroll") for (int r = 0; r < 16; ++r) { const int key = kbase + (r & 3) + 8 * (r >> 2); if (key > qrow) s0[r] = -__builtin_inff(); if (key + 32 > qrow) s1[r] = -__builtin_inff(); } } \
                float mx = max3f(s0[0], s1[0], s0[1]); \
                _Pragma("unroll") for (int r = 2; r < 16; r += 2) mx = max3f(mx, s0[r], s0[r + 1]); \
                _Pragma("unroll") for (int r = 1; r < 15; r += 2) mx = max3f(mx, s1[r], s1[r + 1]); \
                mx = fmaxf(mx, s1[15]); mx = fmaxf(mx, __shfl_xor(mx, 32)); \
                const bool grow = mx > m_run + 8.0f;                   \
                const float mnew = grow ? mx : m_run, alpha = __builtin_amdgcn_exp2f(m_run - mnew); m_run = mnew; \
                float ls = 0.f; \
                _Pragma("unroll") for (int r = 0; r < 16; r += 2) { const float p0 = __builtin_amdgcn_exp2f(s0[r] - mnew), p1 = __builtin_amdgcn_exp2f(s0[r + 1] - mnew), p2 = __builtin_amdgcn_exp2f(s1[r] - mnew), p3 = __builtin_amdgcn_exp2f(s1[r + 1] - mnew); \
                    ls += (p0 + p1) + (p2 + p3); pk[r >> 1] = cvt_pk_bf16(p0, p1); pk[8 + (r >> 1)] = cvt_pk_bf16(p2, p3); } \
                l_run = l_run * alpha + ls; \
                if (__builtin_amdgcn_ballot_w64(grow) != 0ull) { _Pragma("unroll") for (int i = 0; i < 4; ++i) _Pragma("unroll") for (int r = 0; r < 16; ++r) O[i][r] *= alpha; } } while (0)
#define AT_PV(sg) do { const LAS unsigned char* vb_ = lds + (sg) * AT_STAGE + AT_KB + vrow; \
                bf16x8 vfr[2][4]; \
                { const unsigned po = (unsigned)((hi ^ sw) * 16); _Pragma("unroll") for (int i = 0; i < 4; ++i) vfr[0][i] = *(const LAS bf16x8*)(vb_ + i * (32 * 128) + po); } \
                _Pragma("unroll") for (int st = 0; st < 4; ++st) { \
                    if (st + 1 < 4) { const unsigned po = (unsigned)(((2 * (st + 1) + hi) ^ sw) * 16); _Pragma("unroll") for (int i = 0; i < 4; ++i) vfr[(st + 1) & 1][i] = *(const LAS bf16x8*)(vb_ + i * (32 * 128) + po); } \
                    __builtin_amdgcn_sched_barrier(0); \
                    const bf16x8 pf = __builtin_bit_cast(bf16x8, (u32x4){pk[4 * st], pk[4 * st + 1], pk[4 * st + 2], pk[4 * st + 3]}); \
                    _Pragma("unroll") for (int i = 0; i < 4; ++i) O[i] = __builtin_amdgcn_mfma_f32_32x32x16_bf16(vfr[st & 1][i], pf, O[i], 0, 0, 0); \
                    __builtin_amdgcn_sched_barrier(0); } } while (0)
            const bool grpB = w >= 4;
            int sj = 0; bool pending = false;
#pragma unroll 1
            for (int j = 0; j <= nt; ++j) {
                const int sn = (sj == 2) ? 0 : sj + 1, sp = (sj == 0) ? 2 : sj - 1;
                if (grpB) { asm volatile("s_waitcnt vmcnt(0)" ::: "memory"); __syncthreads(); if (j + 1 < nt) AT_ISSUE(j + 1, sn); }
                if (pending) AT_PV(sp);
                if (!grpB) { asm volatile("s_waitcnt vmcnt(0)" ::: "memory"); __syncthreads(); if (j + 1 < nt) AT_ISSUE(j + 1, sn); }
                pending = (j < nt && j <= jmax);
                if (pending) AT_QK_SM(j, sj);
                sj = sn;
            }
#undef AT_QK_SM
#undef AT_PV
            const float lt = l_run + __shfl_xor(l_run, 32), rl = 1.f / lt;
            if (DF8_O5) { unsigned char* orow = (unsigned char*)HB + mq * D + hh * 128 + 4 * hi; const float rs = rl * F8_SHB;
#pragma unroll
                for (int i = 0; i < 4; ++i)
#pragma unroll
                    for (int g4 = 0; g4 < 4; ++g4) *(unsigned*)(orow + 32 * i + 8 * g4) = cvt4_fp8(O[i][4 * g4] * rs, O[i][4 * g4 + 1] * rs, O[i][4 * g4 + 2] * rs, O[i][4 * g4 + 3] * rs);
            } else { bf16_t* orow = HB + mq * D + hh * 128 + 4 * hi;
#pragma unroll
                for (int i = 0; i < 4; ++i)
#pragma unroll
                    for (int g4 = 0; g4 < 4; ++g4) { u32x2 wv; wv.x = cvt_pk_bf16(O[i][4 * g4] * rl, O[i][4 * g4 + 1] * rl); wv.y = cvt_pk_bf16(O[i][4 * g4 + 2] * rl, O[i][4 * g4 + 3] * rl);
                        *(u32x2*)(orow + 32 * i + 8 * g4) = wv; } }
#undef AT_ISSUE
        }
    }
}

constexpr int A8_KB = 64 * 192, A8_VB = 128 * 64, A8_STAGE = A8_KB + A8_VB;
__device__ __forceinline__ void attn8_phase(const Frame& F, const int cv_layer, const int cv_count) {
    unsigned char* ws = F.ws(); const unsigned char* Q8 = (const unsigned char*)(ws + WS_QB); const unsigned char* KN8 = (const unsigned char*)(ws + WS_KN); const unsigned char* KR8 = (const unsigned char*)(ws + WS_KR);
    const unsigned char* VT8 = (const unsigned char*)(ws + WS_VT); bf16_t* HB = (bf16_t*)(ws + WS_HB);
    LAS unsigned char* lds = F.lds;
    const int lane = F.lane, w = F.wave, c32 = lane & 31, hi = lane >> 5;
    const int sw = (c32 >> 2) & 3;
    const unsigned koA = (unsigned)(c32 * 192 + ((2 * hi) ^ sw) * 16), koB = (unsigned)(c32 * 192 + ((2 * hi + 1) ^ sw) * 16);
    const unsigned voA = (unsigned)(c32 * 64 + ((2 * hi) ^ sw) * 16), voB = (unsigned)(c32 * 64 + ((2 * hi + 1) ^ sw) * 16);
    constexpr float CS = 1.0f / (F8_SQ * F8_SK);
    const int cv_stride = F.G * NWAVES; const int CV_TOTAL = cv_count * CV_PER_LAYER; int cvn = cv_layer >= 0 ? F.vcu * NWAVES + w : CV_TOTAL, cvq = 0; bool cvh = false, cvj = false;
    LAS unsigned char* cvb = lds + 3 * A8_STAGE + w * 8192;

    for (int item = F.vcu; item < NB * AH * 16; item += F.G) {
        const int bh = item >> 4, x = item & 15, b = bh >> 3, hh = bh & 7;
#pragma unroll 1
        for (int sub = 0; sub < 2; ++sub) {
            const int qb = sub ? 31 - x : x, nt = 4 * qb + 4, jmax = 4 * qb + (w >> 1);
            const int qrow = 256 * qb + 32 * w + c32;
            const size_t mq = (size_t)b * SEQ + qrow;
            __syncthreads();
            const GAS unsigned char* wsg = (const GAS unsigned char*)ws;
            int hl_ = hi; asm volatile("" : "+v"(hl_));
            int k_isr[2]; unsigned k_off[2], v_off;
            { int ln_ = lane; asm volatile("" : "+v"(ln_));
#pragma unroll
              for (int t = 0; t < 2; ++t) { const int P = (w + 8 * t) * 64 + ln_, row = P / 12, q = P - row * 12, p = (q & ~3) | ((q & 3) ^ ((row >> 2) & 3));
                  k_isr[t] = p >= 8; k_off[t] = (p >= 8) ? (unsigned)(row * AROPE + (p - 8) * 16) : (unsigned)(row * 1024 + p * 16); }
              { const int P = w * 64 + ln_, row = P >> 2, q = P & 3, p = q ^ ((row >> 2) & 3); v_off = (unsigned)row * (unsigned)T + (unsigned)(p * 16); } }
            unsigned kb32[2], ks32[2];
#pragma unroll
            for (int t = 0; t < 2; ++t) { kb32[t] = k_isr[t] ? (unsigned)(WS_KR + (size_t)b * SEQ * AROPE) + k_off[t] : (unsigned)(WS_KN + (size_t)b * SEQ * 1024 + hh * 128) + k_off[t]; ks32[t] = k_isr[t] ? 64u * AROPE : 64u * 1024u; }
            const unsigned vb32 = (unsigned)(WS_VT + (size_t)(hh * 128) * T + (size_t)b * SEQ) + v_off;
#define A8_ISSUE(j, stg) do { _Pragma("unroll") for (int _t = 0; _t < 2; ++_t) { if (_t == 0 || w < 4) { \
                const GAS unsigned char* _g = wsg + (size_t)(kb32[_t] + (unsigned)(j) * ks32[_t]); \
                __builtin_amdgcn_global_load_lds((const GAS unsigned*)_g, (LAS unsigned*)(lds + (stg) * A8_STAGE + (w + 8 * _t) * 1024), 16, 0, 0); } } \
            { const GAS unsigned char* _g = wsg + (size_t)(vb32 + (unsigned)(j) * 64u); \
                __builtin_amdgcn_global_load_lds((const GAS unsigned*)_g, (LAS unsigned*)(lds + (stg) * A8_STAGE + A8_KB + w * 1024), 16, 0, 0); } } while (0)
            A8_ISSUE(0, 0);
            i32x8 qf[3];
            { const GAS unsigned char* qr = wsg + (size_t)((unsigned)WS_QB + (unsigned)mq * 1536u + (unsigned)(hh * AQD + 32 * hl_));
#pragma unroll
              for (int ks = 0; ks < 3; ++ks) { qf[ks].lo = *(const GAS i32x4*)(qr + 64 * ks); qf[ks].hi = *(const GAS i32x4*)(qr + 64 * ks + 16); } }
            f32x16 O[4];
#pragma unroll
            for (int i = 0; i < 4; ++i)
#pragma unroll
                for (int r = 0; r < 16; ++r) O[i][r] = 0.f;
            float m_run = -1.0e30f, l_run = 0.f, l_pa = 1.f, l_ps = 0.f;
            i32x8 pk, ones8;
            int one4 = 0x38383838; asm volatile("" : "+v"(one4));
#pragma unroll
            for (int r = 0; r < 8; ++r) { pk[r] = 0; ones8[r] = one4; }
#define A8_QK_SM(jj, sg) do { const LAS unsigned char* kb_ = lds + (sg) * A8_STAGE; \
                f32x16 s0, s1; _Pragma("unroll") for (int r = 0; r < 16; ++r) { s0[r] = 0.f; s1[r] = 0.f; } \
                i32x8 kf[2][2]; \
                kf[0][0].lo = *(const LAS i32x4*)(kb_ + koA); kf[0][0].hi = *(const LAS i32x4*)(kb_ + koB); kf[0][1].lo = *(const LAS i32x4*)(kb_ + koA + 32 * 192); kf[0][1].hi = *(const LAS i32x4*)(kb_ + koB + 32 * 192); \
                _Pragma("unroll") for (int ks = 0; ks < 3; ++ks) { \
                    if (ks + 1 < 3) { kf[(ks + 1) & 1][0].lo = *(const LAS i32x4*)(kb_ + koA + 64 * (ks + 1)); kf[(ks + 1) & 1][0].hi = *(const LAS i32x4*)(kb_ + koB + 64 * (ks + 1)); \
                        kf[(ks + 1) & 1][1].lo = *(const LAS i32x4*)(kb_ + koA + 64 * (ks + 1) + 32 * 192); kf[(ks + 1) & 1][1].hi = *(const LAS i32x4*)(kb_ + koB + 64 * (ks + 1) + 32 * 192); } \
                    __builtin_amdgcn_sched_barrier(0); \
                    s0 = __builtin_amdgcn_mfma_scale_f32_32x32x64_f8f6f4(kf[ks & 1][0], qf[ks], s0, 0, 0, 0, 0, 0, 0); s1 = __builtin_amdgcn_mfma_scale_f32_32x32x64_f8f6f4(kf[ks & 1][1], qf[ks], s1, 0, 0, 0, 0, 0, 0); \
                    __builtin_amdgcn_sched_barrier(0); } \
                if ((jj) == jmax) { const int kbase = 64 * (jj) + 4 * hi; \
                    _Pragma("unroll") for (int r = 0; r < 16; ++r) { const int key = kbase + (r & 3) + 8 * (r >> 2); if (key > qrow) s0[r] = -__builtin_inff(); if (key + 32 > qrow) s1[r] = -__builtin_inff(); } } \
                l_run = l_run * l_pa + l_ps; l_pa = 1.f; l_ps = 0.f; \
                float mx = max3f(s0[0], s1[0], s0[1]); \
                _Pragma("unroll") for (int r = 2; r < 16; r += 2) mx = max3f(mx, s0[r], s0[r + 1]); \
                _Pragma("unroll") for (int r = 1; r < 15; r += 2) mx = max3f(mx, s1[r], s1[r + 1]); \
                mx = fmaxf(mx, s1[15]); mx = max_x32(mx) * CS; \
                const bool grow = mx > m_run + 1.0f; \
                const float mnew = grow ? mx : m_run, alpha = __builtin_amdgcn_exp2f(m_run - mnew), eb = 7.0f - mnew; m_run = mnew;     \
                _Pragma("unroll") for (int g = 0; g < 4; ++g) { \
                    const float a0 = __builtin_amdgcn_exp2f(__builtin_fmaf(s0[4 * g], CS, eb)), a1 = __builtin_amdgcn_exp2f(__builtin_fmaf(s0[4 * g + 1], CS, eb)), a2 = __builtin_amdgcn_exp2f(__builtin_fmaf(s0[4 * g + 2], CS, eb)), a3 = __builtin_amdgcn_exp2f(__builtin_fmaf(s0[4 * g + 3], CS, eb)); \
                    const float c0 = __builtin_amdgcn_exp2f(__builtin_fmaf(s1[4 * g], CS, eb)), c1 = __builtin_amdgcn_exp2f(__builtin_fmaf(s1[4 * g + 1], CS, eb)), c2 = __builtin_amdgcn_exp2f(__builtin_fmaf(s1[4 * g + 2], CS, eb)), c3 = __builtin_amdgcn_exp2f(__builtin_fmaf(s1[4 * g + 3], CS, eb)); \
                    pk[g] = (int)cvt4_fp8(a0, a1, a2, a3); pk[4 + g] = (int)cvt4_fp8(c0, c1, c2, c3); } \
                { f32x16 lz; _Pragma("unroll") for (int r = 0; r < 16; ++r) lz[r] = 0.f;                    \
                  lz = __builtin_amdgcn_mfma_scale_f32_32x32x64_f8f6f4(ones8, pk, lz, 0, 0, 0, 0, 0, 0); l_pa = alpha; l_ps = lz[0]; }     \
                if (__builtin_amdgcn_ballot_w64(grow) != 0ull) { _Pragma("unroll") for (int i = 0; i < 4; ++i) _Pragma("unroll") for (int r = 0; r < 16; ++r) O[i][r] *= alpha; } } while (0)
#define A8_PV(sg) do { const LAS unsigned char* vb_ = lds + (sg) * A8_STAGE + A8_KB; \
                i32x8 vf[4]; _Pragma("unroll") for (int i = 0; i < 4; ++i) { vf[i].lo = *(const LAS i32x4*)(vb_ + voA + i * 2048); vf[i].hi = *(const LAS i32x4*)(vb_ + voB + i * 2048); } \
                __builtin_amdgcn_sched_barrier(0); \
                _Pragma("unroll") for (int i = 0; i < 4; ++i) O[i] = __builtin_amdgcn_mfma_scale_f32_32x32x64_f8f6f4(vf[i], pk, O[i], 0, 0, 0, 0, 0, 0); \
                __builtin_amdgcn_sched_barrier(0); } while (0)
            const bool grpB = w >= 4;
            int sj = 0; bool pending = false;
#pragma unroll 1
            for (int j = 0; j <= nt; ++j) {
                const int sn = (sj == 2) ? 0 : sj + 1, sp = (sj == 0) ? 2 : sj - 1;
#define A8_WAITBAR() do { if (cvj) { asm volatile("s_waitcnt vmcnt(8) lgkmcnt(0)" ::: "memory"); cvj = false; } else { asm volatile("s_waitcnt vmcnt(0) lgkmcnt(0)" ::: "memory"); } \
                    __builtin_amdgcn_s_barrier(); asm volatile("" ::: "memory"); } while (0)
                if (grpB) { A8_WAITBAR(); if (j + 1 < nt) A8_ISSUE(j + 1, sn); }
                if (pending) A8_PV(sp);
                if (!grpB) { A8_WAITBAR(); if (j + 1 < nt) A8_ISSUE(j + 1, sn); }
#undef A8_WAITBAR
                pending = (j < nt && j <= jmax);
                if (pending) A8_QK_SM(j, sj);
                sj = sn;
                if ((j & 3) == 3 && (cvh || cvn < CV_TOTAL)) {
                    if (cvh) { const int cvl_ = cvq >= CV_PER_LAYER ? 1 : 0, cvr = cvq - cvl_ * CV_PER_LAYER; const CvItem ci = cv_decode(F, cv_layer + cvl_, cvr, lane); cv_finish(ci, cvb, cvr, lane); cvh = false; }
                    if (cvn < CV_TOTAL) { { const int cvl_ = cvn >= CV_PER_LAYER ? 1 : 0, cvr = cvn - cvl_ * CV_PER_LAYER; const CvItem ci = cv_decode(F, cv_layer + cvl_, cvr, lane); cv_issue(ci, cvb); } cvq = cvn; cvn += cv_stride; cvh = true; cvj = (j < nt); }
                }
            }
#undef A8_QK_SM
#undef A8_PV
            const float lt = l_run * l_pa + l_ps, rl = 1.f / (lt * F8_SV);
            if (DF8_O5) { GAS unsigned char* orow = (GAS unsigned char*)wsg + (size_t)((unsigned)WS_HB + (unsigned)mq * (unsigned)D + (unsigned)(hh * 128 + 4 * hl_)); const float rs = rl * F8_SHB;
#pragma unroll
                for (int i = 0; i < 4; ++i)
#pragma unroll
                    for (int g4 = 0; g4 < 4; ++g4) *(GAS unsigned*)(orow + 32 * i + 8 * g4) = cvt4_fp8(O[i][4 * g4] * rs, O[i][4 * g4 + 1] * rs, O[i][4 * g4 + 2] * rs, O[i][4 * g4 + 3] * rs);
            } else { bf16_t* orow = HB + mq * D + hh * 128 + 4 * hi;
#pragma unroll
                for (int i = 0; i < 4; ++i)
#pragma unroll
                    for (int g4 = 0; g4 < 4; ++g4) { u32x2 wv; wv.x = cvt_pk_bf16(O[i][4 * g4] * rl, O[i][4 * g4 + 1] * rl); wv.y = cvt_pk_bf16(O[i][4 * g4 + 2] * rl, O[i][4 * g4 + 3] * rl);
                        *(u32x2*)(orow + 32 * i + 8 * g4) = wv; } }
#undef A8_ISSUE
        }
    }
    const int lane2 = (int)__builtin_amdgcn_mbcnt_hi(~0u, __builtin_amdgcn_mbcnt_lo(~0u, 0u));
    for (;;) { if (cvh) { asm volatile("s_waitcnt vmcnt(0)" ::: "memory"); const int cvl_ = cvq >= CV_PER_LAYER ? 1 : 0, cvr = cvq - cvl_ * CV_PER_LAYER; const CvItem ci = cv_decode(F, cv_layer + cvl_, cvr, lane2); cv_finish(ci, cvb, cvr, lane2); cvh = false; }
        if (cvn >= CV_TOTAL) break; { const int cvl_ = cvn >= CV_PER_LAYER ? 1 : 0, cvr = cvn - cvl_ * CV_PER_LAYER; const CvItem ci = cv_decode(F, cv_layer + cvl_, cvr, lane2); cv_issue(ci, cvb); } cvq = cvn; cvn += cv_stride; cvh = true; }
}
#ifndef DUP_L6
#define DUP_L6 0
#endif
#ifndef DUP_SYNC
#define DUP_SYNC 0
#endif
#ifndef DUP_L9
#define DUP_L9 0
#endif
#ifndef DUP_BAR
#define DUP_BAR 0
#endif
#ifndef DUP_P0
#define DUP_P0 0
#endif
#ifndef DUP_A4
#define DUP_A4 0
#endif
#ifndef DUP_G7
#define DUP_G7 0
#endif
#ifndef DUP_G8
#define DUP_G8 0
#endif
#ifndef DUP_M1
#define DUP_M1 0
#endif
#ifndef DUP_O5
#define DUP_O5 0
#endif
#ifndef DUP_M2
#define DUP_M2 0
#endif
#ifndef DUP_M3
#define DUP_M3 0
#endif
#ifndef DUP_M4
#define DUP_M4 0
#endif
#ifndef DUP_A1
#define DUP_A1 0
#endif
#ifndef DUP_A2
#define DUP_A2 0
#endif
#ifndef DUP_A3
#define DUP_A3 0
#endif
#ifndef EN_P0
#define EN_P0 1
#endif
#ifndef EN_M1
#define EN_M1 1
#endif
#ifndef EN_M2
#define EN_M2 1
#endif
#ifndef EN_M3
#define EN_M3 1
#endif
#ifndef EN_M4
#define EN_M4 1
#endif
#ifndef EN_A1
#define EN_A1 1
#endif
#ifndef EN_A2
#define EN_A2 1
#endif
#ifndef EN_A3
#define EN_A3 1
#endif
#ifndef EN_A4
#define EN_A4 1
#endif
#ifndef EN_O5
#define EN_O5 1
#endif
#ifndef EN_L6
#define EN_L6 1
#endif
#ifndef EN_G7
#define EN_G7 1
#endif
#ifndef EN_G8
#define EN_G8 1
#endif
#ifndef EN_L9
#define EN_L9 1
#endif
#ifndef STAG_G7
#define STAG_G7 0
#endif
#ifndef STAG_G8
#define STAG_G8 0
#endif
__device__ __forceinline__ void stagger_wait(const Frame& F, int step) {
    if (step > 0) { const unsigned long long t0 = wall_clock64(), d = (unsigned long long)((F.vcu & 3) * step);
        while (wall_clock64() - t0 < d) __builtin_amdgcn_s_sleep(8);
        __syncthreads(); }
}
constexpr int PH_PER_LAYER = 9, N_PHASES = 1 + DEPTH * PH_PER_LAYER;
constexpr float Q_SCALE = 0.07216878364870323f * 1.4426950408889634f;

__global__ void __launch_bounds__(NTHR, 2) fwd_kernel(Args args) {
    extern __shared__ __attribute__((aligned(16))) unsigned char lds_raw[];
    Frame F0; Frame& F = F0;
    F.lds = (LAS unsigned char*)lds_raw; F.MISC = (volatile LAS unsigned*)(F.lds + MISC_OFF);
    F.tid = threadIdx.x; F.lane = F.tid & 63; F.wave = __builtin_amdgcn_readfirstlane(F.tid >> 6);
    F.G = gridDim.x; { const int bx = blockIdx.x; F.vcu = (F.G % 8 == 0) ? (bx % 8) * (F.G / 8) + bx / 8 : bx; }
    if (F.tid < 128) F.MISC[F.tid] = 0u;
    if (F.tid == 128) {
#pragma unroll
        for (int i = 0; i < 20; ++i) { const unsigned long long p = (unsigned long long)args.in[i]; F.MISC[128 + 2 * i] = (unsigned)p; F.MISC[129 + 2 * i] = (unsigned)(p >> 32); }
        { const unsigned long long p = (unsigned long long)args.out; F.MISC[168] = (unsigned)p; F.MISC[169] = (unsigned)(p >> 32); }
        { const unsigned long long p = (unsigned long long)args.ws; F.MISC[170] = (unsigned)p; F.MISC[171] = (unsigned)(p >> 32); }
    }
    __syncthreads();
    XcdBarrier bar = xcd_barrier_post(F.ctl() + CW_BAR, F.MISC);
    const int lo = args.ph_lo, hi = args.ph_hi;
#define IN(k) (lo <= (k) && (k) < hi)
#define SEAM(k) do { if (IN(k) && IN((k) + 1)) { xcd_barrier(bar); if (DUP_BAR) xcd_barrier(bar); } else __syncthreads(); } while (0)

    if (EN_P0 && IN(0)) { for (int rep = 0; rep <= DUP_P0; ++rep) { const Frame F = refresh(F0); p0_prologue(F); __syncthreads(); } }
    SEAM(0);

    for (int l = 0; l < DEPTH; ++l) {
        const int pb = 1 + l * PH_PER_LAYER, j = l >> 1;
        if ((l & 1) == 0) {
            if (EN_M1 && IN(pb + 0)) for (int rep = 0; rep <= DUP_M1; ++rep) { const Frame F = refresh(F0); unsigned char* ws = F.ws(); const bf16_t* xres = (const bf16_t*)(ws + WS_XB);
                constexpr int EB = DF8_M1 ? 1 : 2;
                if constexpr (DF8_MV != 0) {
                    { pg8::DenseOrder S; S.init(ws + WS_XB, (bf16_t*)(ws + WS_WINM) + (size_t)j * 3072 * 1024, T, 1024, 1024, 1024, F.G, F.vcu, 2);
                      pg8::EpiBf16 E{(bf16_t*)(ws + WS_PROJ), 3072, 1.0f};
                      pg8::gemm_phase<pg8::EpiBf16, pg8::DenseOrder, false, false>(F.lds, F.tid, 1024, 1024, 1024, S, E); }
                    __syncthreads();
                    { const Frame F = refresh(F0); unsigned char* ws = F.ws();
                      pg8::DenseOrder S; S.init(ws + WS_XB8, (unsigned char*)(ws + WS_WINM8) + ((size_t)j * 2048 + 1024) * 1024, T, 1024, 1024, 1024, F.G, F.vcu, 1);
                      pg8::EpiBf16 E{(bf16_t*)(ws + WS_PROJ) + 2048, 3072, 1.0f / (F8_SX * F8_SWI)};
                      pg8::gemm_phase<pg8::EpiBf16, pg8::DenseOrder, false, true>(F.lds, F.tid, 1024, 1024, 1024, S, E); }
                    __syncthreads();
                    { const Frame F = refresh(F0); unsigned char* ws = F.ws();
                      pg8::DenseOrder S; S.init((unsigned char*)(ws + WS_WINM8) + (size_t)j * 2048 * 1024, ws + WS_XB8, 1024, T, 1024, 1024, F.G, F.vcu, 1);
                      pg8::EpiVT E{(bf16_t*)(ws + WS_VT), T, 1.0f / (F8_SX * F8_SWI)};
                      pg8::gemm_phase<pg8::EpiVT, pg8::DenseOrder, false, true>(F.lds, F.tid, 1024, 1024, 1024, S, E); }
                    __syncthreads();
                } else {
                { pg8::DenseOrder S; S.init(ws + (DF8_M1 ? WS_XB8 : WS_XB), (unsigned char*)(ws + WS_WINM) + (size_t)j * 3072 * 1024 * EB, T, MVT ? 2048 : 3072, 1024, 1024, F.G, F.vcu, EB);
                  if (MVT) { S.skip_at = 4; S.skip_n = 4; }
                  pg8::EpiBf16 E{(bf16_t*)(ws + WS_PROJ), 3072, DF8_M1 ? 1.0f / (F8_SX * F8_SWI) : 1.0f};
                  pg8::gemm_phase<pg8::EpiBf16, pg8::DenseOrder, false, DF8_M1 != 0>(F.lds, F.tid, 1024, 1024, 1024, S, E); }
                __syncthreads();
                if (MVT) { const Frame F = refresh(F0); unsigned char* ws = F.ws();
                  pg8::DenseOrder S; S.init((unsigned char*)(ws + WS_WINM) + ((size_t)j * 3072 + 1024) * 1024 * EB, ws + (DF8_M1 ? WS_XB8 : WS_XB), 1024, T, 1024, 1024, F.G, F.vcu, EB);
                  pg8::EpiVT E{(bf16_t*)(ws + WS_VT), T};
                  pg8::gemm_phase<pg8::EpiVT, pg8::DenseOrder, false, DF8_M1 != 0>(F.lds, F.tid, 1024, 1024, 1024, S, E);
                  __syncthreads(); }
                }
                const Frame F2 = refresh(F0);
                { const f32x4* src = (const f32x4*)(ws + WS_GIMG) + (size_t)j * (D * 16 / 4);
#pragma unroll 4
                  for (int it = 0; it < 8; ++it) ((LAS f32x4*)F2.lds)[F2.tid + NTHR * it] = src[F2.tid + NTHR * it];
                  __syncthreads(); }
                gates_phase(F2, xres, (const float*)F2.ptr(IN_MBG) + j * 16, (float*)(ws + WS_GATES));
            }
            SEAM(pb + 0);
            if (EN_M2 && IN(pb + 1)) for (int rep = 0; rep <= DUP_M2; ++rep) { const Frame F = refresh(F0); mlstm_local_phase(F); __syncthreads(); }
            SEAM(pb + 1);
            if (EN_M3 && IN(pb + 2)) for (int rep = 0; rep <= DUP_M3; ++rep) { const Frame F = refresh(F0); mlstm_scan_phase(F); __syncthreads(); }
            SEAM(pb + 2);
            if (EN_M4 && IN(pb + 3)) for (int rep = 0; rep <= DUP_M4; ++rep) { const Frame F = refresh(F0); __syncthreads(); mlstm_out_phase(F, (const float*)F.ptr(IN_MNG) + (size_t)j * 1024); }
            SEAM(pb + 3);
        } else {
            if (EN_A1 && IN(pb + 0)) for (int rep = 0; rep <= DUP_A1; ++rep) { const Frame F = refresh(F0); unsigned char* ws = F.ws();
                constexpr int EB = DF8_A1 ? 1 : 2;
                pg8::DenseOrder S; S.init(ws + (DF8_A1 ? WS_XB8 : WS_XB), (unsigned char*)(ws + WS_WINA) + (size_t)j * AINP * 1024 * EB, T, AINP, 1024, 1024, F.G, F.vcu, EB);
                pg8::EpiF32 E{(float*)(ws + WS_A32), AINP, DF8_A1 ? 1.0f / (F8_SX * F8_SWI) : 1.0f};
                pg8::gemm_phase<pg8::EpiF32, pg8::DenseOrder, false, DF8_A1 != 0>(F.lds, F.tid, 1024, 1024, 1024, S, E);
            }
            SEAM(pb + 0);
            if (EN_A2 && IN(pb + 1)) { const Frame F = refresh(F0); mla_norm_phase(F, j); }
            SEAM(pb + 1);
            if (EN_A3 && IN(pb + 2)) for (int rep = 0; rep <= DUP_A3; ++rep) { const Frame F = refresh(F0); unsigned char* ws = F.ws();
                { pg8::DenseOrder S; S.init(ws + WS_CQ, (bf16_t*)(ws + WS_WQB) + (size_t)j * 1536 * AQL, T, 1536, AQL, AQL, F.G, F.vcu);
                  pg8::EpiQRope E{(bf16_t*)(ws + WS_QB), 1536, (const float*)(ws + WS_COS), (const float*)(ws + WS_SIN), ATT_FP8 ? Q_SCALE * F8_SQ : Q_SCALE};
                  pg8::gemm_phase<pg8::EpiQRope, pg8::DenseOrder, false>(F.lds, F.tid, AQL, AQL, AQL, S, E); }
                __syncthreads();
                { const Frame F = refresh(F0); unsigned char* ws = F.ws();
                  pg8::DenseOrder S; S.init(ws + WS_CKV, (bf16_t*)(ws + WS_WKV) + (size_t)j * 2048 * AKL, T, 1024, AKL, AKL, F.G, F.vcu);
                  if constexpr (ATT_FP8 != 0) { pg8::EpiF8 E{(unsigned char*)(ws + WS_KN), 1024, F8_SK}; pg8::gemm_phase<pg8::EpiF8, pg8::DenseOrder, false>(F.lds, F.tid, AKL, AKL, AKL, S, E); }
                  else { pg8::EpiBf16 E{(bf16_t*)(ws + WS_KN), 1024, 1.0f}; pg8::gemm_phase<pg8::EpiBf16, pg8::DenseOrder, false>(F.lds, F.tid, AKL, AKL, AKL, S, E); } }
                __syncthreads();
                { const Frame F = refresh(F0); unsigned char* ws = F.ws();
                  pg8::DenseOrder S; S.init((bf16_t*)(ws + WS_WKV) + (size_t)j * 2048 * AKL + (size_t)1024 * AKL, ws + WS_CKV, 1024, T, AKL, AKL, F.G, F.vcu);
                  if constexpr (ATT_FP8 != 0) { pg8::EpiVT8 E{(unsigned char*)(ws + WS_VT), T, F8_SV}; pg8::gemm_phase<pg8::EpiVT8, pg8::DenseOrder, false>(F.lds, F.tid, AKL, AKL, AKL, S, E); }
                  else { pg8::EpiVT E{(bf16_t*)(ws + WS_VT), T}; pg8::gemm_phase<pg8::EpiVT, pg8::DenseOrder, false>(F.lds, F.tid, AKL, AKL, AKL, S, E); } }
            }
            SEAM(pb + 2);
            if (EN_A4 && IN(pb + 3)) { for (int rep = 0; rep <= DUP_A4; ++rep) { const Frame F = refresh(F0); if constexpr (ATT_FP8 != 0) attn8_phase(F, (CV_IN_ATTN && MOE_FP8 && rep == 0) ? l : -1, l == 1 ? 2 : 1);     else attn_phase(F); __syncthreads(); } }
            SEAM(pb + 3);
        }
        if (EN_O5 && IN(pb + 4)) for (int rep = 0; rep <= DUP_O5; ++rep) { const Frame F = refresh(F0); unsigned char* ws = F.ws(); const bf16_t* xres = (const bf16_t*)(ws + WS_XB);
            constexpr int EB = DF8_O5 ? 1 : 2;
            const unsigned char* wo = (l & 1) ? (const unsigned char*)(ws + WS_WOUTA) + (size_t)j * 1024 * 1024 * EB : (const unsigned char*)(ws + WS_WOUTM) + (size_t)j * 1024 * 1024 * EB;
            pg8::DenseOrder S; S.init(ws + WS_HB, wo, T, 1024, 1024, 1024, F.G, F.vcu, EB);
            pg8::EpiResid E{xres, (float*)(ws + WS_ZF), 1024, DN_ALPHA, DF8_O5 ? 1.0f / (F8_SHB * F8_SWO) : 1.0f};
            pg8::gemm_phase<pg8::EpiResid, pg8::DenseOrder, false, DF8_O5 != 0>(F.lds, F.tid, 1024, 1024, 1024, S, E);
        }
        SEAM(pb + 4);
        if (EN_L6 && IN(pb + 5)) { if (DUP_L6) { const Frame F = refresh(F0); ln_router_phase(F, l, l + 4); __syncthreads(); } const Frame F = refresh(F0); ln_router_phase(F, l, l); }
        SEAM(pb + 5);
        if (EN_G7 && IN(pb + 6)) for (int rep = 0; rep <= DUP_G7; ++rep) { if (DUP_SYNC && rep) xcd_barrier(bar); const Frame F = refresh(F0); unsigned char* ws = F.ws();
            moe_prefix(F, l);
            constexpr size_t EB = MOE_FP8 ? 1 : 2;
            const int nu = moe_units(F, l, 8);
            pg8::MoeOrder S{(const volatile LAS int*)(F.lds + pg8::MOE_UTAB_OFF), (const char*)(ws + (MOE_FP8 ? WS_XB8 : WS_XB)), (const char*)(ws + WS_WGU) + (size_t)l * 32 * 2048 * 1024 * EB, (const int*)(ws + WS_LIST),
                            nu, (size_t)2048 * 1024 * EB, (size_t)256 * 1024 * EB, true, 0};
            pg8::EpiSwiglu E{(unsigned char*)(ws + WS_HMOE), (const float*)F.ptr(IN_BGU) + (size_t)l * 32 * 2048, F.lds};
            pg8::gemm_phase<pg8::EpiSwiglu, pg8::MoeOrder, true, MOE_FP8 != 0>(F.lds, F.tid, 1024, 1024, 1024, S, E);
        }
        SEAM(pb + 6);
        if (EN_G8 && IN(pb + 7)) for (int rep = 0; rep <= DUP_G8; ++rep) { if (DUP_SYNC && rep) xcd_barrier(bar); const Frame F = refresh(F0); unsigned char* ws = F.ws();
            if (MK_PER_PHASE) moe_prefix(F, l);
            constexpr size_t EB = MOE_FP8 ? 1 : 2;
            const int nu = moe_units(F, l, 4);
            pg8::MoeOrder S{(const volatile LAS int*)(F.lds + pg8::MOE_UTAB_OFF), (const char*)(ws + WS_HMOE), (const char*)(ws + WS_WD) + (size_t)l * 32 * 1024 * 1024 * EB, (const int*)(ws + WS_LIST),
                            nu, (size_t)1024 * 1024 * EB, (size_t)256 * 1024 * EB, false, (size_t)256 * 1024 * EB};
            pg8::EpiDown E{(bf16_t*)(ws + WS_YMOE), (const float*)F.ptr(IN_BD) + (size_t)l * 32 * 1024, F.lds};
            pg8::gemm_phase<pg8::EpiDown, pg8::MoeOrder, false, MOE_FP8 != 0>(F.lds, F.tid, 1024, 1024, 1024, S, E);
        }
        SEAM(pb + 7);
        if (EN_L9 && IN(pb + 8)) { if (DUP_L9) { const Frame F = refresh(F0); moe_prefix(F, l); ln_combine_phase(F, l, false, true); __syncthreads(); } const Frame F = refresh(F0); if (MK_PER_PHASE) moe_prefix(F, l); else __syncthreads(); ln_combine_phase(F, l, l == DEPTH - 1, false); }
        SEAM(pb + 8);
    }
#undef IN
#undef SEAM
}

extern "C" void kernel_launch(void* const* d_in, const int* in_sizes, int n_in, void* d_out, int out_size, void* d_ws, size_t ws_size, hipStream_t stream) {
    static int grid = 0;
    if (grid == 0) {
        if (n_in != 20 || out_size != T * D || ws_size < WS_END) { fprintf(stderr, "kernel_launch: unexpected problem (n_in %d out %d ws %zu)\n", n_in, out_size, ws_size); grid = -1; return; }
        int dev = 0, cus = 0, per_cu = 0;
        if (hipGetDevice(&dev) != hipSuccess || hipDeviceGetAttribute(&cus, hipDeviceAttributeMultiprocessorCount, dev) != hipSuccess) { grid = -1; return; }
        if (hipFuncSetAttribute((const void*)fwd_kernel, hipFuncAttributeMaxDynamicSharedMemorySize, LDS_BYTES) != hipSuccess) { fprintf(stderr, "kernel_launch: hipFuncSetAttribute failed\n"); grid = -1; return; }
        if (hipOccupancyMaxActiveBlocksPerMultiprocessor(&per_cu, (const void*)fwd_kernel, NTHR, LDS_BYTES) != hipSuccess || per_cu < 1) fprintf(stderr, "kernel_launch: occupancy query reports %d\n", per_cu);
        (void)hipGetLastError();
        grid = cus;
    }
    if (grid < 0) return;
    (void)hipMemsetAsync((char*)d_ws + WS_CTL, 0, CTL_ZERO_BYTES, stream);
    Args a; memset(&a, 0, sizeof(a));
    for (int i = 0; i < 20; ++i) a.in[i] = d_in[i];
    a.out = (float*)d_out; a.ws = (unsigned char*)d_ws;
#if MK_PER_PHASE
    for (int p = 0; p < N_PHASES; ++p) { a.ph_lo = p; a.ph_hi = p + 1; hipLaunchKernelGGL(fwd_kernel, dim3(grid), dim3(NTHR), LDS_BYTES, stream, a); }
#else
    a.ph_lo = 0; a.ph_hi = N_PHASES;
    hipLaunchKernelGGL(fwd_kernel, dim3(grid), dim3(NTHR), LDS_BYTES, stream, a);
#endif
    const hipError_t le = hipPeekAtLastError();
    if (le != hipSuccess) fprintf(stderr, "kernel_launch: launch failed: %s\n", hipGetErrorName(le));
}
```

```cpp
#include <hip/hip_runtime.h>
#include <cstdio>
#include <cstdint>
#include <cstring>

#define LAS __attribute__((address_space(3)))
#define GAS __attribute__((address_space(1)))
typedef unsigned short bf16_t;
typedef short bf16x8 __attribute__((ext_vector_type(8)));
typedef short s16x4 __attribute__((ext_vector_type(4)));
typedef float f32x2 __attribute__((ext_vector_type(2)));
typedef float f32x4 __attribute__((ext_vector_type(4)));
typedef float f32x16 __attribute__((ext_vector_type(16)));
typedef unsigned u32x2 __attribute__((ext_vector_type(2)));
typedef unsigned u32x4 __attribute__((ext_vector_type(4)));
typedef int i32x4 __attribute__((ext_vector_type(4)));
typedef int i32x8 __attribute__((ext_vector_type(8)));

#ifndef MK_PER_PHASE
#define MK_PER_PHASE 0
#endif

constexpr int NB = 4, SEQ = 8192, T = NB * SEQ, D = 1024, DEPTH = 4;
constexpr int MH = 8, MDV = 128, MDK = 64, MCH = 64, MNC = SEQ / MCH, MIN_ = 3088, MUNITS = NB * MH * MNC;
constexpr int AH = 8, AQL = 384, AKL = 256, ANOPE = 128, AROPE = 64, AV = 128, AIN = 704, AINP = 768, AQD = 192;
constexpr int NE = 32, TOPK = 4, DFF = 1024;
constexpr float DN_ALPHA = 1.6817928305074290f;
constexpr float LN_EPS = 1e-5f, RMS_EPS = 1e-6f;
constexpr int MOE_ROWS = 139264;

constexpr size_t MiB = 1ull << 20;
constexpr size_t WS_CTL = 0, CTL_ZERO_BYTES = 128 * 1024;
constexpr size_t WS_COS = 1 * MiB, WS_SIN = 5 * MiB, WS_GATES = 9 * MiB, WS_TOKINFO = 11 * MiB, WS_TOKGATE = 11 * MiB + 512 * 1024, WS_LIST = 12 * MiB;
constexpr size_t WS_GIMG = 16 * MiB + 128 * 1024  , WS_RIMG = 16 * MiB + 256 * 1024  , WS_RCV = 16 * MiB + 768 * 1024  , WS_MSC = 16 * MiB, WS_NLOC = 17 * MiB, WS_NPREV = 18 * MiB, WS_LNST = 19 * MiB  ;
constexpr size_t WS_WINM = 20 * MiB, WS_WOUTM = 32 * MiB, WS_WINA = 36 * MiB, WS_WQB = 39 * MiB, WS_WKV = 42 * MiB, WS_WOUTA = 44 * MiB;
constexpr size_t WS_WINM8 = 48 * MiB  ;
constexpr size_t WS_WGU = 64 * MiB, WS_WD = 576 * MiB;
constexpr size_t WS_XM = 832 * MiB, WS_XF = 832 * MiB, WS_ZF = 960 * MiB, WS_XB = 1088 * MiB, WS_PROJ = 1152 * MiB;
constexpr size_t WS_A32 = WS_PROJ, WS_CQ = WS_PROJ + 96 * MiB, WS_CKV = WS_PROJ + 120 * MiB, WS_KR = WS_PROJ + 136 * MiB;
constexpr size_t WS_QB = 1344 * MiB, WS_CLOC = WS_QB, WS_KN = 1472 * MiB, WS_CPREV = WS_KN, WS_VT = 1536 * MiB, WS_HB = 1600 * MiB;
constexpr size_t WS_HMOE = 1664 * MiB, WS_YMOE = 1936 * MiB, WS_XB8 = 2208 * MiB, WS_END = 2240 * MiB;
constexpr int CW_BAR = 4096, CW_CNT = 16384;

constexpr int RING_BYTES = 147456;
constexpr int MISC_OFF = RING_BYTES;
constexpr int LDS_BYTES = RING_BYTES + 1024;
constexpr int NWAVES = 8, NTHR = 512;

__device__ __forceinline__ unsigned cvt_pk_bf16(float lo, float hi) { unsigned r; asm("v_cvt_pk_bf16_f32 %0, %1, %2" : "=v"(r) : "v"(lo), "v"(hi)); return r; }
__device__ __forceinline__ float bf_lo(unsigned w) { return __uint_as_float(w << 16); }
__device__ __forceinline__ float bf_hi(unsigned w) { return __uint_as_float(w & 0xffff0000u); }
template <int CTRL> __device__ __forceinline__ float dpp_mov(float v) { return __int_as_float(__builtin_amdgcn_update_dpp(0, __float_as_int(v), CTRL, 0xf, 0xf, true)); }
__device__ __forceinline__ float xor16(float v, float& other) { const u32x2 r = __builtin_amdgcn_permlane16_swap(__float_as_uint(v), __float_as_uint(v), false, false); other = __uint_as_float(r.y); return __uint_as_float(r.x); }
__device__ __forceinline__ float xor32(float v, float& other) { const u32x2 r = __builtin_amdgcn_permlane32_swap(__float_as_uint(v), __float_as_uint(v), false, false); other = __uint_as_float(r.y); return __uint_as_float(r.x); }
__device__ __forceinline__ float wave_sum(float v) {
    v += dpp_mov<0xB1>(v); v += dpp_mov<0x4E>(v); v += dpp_mov<0x141>(v); v += dpp_mov<0x140>(v);
    float o; v = xor16(v, o) + o; v = xor32(v, o) + o;
    return v;
}
__device__ __forceinline__ float wave_max(float v) {
    v = fmaxf(v, dpp_mov<0xB1>(v)); v = fmaxf(v, dpp_mov<0x4E>(v)); v = fmaxf(v, dpp_mov<0x141>(v)); v = fmaxf(v, dpp_mov<0x140>(v));
    float o; v = xor16(v, o); v = fmaxf(v, o); v = xor32(v, o); v = fmaxf(v, o);
    return v;
}
__device__ __forceinline__ float max_x32(float v) { float o; const float a = xor32(v, o); return fmaxf(a, o); }
__device__ __forceinline__ float sum_x32(float v) { float o; const float a = xor32(v, o); return a + o; }
#ifndef DUP_EPI
#define DUP_EPI 0
#endif
#ifndef PG8_SP2
#define PG8_SP2 0
#endif
#ifndef MOE_FP8
#define MOE_FP8 1
#endif
constexpr float F8_SX = 16.f, F8_SWG = 256.f, F8_SH = 4.f, F8_SWD = 512.f;
#ifndef DF8_M1
#define DF8_M1 0
#endif
#ifndef DF8_A1
#define DF8_A1 1
#endif
#ifndef DF8_O5
#define DF8_O5 1
#endif
#ifndef DF8_MV
#define DF8_MV 1
#endif
#ifndef DENSE_FP8
#define DENSE_FP8 (DF8_M1 || DF8_MV || DF8_A1)
#endif
constexpr float F8_SHB = 16.f, F8_SWI = 256.f, F8_SWO = 512.f;
#ifndef MVT
#define MVT 1
#endif
static_assert(!(DF8_MV && (DF8_M1 || !MVT)), "DF8_MV: the split in-projection needs MVT and a bf16 q/k part");
#ifndef XM_RECOMP
#define XM_RECOMP 1
#endif
#ifndef RT_BF16
#define RT_BF16 1
#endif
#ifndef ZF_BF16
#define ZF_BF16 1
#endif
static_assert(!(RT_BF16 && !ZF_BF16), "RT_BF16 reads z as bf16");
static_assert(!(XM_RECOMP && !ZF_BF16), "XM_RECOMP reads z as bf16");
#ifndef CV_IN_ATTN
#define CV_IN_ATTN 1
#endif
#ifndef ATT_FP8
#define ATT_FP8 1
#endif
#ifndef Y_FP8
#define Y_FP8 1
#endif
constexpr float F8_SY = 64.f;
constexpr float F8_SQ = 64.f, F8_SK = 16.f, F8_SV = 16.f, F8_SP = 128.f;
#ifndef F8_SWCVT
#define F8_SWCVT 0
#endif
__device__ __forceinline__ unsigned f32_to_e4m3_sw(float x) {
    const unsigned b = __float_as_uint(x), sgn = (b >> 24) & 0x80u; const float ax = fabsf(x);
    if (ax < 0.015625f) return sgn | (unsigned)__builtin_rintf(ax * 512.0f);
    unsigned u = b & 0x7fffffffu; u += 0x7ffffu + ((u >> 20) & 1u);
    const unsigned e8 = (u >> 23) - 120u, m = (u >> 20) & 7u; unsigned enc = (e8 << 3) | m; enc = enc > 0x7eu ? 0x7eu : enc;
    return sgn | enc;
}
__device__ __forceinline__ unsigned cvt4_fp8(float a, float b, float c, float d) {
#if F8_SWCVT
    return f32_to_e4m3_sw(a) | (f32_to_e4m3_sw(b) << 8) | (f32_to_e4m3_sw(c) << 16) | (f32_to_e4m3_sw(d) << 24);
#else
    int w = __float_as_int(a);
    w = __builtin_amdgcn_cvt_pk_fp8_f32(a, b, w, false); w = __builtin_amdgcn_cvt_pk_fp8_f32(c, d, w, true); return (unsigned)w;
#endif
}
#define LDS_WAIT() asm volatile("s_waitcnt lgkmcnt(0)" ::: "memory")
#define VM_WAIT() asm volatile("s_waitcnt vmcnt(0)" ::: "memory")

#define XB_TMO      128
#define XB_XCNT(j)  (256  + 64 * (j))
#define XB_XSUB(j)  (1280 + 64 * (j))
#define XB_XGEN(j)  (2304 + 64 * (j))
#define XB_TOP      3328
#define XB_TOPGEN   3392
#define XCD_BAR_WORDS 3456
#define XB_SPIN_CAP (1u << 18)
__device__ __forceinline__ unsigned xb_ld(unsigned* p)              { return __hip_atomic_load(p, __ATOMIC_RELAXED, __HIP_MEMORY_SCOPE_AGENT); }
__device__ __forceinline__ unsigned xb_add(unsigned* p, unsigned v) { return __hip_atomic_fetch_add(p, v, __ATOMIC_RELAXED, __HIP_MEMORY_SCOPE_AGENT); }
__device__ __forceinline__ unsigned xb_xcc_id() { return (unsigned)__builtin_amdgcn_s_getreg((3 << 11) | 20) & 0xFu; }
#define XB_SPIN(cond, bar) do { unsigned _sp = 0; while (cond) { __builtin_amdgcn_s_sleep(1); \
    if ((++_sp & 255u) == 0u) { if (xb_ld(&(bar)[XB_TMO])) break; if (_sp > XB_SPIN_CAP) { atomicAdd(&(bar)[XB_TMO], 1u); break; } } } } while (0)
struct XcdBarrier { unsigned* bar; unsigned x; volatile LAS unsigned* st; };
__device__ __forceinline__ XcdBarrier xcd_barrier_post(unsigned* bar, volatile LAS unsigned* st) {
    XcdBarrier b; b.bar = bar; b.x = xb_xcc_id(); b.st = st;
    if (threadIdx.x == 0) (void)xb_add(&bar[XB_XCNT(b.x)], 1u);
    return b;
}
__device__ __forceinline__ void xcd_barrier_complete(unsigned* bar, unsigned x, unsigned& nloc, unsigned& nx) {
    const unsigned G = gridDim.x * gridDim.y * gridDim.z;
    unsigned sum, cnt, mine, sp = 0u;
    for (;;) {
        sum = 0u; cnt = 0u; mine = 0u;
#pragma unroll
        for (unsigned j = 0; j < 16; ++j) { const unsigned c = xb_ld(&bar[XB_XCNT(j)]); sum += c; cnt += (c > 0u) ? 1u : 0u; mine = (j == x) ? c : mine; }
        if (sum == G) break;
        __builtin_amdgcn_s_sleep(1);
        if ((++sp & 255u) == 0u) { if (xb_ld(&bar[XB_TMO])) break; if (sp > XB_SPIN_CAP) { atomicAdd(&bar[XB_TMO], 1u); break; } }
    }
    nloc = mine > 0u ? mine : 1u; nx = cnt > 0u ? cnt : 1u;
}
__device__ __forceinline__ void xcd_barrier(const XcdBarrier& b) {
    asm volatile("s_waitcnt vmcnt(0)" ::: "memory");
    __syncthreads();
    if (threadIdx.x == 0) {
        unsigned* bar = b.bar;
        __builtin_amdgcn_s_waitcnt(0);
        unsigned nloc = b.st[0], nx = b.st[1];
        if (nloc == 0u) { xcd_barrier_complete(bar, b.x, nloc, nx); b.st[0] = nloc; b.st[1] = nx; }
        const unsigned old = xb_add(&bar[XB_XSUB(b.x)], 1u);
        const unsigned gen = old / nloc;
        if (old + 1u == (gen + 1u) * nloc) {
            __builtin_amdgcn_fence(__ATOMIC_RELEASE, "agent");
            asm volatile("s_waitcnt vmcnt(0)" ::: "memory");
            const unsigned og = xb_add(&bar[XB_TOP], 1u);
            const unsigned tg = og / nx;
            if (og + 1u == (tg + 1u) * nx) xb_add(&bar[XB_TOPGEN], 1u);
            else XB_SPIN(xb_ld(&bar[XB_TOPGEN]) == tg, bar);
            __builtin_amdgcn_fence(__ATOMIC_ACQUIRE, "agent");
            xb_add(&bar[XB_XGEN(b.x)], 1u);
            asm volatile("s_waitcnt vmcnt(0)" ::: "memory");
        } else {
            XB_SPIN(xb_ld(&bar[XB_XGEN(b.x)]) == gen, bar);
            __builtin_amdgcn_fence(__ATOMIC_ACQUIRE, "agent");
            asm volatile("s_waitcnt vmcnt(0)" ::: "memory");
        }
    }
    __syncthreads();
}

namespace pg8 {
constexpr int BM = 256, BK = 64, HALF = 128, HTB = HALF * BK * 2, STAGE_BYTES = 8 * HTB;
__host__ __device__ __forceinline__ int lds_byte(int r, int c) { const int st = (r >> 4) * 2 + (c >> 5), rr = r & 15, cc = c & 31, ob = rr * 64 + cc * 2; return st * 1024 + (ob ^ (((ob >> 9) & 1) << 5)); }
__host__ __device__ __forceinline__ void stage_rc(int b, int& R, int& C) { const int st = b / 1024, sb = b % 1024, swz = sb ^ (((sb >> 9) & 1) << 5); R = (st >> 1) * 16 + swz / 64; C = (st & 1) * 32 + (swz % 64) / 2; }
__host__ __device__ __forceinline__ int perm32(int rho) { const int n = rho >> 4, i = rho & 15; return 8 * (i >> 2) + 4 * n + (i & 3); }

constexpr int BIAS_LDS_OFF = 131072 + 2048;
struct Unit { int pm, pn, aux, nvalid; const char* A; const char* B; const int* rows; int par = 0; };

template <class Epi, class Sched, bool GATHER, bool FP8 = false, bool SP2 = (PG8_SP2 != 0)>
__device__ __forceinline__ void gemm_phase(LAS unsigned char* lds, const int tid, const int K, const int lda, const int ldb, const Sched& S, const Epi& E) {
    const int wid = __builtin_amdgcn_readfirstlane(tid >> 6), lane = tid & 63, wr = wid >> 2, wc = wid & 3, fr = lane & 15, fq = lane >> 4;
    constexpr int ESZ = FP8 ? 1 : 2;
    const int nt = K * ESZ / (BK * 2);
    int RC[2];
    unsigned offB[2], offA[2], gAc[2][2];
#pragma unroll
    for (int i = 0; i < 2; ++i) { int R, C; stage_rc(tid * 16 + i * 8192, R, C); RC[i] = (R << 8) | (2 * C); const int Rb = Epi::PERM ? ((R & ~31) + perm32(R & 31)) : R;
        offB[i] = (unsigned)(Rb * ldb * ESZ + C * 2); offA[i] = (unsigned)(R * lda * ESZ + C * 2);
#pragma unroll
        for (int h = 0; h < 2; ++h) gAc[h][i] = offA[i]; }
    const size_t hstepA = (size_t)HALF * lda * ESZ, hstepB = (size_t)HALF * ldb * ESZ;
    const size_t kstep = (size_t)(BK * 2);
    const unsigned ldsw = (unsigned)wid * 1024u;
    const int aoff = lds_byte(wr * 64 + fr, fq * 8), boff = lds_byte(wc * 32 + fr, fq * 8);
#define PG8_SA(b, h) (((b) * 2 + (h)) * HTB)
#define PG8_SB(b, h) ((4 + (b) * 2 + (h)) * HTB)
#define PG8_STAGE(bufoff, gbase, voff) do { _Pragma("unroll") for (int _i = 0; _i < 2; ++_i) \
        __builtin_amdgcn_global_load_lds((const unsigned*)((const char*)(gbase) + (voff)[_i]), (LAS unsigned*)(lds + (bufoff) + ldsw + _i * 8192), 16, 0, 0); } while (0)
#define PG8_STAGEA(bufoff, gbase, h, G) do { if constexpr (GATHER) { PG8_STAGE(bufoff, gbase, G[h]); } else { PG8_STAGE(bufoff, (gbase) + (h) * hstepA, offA); } } while (0)
#define PG8_STAGEA2(bufoff, gbase, h) PG8_STAGEA(bufoff, gbase, h, gAc)
#define PG8_LDA(dst, b, h) do { _Pragma("unroll") for (int m = 0; m < 4; ++m) { dst[m].lo = *(const LAS i32x4*)(lds + PG8_SA(b, h) + aoff + m * 2048); dst[m].hi = *(const LAS i32x4*)(lds + PG8_SA(b, h) + aoff + m * 2048 + 1024); } } while (0)
#define PG8_LDB(dst, b, h) do { _Pragma("unroll") for (int n = 0; n < 2; ++n) { dst[n].lo = *(const LAS i32x4*)(lds + PG8_SB(b, h) + boff + n * 2048); dst[n].hi = *(const LAS i32x4*)(lds + PG8_SB(b, h) + boff + n * 2048 + 1024); } } while (0)
#define PG8_MMA(ai, bj, At, Bt) do { __builtin_amdgcn_s_setprio(1); _Pragma("unroll") for (int m = 0; m < 4; ++m) _Pragma("unroll") for (int n = 0; n < 2; ++n) { \
        if constexpr (FP8) { asm volatile("v_mfma_f32_16x16x128_f8f6f4 %0, %1, %2, %0" : "+v"(acc[ai][bj][m][n]) : "v"(Bt[n]), "v"(At[m])); }     \
        else { const i32x4 _bl = Bt[n].lo, _bh = Bt[n].hi, _al = At[m].lo, _ah = At[m].hi;     \
               acc[ai][bj][m][n] = __builtin_amdgcn_mfma_f32_16x16x32_bf16(__builtin_bit_cast(bf16x8, _bl), __builtin_bit_cast(bf16x8, _al), acc[ai][bj][m][n], 0, 0, 0); \
               acc[ai][bj][m][n] = __builtin_amdgcn_mfma_f32_16x16x32_bf16(__builtin_bit_cast(bf16x8, _bh), __builtin_bit_cast(bf16x8, _ah), acc[ai][bj][m][n], 0, 0, 0); } } \
        __builtin_amdgcn_s_setprio(0); } while (0)
#define PG8_WAIT_V(n) asm volatile("s_waitcnt vmcnt(" #n ")" ::: "memory")
#define PG8_WAIT_L(n) asm volatile("s_waitcnt lgkmcnt(" #n ")" ::: "memory")
#define PG8_BAR __builtin_amdgcn_s_barrier()
#define PG8_SCHED __builtin_amdgcn_sched_barrier(0)
#define PG8_GATHER_LD(U, TOK) do { _Pragma("unroll") for (int _h = 0; _h < 2; ++_h) _Pragma("unroll") for (int _i = 0; _i < 2; ++_i) { const int _r = _h * HALF + (RC[_i] >> 8); \
        TOK[_h][_i] = ((const GAS int*)(U).rows)[_r < (U).nvalid ? _r : 0]; } } while (0)
#define PG8_GATHER_CV(TOK, OFF) do { _Pragma("unroll") for (int _h = 0; _h < 2; ++_h) _Pragma("unroll") for (int _i = 0; _i < 2; ++_i) OFF[_h][_i] = (unsigned)(TOK[_h][_i] * lda * ESZ + (RC[_i] & 0xff)); } while (0)
#define PG8_GATHER(U, OFF) do { _Pragma("unroll") for (int _h = 0; _h < 2; ++_h) _Pragma("unroll") for (int _i = 0; _i < 2; ++_i) { const int _r = _h * HALF + (RC[_i] >> 8); \
        const int _tok = ((const GAS int*)(U).rows)[_r < (U).nvalid ? _r : 0]; OFF[_h][_i] = (unsigned)(_tok * lda * ESZ + (RC[_i] & 0xff)); } } while (0)
    Unit cur, nxt; int ui = 0;
    if (!S.next(0, cur)) return;
    f32x4 acc[2][2][4][2];
#pragma unroll
    for (int a = 0; a < 2; ++a)
#pragma unroll
        for (int b = 0; b < 2; ++b)
#pragma unroll
            for (int m = 0; m < 4; ++m)
#pragma unroll
                for (int n = 0; n < 2; ++n) acc[a][b][m][n] = (f32x4){0.f, 0.f, 0.f, 0.f};
    i32x8 At[4], B0[2], B1[2];
    const char* cA = cur.A; const char* cB = cur.B;
    if constexpr (GATHER) { PG8_GATHER(cur, gAc); }
    if constexpr (SP2) {
        PG8_STAGE(PG8_SB(0, 0), cB, offB); PG8_STAGE(PG8_SB(0, 1), cB + hstepB, offB); PG8_STAGEA(PG8_SA(0, 0), cA, 0, gAc); PG8_STAGEA(PG8_SA(0, 1), cA, 1, gAc);
        if (wr == 1) PG8_BAR;
        PG8_WAIT_V(2); PG8_BAR;
        PG8_STAGE(PG8_SB(1, 0), cB + kstep, offB); PG8_STAGEA(PG8_SA(1, 0), cA + kstep, 0, gAc); PG8_STAGE(PG8_SB(1, 1), cB + kstep + hstepB, offB);
        PG8_WAIT_V(6); PG8_BAR;
    } else {
    PG8_STAGE(PG8_SB(0, 0), cB, offB); PG8_STAGEA(PG8_SA(0, 0), cA, 0, gAc); PG8_STAGE(PG8_SB(0, 1), cB + hstepB, offB); PG8_STAGEA(PG8_SA(0, 1), cA, 1, gAc);
    if (wr == 1) PG8_BAR;
    PG8_WAIT_V(4); PG8_BAR;
    PG8_STAGE(PG8_SB(1, 0), cB + kstep, offB); PG8_STAGEA(PG8_SA(1, 0), cA + kstep, 0, gAc); PG8_STAGE(PG8_SB(1, 1), cB + kstep + hstepB, offB);
    PG8_WAIT_V(6); PG8_BAR;
    }
    for (;;) {
        const bool has_next = S.next(ui + 1, nxt);
        cur.par = ui & 1;
        if constexpr (Epi::BIASLDS) { if (wid == 0) { int l2; asm volatile("v_mbcnt_lo_u32_b32 %0, -1, 0\n\tv_mbcnt_hi_u32_b32 %0, -1, %0" : "=v"(l2)); E.prefetch(cur, ui & 1, l2); } }
        const char* nA = has_next ? nxt.A : cA; const char* nB = has_next ? nxt.B : cB;
#pragma unroll 1
        for (int t = 0; t < nt; t += 2) {
            const bool last = (t == nt - 2);
            const char* a1 = cA + (size_t)(t + 1) * kstep;
            const char* a2 = last ? nA : cA + (size_t)(t + 2) * kstep; const char* b2 = last ? nB : cB + (size_t)(t + 2) * kstep;
            const char* a3 = a2 + kstep; const char* b3 = b2 + kstep;
            int tokn[2][2];
            if constexpr (GATHER) { if (last && has_next) { PG8_GATHER_LD(nxt, tokn); } }
            if constexpr (SP2) {
            PG8_LDB(B0, 0, 0); PG8_LDB(B1, 0, 1); PG8_SCHED; PG8_LDA(At, 0, 0); PG8_STAGEA(PG8_SA(1, 1), a1, 1, gAc);
            PG8_WAIT_V(8); PG8_WAIT_L(0); PG8_BAR; PG8_MMA(0, 0, At, B0); PG8_MMA(0, 1, At, B1); PG8_BAR; PG8_SCHED;
            if constexpr (GATHER) { if (last && has_next) { PG8_GATHER_CV(tokn, gAc); } }
            PG8_LDA(At, 0, 1); PG8_STAGE(PG8_SB(0, 0), b2, offB); PG8_STAGE(PG8_SB(0, 1), b2 + hstepB, offB); PG8_STAGEA2(PG8_SA(0, 0), a2, 0);
            PG8_WAIT_V(8); PG8_WAIT_L(0); PG8_BAR; PG8_MMA(1, 0, At, B0); PG8_MMA(1, 1, At, B1); PG8_BAR; PG8_SCHED;
            PG8_LDB(B0, 1, 0); PG8_LDB(B1, 1, 1); PG8_SCHED; PG8_LDA(At, 1, 0); PG8_STAGEA2(PG8_SA(0, 1), a2, 1);
            PG8_WAIT_V(8); PG8_WAIT_L(0); PG8_BAR; PG8_MMA(0, 0, At, B0); PG8_MMA(0, 1, At, B1); PG8_BAR; PG8_SCHED;
            PG8_LDA(At, 1, 1); PG8_STAGE(PG8_SB(1, 0), b3, offB); PG8_STAGE(PG8_SB(1, 1), b3 + hstepB, offB); PG8_STAGEA2(PG8_SA(1, 0), a3, 0);
            PG8_WAIT_V(8); PG8_WAIT_L(0); PG8_BAR; PG8_MMA(1, 0, At, B0); PG8_MMA(1, 1, At, B1); PG8_BAR; PG8_SCHED;
            } else {
            PG8_LDB(B0, 0, 0); PG8_SCHED; PG8_LDA(At, 0, 0); PG8_STAGEA(PG8_SA(1, 1), a1, 1, gAc);
            PG8_WAIT_L(8); PG8_BAR; PG8_WAIT_L(0); PG8_MMA(0, 0, At, B0); PG8_BAR; PG8_SCHED;
            if constexpr (GATHER) { if (last && has_next) { PG8_GATHER_CV(tokn, gAc); } }
            PG8_LDB(B1, 0, 1); PG8_STAGE(PG8_SB(0, 0), b2, offB);
            PG8_BAR; PG8_WAIT_L(0); PG8_MMA(0, 1, At, B1); PG8_BAR;
            PG8_LDA(At, 0, 1); PG8_STAGEA2(PG8_SA(0, 0), a2, 0);
            PG8_BAR; PG8_WAIT_L(0); PG8_MMA(1, 0, At, B0); PG8_BAR; PG8_SCHED;
            PG8_STAGE(PG8_SB(0, 1), b2 + hstepB, offB);
            PG8_WAIT_V(6); PG8_BAR; PG8_MMA(1, 1, At, B1); PG8_BAR;
            PG8_LDB(B0, 1, 0); PG8_SCHED; PG8_LDA(At, 1, 0); PG8_STAGEA2(PG8_SA(0, 1), a2, 1);
            PG8_WAIT_L(8); PG8_BAR; PG8_WAIT_L(0); PG8_MMA(0, 0, At, B0); PG8_BAR; PG8_SCHED;
            PG8_LDB(B1, 1, 1); PG8_STAGE(PG8_SB(1, 0), b3, offB);
            PG8_BAR; PG8_WAIT_L(0); PG8_MMA(0, 1, At, B1); PG8_BAR;
            PG8_LDA(At, 1, 1); PG8_STAGEA2(PG8_SA(1, 0), a3, 0);
            PG8_BAR; PG8_WAIT_L(0); PG8_MMA(1, 0, At, B0); PG8_BAR; PG8_SCHED;
            PG8_STAGE(PG8_SB(1, 1), b3 + hstepB, offB);
            PG8_WAIT_V(6); PG8_BAR; PG8_MMA(1, 1, At, B1); PG8_BAR;
            }
        }
        if constexpr (FP8) asm volatile("s_nop 15" ::: "memory");
        { int l2; asm volatile("v_mbcnt_lo_u32_b32 %0, -1, 0\n\tv_mbcnt_hi_u32_b32 %0, -1, %0" : "=v"(l2)); E(acc, cur, wr, wc, l2 & 15, l2 >> 4); if (DUP_EPI && FP8) { asm volatile("" ::: "memory"); E(acc, cur, wr, wc, l2 & 15, l2 >> 4); } }
        if (!has_next) break;
#pragma unroll
        for (int a = 0; a < 2; ++a)
#pragma unroll
            for (int b = 0; b < 2; ++b)
#pragma unroll
                for (int m = 0; m < 4; ++m)
#pragma unroll
                    for (int n = 0; n < 2; ++n) acc[a][b][m][n] = (f32x4){0.f, 0.f, 0.f, 0.f};
        cur = nxt; cA = nA; cB = nB; ++ui;
    }
    PG8_WAIT_V(0);
    if (wr == 0) PG8_BAR;
    PG8_BAR;
#undef PG8_SA
#undef PG8_SB
#undef PG8_STAGE
#undef PG8_LDA
#undef PG8_LDB
#undef PG8_MMA
#undef PG8_WAIT_V
#undef PG8_WAIT_L
#undef PG8_BAR
#undef PG8_SCHED
#undef PG8_GATHER
#undef PG8_GATHER_LD
#undef PG8_GATHER_CV
#undef PG8_STAGEA
#undef PG8_STAGEA2
}
}
namespace pg8 {
__device__ __forceinline__ u32x4 widen16(u32x2 we, u32x2 wo) {
    const u32x2 r0 = __builtin_amdgcn_permlane16_swap(we.x, wo.x, false, false), r1 = __builtin_amdgcn_permlane16_swap(we.y, wo.y, false, false);
    return (u32x4){r0.x, r1.x, r0.y, r1.y};
}
struct EpiBf16 {
    static constexpr bool PERM = true; static constexpr bool BIASLDS = false;
    bf16_t* O; int ldc; float scale;
    __device__ __forceinline__ void operator()(const f32x4 (&acc)[2][2][4][2], const Unit& u, int wr, int wc, int fr, int fq) const {
        const int row0 = u.pm * BM + wr * 64 + fr, col0 = u.pn * BM + wc * 32 + 8 * fq;
#pragma unroll
        for (int ai = 0; ai < 2; ++ai)
#pragma unroll
            for (int m = 0; m < 4; ++m) { bf16_t* rowp = O + (size_t)(row0 + ai * HALF + m * 16) * ldc + col0;
#pragma unroll
                for (int bj = 0; bj < 2; ++bj) { const f32x4 v0 = acc[ai][bj][m][0] * scale, v1 = acc[ai][bj][m][1] * scale;
                    u32x4 w; w.x = cvt_pk_bf16(v0[0], v0[1]); w.y = cvt_pk_bf16(v0[2], v0[3]); w.z = cvt_pk_bf16(v1[0], v1[1]); w.w = cvt_pk_bf16(v1[2], v1[3]);
                    *(u32x4*)(rowp + bj * HALF) = w; } }
    }
};
struct EpiVT {
    static constexpr bool PERM = true; static constexpr bool BIASLDS = false;
    bf16_t* O; int ldc; float scale = 1.0f;
    __device__ __forceinline__ void operator()(const f32x4 (&acc)[2][2][4][2], const Unit& u, int wr, int wc, int fr, int fq) const {
        const int row0 = u.pm * BM + wr * 64 + fr, col0 = u.pn * BM + wc * 32 + 8 * fq;
        const int cb = col0 & ~15, g = (col0 >> 2) & 3;
        const int s0 = cb + ((g == 0) ? 0 : 4), s1 = cb + ((g == 0) ? 8 : 12);
#pragma unroll
        for (int ai = 0; ai < 2; ++ai)
#pragma unroll
            for (int m = 0; m < 4; ++m) { bf16_t* rowp = O + (size_t)(row0 + ai * HALF + m * 16) * ldc;
#pragma unroll
                for (int bj = 0; bj < 2; ++bj) { const f32x4 v0 = acc[ai][bj][m][0] * scale, v1 = acc[ai][bj][m][1] * scale;
                    u32x2 w0, w1; w0.x = cvt_pk_bf16(v0[0], v0[1]); w0.y = cvt_pk_bf16(v0[2], v0[3]); w1.x = cvt_pk_bf16(v1[0], v1[1]); w1.y = cvt_pk_bf16(v1[2], v1[3]);
                    *(u32x2*)(rowp + bj * HALF + s0) = w0; *(u32x2*)(rowp + bj * HALF + s1) = w1; } }
    }
};
struct EpiF8 {
    static constexpr bool PERM = true; static constexpr bool BIASLDS = false;
    unsigned char* O; int ldc; float scale;
    __device__ __forceinline__ void operator()(const f32x4 (&acc)[2][2][4][2], const Unit& u, int wr, int wc, int fr, int fq) const {
        const int row0 = u.pm * BM + wr * 64 + fr, col0 = u.pn * BM + wc * 32 + 8 * fq;
#pragma unroll
        for (int ai = 0; ai < 2; ++ai)
#pragma unroll
            for (int m = 0; m < 4; ++m) { unsigned char* rowp = O + (size_t)(row0 + ai * HALF + m * 16) * ldc + col0;
#pragma unroll
                for (int bj = 0; bj < 2; ++bj) { const f32x4 v0 = acc[ai][bj][m][0] * scale, v1 = acc[ai][bj][m][1] * scale;
                    u32x2 w; w.x = cvt4_fp8(v0[0], v0[1], v0[2], v0[3]); w.y = cvt4_fp8(v1[0], v1[1], v1[2], v1[3]); *(u32x2*)(rowp + bj * HALF) = w; } }
    }
};
struct EpiVT8 {
    static constexpr bool PERM = true; static constexpr bool BIASLDS = false;
    unsigned char* O; int ldc; float scale;
    __device__ __forceinline__ void operator()(const f32x4 (&acc)[2][2][4][2], const Unit& u, int wr, int wc, int fr, int fq) const {
        const int row0 = u.pm * BM + wr * 64 + fr, col0 = u.pn * BM + wc * 32 + 8 * fq;
#pragma unroll
        for (int ai = 0; ai < 2; ++ai)
#pragma unroll
            for (int m = 0; m < 4; ++m) { unsigned char* rowp = O + (size_t)(row0 + ai * HALF + m * 16) * ldc;
#pragma unroll
                for (int bj = 0; bj < 2; ++bj) { const int c = col0 + bj * HALF, p0 = (c & ~63) + 16 * ((c >> 5) & 1) + 4 * ((c & 31) >> 3);
                    const f32x4 v0 = acc[ai][bj][m][0] * scale, v1 = acc[ai][bj][m][1] * scale;
                    *(unsigned*)(rowp + p0) = cvt4_fp8(v0[0], v0[1], v0[2], v0[3]); *(unsigned*)(rowp + p0 + 32) = cvt4_fp8(v1[0], v1[1], v1[2], v1[3]); } }
    }
};
struct EpiF32 {
    static constexpr bool PERM = false; static constexpr bool BIASLDS = false;
    float* C; int ldc; float scale;
    __device__ __forceinline__ void operator()(const f32x4 (&acc)[2][2][4][2], const Unit& u, int wr, int wc, int fr, int fq) const {
        const int row0 = u.pm * BM + wr * 64 + fr, col0 = u.pn * BM + wc * 32 + 4 * fq;
#pragma unroll
        for (int ai = 0; ai < 2; ++ai)
#pragma unroll
            for (int m = 0; m < 4; ++m) { float* rowp = C + (size_t)(row0 + ai * HALF + m * 16) * ldc + col0;
#pragma unroll
                for (int bj = 0; bj < 2; ++bj)
#pragma unroll
                    for (int n = 0; n < 2; ++n) *(f32x4*)(rowp + bj * HALF + n * 16) = acc[ai][bj][m][n] * scale; }
    }
};
struct EpiResid {
    static constexpr bool PERM = true; static constexpr bool BIASLDS = false;
    const bf16_t* X; float* Z; int ldc; float alpha, ascale;
    __device__ __forceinline__ void operator()(const f32x4 (&acc)[2][2][4][2], const Unit& u, int wr, int wc, int fr, int fq) const {
        const int row0 = u.pm * BM + wr * 64 + fr, col0 = u.pn * BM + wc * 32 + 8 * fq;
        u32x4 xw[2][2];
#define ER_LOAD(g) do { const size_t off_ = (size_t)(row0 + ((g) >> 2) * HALF + ((g) & 3) * 16) * ldc + col0; \
            _Pragma("unroll") for (int bj = 0; bj < 2; ++bj) xw[(g) & 1][bj] = *(const u32x4*)(X + off_ + bj * HALF); } while (0)
        ER_LOAD(0);
#pragma unroll
        for (int g = 0; g < 8; ++g) { const int ai = g >> 2, m = g & 3; const size_t off = (size_t)(row0 + ai * HALF + m * 16) * ldc + col0;
            if (g + 1 < 8) ER_LOAD(g + 1);
            __builtin_amdgcn_sched_barrier(0);
#pragma unroll
            for (int bj = 0; bj < 2; ++bj) { const u32x4 x = xw[g & 1][bj];
                const f32x4 x0 = {bf_lo(x.x), bf_hi(x.x), bf_lo(x.y), bf_hi(x.y)}, x1 = {bf_lo(x.z), bf_hi(x.z), bf_lo(x.w), bf_hi(x.w)};
                const f32x4 z0 = x0 * alpha + acc[ai][bj][m][0] * ascale, z1 = x1 * alpha + acc[ai][bj][m][1] * ascale;
                if (ZF_BF16) { u32x4 w; w.x = cvt_pk_bf16(z0[0], z0[1]); w.y = cvt_pk_bf16(z0[2], z0[3]); w.z = cvt_pk_bf16(z1[0], z1[1]); w.w = cvt_pk_bf16(z1[2], z1[3]); *(u32x4*)((bf16_t*)Z + off + bj * HALF) = w; }
                else { *(f32x4*)(Z + off + bj * HALF) = z0; *(f32x4*)(Z + off + bj * HALF + 4) = z1; } }
            __builtin_amdgcn_sched_barrier(0); }
#undef ER_LOAD
    }
};
struct EpiQRope {
    static constexpr bool PERM = true; static constexpr bool BIASLDS = false;
    bf16_t* O; int ldc; const float* cosT; const float* sinT; float scale;
    __device__ __forceinline__ void operator()(const f32x4 (&acc)[2][2][4][2], const Unit& u, int wr, int wc, int fr, int fq) const {
        const int row0 = u.pm * BM + wr * 64 + fr, col0 = u.pn * BM + wc * 32 + 8 * fq;
        f32x4 cc[2][2], ss[2][2];
        const int rr0 = col0 % AQD, rr1 = (col0 + HALF) % AQD;
#define QR_LOAD(g) do { const unsigned row_ = (unsigned)(row0 + ((g) >> 2) * HALF + ((g) & 3) * 16); \
            _Pragma("unroll") for (int bj = 0; bj < 2; ++bj) { const int rr_ = bj ? rr1 : rr0; \
                if (rr_ >= ANOPE) { const unsigned tb_ = (row_ * 32u + (unsigned)((rr_ - ANOPE) >> 1)) * 4u; cc[(g) & 1][bj] = *(const f32x4*)((const char*)cosT + tb_); ss[(g) & 1][bj] = *(const f32x4*)((const char*)sinT + tb_); } } } while (0)
        QR_LOAD(0);
#pragma unroll
        for (int g = 0; g < 8; ++g) { const int ai = g >> 2, m = g & 3; const unsigned row = (unsigned)(row0 + ai * HALF + m * 16);
            if (g + 1 < 8) QR_LOAD(g + 1);
            __builtin_amdgcn_sched_barrier(0);
#pragma unroll
            for (int bj = 0; bj < 2; ++bj) { f32x4 v0 = acc[ai][bj][m][0] * scale, v1 = acc[ai][bj][m][1] * scale;
                const int col = col0 + bj * HALF, rr = bj ? rr1 : rr0;
                if (rr >= ANOPE) { const f32x4 c = cc[g & 1][bj], s = ss[g & 1][bj];
                    const f32x4 a0 = v0, a1 = v1;
                    v0[0] = a0[0] * c[0] - a0[1] * s[0]; v0[1] = a0[1] * c[0] + a0[0] * s[0]; v0[2] = a0[2] * c[1] - a0[3] * s[1]; v0[3] = a0[3] * c[1] + a0[2] * s[1];
                    v1[0] = a1[0] * c[2] - a1[1] * s[2]; v1[1] = a1[1] * c[2] + a1[0] * s[2]; v1[2] = a1[2] * c[3] - a1[3] * s[3]; v1[3] = a1[3] * c[3] + a1[2] * s[3]; }
                if (ATT_FP8) { u32x2 w; w.x = cvt4_fp8(v0[0], v0[1], v0[2], v0[3]); w.y = cvt4_fp8(v1[0], v1[1], v1[2], v1[3]); *(u32x2*)((char*)O + ((size_t)row * (unsigned)ldc + (unsigned)col)) = w; }
                else { u32x4 w; w.x = cvt_pk_bf16(v0[0], v0[1]); w.y = cvt_pk_bf16(v0[2], v0[3]); w.z = cvt_pk_bf16(v1[0], v1[1]); w.w = cvt_pk_bf16(v1[2], v1[3]);
                    *(u32x4*)((char*)O + ((size_t)row * (unsigned)ldc + (unsigned)col) * 2u) = w; } }
            __builtin_amdgcn_sched_barrier(0); }
#undef QR_LOAD
    }
};
struct EpiSwiglu {
    static constexpr bool PERM = true; static constexpr bool BIASLDS = true;
    unsigned char* Hh; const float* bgu; LAS unsigned char* lds;
    __device__ __forceinline__ void prefetch(const Unit& u, int par, int lane) const {
        __builtin_amdgcn_global_load_lds((const unsigned*)(bgu + (size_t)u.aux * 2048 + 2 * (u.pn * HALF) + 4 * lane), (LAS unsigned*)(lds + BIAS_LDS_OFF + par * 1024), 16, 0, 0); }
    __device__ __forceinline__ void operator()(const f32x4 (&acc)[2][2][4][2], const Unit& u, int wr, int wc, int fr, int fq) const {
        const int row0 = u.pm * BM + wr * 64 + fr, j0 = u.pn * HALF + wc * 32 + 8 * fq;
        const LAS f32x4* bp = (const LAS f32x4*)(lds + BIAS_LDS_OFF + u.par * 1024 + (64 * wc + 16 * fq) * 4);
        const f32x4 b0 = bp[0], b1 = bp[1], b2 = bp[2], b3 = bp[3];
        const float bg[8] = {b0[0], b0[2], b1[0], b1[2], b2[0], b2[2], b3[0], b3[2]}, bl[8] = {b0[1], b0[3], b1[1], b1[3], b2[1], b2[3], b3[1], b3[3]};
        constexpr float inv = MOE_FP8 ? 1.0f / (F8_SX * F8_SWG) : 1.0f;
#pragma unroll
        for (int ai = 0; ai < 2; ++ai)
#pragma unroll
            for (int mp = 0; mp < 2; ++mp) { u32x2 w8[2];
#pragma unroll
                for (int mo = 0; mo < 2; ++mo) { const int m = 2 * mp + mo; unsigned char* rowp = Hh + ((size_t)(row0 + ai * HALF + m * 16) * DFF + j0) * (MOE_FP8 ? 1 : 2);
                float o[8];
#pragma unroll
                for (int q = 0; q < 8; ++q) { float g = acc[ai][0][m][q >> 2][q & 3] * inv + bg[q], l = acc[ai][1][m][q >> 2][q & 3] * inv + bl[q];
                    g = fminf(g, 7.0f); l = fminf(fmaxf(l, -7.0f), 7.0f);
                    const float sg = __builtin_amdgcn_rcpf(1.0f + __builtin_amdgcn_exp2f(-1.702f * 1.4426950408889634f * g));
                    o[q] = (l + 1.0f) * g * sg * (MOE_FP8 ? F8_SH : 1.0f); }
                if (MOE_FP8) { w8[mo].x = cvt4_fp8(o[0], o[1], o[2], o[3]); w8[mo].y = cvt4_fp8(o[4], o[5], o[6], o[7]); }
                else { u32x4 w; w.x = cvt_pk_bf16(o[0], o[1]); w.y = cvt_pk_bf16(o[2], o[3]); w.z = cvt_pk_bf16(o[4], o[5]); w.w = cvt_pk_bf16(o[6], o[7]); *(u32x4*)rowp = w; } }
                if (MOE_FP8) { const u32x4 w16 = widen16(w8[0], w8[1]);
                    *(u32x4*)(Hh + (size_t)(row0 + ai * HALF + (2 * mp + (fq & 1)) * 16) * DFF + (j0 - 8 * fq) + 16 * (fq >> 1)) = w16; } }
    }
};
struct EpiDown {
    static constexpr bool PERM = true; static constexpr bool BIASLDS = true;
    bf16_t* Y; const float* bd; LAS unsigned char* lds;
    __device__ __forceinline__ void prefetch(const Unit& u, int par, int lane) const {
        __builtin_amdgcn_global_load_lds((const unsigned*)(bd + (size_t)u.aux * D + u.pn * BM + 4 * lane), (LAS unsigned*)(lds + BIAS_LDS_OFF + par * 1024), 16, 0, 0); }
    __device__ __forceinline__ void operator()(const f32x4 (&acc)[2][2][4][2], const Unit& u, int wr, int wc, int fr, int fq) const {
        const int row0 = u.pm * BM + wr * 64 + fr, col0 = u.pn * BM + wc * 32 + 8 * fq;
        const LAS f32x4* bp = (const LAS f32x4*)(lds + BIAS_LDS_OFF + u.par * 1024 + (wc * 32 + 8 * fq) * 4);
        constexpr float inv = MOE_FP8 ? 1.0f / (F8_SH * F8_SWD) : 1.0f;
#pragma unroll
        for (int bj = 0; bj < 2; ++bj) {
            const f32x4 b0 = bp[bj * (HALF / 4)], b1 = bp[bj * (HALF / 4) + 1];
#pragma unroll
            for (int ai = 0; ai < 2; ++ai)
#pragma unroll
                for (int mp = 0; mp < 2; ++mp) { u32x2 w8[2];
#pragma unroll
                    for (int mo = 0; mo < 2; ++mo) { const int m = 2 * mp + mo; const f32x4 v0 = acc[ai][bj][m][0] * inv + b0, v1 = acc[ai][bj][m][1] * inv + b1;
                    if (Y_FP8) { w8[mo].x = cvt4_fp8(v0[0] * F8_SY, v0[1] * F8_SY, v0[2] * F8_SY, v0[3] * F8_SY); w8[mo].y = cvt4_fp8(v1[0] * F8_SY, v1[1] * F8_SY, v1[2] * F8_SY, v1[3] * F8_SY); }
                    else { u32x4 w; w.x = cvt_pk_bf16(v0[0], v0[1]); w.y = cvt_pk_bf16(v0[2], v0[3]); w.z = cvt_pk_bf16(v1[0], v1[1]); w.w = cvt_pk_bf16(v1[2], v1[3]);
                        *(u32x4*)((char*)Y + ((size_t)(unsigned)(row0 + ai * HALF + m * 16) * D + (unsigned)(col0 + bj * HALF)) * 2u) = w; } }
                    if (Y_FP8) { const u32x4 w16 = widen16(w8[0], w8[1]);
                        *(u32x4*)((char*)Y + ((size_t)(unsigned)(row0 + ai * HALF + (2 * mp + (fq & 1)) * 16) * D + (unsigned)(col0 - 8 * fq + 16 * (fq >> 1) + bj * HALF))) = w16; } }
            asm volatile("" ::: "memory"); }
    }
};

struct DenseOrder {
    const char* A; const char* Bt; int nM, nN, G, c; size_t astep, bstep;
    int skip_at = 1 << 30, skip_n = 0;
    __device__ __forceinline__ void init(const void* A_, const void* Bt_, int M, int N, int lda, int ldb, int G_, int c_, int esz = 2) { A = (const char*)A_; Bt = (const char*)Bt_; nM = M / BM; nN = N / BM; G = G_; c = c_; astep = (size_t)BM * lda * esz; bstep = (size_t)BM * ldb * esz; }
    __device__ __forceinline__ bool next(int i, Unit& u) const {
        const int L = i * G + c; if (L >= nM * nN) return false;
        u.pm = L / nN; u.pn = L - u.pm * nN; if (u.pn >= skip_at) u.pn += skip_n;
        u.aux = 0; u.nvalid = 256; u.A = A + (size_t)u.pm * astep; u.B = Bt + (size_t)u.pn * bstep; u.rows = nullptr; return true;
    }
};
constexpr int MOE_UTAB_OFF = 131072;
struct MoeOrder {
    const volatile LAS int* utab; const char* A; const char* W; const int* list; int nunits; size_t wstep_e, astep;
    bool gather; size_t arow_step;
    __device__ __forceinline__ bool next(int i, Unit& u) const {
        if (i >= nunits) return false;
        const i32x4 ut = *(const LAS i32x4*)((const LAS int*)utab + 4 * i);
        const int rt = __builtin_amdgcn_readfirstlane(ut.x), pn = __builtin_amdgcn_readfirstlane(ut.y), er = __builtin_amdgcn_readfirstlane(ut.z), nv = __builtin_amdgcn_readfirstlane(ut.w);
        const int e = er & 0xff, rtl = er >> 8;
        u.pm = rt; u.pn = pn; u.aux = e; u.nvalid = nv; u.B = W + (size_t)e * wstep_e + (size_t)pn * astep;
        if (gather) { u.A = A; u.rows = list + (size_t)e * T + (size_t)rtl * 256; } else { u.A = A + (size_t)rt * arow_step; u.rows = nullptr; }
        return true;
    }
};
}
struct Args { const void* in[20]; float* out; unsigned char* ws; int ph_lo, ph_hi; };
struct Frame {
    LAS unsigned char* lds; volatile LAS unsigned* MISC;
    int tid, lane, wave, vcu, G;
    __device__ __forceinline__ const void* ptr(int i) const { const unsigned lo = __builtin_amdgcn_readfirstlane(MISC[128 + 2 * i]), hi = __builtin_amdgcn_readfirstlane(MISC[129 + 2 * i]);
        return (const void*)(const GAS char*)(((unsigned long long)hi << 32) | lo); }
    __device__ __forceinline__ unsigned char* ws() const { return (unsigned char*)ptr(21); }
    __device__ __forceinline__ float* out() const { return (float*)ptr(20); }
    __device__ __forceinline__ unsigned* ctl() const { return (unsigned*)ptr(21); }
};
__device__ __forceinline__ Frame refresh(const Frame& F) {
    Frame R = F; int ln, w = F.wave, v = F.vcu, g = F.G;
    asm volatile("v_mbcnt_lo_u32_b32 %0, -1, 0\n\tv_mbcnt_hi_u32_b32 %0, -1, %0" : "=v"(ln));
    asm volatile("" : "+s"(w), "+s"(v), "+s"(g));
    R.tid = w * 64 + ln; R.lane = ln; R.wave = w; R.vcu = v; R.G = g; return R;
}
enum { IN_X = 0, IN_POS, IN_LNG, IN_LNB, IN_MWIN, IN_MBG, IN_MNG, IN_MWOUT, IN_AWIN, IN_AQN, IN_AKVN, IN_AWQB, IN_AWKVB, IN_AWOUT, IN_RW, IN_RB, IN_WGU, IN_BGU, IN_WD, IN_BD };

template <class RowMap>
__device__ __forceinline__ void transpose_item(const float* __restrict__ W, int ldw, int K, bf16_t* __restrict__ WT, LAS float*, int kb, int nb, int lane, RowMap rm) {
    const int n4 = lane & 7, kg = lane >> 3, k0 = 64 * kb + 8 * kg, n0 = 32 * nb + 4 * n4;
    f32x4 v[8];
#pragma unroll
    for (int i = 0; i < 8; ++i) v[i] = *(const f32x4*)(W + (size_t)(k0 + i) * ldw + n0);
#pragma unroll
    for (int jn = 0; jn < 4; ++jn) { u32x4 o; o.x = cvt_pk_bf16(v[0][jn], v[1][jn]); o.y = cvt_pk_bf16(v[2][jn], v[3][jn]); o.z = cvt_pk_bf16(v[4][jn], v[5][jn]); o.w = cvt_pk_bf16(v[6][jn], v[7][jn]);
        *(u32x4*)(WT + (size_t)rm(n0 + jn) * K + k0) = o; }
}
template <class RowMap>
__device__ __forceinline__ void transpose_item_f8(const float* __restrict__ W, int ldw, int K, unsigned char* __restrict__ WT, LAS float*, int kb, int nb, int lane, RowMap rm, float scale) {
    const int n4 = lane & 7, kg = lane >> 3, k0 = 64 * kb + 8 * kg, n0 = 32 * nb + 4 * n4;
    f32x4 v[8];
#pragma unroll
    for (int i = 0; i < 8; ++i) v[i] = *(const f32x4*)(W + (size_t)(k0 + i) * ldw + n0) * scale;
#pragma unroll
    for (int jn = 0; jn < 4; ++jn) { u32x2 o; o.x = cvt4_fp8(v[0][jn], v[1][jn], v[2][jn], v[3][jn]); o.y = cvt4_fp8(v[4][jn], v[5][jn], v[6][jn], v[7][jn]);
        *(u32x2*)(WT + (size_t)rm(n0 + jn) * K + k0) = o; }
}
template <class RowMap>
__device__ __forceinline__ void transpose_item_f8w(const float* __restrict__ W, int ldw, int K, unsigned char* __restrict__ WT, int kb, int nb, int lane, RowMap rm, float scale) {
    const int n4 = lane & 15, kg = lane >> 4, k0 = 64 * kb + 16 * kg, n0 = 64 * nb + 4 * n4;
    f32x4 v[16];
#pragma unroll
    for (int i = 0; i < 16; ++i) v[i] = *(const f32x4*)(W + (size_t)(k0 + i) * ldw + n0) * scale;
#pragma unroll
    for (int jn = 0; jn < 4; ++jn) { u32x4 o; o.x = cvt4_fp8(v[0][jn], v[1][jn], v[2][jn], v[3][jn]); o.y = cvt4_fp8(v[4][jn], v[5][jn], v[6][jn], v[7][jn]);
        o.z = cvt4_fp8(v[8][jn], v[9][jn], v[10][jn], v[11][jn]); o.w = cvt4_fp8(v[12][jn], v[13][jn], v[14][jn], v[15][jn]);
        *(u32x4*)(WT + (size_t)rm(n0 + jn) * K + k0) = o; }
}
struct RmId { __device__ __forceinline__ int operator()(int n) const { return n; } };
struct RmQb { __device__ __forceinline__ int operator()(int n) const { const int hh = n / AQD, r = n - hh * AQD; if (r < ANOPE) return n; const int i = r - ANOPE; return hh * AQD + ANOPE + ((i < 32) ? 2 * i : 2 * (i - 32) + 1); } };
struct RmKv { __device__ __forceinline__ int operator()(int n) const { const int hh = n >> 8, r = n & 255; return (r < 128) ? hh * 128 + r : 1024 + hh * 128 + (r - 128); } };
struct RmGu { __device__ __forceinline__ int operator()(int n) const { const int j = n >> 1, l = n & 1; return (j >> 7) * 256 + l * 128 + (j & 127); } };

__device__ __forceinline__ void p0_prologue(const Frame& F) {
    LAS float* scr = (LAS float*)(F.lds + F.wave * 8704);
    const int gw = F.vcu * NWAVES + F.wave, NGW = F.G * NWAVES, lane = F.lane;
    unsigned char* ws = F.ws();
    constexpr int I_MWIN = 16 * 96, I_SQ = 16 * 32, I_AWIN = 16 * 22, I_QB = 6 * 48, I_KV = 4 * 64, I_GU = MOE_FP8 ? 16 * 32 : 16 * 64, I_D = MOE_FP8 ? 16 * 16 : 16 * 32;
    constexpr int N_SMALL = 2 * (I_MWIN + I_SQ + I_AWIN + I_QB + I_KV + I_SQ);
    constexpr int P0_LAYERS = (CV_IN_ATTN && MOE_FP8 && ATT_FP8) ? 1 : 4;
    constexpr int NITEMS = N_SMALL + P0_LAYERS * 32 * (I_GU + I_D);
    constexpr int N_LAYER = 32 * (I_GU + I_D);
    for (int it = gw; it < NITEMS; it += NGW) {
        int r = it;
        if (r < P0_LAYERS * N_LAYER) {
            const int l = (P0_LAYERS - 1) - r / N_LAYER; r -= (P0_LAYERS - 1 - l) * N_LAYER;
            if (r < 32 * I_GU) { const int mtx = l * 32 + r / I_GU, q = r % I_GU;
                if (MOE_FP8) transpose_item_f8w((const float*)F.ptr(IN_WGU) + (size_t)mtx * 1024 * 2048, 2048, 1024, (unsigned char*)(ws + WS_WGU) + (size_t)mtx * 2048 * 1024, q >> 5, q & 31, lane, RmGu(), F8_SWG);
                else transpose_item((const float*)F.ptr(IN_WGU) + (size_t)mtx * 1024 * 2048, 2048, 1024, (bf16_t*)(ws + WS_WGU) + (size_t)mtx * 2048 * 1024, scr, q >> 6, q & 63, lane, RmGu()); }
            else { r -= 32 * I_GU; const int mtx = l * 32 + r / I_D, q = r % I_D;
                if (MOE_FP8) transpose_item_f8w((const float*)F.ptr(IN_WD) + (size_t)mtx * 1024 * 1024, 1024, 1024, (unsigned char*)(ws + WS_WD) + (size_t)mtx * 1024 * 1024, q >> 4, q & 15, lane, RmId(), F8_SWD);
                else transpose_item((const float*)F.ptr(IN_WD) + (size_t)mtx * 1024 * 1024, 1024, 1024, (bf16_t*)(ws + WS_WD) + (size_t)mtx * 1024 * 1024, scr, q >> 5, q & 31, lane, RmId()); }
            continue;
        }
        r -= P0_LAYERS * N_LAYER;
        const int j = (r >= N_SMALL / 2) ? 1 : 0; r -= j * (N_SMALL / 2);
        if (r < I_MWIN) { if (DF8_MV && (r % 96) >= 32) transpose_item_f8((const float*)F.ptr(IN_MWIN) + (size_t)j * 1024 * MIN_, MIN_, 1024, (unsigned char*)(ws + WS_WINM8) + (size_t)j * 2048 * 1024 - (size_t)1024 * 1024, scr, r / 96, r % 96, lane, RmId(), F8_SWI);
            else if (DF8_M1) transpose_item_f8((const float*)F.ptr(IN_MWIN) + (size_t)j * 1024 * MIN_, MIN_, 1024, (unsigned char*)(ws + WS_WINM) + (size_t)j * 3072 * 1024, scr, r / 96, r % 96, lane, RmId(), F8_SWI);
            else transpose_item((const float*)F.ptr(IN_MWIN) + (size_t)j * 1024 * MIN_, MIN_, 1024, (bf16_t*)(ws + WS_WINM) + (size_t)j * 3072 * 1024, scr, r / 96, r % 96, lane, RmId()); continue; } r -= I_MWIN;
        if (r < I_SQ) { if (DF8_O5) transpose_item_f8((const float*)F.ptr(IN_MWOUT) + (size_t)j * 1024 * 1024, 1024, 1024, (unsigned char*)(ws + WS_WOUTM) + (size_t)j * 1024 * 1024, scr, r >> 5, r & 31, lane, RmId(), F8_SWO);
            else transpose_item((const float*)F.ptr(IN_MWOUT) + (size_t)j * 1024 * 1024, 1024, 1024, (bf16_t*)(ws + WS_WOUTM) + (size_t)j * 1024 * 1024, scr, r >> 5, r & 31, lane, RmId()); continue; } r -= I_SQ;
        if (r < I_AWIN) { if (DF8_A1) transpose_item_f8((const float*)F.ptr(IN_AWIN) + (size_t)j * 1024 * AIN, AIN, 1024, (unsigned char*)(ws + WS_WINA) + (size_t)j * AINP * 1024, scr, r / 22, r % 22, lane, RmId(), F8_SWI);
            else transpose_item((const float*)F.ptr(IN_AWIN) + (size_t)j * 1024 * AIN, AIN, 1024, (bf16_t*)(ws + WS_WINA) + (size_t)j * AINP * 1024, scr, r / 22, r % 22, lane, RmId()); continue; } r -= I_AWIN;
        if (r < I_QB) { transpose_item((const float*)F.ptr(IN_AWQB) + (size_t)j * AQL * 1536, 1536, AQL, (bf16_t*)(ws + WS_WQB) + (size_t)j * 1536 * AQL, scr, r / 48, r % 48, lane, RmQb()); continue; } r -= I_QB;
        if (r < I_KV) { transpose_item((const float*)F.ptr(IN_AWKVB) + (size_t)j * AKL * 2048, 2048, AKL, (bf16_t*)(ws + WS_WKV) + (size_t)j * 2048 * AKL, scr, r >> 6, r & 63, lane, RmKv()); continue; } r -= I_KV;
        if (DF8_O5) transpose_item_f8((const float*)F.ptr(IN_AWOUT) + (size_t)j * 1024 * 1024, 1024, 1024, (unsigned char*)(ws + WS_WOUTA) + (size_t)j * 1024 * 1024, scr, r >> 5, r & 31, lane, RmId(), F8_SWO);
        else transpose_item((const float*)F.ptr(IN_AWOUT) + (size_t)j * 1024 * 1024, 1024, 1024, (bf16_t*)(ws + WS_WOUTA) + (size_t)j * 1024 * 1024, scr, r >> 5, r & 31, lane, RmId());
    }
    { const int gt = F.vcu * NTHR + F.tid, NGT = F.G * NTHR;
      for (int i = gt; i < 2 * 64 * 1024 / 8; i += NGT) { const int j = i / (64 * 1024 / 8), q = i - j * (64 * 1024 / 8);
          if (DF8_A1) { if (q < 64 * 1024 / 16) *(u32x4*)((unsigned char*)(ws + WS_WINA) + (size_t)j * AINP * 1024 + (size_t)AIN * 1024 + (size_t)q * 16) = (u32x4){0u, 0u, 0u, 0u}; }
          else *(u32x4*)((bf16_t*)(ws + WS_WINA) + (size_t)j * AINP * 1024 + (size_t)AIN * 1024 + (size_t)q * 8) = (u32x4){0u, 0u, 0u, 0u}; }
      const float* x = (const float*)F.ptr(IN_X); bf16_t* xb = (bf16_t*)(ws + WS_XB);
      for (size_t i = gt; i < (size_t)T * D / 8; i += NGT) { const f32x4 v0 = *(const f32x4*)(x + i * 8), v1 = *(const f32x4*)(x + i * 8 + 4);
          u32x4 w; w.x = cvt_pk_bf16(v0[0], v0[1]); w.y = cvt_pk_bf16(v0[2], v0[3]); w.z = cvt_pk_bf16(v1[0], v1[1]); w.w = cvt_pk_bf16(v1[2], v1[3]); *(u32x4*)(xb + i * 8) = w;
          if (DF8_M1 || DF8_MV) { u32x2 w8; w8.x = cvt4_fp8(v0[0] * F8_SX, v0[1] * F8_SX, v0[2] * F8_SX, v0[3] * F8_SX); w8.y = cvt4_fp8(v1[0] * F8_SX, v1[1] * F8_SX, v1[2] * F8_SX, v1[3] * F8_SX); *(u32x2*)((unsigned char*)(ws + WS_XB8) + i * 8) = w8; } }
      { float* gimg = (float*)(ws + WS_GIMG); const float* Wi = (const float*)F.ptr(IN_MWIN);
        for (int i = gt; i < 2 * D * 16; i += NGT) { const int j = i >> 14, r = i & 16383, k = r >> 4, e = r & 15; gimg[(size_t)j * (D * 16) + ((k >> 2) * 16 + e) * 4 + (k & 3)] = Wi[(size_t)j * D * MIN_ + (size_t)k * MIN_ + 3072 + e]; } }
      { float* rimg = (float*)(ws + WS_RIMG); const float* Wr = (const float*)F.ptr(IN_RW); const float* lg = (const float*)F.ptr(IN_LNG);
        for (int i = gt; i < DEPTH * D * NE; i += NGT) { const int l = i >> 15, r = i & 32767, k = r >> 5, e = r & 31; const float wv = Wr[i] * lg[(size_t)(l * 2) * D + k];
            if (RT_BF16) ((bf16_t*)rimg)[(size_t)l * (D * NE) + ((((k >> 5) * 2 + (e >> 4)) * 64 + (((k >> 3) & 3) * 16 + (e & 15))) * 8 + (k & 7))] = (bf16_t)(cvt_pk_bf16(wv, 0.f) & 0xffffu);
            else rimg[(size_t)l * (D * NE) + ((k >> 2) * 32 + e) * 4 + (k & 3)] = wv; }
        const int gwv = F.vcu * NWAVES + F.wave;
        if (gwv < DEPTH * NE) { const int l = gwv >> 5, e = gwv & 31; const float* lb = (const float*)F.ptr(IN_LNB) + (size_t)(l * 2) * D; float c = 0.f;
            float cs = 0.f;
            for (int k = lane; k < D; k += 64) { const float wr = Wr[(size_t)l * D * NE + (size_t)k * NE + e]; c += wr * lb[k]; cs += bf_lo(cvt_pk_bf16(wr * lg[(size_t)(l * 2) * D + k], 0.f)); }
            c = wave_sum(c); cs = wave_sum(cs); if (lane == 0) { ((float*)(ws + WS_RCV))[gwv] = c + ((const float*)F.ptr(IN_RB))[gwv]; ((float*)(ws + WS_RCV))[DEPTH * NE + gwv] = cs; } } }
      const int* pos = (const int*)F.ptr(IN_POS); float* ct = (float*)(ws + WS_COS); float* st = (float*)(ws + WS_SIN);
      for (int i = gt; i < T * 32; i += NGT) { const int m = i >> 5, k = i & 31;
          const float inv = exp2f(-(float)(2 * k) * (13.287712379549449f / 64.0f));
          const float ang = (float)pos[m] * inv;
          const double rev = (double)ang * 0.15915494309189535; const float fr = (float)(rev - floor(rev));
          ct[i] = __builtin_amdgcn_cosf(fr); st[i] = __builtin_amdgcn_sinf(fr); }
    }
}

constexpr int CV_PER_LAYER = 32 * (16 * 64 + 16 * 32);
struct CvItem { const float* src; unsigned char* dst; int ldw, gu; };
__device__ __forceinline__ CvItem cv_decode(const Frame& F, int l, int r, int lane) {
    int q = r; CvItem c;
    const int n4 = lane & 7, kg = lane >> 3;
    if (q < 32 * 1024) { const int mtx = l * 32 + (q >> 10), kb = (q >> 6) & 15, nb = q & 63; c.gu = 1; c.ldw = 2048;
        c.src = (const float*)F.ptr(IN_WGU) + (size_t)mtx * 1024 * 2048 + (size_t)(64 * kb + 8 * kg) * 2048 + 32 * nb + 4 * n4;
        c.dst = (unsigned char*)(F.ws() + WS_WGU) + (size_t)mtx * 2048 * 1024 + 64 * kb + 8 * kg; }
    else { q -= 32 * 1024; const int mtx = l * 32 + (q >> 9), kb = (q >> 5) & 15, nb = q & 31; c.gu = 0; c.ldw = 1024;
        c.src = (const float*)F.ptr(IN_WD) + (size_t)mtx * 1024 * 1024 + (size_t)(64 * kb + 8 * kg) * 1024 + 32 * nb + 4 * n4;
        c.dst = (unsigned char*)(F.ws() + WS_WD) + (size_t)mtx * 1024 * 1024 + 64 * kb + 8 * kg; }
    return c;
}
__device__ __forceinline__ void cv_issue(const CvItem& c, LAS unsigned char* buf) {
#pragma unroll
    for (int i = 0; i < 8; ++i) __builtin_amdgcn_global_load_lds((const unsigned*)(c.src + (size_t)i * c.ldw), (LAS unsigned*)(buf + i * 1024), 16, 0, 2);
}
__device__ __forceinline__ void cv_finish(const CvItem& c, const LAS unsigned char* buf, int r, int lane) {
    f32x4 v[8];
#pragma unroll
    for (int i = 0; i < 8; ++i) v[i] = *(const LAS f32x4*)(buf + i * 1024 + lane * 16);
    int q = r; const int n4 = lane & 7; const int nb = c.gu ? (q & 63) : ((q - 32 * 1024) & 31); const int n0 = 32 * nb + 4 * n4; const float sc = c.gu ? F8_SWG : F8_SWD;
#pragma unroll
    for (int jn = 0; jn < 4; ++jn) { u32x2 o; o.x = cvt4_fp8(v[0][jn] * sc, v[1][jn] * sc, v[2][jn] * sc, v[3][jn] * sc); o.y = cvt4_fp8(v[4][jn] * sc, v[5][jn] * sc, v[6][jn] * sc, v[7][jn] * sc);
        const int n = n0 + jn, row = c.gu ? RmGu()(n) : n;
        __builtin_nontemporal_store(o, (u32x2*)(c.dst + (size_t)row * 1024)); }
}

template <int NEX>
__device__ __forceinline__ void skinny_fill(const Frame& F, const float* __restrict__ W, int ldw) {
    LAS float* wl = (LAS float*)F.lds;
    for (int idx = F.tid; idx < 1024 * NEX; idx += NTHR) { const int k = idx / NEX, e = idx % NEX; wl[((k >> 2) * NEX + e) * 4 + (k & 3)] = W[(size_t)k * ldw + e]; }
    __syncthreads();
}
__device__ __forceinline__ void gates_phase(const Frame& F, const bf16_t* __restrict__ X, const float* __restrict__ bg, float* __restrict__ Gt) {
    const LAS f32x4* wl = (const LAS f32x4*)F.lds;
    const int tok = F.lane & 15, kq = F.lane >> 4;
    const f32x4 bias = *(const f32x4*)(bg + 4 * kq);
    for (int grp = F.vcu * NWAVES + F.wave; grp < T / 16; grp += F.G * NWAVES) {
        const int m0 = grp * 16; const bf16_t* xr = X + (size_t)(m0 + tok) * D + 4 * kq;
        f32x4 acc0 = {0.f, 0.f, 0.f, 0.f}, acc1 = {0.f, 0.f, 0.f, 0.f};
        u32x2 xa[16], xb[16];
#define GP_LOAD(dst, q) do { _Pragma("unroll") for (int t = 0; t < 16; ++t) dst[t] = *(const u32x2*)(xr + 16 * (16 * (q) + t)); } while (0)
#define GP_MMA(src, q) do { _Pragma("unroll") for (int t = 0; t < 16; t += 2) { const int i = 16 * (q) + t; const u32x2 r0 = src[t], r1 = src[t + 1]; \
            const f32x4 x0 = {bf_lo(r0.x), bf_hi(r0.x), bf_lo(r0.y), bf_hi(r0.y)}, x1 = {bf_lo(r1.x), bf_hi(r1.x), bf_lo(r1.y), bf_hi(r1.y)}; \
            const f32x4 w0 = wl[(i * 4 + kq) * 16 + tok], w1 = wl[((i + 1) * 4 + kq) * 16 + tok]; \
            _Pragma("unroll") for (int j = 0; j < 4; ++j) { acc0 = __builtin_amdgcn_mfma_f32_16x16x4f32(w0[j], x0[j], acc0, 0, 0, 0); acc1 = __builtin_amdgcn_mfma_f32_16x16x4f32(w1[j], x1[j], acc1, 0, 0, 0); } } } while (0)
        GP_LOAD(xa, 0);
#pragma unroll 1
        for (int p = 0; p < 2; ++p) {
            GP_LOAD(xb, 2 * p + 1); __builtin_amdgcn_sched_barrier(0);
            GP_MMA(xa, 2 * p); __builtin_amdgcn_sched_barrier(0);
            if (p == 0) GP_LOAD(xa, 2);
            __builtin_amdgcn_sched_barrier(0);
            GP_MMA(xb, 2 * p + 1); __builtin_amdgcn_sched_barrier(0);
        }
#undef GP_LOAD
#undef GP_MMA
        *(f32x4*)(Gt + (size_t)(m0 + tok) * 16 + 4 * kq) = acc0 + acc1 + bias;
    }
}

__device__ __forceinline__ void ln_router_phase(const Frame& F, int layer, int cnt_layer) {
    unsigned char* ws = F.ws();
    const float* __restrict__ ZF = (const float*)(ws + WS_ZF); bf16_t* __restrict__ XM = (bf16_t*)(ws + WS_XM); unsigned char* __restrict__ XB8 = (unsigned char*)(ws + WS_XB8);
    const float* lng = (const float*)F.ptr(IN_LNG) + (size_t)(layer * 2) * D; const float* lnb = (const float*)F.ptr(IN_LNB) + (size_t)(layer * 2) * D;
    const int lane = F.lane, tok = lane & 15, kq = lane >> 4;
    unsigned* cnt = F.ctl() + CW_CNT + cnt_layer * 32 * 64;
    volatile LAS unsigned* hist = F.MISC + 64; volatile LAS unsigned* hbase = F.MISC + 96; volatile LAS float* cvec = (volatile LAS float*)(F.MISC + 192); volatile LAS float* scol = (volatile LAS float*)(F.MISC + 224);
    LAS float* wl = (LAS float*)F.lds; LAS float* part = (LAS float*)(F.lds + 131072);
    {
        const f32x4* src = (const f32x4*)((const char*)(ws + WS_RIMG) + (size_t)layer * (D * NE) * (RT_BF16 ? 2 : 4));
#pragma unroll 4
        for (int it = 0; it < (RT_BF16 ? 8 : 16); ++it) ((LAS f32x4*)wl)[F.tid + NTHR * it] = src[F.tid + NTHR * it];
        if (F.tid < 32) { hist[F.tid] = 0u; cvec[F.tid] = ((const float*)(ws + WS_RCV))[layer * NE + F.tid]; scol[F.tid] = ((const float*)(ws + WS_RCV))[DEPTH * NE + layer * NE + F.tid]; }
        __syncthreads();
    }
    f32x4 gv[4], bv[4];
#pragma unroll
    for (int j = 0; j < 4; ++j) { gv[j] = *(const f32x4*)(lng + 4 * lane + 256 * j); bv[j] = *(const f32x4*)(lnb + 4 * lane + 256 * j); }
#define LZ4(idx) (ZF_BF16 ? ({ const u32x2 w_ = *(const u32x2*)((const bf16_t*)ZF + (idx)); (f32x4){bf_lo(w_.x), bf_hi(w_.x), bf_lo(w_.y), bf_hi(w_.y)}; }) : *(const f32x4*)(ZF + (idx)))
    for (int grp = F.vcu; grp < T / 128; grp += F.G) {
        const int m0 = grp * 128 + F.wave * 16;
        float mu_l = 0.f, rs_l = 0.f;
        f32x4 nx[4];
#pragma unroll
        for (int j = 0; j < 4; ++j) nx[j] = LZ4((size_t)m0 * D + 4 * lane + 256 * j);
#pragma unroll 2
        for (int r = 0; r < 16; ++r) {
            const int m = m0 + r; f32x4 v[4];
#pragma unroll
            for (int j = 0; j < 4; ++j) v[j] = nx[j];
            if (r < 15) {
#pragma unroll
                for (int j = 0; j < 4; ++j) nx[j] = LZ4((size_t)(m + 1) * D + 4 * lane + 256 * j); }
            float s = 0.f;
#pragma unroll
            for (int j = 0; j < 4; ++j) s += (v[j][0] + v[j][1]) + (v[j][2] + v[j][3]);
            const float mean = wave_sum(s) * (1.f / D); float s2 = 0.f;
#pragma unroll
            for (int j = 0; j < 4; ++j) { v[j] = v[j] - mean; s2 += (v[j][0] * v[j][0] + v[j][1] * v[j][1]) + (v[j][2] * v[j][2] + v[j][3] * v[j][3]); }
            const float rstd = 1.f / sqrtf(wave_sum(s2) * (1.f / D) + LN_EPS);
            if (tok == r) { mu_l = mean; rs_l = rstd; }
#pragma unroll
            for (int j = 0; j < 4; ++j) { const f32x4 y = v[j] * rstd * gv[j] + bv[j];
                if (!XM_RECOMP) { u32x2 w; w.x = cvt_pk_bf16(y[0], y[1]); w.y = cvt_pk_bf16(y[2], y[3]); *(u32x2*)(XM + (size_t)m * D + 4 * lane + 256 * j) = w; }
                if (MOE_FP8) *(unsigned*)(XB8 + (size_t)m * D + 4 * lane + 256 * j) = cvt4_fp8(y[0] * F8_SX, y[1] * F8_SX, y[2] * F8_SX, y[3] * F8_SX);
                else { u32x2 w; w.x = cvt_pk_bf16(y[0], y[1]); w.y = cvt_pk_bf16(y[2], y[3]); *(u32x2*)((bf16_t*)(ws + WS_XB) + (size_t)m * D + 4 * lane + 256 * j) = w; } }
        }
        if (XM_RECOMP && kq == 0) *(f32x2*)((float*)(ws + WS_LNST) + 2 * (size_t)(m0 + tok)) = (f32x2){mu_l, rs_l};
        f32x4 acc0 = {0.f, 0.f, 0.f, 0.f}, acc1 = {0.f, 0.f, 0.f, 0.f};
        float lv[8]; int used = 0;
        if constexpr (RT_BF16 != 0) {
            const LAS bf16x8* wl8 = (const LAS bf16x8*)F.lds;
            const bf16_t* zq = (const bf16_t*)ZF + (size_t)(m0 + tok) * D + 8 * kq;
            bf16x8 za[16], zc[16];
#pragma unroll
            for (int i = 0; i < 16; ++i) za[i] = *(const bf16x8*)(zq + 32 * i);
#pragma unroll
            for (int i = 0; i < 16; ++i) zc[i] = *(const bf16x8*)(zq + 32 * (16 + i));
            __builtin_amdgcn_sched_barrier(0);
#pragma unroll
            for (int i = 0; i < 16; ++i) { acc0 = __builtin_amdgcn_mfma_f32_16x16x32_bf16(wl8[(i * 2) * 64 + lane], za[i], acc0, 0, 0, 0); acc1 = __builtin_amdgcn_mfma_f32_16x16x32_bf16(wl8[(i * 2 + 1) * 64 + lane], za[i], acc1, 0, 0, 0); }
#pragma unroll
            for (int i = 0; i < 16; ++i) { acc0 = __builtin_amdgcn_mfma_f32_16x16x32_bf16(wl8[((16 + i) * 2) * 64 + lane], zc[i], acc0, 0, 0, 0); acc1 = __builtin_amdgcn_mfma_f32_16x16x32_bf16(wl8[((16 + i) * 2 + 1) * 64 + lane], zc[i], acc1, 0, 0, 0); }
#pragma unroll
            for (int r = 0; r < 4; ++r) { lv[r] = (acc0[r] - mu_l * scol[4 * kq + r]) * rs_l + cvec[4 * kq + r]; lv[4 + r] = (acc1[r] - mu_l * scol[16 + 4 * kq + r]) * rs_l + cvec[16 + 4 * kq + r]; }
        } else {
        const LAS f32x4* wl4 = (const LAS f32x4*)F.lds;
        const size_t zr = (size_t)(m0 + tok) * D + 4 * kq;
        f32x4 za[16], zc[16];
#define LR_LOAD(dst, c) do { _Pragma("unroll") for (int i = 0; i < 16; ++i) dst[i] = LZ4(zr + 16 * (16 * (c) + i)); } while (0)
#define LR_MMA(src, c) do { _Pragma("unroll") for (int i = 0; i < 16; ++i) { const f32x4 xn = src[i] - mu_l; const int ii = 16 * (c) + i; \
                const f32x4 w0 = wl4[(ii * 4 + kq) * 32 + tok], w1 = wl4[(ii * 4 + kq) * 32 + 16 + tok]; \
                _Pragma("unroll") for (int j = 0; j < 4; ++j) { acc0 = __builtin_amdgcn_mfma_f32_16x16x4f32(w0[j], xn[j], acc0, 0, 0, 0); acc1 = __builtin_amdgcn_mfma_f32_16x16x4f32(w1[j], xn[j], acc1, 0, 0, 0); } } } while (0)
        LR_LOAD(za, 0);
#pragma unroll 1
        for (int p = 0; p < 2; ++p) {
            LR_LOAD(zc, 2 * p + 1); __builtin_amdgcn_sched_barrier(0);
            LR_MMA(za, 2 * p); __builtin_amdgcn_sched_barrier(0);
            if (p == 0) LR_LOAD(za, 2);
            __builtin_amdgcn_sched_barrier(0);
            LR_MMA(zc, 2 * p + 1); __builtin_amdgcn_sched_barrier(0);
        }
#undef LR_LOAD
#undef LR_MMA
#pragma unroll
        for (int r = 0; r < 4; ++r) { lv[r] = acc0[r] * rs_l + cvec[4 * kq + r]; lv[4 + r] = acc1[r] * rs_l + cvec[16 + 4 * kq + r]; }
        }
        float tv[4]; int ti[4];
#pragma unroll
        for (int k = 0; k < 4; ++k) {
            float bvv = -3.0e38f; int bi = 64, bslot = -1;
#pragma unroll
            for (int q = 0; q < 8; ++q) { const int idx = (q < 4) ? 4 * kq + q : 16 + 4 * kq + (q - 4); const bool ok = !((used >> q) & 1) && (lv[q] > bvv || (lv[q] == bvv && idx < bi)); if (ok) { bvv = lv[q]; bi = idx; bslot = q; } }
            float gvv = bvv; int gi = bi;
#pragma unroll
            for (int o = 16; o <= 32; o <<= 1) { const float ov = __shfl_xor(gvv, o); const int oi = __shfl_xor(gi, o); if (ov > gvv || (ov == gvv && oi < gi)) { gvv = ov; gi = oi; } }
            if (gi == bi && bslot >= 0) used |= (1 << bslot);
            tv[k] = gvv; ti[k] = gi;
        }
        const float e1 = __expf(tv[1] - tv[0]), e2 = __expf(tv[2] - tv[0]), e3 = __expf(tv[3] - tv[0]); const float inv = 1.f / (1.f + e1 + e2 + e3);
        const float myg = (kq == 0 ? 1.f : kq == 1 ? e1 : kq == 2 ? e2 : e3) * inv; const int mye = (kq == 0 ? ti[0] : kq == 1 ? ti[1] : kq == 2 ? ti[2] : ti[3]);
        const unsigned rank = __hip_atomic_fetch_add((LAS unsigned*)(hist + mye), 1u, __ATOMIC_RELAXED, __HIP_MEMORY_SCOPE_WORKGROUP);
        __syncthreads();
        if (F.tid < 32) { const unsigned c = hist[F.tid]; hbase[F.tid] = __hip_atomic_fetch_add(cnt + F.tid * 64, c, __ATOMIC_RELAXED, __HIP_MEMORY_SCOPE_AGENT); hist[F.tid] = 0u; }
        __syncthreads();
        const unsigned pos = hbase[mye] + rank; const int m = m0 + tok;
        ((int*)(ws + WS_TOKINFO))[m * 4 + kq] = (mye << 20) | (int)pos; ((float*)(ws + WS_TOKGATE))[m * 4 + kq] = myg;
        ((int*)(ws + WS_LIST))[(size_t)mye * T + pos] = m;
    }
}

__device__ __forceinline__ void ln_combine_phase(const Frame& F, int layer, bool is_last, bool dummy) {
    unsigned char* ws = F.ws();
    const bf16_t* __restrict__ XM = (const bf16_t*)(ws + WS_XM); bf16_t* __restrict__ XB = (bf16_t*)(ws + WS_XB); const bf16_t* __restrict__ YM = (const bf16_t*)(ws + WS_YMOE);
    const float* lng = (const float*)F.ptr(IN_LNG) + (size_t)(layer * 2 + 1) * D; const float* lnb = (const float*)F.ptr(IN_LNB) + (size_t)(layer * 2 + 1) * D;
    const int lane = F.lane;
    const int* tokinfo = (const int*)(ws + WS_TOKINFO); const float* tokgate = (const float*)(ws + WS_TOKGATE);
    volatile LAS int* ntp = (volatile LAS int*)(F.MISC + 16);
    f32x4 gv[4], bv[4];
#pragma unroll
    for (int j = 0; j < 4; ++j) { gv[j] = *(const f32x4*)(lng + 4 * lane + 256 * j); bv[j] = *(const f32x4*)(lnb + 4 * lane + 256 * j); }
    f32x4 ga[4], ba[4];
    if (XM_RECOMP) { const float* lng1 = (const float*)F.ptr(IN_LNG) + (size_t)(layer * 2) * D; const float* lnb1 = (const float*)F.ptr(IN_LNB) + (size_t)(layer * 2) * D;
#pragma unroll
        for (int j = 0; j < 4; ++j) { ga[j] = *(const f32x4*)(lng1 + 4 * lane + 256 * j) * DN_ALPHA; ba[j] = *(const f32x4*)(lnb1 + 4 * lane + 256 * j) * DN_ALPHA; } }
    const bf16_t* __restrict__ XS = XM_RECOMP ? (const bf16_t*)(ws + WS_ZF) : XM;
    float* OUT = F.out();
    bf16_t* XBo = XB; if (dummy) { OUT = (float*)(ws + WS_ZF); XBo = (bf16_t*)(ws + WS_HB); }
    for (int grp = F.vcu * NWAVES + F.wave; grp < T / 16; grp += F.G * NWAVES) {
        const int m0 = grp * 16;
        const int inf = tokinfo[m0 * 4 + lane]; const float gl = tokgate[m0 * 4 + lane];
        const unsigned prl = (unsigned)(ntp[inf >> 20] * 256 + (inf & 0xfffff));
        f32x2 stl = {0.f, 1.f}; if (XM_RECOMP) stl = *(const f32x2*)((const float*)(ws + WS_LNST) + 2 * (size_t)(m0 + (lane >> 2)));
        u32x2 nx[4]; u32x2 ny[4][4]; float ng[4];
#define LNC_LOAD(r) do { _Pragma("unroll") for (int j = 0; j < 4; ++j) nx[j] = *(const u32x2*)(XS + (size_t)(m0 + (r)) * D + 4 * lane + 256 * j); \
            _Pragma("unroll") for (int k = 0; k < 4; ++k) { const unsigned pr = (unsigned)__builtin_amdgcn_readlane((int)prl, 4 * (r) + k); ng[k] = __uint_as_float((unsigned)__builtin_amdgcn_readlane((int)__float_as_uint(gl), 4 * (r) + k)); \
                if (Y_FP8) { const unsigned char* yr = (const unsigned char*)YM + (size_t)pr * D + 4 * lane; _Pragma("unroll") for (int j = 0; j < 4; ++j) { ny[k][j].x = *(const unsigned*)(yr + 256 * j); ny[k][j].y = 0u; } } \
                else { const bf16_t* yr = YM + (size_t)pr * D + 4 * lane; _Pragma("unroll") for (int j = 0; j < 4; ++j) ny[k][j] = *(const u32x2*)(yr + 256 * j); } } } while (0)
        LNC_LOAD(0);
#pragma unroll 1
        for (int r = 0; r < 16; ++r) {
            const int m = m0 + r; f32x4 v[4];
#pragma unroll
            for (int j = 0; j < 4; ++j) v[j] = (f32x4){bf_lo(nx[j].x), bf_hi(nx[j].x), bf_lo(nx[j].y), bf_hi(nx[j].y)} * DN_ALPHA;
            if (XM_RECOMP) { const float mu1 = __uint_as_float((unsigned)__builtin_amdgcn_readlane((int)__float_as_uint(stl[0]), 4 * r)), rs1 = __uint_as_float((unsigned)__builtin_amdgcn_readlane((int)__float_as_uint(stl[1]), 4 * r));
#pragma unroll
                for (int j = 0; j < 4; ++j) { const f32x4 z = (f32x4){bf_lo(nx[j].x), bf_hi(nx[j].x), bf_lo(nx[j].y), bf_hi(nx[j].y)}; v[j] = (z - mu1) * rs1 * ga[j] + ba[j]; } }
#pragma unroll
            for (int k = 0; k < 4; ++k) { const float g = Y_FP8 ? ng[k] * (1.0f / F8_SY) : ng[k];
#pragma unroll
                for (int j = 0; j < 4; ++j) { const u32x2 w = ny[k][j];
                    if (Y_FP8) { const f32x2 lo2 = __builtin_amdgcn_cvt_pk_f32_fp8((int)w.x, false), hi2 = __builtin_amdgcn_cvt_pk_f32_fp8((int)w.x, true); v[j][0] += g * lo2[0]; v[j][1] += g * lo2[1]; v[j][2] += g * hi2[0]; v[j][3] += g * hi2[1]; }
                    else { v[j][0] += g * bf_lo(w.x); v[j][1] += g * bf_hi(w.x); v[j][2] += g * bf_lo(w.y); v[j][3] += g * bf_hi(w.y); } } }
            if (r < 15) LNC_LOAD(r + 1);
            float s = 0.f;
#pragma unroll
            for (int j = 0; j < 4; ++j) s += (v[j][0] + v[j][1]) + (v[j][2] + v[j][3]);
            const float mean = wave_sum(s) * (1.f / D); float s2 = 0.f;
#pragma unroll
            for (int j = 0; j < 4; ++j) { v[j] = v[j] - mean; s2 += (v[j][0] * v[j][0] + v[j][1] * v[j][1]) + (v[j][2] * v[j][2] + v[j][3] * v[j][3]); }
            const float rstd = 1.f / sqrtf(wave_sum(s2) * (1.f / D) + LN_EPS);
#pragma unroll
            for (int j = 0; j < 4; ++j) { const f32x4 y = v[j] * rstd * gv[j] + bv[j];
                if (is_last || dummy) *(f32x4*)(OUT + (size_t)m * D + 4 * lane + 256 * j) = y;
                if (!is_last) { u32x2 w; w.x = cvt_pk_bf16(y[0], y[1]); w.y = cvt_pk_bf16(y[2], y[3]); *(u32x2*)(XBo + (size_t)m * D + 4 * lane + 256 * j) = w;
                    if (DF8_M1 || DF8_MV || (DF8_A1 && (layer & 1) == 0)) *(unsigned*)((unsigned char*)(ws + WS_XB8) + (size_t)m * D + 4 * lane + 256 * j) = cvt4_fp8(y[0] * F8_SX, y[1] * F8_SX, y[2] * F8_SX, y[3] * F8_SX); } }
        }
#undef LNC_LOAD
    }
}

__device__ __forceinline__ void moe_prefix(const Frame& F, int layer) {
    volatile LAS int* ntp = (volatile LAS int*)(F.MISC + 16); volatile LAS int* cnte = (volatile LAS int*)(F.MISC + 224);
    __syncthreads();
    if (F.tid < 64) { const int ln = F.tid; unsigned* cnt = F.ctl() + CW_CNT + layer * 32 * 64;
        const int c = ln < 32 ? (int)__hip_atomic_load(cnt + ln * 64, __ATOMIC_RELAXED, __HIP_MEMORY_SCOPE_AGENT) : 0; const int tiles = (c + 255) >> 8;
        int incl = tiles;
#pragma unroll
        for (int o = 1; o < 32; o <<= 1) { const int t = __shfl_up(incl, o); if (ln >= o) incl += t; }
        if (ln < 32) { ntp[ln] = incl - tiles; cnte[ln] = c; }
        if (ln == 31) ntp[32] = incl; }
    __syncthreads();
}

__device__ __forceinline__ int moe_units(const Frame& F, int layer, int NC) {
    volatile LAS int* ntp = (volatile LAS int*)(F.MISC + 16); volatile LAS int* utab = (volatile LAS int*)(F.lds + pg8::MOE_UTAB_OFF);
    const int total = ntp[32] * NC;
    if (F.tid < 32) { const int L = F.tid * F.G + F.vcu;
        if (L < total) { const int rt = L / NC, pn = L - rt * NC; int e = 0;
            { const LAS int* ntq = (const LAS int*)(F.MISC + 16);
#pragma unroll
              for (int k = 1; k < 32; ++k) e += (rt >= ntq[k]) ? 1 : 0; }
            const int rtl = rt - ntp[e]; const int c_e = ((volatile LAS int*)(F.MISC + 224))[e];
            int nv = c_e - rtl * 256; nv = nv > 256 ? 256 : nv;
            utab[4 * F.tid] = rt; utab[4 * F.tid + 1] = pn; utab[4 * F.tid + 2] = e | (rtl << 8); utab[4 * F.tid + 3] = nv; } }
    __syncthreads();
    const int mine = (total - F.vcu + F.G - 1) / F.G;
    return total > F.vcu ? (mine > 32 ? 32 : mine) : 0;
}

__device__ __forceinline__ void mla_norm_phase(const Frame& F, int j) {
    unsigned char* ws = F.ws(); const float* A32 = (const float*)(ws + WS_A32);
    bf16_t* CQ = (bf16_t*)(ws + WS_CQ); bf16_t* CKV = (bf16_t*)(ws + WS_CKV); bf16_t* KR = (bf16_t*)(ws + WS_KR);
    const float* qn = (const float*)F.ptr(IN_AQN) + j * AQL; const float* kvn = (const float*)F.ptr(IN_AKVN) + j * AKL;
    const float* ct = (const float*)(ws + WS_COS); const float* st = (const float*)(ws + WS_SIN);
    const int lane = F.lane;
    f32x4 gq0 = {0.f, 0.f, 0.f, 0.f}, gq1 = gq0, gk0 = gq0, gk1 = gq0;
    if (lane < 48) { gq0 = *(const f32x4*)(qn + 8 * lane); gq1 = *(const f32x4*)(qn + 8 * lane + 4); }
    if (lane < 32) { gk0 = *(const f32x4*)(kvn + 8 * lane); gk1 = *(const f32x4*)(kvn + 8 * lane + 4); }
    const int mstep = F.G * NWAVES;
    f32x4 nq0 = {0.f, 0.f, 0.f, 0.f}, nq1 = nq0, nk0 = nq0, nk1 = nq0; float nx1 = 0.f, nx2 = 0.f, nc = 0.f, ns = 0.f;
#define MN_LOAD(mm) do { const float* ar_ = A32 + (size_t)(mm) * AINP; \
        if (lane < 48) { nq0 = *(const f32x4*)(ar_ + 8 * lane); nq1 = *(const f32x4*)(ar_ + 8 * lane + 4); } \
        if (lane < 32) { nk0 = *(const f32x4*)(ar_ + AQL + 8 * lane); nk1 = *(const f32x4*)(ar_ + AQL + 8 * lane + 4); nx1 = ar_[AQL + AKL + lane]; nx2 = ar_[AQL + AKL + 32 + lane]; nc = ct[(size_t)(mm) * 32 + lane]; ns = st[(size_t)(mm) * 32 + lane]; } } while (0)
    int m = F.vcu * NWAVES + F.wave;
    if (m < T) MN_LOAD(m);
    for (; m < T; m += mstep) {
        const f32x4 q0 = nq0, q1 = nq1, k0 = nk0, k1 = nk1; const float x1 = nx1, x2 = nx2, c = nc, s = ns;
        if (m + mstep < T) MN_LOAD(m + mstep);
        float sq = 0.f, sk = 0.f;
        if (lane < 48) sq = (q0[0] * q0[0] + q0[1] * q0[1]) + (q0[2] * q0[2] + q0[3] * q0[3]) + (q1[0] * q1[0] + q1[1] * q1[1]) + (q1[2] * q1[2] + q1[3] * q1[3]);
        if (lane < 32) sk = (k0[0] * k0[0] + k0[1] * k0[1]) + (k0[2] * k0[2] + k0[3] * k0[3]) + (k1[0] * k1[0] + k1[1] * k1[1]) + (k1[2] * k1[2] + k1[3] * k1[3]);
        const float rq = 1.f / sqrtf(wave_sum(sq) * (1.f / AQL) + RMS_EPS), rk = 1.f / sqrtf(wave_sum(sk) * (1.f / AKL) + RMS_EPS);
        if (lane < 48) { const f32x4 y0 = q0 * rq * gq0, y1 = q1 * rq * gq1;
            u32x4 w; w.x = cvt_pk_bf16(y0[0], y0[1]); w.y = cvt_pk_bf16(y0[2], y0[3]); w.z = cvt_pk_bf16(y1[0], y1[1]); w.w = cvt_pk_bf16(y1[2], y1[3]); *(u32x4*)(CQ + (size_t)m * AQL + 8 * lane) = w; }
        if (lane < 32) { const f32x4 y0 = k0 * rk * gk0, y1 = k1 * rk * gk1;
            u32x4 w; w.x = cvt_pk_bf16(y0[0], y0[1]); w.y = cvt_pk_bf16(y0[2], y0[3]); w.z = cvt_pk_bf16(y1[0], y1[1]); w.w = cvt_pk_bf16(y1[2], y1[3]); *(u32x4*)(CKV + (size_t)m * AKL + 8 * lane) = w;
            const float r1 = x1 * c - x2 * s, r2 = x2 * c + x1 * s;
            if (ATT_FP8) *(unsigned short*)((unsigned char*)KR + (size_t)m * AROPE + 2 * lane) = (unsigned short)(cvt4_fp8(r1 * F8_SK, r2 * F8_SK, 0.f, 0.f) & 0xffffu);
            else *(unsigned*)(KR + (size_t)m * AROPE + 2 * lane) = cvt_pk_bf16(r1, r2); }
    }
#undef MN_LOAD
}
constexpr int MT_STRIDE = 144;
__device__ __forceinline__ float log_sigmoid(float x) { return fminf(x, 0.f) - __logf(1.f + __expf(-fabsf(x))); }
__device__ __forceinline__ float wave_incl_scan_add(float v, int lane) {
#pragma unroll
    for (int o = 1; o < 64; o <<= 1) { const float t = __shfl_up(v, o); if (lane >= o) v += t; }
    return v;
}
__device__ __forceinline__ float wave_incl_scan_max(float v, int lane) {
#pragma unroll
    for (int o = 1; o < 64; o <<= 1) { const float t = __shfl_up(v, o); if (lane >= o) v = fmaxf(v, t); }
    return v;
}
template <int NCH>
__device__ __forceinline__ void stage_transposed(LAS unsigned char* tile, const bf16_t* __restrict__ src, int lane, float scale, bool do_scale) {
#pragma unroll
    for (int c = 0; c < NCH; ++c) { const u32x4 w = *(const u32x4*)(src + 8 * c); const unsigned ww[4] = {w.x, w.y, w.z, w.w};
#pragma unroll
        for (int p = 0; p < 4; ++p) { unsigned lo = ww[p] & 0xffffu, hi = ww[p] >> 16;
            if (do_scale) { const unsigned pk = cvt_pk_bf16(bf_lo(ww[p]) * scale, bf_hi(ww[p]) * scale); lo = pk & 0xffffu; hi = pk >> 16; }
            *(LAS bf16_t*)(tile + (8 * c + 2 * p) * MT_STRIDE + 2 * lane) = (bf16_t)lo; *(LAS bf16_t*)(tile + (8 * c + 2 * p + 1) * MT_STRIDE + 2 * lane) = (bf16_t)hi; } }
}

__device__ __forceinline__ void mlstm_local_phase(const Frame& F) {
    unsigned char* ws = F.ws(); const bf16_t* PROJ = (const bf16_t*)(ws + WS_PROJ); const float* Gt = (const float*)(ws + WS_GATES);
    bf16_t* CLOC = (bf16_t*)(ws + WS_CLOC); float* NLOC = (float*)(ws + WS_NLOC); float* GMAX = (float*)(ws + WS_MSC); float* BL = GMAX + MUNITS;
    const bf16_t* VTg = (const bf16_t*)(ws + WS_VT);
    const int lane = F.lane, c32 = lane & 31, hi = lane >> 5;
    const int plane = (lane & ~12) | ((lane & 4) << 1) | ((lane & 8) >> 1);
    LAS unsigned char* kt = F.lds + F.wave * (2 * 64 * MT_STRIDE); LAS unsigned char* vt = kt + 64 * MT_STRIDE;
    for (int it = F.vcu * NWAVES + F.wave; it < MUNITS * 2; it += F.G * NWAVES) {
        const int u = it >> 1, half = it & 1, c = u & (MNC - 1), bh = u >> 7, h = bh & 7, b = bh >> 3, m0 = b * SEQ + c * MCH;
        const int m = m0 + lane;
        const float ig = Gt[(size_t)m * 16 + h], lf = log_sigmoid(Gt[(size_t)m * 16 + 8 + h]);
        const float bc = wave_incl_scan_add(lf, lane), bl = __shfl(bc, 63);
        const float g = bl - bc + ig, gmax = wave_max(g), w = __expf(g - gmax);
        stage_transposed<8>(kt, PROJ + (size_t)m * 3072 + 512 + h * 64, MVT ? plane : lane, w, true);
        if (!MVT) stage_transposed<8>(vt, PROJ + (size_t)m * 3072 + 1024 + h * 128 + half * 64, lane, 1.f, false);
        const bf16_t* vg = VTg + (size_t)(h * 128 + half * 64 + c32) * T + m0 + 8 * hi;
        bf16x8 vgf[4][2];
        if (MVT) {
#pragma unroll
            for (int ks = 0; ks < 4; ++ks)
#pragma unroll
                for (int i = 0; i < 2; ++i) vgf[ks][i] = *(const bf16x8*)(vg + (size_t)(32 * i) * T + 16 * ks);
        }
        LDS_WAIT();
        f32x16 acc[2][2];
#pragma unroll
        for (int i = 0; i < 2; ++i)
#pragma unroll
            for (int j = 0; j < 2; ++j)
#pragma unroll
                for (int r = 0; r < 16; ++r) acc[i][j][r] = 0.f;
#pragma unroll
        for (int ks = 0; ks < 4; ++ks) {
            bf16x8 af[2], bfr[2];
#pragma unroll
            for (int i = 0; i < 2; ++i) { if (MVT) af[i] = vgf[ks][i]; else af[i] = *(const LAS bf16x8*)(vt + (32 * i + c32) * MT_STRIDE + (16 * ks + 8 * hi) * 2); bfr[i] = *(const LAS bf16x8*)(kt + (32 * i + c32) * MT_STRIDE + (16 * ks + 8 * hi) * 2); }
#pragma unroll
            for (int i = 0; i < 2; ++i)
#pragma unroll
                for (int j = 0; j < 2; ++j) acc[i][j] = __builtin_amdgcn_mfma_f32_32x32x16_bf16(bfr[j], af[i], acc[i][j], 0, 0, 0);
        }
        asm volatile("s_nop 15\n\ts_nop 3" : "+v"(acc[0][0]), "+v"(acc[0][1]), "+v"(acc[1][0]), "+v"(acc[1][1]));
        bf16_t* cl = CLOC + (size_t)u * (MDV * MDK) + (size_t)(half * 64 + c32) * MDK + 4 * hi;
#pragma unroll
        for (int i = 0; i < 2; ++i)
#pragma unroll
            for (int j = 0; j < 2; ++j)
#pragma unroll
                for (int g = 0; g < 4; ++g) { u32x2 w; w.x = cvt_pk_bf16(acc[i][j][4 * g], acc[i][j][4 * g + 1]); w.y = cvt_pk_bf16(acc[i][j][4 * g + 2], acc[i][j][4 * g + 3]);
                    *(u32x2*)(cl + (size_t)(32 * i) * MDK + 32 * j + 8 * g) = w; }
        if (half == 0) {
            float s = 0.f;
#pragma unroll
            for (int q = 0; q < 8; ++q) { const u32x4 w4 = *(const LAS u32x4*)(kt + lane * MT_STRIDE + 16 * q); s += (bf_lo(w4.x) + bf_hi(w4.x)) + (bf_lo(w4.y) + bf_hi(w4.y)) + (bf_lo(w4.z) + bf_hi(w4.z)) + (bf_lo(w4.w) + bf_hi(w4.w)); }
            NLOC[(size_t)u * MDK + lane] = s;
            if (lane == 0) { GMAX[u] = gmax; BL[u] = bl; }
        }
        LDS_WAIT();
    }
}

__device__ __forceinline__ void mlstm_scan_phase(const Frame& F) {
    unsigned char* ws = F.ws(); const bf16_t* __restrict__ CLOC = (const bf16_t*)(ws + WS_CLOC); const float* __restrict__ NLOC = (const float*)(ws + WS_NLOC);
    const float* __restrict__ GMAX = (const float*)(ws + WS_MSC); const float* __restrict__ BL = GMAX + MUNITS; float* __restrict__ MPREV = (float*)(ws + WS_MSC) + 2 * MUNITS;
    bf16_t* __restrict__ CPREV = (bf16_t*)(ws + WS_CPREV); float* __restrict__ NPREV = (float*)(ws + WS_NPREV);
    constexpr int PER = MDV * MDK / 2;
    for (int it = F.vcu * NTHR + F.tid; it < NB * MH * PER; it += F.G * NTHR) {
        const int bh = it / PER, e = it - bh * PER; const bool hasn = e < 32; const int eo = e * 2;
        float c0 = 0.f, c1 = 0.f, n0 = 0.f, n1 = 0.f, mm = 0.f;
        for (int cb = 0; cb < MNC; cb += 16) {
            f32x2 loc[16], nl[16]; float gm[16], bl[16];
#pragma unroll
            for (int k = 0; k < 16; ++k) { const int u = bh * MNC + cb + k; { const unsigned cw = *(const unsigned*)(CLOC + (size_t)u * (MDV * MDK) + eo); loc[k] = (f32x2){bf_lo(cw), bf_hi(cw)}; } gm[k] = GMAX[u]; bl[k] = BL[u];
                nl[k] = hasn ? *(const f32x2*)(NLOC + (size_t)u * MDK + eo) : (f32x2){0.f, 0.f}; }
#pragma unroll
            for (int k = 0; k < 16; ++k) { const int u = bh * MNC + cb + k;
                const float mnew = fmaxf(bl[k] + mm, gm[k]), dec = __expf(bl[k] + mm - mnew), sc = __expf(gm[k] - mnew);
                *(unsigned*)(CPREV + (size_t)u * (MDV * MDK) + eo) = cvt_pk_bf16(c0, c1);
                if (hasn) { *(f32x2*)(NPREV + (size_t)u * MDK + eo) = (f32x2){n0, n1}; if (e == 0) MPREV[u] = mm; }
                c0 = dec * c0 + sc * loc[k].x; c1 = dec * c1 + sc * loc[k].y; n0 = dec * n0 + sc * nl[k].x; n1 = dec * n1 + sc * nl[k].y; mm = mnew; }
        }
    }
}

static_assert(MVT, "mlstm_out_phase reads V^T from WS_VT");
#ifndef DUP_M4I
#define DUP_M4I 0
#endif
__device__ __forceinline__ void mlstm_out_phase(const Frame& F, const float* __restrict__ gain) {
    unsigned char* ws = F.ws(); const bf16_t* PROJ = (const bf16_t*)(ws + WS_PROJ); const float* Gt = (const float*)(ws + WS_GATES);
    const bf16_t* CPREV = (const bf16_t*)(ws + WS_CPREV); const float* NPREV = (const float*)(ws + WS_NPREV); const float* MPREV = (const float*)(ws + WS_MSC) + 2 * MUNITS;
    bf16_t* HB = (bf16_t*)(ws + WS_HB); const bf16_t* VTg = (const bf16_t*)(ws + WS_VT);
    const int lane = F.lane, c32 = lane & 31, hi = lane >> 5;
    LAS unsigned char* cpl = F.lds + F.wave * 18432; LAS unsigned char* stg = cpl + 16384;
    const int ckey = (c32 >> 1) & 7, row8 = lane >> 3, sl8 = lane & 7;
    const unsigned cpoff = (unsigned)(row8 * 128 + ((sl8 ^ (row8 >> 1)) * 16));
    for (int u0 = F.vcu * NWAVES + F.wave; u0 < MUNITS * (1 + DUP_M4I); u0 += F.G * NWAVES) {
        const int u = u0 & (MUNITS - 1), c = u & (MNC - 1), bh = u >> 7, h = bh & 7, b = bh >> 3, m0 = b * SEQ + c * MCH;
        { const unsigned char* cg = (const unsigned char*)(CPREV + (size_t)u * (MDV * MDK));
          asm volatile("" ::: "memory");
#pragma unroll
          for (int n = 0; n < 16; ++n) __builtin_amdgcn_global_load_lds((const unsigned*)(cg + n * 1024 + ((n & 1) ? (cpoff ^ 64u) : cpoff)), (LAS unsigned*)(cpl + n * 1024), 16, 0, 0); }
        const int mg = m0 + lane;
        const float ig = Gt[(size_t)mg * 16 + h], lf = log_sigmoid(Gt[(size_t)mg * 16 + 8 + h]);
        const bf16_t* vg = VTg + (size_t)(h * 128 + c32) * T + m0 + 8 * hi;
        const float bc = wave_incl_scan_add(lf, lane), av = ig - bc, pm = wave_incl_scan_max(av, lane);
        const float mprev = MPREV[u];
        f32x4 gn[4];
#pragma unroll
        for (int q = 0; q < 4; ++q) gn[q] = *(const f32x4*)(gain + h * 128 + 64 * (q >> 1) + 8 * sl8 + 4 * (q & 1));
        asm volatile("s_waitcnt vmcnt(0)" ::: "memory");
#pragma unroll 1
        for (int tb = 0; tb < 2; ++tb) {
        const int tl = 32 * tb + c32;
        int hi16 = 16 * hi; asm volatile("" : "+v"(hi16));
        const float Mt = fmaxf(mprev, __shfl(pm, tl)), bt = __shfl(bc, tl);
        const float winter = __expf(mprev - Mt) * 0.125f;
        bf16x8 qf[4];
        const bf16_t* qrow = PROJ + (size_t)(m0 + tl) * 3072 + h * 64 + 8 * hi;
#pragma unroll
        for (int ks = 0; ks < 4; ++ks) qf[ks] = *(const bf16x8*)(qrow + 16 * ks);
        float qn = 0.f;
        { const float* np = NPREV + (size_t)u * MDK + 8 * hi;
#pragma unroll
          for (int ks = 0; ks < 4; ++ks) { const f32x4 n0 = *(const f32x4*)(np + 16 * ks), n1 = *(const f32x4*)(np + 16 * ks + 4); const u32x4 qw = __builtin_bit_cast(u32x4, qf[ks]);
              qn += bf_lo(qw.x) * n0[0] + bf_hi(qw.x) * n0[1] + bf_lo(qw.y) * n0[2] + bf_hi(qw.y) * n0[3] + bf_lo(qw.z) * n1[0] + bf_hi(qw.z) * n1[1] + bf_lo(qw.w) * n1[2] + bf_hi(qw.w) * n1[3]; } }
        qn = sum_x32(qn);
        f32x16 acc[4];
#pragma unroll
        for (int i = 0; i < 4; ++i)
#pragma unroll
            for (int r = 0; r < 16; ++r) acc[i][r] = 0.f;
#pragma unroll
        for (int i = 0; i < 4; ++i)
#pragma unroll
            for (int ks = 0; ks < 4; ++ks) { const bf16x8 af = *(const LAS bf16x8*)(cpl + (32 * i + c32) * 128 + (((2 * ks + hi) ^ ckey) * 16)); acc[i] = __builtin_amdgcn_mfma_f32_32x32x16_bf16(af, qf[ks], acc[i], 0, 0, 0); }
#pragma unroll
        for (int i = 0; i < 4; ++i)
#pragma unroll
            for (int r = 0; r < 16; ++r) acc[i][r] *= winter;
        float den = 0.f;
#pragma unroll
        for (int sb = 0; sb < 2; ++sb) {
            if (sb <= tb) {
                f32x16 st;
#pragma unroll
                for (int r = 0; r < 16; ++r) st[r] = 0.f;
                const bf16_t* krow = PROJ + (size_t)(m0 + 32 * sb + c32) * 3072 + 512 + h * 64 + 8 * hi;
#pragma unroll
                for (int ks = 0; ks < 4; ++ks) { const bf16x8 kf = *(const bf16x8*)(krow + 16 * ks); st = __builtin_amdgcn_mfma_f32_32x32x16_bf16(kf, qf[ks], st, 0, 0, 0); }
                unsigned pk[8];
#pragma unroll
                for (int r = 0; r < 16; r += 2) {
                    const int s0 = 32 * sb + (r & 3) + 8 * (r >> 2) + 4 * hi, s1 = s0 + 1;
                    const float a0 = __int_as_float(__builtin_amdgcn_ds_bpermute(hi16 + 4 * (32 * sb + (r & 3) + 8 * (r >> 2)), __float_as_int(av))),
                                a1 = __int_as_float(__builtin_amdgcn_ds_bpermute(hi16 + 4 * (32 * sb + (r & 3) + 8 * (r >> 2) + 1), __float_as_int(av)));
                    float p0 = st[r] * 0.125f * __expf(a0 - Mt), p1 = st[r + 1] * 0.125f * __expf(a1 - Mt);
                    if (s0 > tl) p0 = 0.f; if (s1 > tl) p1 = 0.f;
                    den += p0 + p1; pk[r >> 1] = cvt_pk_bf16(p0, p1);
                }
#pragma unroll
                for (int s2 = 0; s2 < 2; ++s2) {
                    const bf16x8 pf = __builtin_bit_cast(bf16x8, (u32x4){pk[4 * s2], pk[4 * s2 + 1], pk[4 * s2 + 2], pk[4 * s2 + 3]});
#pragma unroll
                    for (int i = 0; i < 4; ++i) { const bf16x8 vf = *(const bf16x8*)(vg + (size_t)(32 * i) * T + 16 * (2 * sb + s2));
                        acc[i] = __builtin_amdgcn_mfma_f32_32x32x16_bf16(vf, pf, acc[i], 0, 0, 0); }
                }
            }
        }
        den = sum_x32(den);
        den += winter * qn;
        const float mrow = bt + Mt, dnm = fmaxf(fabsf(den), __expf(-mrow)), rinv = 1.f / dnm;
        float ss = 0.f;
#pragma unroll
        for (int i = 0; i < 4; ++i)
#pragma unroll
            for (int r = 0; r < 16; ++r) { acc[i][r] *= rinv; ss += acc[i][r] * acc[i][r]; }
        ss = sum_x32(ss);
        const float rn = 1.f / sqrtf(ss * (1.f / MDV) + RMS_EPS);
        u32x4 ow[4][2];
        { const bf16_t* orow = PROJ + (size_t)(m0 + 32 * tb + row8) * 3072 + 2048 + h * 128 + 8 * sl8;
#pragma unroll
          for (int rr = 0; rr < 4; ++rr) { ow[rr][0] = *(const u32x4*)(orow + (size_t)(8 * rr) * 3072); ow[rr][1] = *(const u32x4*)(orow + (size_t)(8 * rr) * 3072 + 64); } }
#pragma unroll
        for (int rr = 0; rr < 4; ++rr) {
            if ((c32 >> 3) == rr) {
#pragma unroll
                for (int i = 0; i < 4; ++i)
#pragma unroll
                    for (int g = 0; g < 4; ++g) { u32x2 w; w.x = cvt_pk_bf16(acc[i][4 * g] * rn, acc[i][4 * g + 1] * rn); w.y = cvt_pk_bf16(acc[i][4 * g + 2] * rn, acc[i][4 * g + 3] * rn);
                        *(LAS u32x2*)(stg + (c32 & 7) * 256 + (((4 * i + g) ^ (c32 & 7)) * 16) + 8 * hi) = w; }
            }
            asm volatile("" ::: "memory");
            const u32x4 y0 = *(const LAS u32x4*)(stg + row8 * 256 + ((sl8 ^ row8) * 16)), y1 = *(const LAS u32x4*)(stg + row8 * 256 + (((8 + sl8) ^ row8) * 16));
            asm volatile("" ::: "memory");
            const size_t mrowi = (size_t)(m0 + 32 * tb + 8 * rr + row8);
#pragma unroll
            for (int hf = 0; hf < 2; ++hf) { const u32x4 yw = hf ? y1 : y0, o4 = ow[rr][hf]; const unsigned yv[4] = {yw.x, yw.y, yw.z, yw.w}, ov[4] = {o4.x, o4.y, o4.z, o4.w};
                float z[8];
#pragma unroll
                for (int e = 0; e < 4; ++e) { const f32x4 gg = gn[2 * hf + (e >> 1)];
                    z[2 * e] = bf_lo(yv[e]) * gg[2 * (e & 1)] * __builtin_amdgcn_rcpf(1.f + __expf(-bf_lo(ov[e]))); z[2 * e + 1] = bf_hi(yv[e]) * gg[2 * (e & 1) + 1] * __builtin_amdgcn_rcpf(1.f + __expf(-bf_hi(ov[e]))); }
                if (DF8_O5) { u32x2 w; w.x = cvt4_fp8(z[0] * F8_SHB, z[1] * F8_SHB, z[2] * F8_SHB, z[3] * F8_SHB); w.y = cvt4_fp8(z[4] * F8_SHB, z[5] * F8_SHB, z[6] * F8_SHB, z[7] * F8_SHB);
                    *(u32x2*)((unsigned char*)HB + mrowi * D + h * 128 + 64 * hf + 8 * sl8) = w; }
                else { u32x4 w; w.x = cvt_pk_bf16(z[0], z[1]); w.y = cvt_pk_bf16(z[2], z[3]); w.z = cvt_pk_bf16(z[4], z[5]); w.w = cvt_pk_bf16(z[6], z[7]); *(u32x4*)(HB + mrowi * D + h * 128 + 64 * hf + 8 * sl8) = w; } }
        }
        }
        LDS_WAIT();
    }
}
__device__ __forceinline__ float max3f(float a, float b, float c) { return fmaxf(fmaxf(a, b), c); }
constexpr int AT_KB = 64 * 384, AT_VB = 128 * 128, AT_STAGE = AT_KB + AT_VB;
__device__ __forceinline__ void attn_phase(const Frame& F) {
    unsigned char* ws = F.ws(); const bf16_t* QB = (const bf16_t*)(ws + WS_QB); const bf16_t* KN = (const bf16_t*)(ws + WS_KN); const bf16_t* KR = (const bf16_t*)(ws + WS_KR); const bf16_t* VT = (const bf16_t*)(ws + WS_VT);
    bf16_t* HB = (bf16_t*)(ws + WS_HB);
    LAS unsigned char* lds = F.lds;
    const int lane = F.lane, w = F.wave, c32 = lane & 31, hi = lane >> 5;
    int k_isr[3]; unsigned k_off[3], v_off[2];
#pragma unroll
    for (int n = 0; n < 3; ++n) { const int P = (n * 8 + w) * 64 + lane, row = P / 24, q = P - row * 24, p = (q & ~7) | ((q & 7) ^ ((row >> 1) & 7));
        k_isr[n] = p >= 16; k_off[n] = (p >= 16) ? (unsigned)(row * AROPE + (p - 16) * 8) * 2u : (unsigned)(row * 1024 + p * 8) * 2u; }
#pragma unroll
    for (int n = 0; n < 2; ++n) { const int P = (n * 8 + w) * 64 + lane, row = P >> 3, q = P & 7, p = q ^ ((row >> 1) & 7); v_off[n] = (unsigned)row * (unsigned)(T * 2) + (unsigned)(p * 16); }
    const int sw = (c32 >> 1) & 7;
    unsigned ko[4];
#pragma unroll
    for (int i = 0; i < 4; ++i) ko[i] = (unsigned)(c32 * 384 + (((2 * i + hi) ^ sw) * 16));
    const unsigned vrow = (unsigned)(c32 * 128);

    for (int item = F.vcu; item < NB * AH * 16; item += F.G) {
        const int bh = item >> 4, x = item & 15, b = bh >> 3, hh = bh & 7;
#pragma unroll 1
        for (int sub = 0; sub < 2; ++sub) {
            const int qb = sub ? 31 - x : x, nt = 4 * qb + 4, jmax = 4 * qb + (w >> 1);
            const int qrow = 256 * qb + 32 * w + c32;
            const size_t mq = (size_t)b * SEQ + qrow;
            __syncthreads();
            const bf16_t* knb = KN + (size_t)b * SEQ * 1024 + hh * 128; const bf16_t* krb = KR + (size_t)b * SEQ * AROPE; const bf16_t* vtb = VT + (size_t)(hh * 128) * T + (size_t)b * SEQ;
#define AT_ISSUE(j, stg) do { _Pragma("unroll") for (int _n = 0; _n < 3; ++_n) { \
                const char* _g = k_isr[_n] ? (const char*)(krb + (size_t)(j) * 64 * AROPE) + k_off[_n] : (const char*)(knb + (size_t)(j) * 64 * 1024) + k_off[_n]; \
                __builtin_amdgcn_global_load_lds((const unsigned*)_g, (LAS unsigned*)(lds + (stg) * AT_STAGE + (_n * 8 + w) * 1024), 16, 0, 0); } \
            _Pragma("unroll") for (int _n = 0; _n < 2; ++_n) { const char* _g = (const char*)(vtb + (size_t)(j) * 64) + v_off[_n]; \
                __builtin_amdgcn_global_load_lds((const unsigned*)_g, (LAS unsigned*)(lds + (stg) * AT_STAGE + AT_KB + (_n * 8 + w) * 1024), 16, 0, 0); } } while (0)
            AT_ISSUE(0, 0);
            bf16x8 qf[12];
            { const bf16_t* qr = QB + mq * 1536 + hh * AQD + 8 * hi;
#pragma unroll
              for (int ks = 0; ks < 12; ++ks) qf[ks] = *(const bf16x8*)(qr + 16 * ks); }
            f32x16 O[4];
#pragma unroll
            for (int i = 0; i < 4; ++i)
#pragma unroll
                for (int r = 0; r < 16; ++r) O[i][r] = 0.f;
            float m_run = -1.0e30f, l_run = 0.f;
            unsigned pk[16];
#pragma unroll
            for (int r = 0; r < 16; ++r) pk[r] = 0u;
#define AT_QK_SM(jj, sg) do { const LAS unsigned char* kb_ = lds + (sg) * AT_STAGE; \
                f32x16 s0, s1; _Pragma("unroll") for (int r = 0; r < 16; ++r) { s0[r] = 0.f; s1[r] = 0.f; } \
                bf16x8 kf[2][4]; \
                _Pragma("unroll") for (int _q = 0; _q < 2; ++_q) { kf[0][2 * _q] = *(const LAS bf16x8*)(kb_ + ko[_q & 3]); kf[0][2 * _q + 1] = *(const LAS bf16x8*)(kb_ + ko[_q & 3] + 32 * 384); } \
                _Pragma("unroll") for (int g = 0; g < 6; ++g) { \
                    if (g + 1 < 6) { _Pragma("unroll") for (int _q = 0; _q < 2; ++_q) { const int _ks = 2 * (g + 1) + _q; \
                        kf[(g + 1) & 1][2 * _q] = *(const LAS bf16x8*)(kb_ + ko[_ks & 3] + (_ks >> 2) * 128); kf[(g + 1) & 1][2 * _q + 1] = *(const LAS bf16x8*)(kb_ + ko[_ks & 3] + (_ks >> 2) * 128 + 32 * 384); } } \
                    __builtin_amdgcn_sched_barrier(0); \
                    _Pragma("unroll") for (int q = 0; q < 2; ++q) { s0 = __builtin_amdgcn_mfma_f32_32x32x16_bf16(kf[g & 1][2 * q], qf[2 * g + q], s0, 0, 0, 0); s1 = __builtin_amdgcn_mfma_f32_32x32x16_bf16(kf[g & 1][2 * q + 1], qf[2 * g + q], s1, 0, 0, 0); } \
                    __builtin_amdgcn_sched_barrier(0); } \
                if ((jj) == jmax) { const int kbase = 64 * (jj) + 4 * hi; \
                    _Pragma("unroll") for (int r = 0; r < 16; ++r) { const int key = kbase + (r & 3) + 8 * (r >> 2); if (key > qrow) s0[r] = -__builtin_inff(); if (key + 32 > qrow) s1[r] = -__builtin_inff(); } } \
                float mx = max3f(s0[0], s1[0], s0[1]); \
                _Pragma("unroll") for (int r = 2; r < 16; r += 2) mx = max3f(mx, s0[r], s0[r + 1]); \
                _Pragma("unroll") for (int r = 1; r < 15; r += 2) mx = max3f(mx, s1[r], s1[r + 1]); \
                mx = fmaxf(mx, s1[15]); mx = fmaxf(mx, __shfl_xor(mx, 32)); \
                const bool grow = mx > m_run + 8.0f;                   \
                const float mnew = grow ? mx : m_run, alpha = __builtin_amdgcn_exp2f(m_run - mnew); m_run = mnew; \
                float ls = 0.f; \
                _Pragma("unroll") for (int r = 0; r < 16; r += 2) { const float p0 = __builtin_amdgcn_exp2f(s0[r] - mnew), p1 = __builtin_amdgcn_exp2f(s0[r + 1] - mnew), p2 = __builtin_amdgcn_exp2f(s1[r] - mnew), p3 = __builtin_amdgcn_exp2f(s1[r + 1] - mnew); \
                    ls += (p0 + p1) + (p2 + p3); pk[r >> 1] = cvt_pk_bf16(p0, p1); pk[8 + (r >> 1)] = cvt_pk_bf16(p2, p3); } \
                l_run = l_run * alpha + ls; \
                if (__builtin_amdgcn_ballot_w64(grow) != 0ull) { _Pragma("unroll") for (int i = 0; i < 4; ++i) _Pragma("unroll") for (int r = 0; r < 16; ++r) O[i][r] *= alpha; } } while (0)
#define AT_PV(sg) do { const LAS unsigned char* vb_ = lds + (sg) * AT_STAGE + AT_KB + vrow; \
                bf16x8 vfr[2][4]; \
                { const unsigned po = (unsigned)((hi ^ sw) * 16); _Pragma("unroll") for (int i = 0; i < 4; ++i) vfr[0][i] = *(const LAS bf16x8*)(vb_ + i * (32 * 128) + po); } \
                _Pragma("unroll") for (int st = 0; st < 4; ++st) { \
                    if (st + 1 < 4) { const unsigned po = (unsigned)(((2 * (st + 1) + hi) ^ sw) * 16); _Pragma("unroll") for (int i = 0; i < 4; ++i) vfr[(st + 1) & 1][i] = *(const LAS bf16x8*)(vb_ + i * (32 * 128) + po); } \
                    __builtin_amdgcn_sched_barrier(0); \
                    const bf16x8 pf = __builtin_bit_cast(bf16x8, (u32x4){pk[4 * st], pk[4 * st + 1], pk[4 * st + 2], pk[4 * st + 3]}); \
                    _Pragma("unroll") for (int i = 0; i < 4; ++i) O[i] = __builtin_amdgcn_mfma_f32_32x32x16_bf16(vfr[st & 1][i], pf, O[i], 0, 0, 0); \
                    __builtin_amdgcn_sched_barrier(0); } } while (0)
            const bool grpB = w >= 4;
            int sj = 0; bool pending = false;
#pragma unroll 1
            for (int j = 0; j <= nt; ++j) {
                const int sn = (sj == 2) ? 0 : sj + 1, sp = (sj == 0) ? 2 : sj - 1;
                if (grpB) { asm volatile("s_waitcnt vmcnt(0)" ::: "memory"); __syncthreads(); if (j + 1 < nt) AT_ISSUE(j + 1, sn); }
                if (pending) AT_PV(sp);
                if (!grpB) { asm volatile("s_waitcnt vmcnt(0)" ::: "memory"); __syncthreads(); if (j + 1 < nt) AT_ISSUE(j + 1, sn); }
                pending = (j < nt && j <= jmax);
                if (pending) AT_QK_SM(j, sj);
                sj = sn;
            }
#undef AT_QK_SM
#undef AT_PV
            const float lt = l_run + __shfl_xor(l_run, 32), rl = 1.f / lt;
            if (DF8_O5) { unsigned char* orow = (unsigned char*)HB + mq * D + hh * 128 + 4 * hi; const float rs = rl * F8_SHB;
#pragma unroll
                for (int i = 0; i < 4; ++i)
#pragma unroll
                    for (int g4 = 0; g4 < 4; ++g4) *(unsigned*)(orow + 32 * i + 8 * g4) = cvt4_fp8(O[i][4 * g4] * rs, O[i][4 * g4 + 1] * rs, O[i][4 * g4 + 2] * rs, O[i][4 * g4 + 3] * rs);
            } else { bf16_t* orow = HB + mq * D + hh * 128 + 4 * hi;
#pragma unroll
                for (int i = 0; i < 4; ++i)
#pragma unroll
                    for (int g4 = 0; g4 < 4; ++g4) { u32x2 wv; wv.x = cvt_pk_bf16(O[i][4 * g4] * rl, O[i][4 * g4 + 1] * rl); wv.y = cvt_pk_bf16(O[i][4 * g4 + 2] * rl, O[i][4 * g4 + 3] * rl);
                        *(u32x2*)(orow + 32 * i + 8 * g4) = wv; } }
#undef AT_ISSUE
        }
    }
}

constexpr int A8_KB = 64 * 192, A8_VB = 128 * 64, A8_STAGE = A8_KB + A8_VB;
__device__ __forceinline__ void attn8_phase(const Frame& F, const int cv_layer, const int cv_count) {
    unsigned char* ws = F.ws(); const unsigned char* Q8 = (const unsigned char*)(ws + WS_QB); const unsigned char* KN8 = (const unsigned char*)(ws + WS_KN); const unsigned char* KR8 = (const unsigned char*)(ws + WS_KR);
    const unsigned char* VT8 = (const unsigned char*)(ws + WS_VT); bf16_t* HB = (bf16_t*)(ws + WS_HB);
    LAS unsigned char* lds = F.lds;
    const int lane = F.lane, w = F.wave, c32 = lane & 31, hi = lane >> 5;
    const int sw = (c32 >> 2) & 3;
    const unsigned koA = (unsigned)(c32 * 192 + ((2 * hi) ^ sw) * 16), koB = (unsigned)(c32 * 192 + ((2 * hi + 1) ^ sw) * 16);
    const unsigned voA = (unsigned)(c32 * 64 + ((2 * hi) ^ sw) * 16), voB = (unsigned)(c32 * 64 + ((2 * hi + 1) ^ sw) * 16);
    constexpr float CS = 1.0f / (F8_SQ * F8_SK);
    const int cv_stride = F.G * NWAVES; const int CV_TOTAL = cv_count * CV_PER_LAYER; int cvn = cv_layer >= 0 ? F.vcu * NWAVES + w : CV_TOTAL, cvq = 0; bool cvh = false, cvj = false;
    LAS unsigned char* cvb = lds + 3 * A8_STAGE + w * 8192;

    for (int item = F.vcu; item < NB * AH * 16; item += F.G) {
        const int bh = item >> 4, x = item & 15, b = bh >> 3, hh = bh & 7;
#pragma unroll 1
        for (int sub = 0; sub < 2; ++sub) {
            const int qb = sub ? 31 - x : x, nt = 4 * qb + 4, jmax = 4 * qb + (w >> 1);
            const int qrow = 256 * qb + 32 * w + c32;
            const size_t mq = (size_t)b * SEQ + qrow;
            __syncthreads();
            const GAS unsigned char* wsg = (const GAS unsigned char*)ws;
            int hl_ = hi; asm volatile("" : "+v"(hl_));
            int k_isr[2]; unsigned k_off[2], v_off;
            { int ln_ = lane; asm volatile("" : "+v"(ln_));
#pragma unroll
              for (int t = 0; t < 2; ++t) { const int P = (w + 8 * t) * 64 + ln_, row = P / 12, q = P - row * 12, p = (q & ~3) | ((q & 3) ^ ((row >> 2) & 3));
                  k_isr[t] = p >= 8; k_off[t] = (p >= 8) ? (unsigned)(row * AROPE + (p - 8) * 16) : (unsigned)(row * 1024 + p * 16); }
              { const int P = w * 64 + ln_, row = P >> 2, q = P & 3, p = q ^ ((row >> 2) & 3); v_off = (unsigned)row * (unsigned)T + (unsigned)(p * 16); } }
            unsigned kb32[2], ks32[2];
#pragma unroll
            for (int t = 0; t < 2; ++t) { kb32[t] = k_isr[t] ? (unsigned)(WS_KR + (size_t)b * SEQ * AROPE) + k_off[t] : (unsigned)(WS_KN + (size_t)b * SEQ * 1024 + hh * 128) + k_off[t]; ks32[t] = k_isr[t] ? 64u * AROPE : 64u * 1024u; }
            const unsigned vb32 = (unsigned)(WS_VT + (size_t)(hh * 128) * T + (size_t)b * SEQ) + v_off;
#define A8_ISSUE(j, stg) do { _Pragma("unroll") for (int _t = 0; _t < 2; ++_t) { if (_t == 0 || w < 4) { \
                const GAS unsigned char* _g = wsg + (size_t)(kb32[_t] + (unsigned)(j) * ks32[_t]); \
                __builtin_amdgcn_global_load_lds((const GAS unsigned*)_g, (LAS unsigned*)(lds + (stg) * A8_STAGE + (w + 8 * _t) * 1024), 16, 0, 0); } } \
            { const GAS unsigned char* _g = wsg + (size_t)(vb32 + (unsigned)(j) * 64u); \
                __builtin_amdgcn_global_load_lds((const GAS unsigned*)_g, (LAS unsigned*)(lds + (stg) * A8_STAGE + A8_KB + w * 1024), 16, 0, 0); } } while (0)
            A8_ISSUE(0, 0);
            i32x8 qf[3];
            { const GAS unsigned char* qr = wsg + (size_t)((unsigned)WS_QB + (unsigned)mq * 1536u + (unsigned)(hh * AQD + 32 * hl_));
#pragma unroll
              for (int ks = 0; ks < 3; ++ks) { qf[ks].lo = *(const GAS i32x4*)(qr + 64 * ks); qf[ks].hi = *(const GAS i32x4*)(qr + 64 * ks + 16); } }
            f32x16 O[4];
#pragma unroll
            for (int i = 0; i < 4; ++i)
#pragma unroll
                for (int r = 0; r < 16; ++r) O[i][r] = 0.f;
            float m_run = -1.0e30f, l_run = 0.f, l_pa = 1.f, l_ps = 0.f;
            i32x8 pk, ones8;
            int one4 = 0x38383838; asm volatile("" : "+v"(one4));
#pragma unroll
            for (int r = 0; r < 8; ++r) { pk[r] = 0; ones8[r] = one4; }
#define A8_QK_SM(jj, sg) do { const LAS unsigned char* kb_ = lds + (sg) * A8_STAGE; \
                f32x16 s0, s1; _Pragma("unroll") for (int r = 0; r < 16; ++r) { s0[r] = 0.f; s1[r] = 0.f; } \
                i32x8 kf[2][2]; \
                kf[0][0].lo = *(const LAS i32x4*)(kb_ + koA); kf[0][0].hi = *(const LAS i32x4*)(kb_ + koB); kf[0][1].lo = *(const LAS i32x4*)(kb_ + koA + 32 * 192); kf[0][1].hi = *(const LAS i32x4*)(kb_ + koB + 32 * 192); \
                _Pragma("unroll") for (int ks = 0; ks < 3; ++ks) { \
                    if (ks + 1 < 3) { kf[(ks + 1) & 1][0].lo = *(const LAS i32x4*)(kb_ + koA + 64 * (ks + 1)); kf[(ks + 1) & 1][0].hi = *(const LAS i32x4*)(kb_ + koB + 64 * (ks + 1)); \
                        kf[(ks + 1) & 1][1].lo = *(const LAS i32x4*)(kb_ + koA + 64 * (ks + 1) + 32 * 192); kf[(ks + 1) & 1][1].hi = *(const LAS i32x4*)(kb_ + koB + 64 * (ks + 1) + 32 * 192); } \
                    __builtin_amdgcn_sched_barrier(0); \
                    s0 = __builtin_amdgcn_mfma_scale_f32_32x32x64_f8f6f4(kf[ks & 1][0], qf[ks], s0, 0, 0, 0, 0, 0, 0); s1 = __builtin_amdgcn_mfma_scale_f32_32x32x64_f8f6f4(kf[ks & 1][1], qf[ks], s1, 0, 0, 0, 0, 0, 0); \
                    __builtin_amdgcn_sched_barrier(0); } \
                if ((jj) == jmax) { const int kbase = 64 * (jj) + 4 * hi; \
                    _Pragma("unroll") for (int r = 0; r < 16; ++r) { const int key = kbase + (r & 3) + 8 * (r >> 2); if (key > qrow) s0[r] = -__builtin_inff(); if (key + 32 > qrow) s1[r] = -__builtin_inff(); } } \
                l_run = l_run * l_pa + l_ps; l_pa = 1.f; l_ps = 0.f; \
                float mx = max3f(s0[0], s1[0], s0[1]); \
                _Pragma("unroll") for (int r = 2; r < 16; r += 2) mx = max3f(mx, s0[r], s0[r + 1]); \
                _Pragma("unroll") for (int r = 1; r < 15; r += 2) mx = max3f(mx, s1[r], s1[r + 1]); \
                mx = fmaxf(mx, s1[15]); mx = max_x32(mx) * CS; \
                const bool grow = mx > m_run + 1.0f; \
                const float mnew = grow ? mx : m_run, alpha = __builtin_amdgcn_exp2f(m_run - mnew), eb = 7.0f - mnew; m_run = mnew;     \
                _Pragma("unroll") for (int g = 0; g < 4; ++g) { \
                    const float a0 = __builtin_amdgcn_exp2f(__builtin_fmaf(s0[4 * g], CS, eb)), a1 = __builtin_amdgcn_exp2f(__builtin_fmaf(s0[4 * g + 1], CS, eb)), a2 = __builtin_amdgcn_exp2f(__builtin_fmaf(s0[4 * g + 2], CS, eb)), a3 = __builtin_amdgcn_exp2f(__builtin_fmaf(s0[4 * g + 3], CS, eb)); \
                    const float c0 = __builtin_amdgcn_exp2f(__builtin_fmaf(s1[4 * g], CS, eb)), c1 = __builtin_amdgcn_exp2f(__builtin_fmaf(s1[4 * g + 1], CS, eb)), c2 = __builtin_amdgcn_exp2f(__builtin_fmaf(s1[4 * g + 2], CS, eb)), c3 = __builtin_amdgcn_exp2f(__builtin_fmaf(s1[4 * g + 3], CS, eb)); \
                    pk[g] = (int)cvt4_fp8(a0, a1, a2, a3); pk[4 + g] = (int)cvt4_fp8(c0, c1, c2, c3); } \
                { f32x16 lz; _Pragma("unroll") for (int r = 0; r < 16; ++r) lz[r] = 0.f;                    \
                  lz = __builtin_amdgcn_mfma_scale_f32_32x32x64_f8f6f4(ones8, pk, lz, 0, 0, 0, 0, 0, 0); l_pa = alpha; l_ps = lz[0]; }     \
                if (__builtin_amdgcn_ballot_w64(grow) != 0ull) { _Pragma("unroll") for (int i = 0; i < 4; ++i) _Pragma("unroll") for (int r = 0; r < 16; ++r) O[i][r] *= alpha; } } while (0)
#define A8_PV(sg) do { const LAS unsigned char* vb_ = lds + (sg) * A8_STAGE + A8_KB; \
                i32x8 vf[4]; _Pragma("unroll") for (int i = 0; i < 4; ++i) { vf[i].lo = *(const LAS i32x4*)(vb_ + voA + i * 2048); vf[i].hi = *(const LAS i32x4*)(vb_ + voB + i * 2048); } \
                __builtin_amdgcn_sched_barrier(0); \
                _Pragma("unroll") for (int i = 0; i < 4; ++i) O[i] = __builtin_amdgcn_mfma_scale_f32_32x32x64_f8f6f4(vf[i], pk, O[i], 0, 0, 0, 0, 0, 0); \
                __builtin_amdgcn_sched_barrier(0); } while (0)
            const bool grpB = w >= 4;
            int sj = 0; bool pending = false;
#pragma unroll 1
            for (int j = 0; j <= nt; ++j) {
                const int sn = (sj == 2) ? 0 : sj + 1, sp = (sj == 0) ? 2 : sj - 1;
#define A8_WAITBAR() do { if (cvj) { asm volatile("s_waitcnt vmcnt(8) lgkmcnt(0)" ::: "memory"); cvj = false; } else { asm volatile("s_waitcnt vmcnt(0) lgkmcnt(0)" ::: "memory"); } \
                    __builtin_amdgcn_s_barrier(); asm volatile("" ::: "memory"); } while (0)
                if (grpB) { A8_WAITBAR(); if (j + 1 < nt) A8_ISSUE(j + 1, sn); }
                if (pending) A8_PV(sp);
                if (!grpB) { A8_WAITBAR(); if (j + 1 < nt) A8_ISSUE(j + 1, sn); }
#undef A8_WAITBAR
                pending = (j < nt && j <= jmax);
                if (pending) A8_QK_SM(j, sj);
                sj = sn;
                if ((j & 3) == 3 && (cvh || cvn < CV_TOTAL)) {
                    if (cvh) { const int cvl_ = cvq >= CV_PER_LAYER ? 1 : 0, cvr = cvq - cvl_ * CV_PER_LAYER; const CvItem ci = cv_decode(F, cv_layer + cvl_, cvr, lane); cv_finish(ci, cvb, cvr, lane); cvh = false; }
                    if (cvn < CV_TOTAL) { { const int cvl_ = cvn >= CV_PER_LAYER ? 1 : 0, cvr = cvn - cvl_ * CV_PER_LAYER; const CvItem ci = cv_decode(F, cv_layer + cvl_, cvr, lane); cv_issue(ci, cvb); } cvq = cvn; cvn += cv_stride; cvh = true; cvj = (j < nt); }
                }
            }
#undef A8_QK_SM
#undef A8_PV
            const float lt = l_run * l_pa + l_ps, rl = 1.f / (lt * F8_SV);
            if (DF8_O5) { GAS unsigned char* orow = (GAS unsigned char*)wsg + (size_t)((unsigned)WS_HB + (unsigned)mq * (unsigned)D + (unsigned)(hh * 128 + 4 * hl_)); const float rs = rl * F8_SHB;
#pragma unroll
                for (int i = 0; i < 4; ++i)
#pragma unroll
                    for (int g4 = 0; g4 < 4; ++g4) *(GAS unsigned*)(orow + 32 * i + 8 * g4) = cvt4_fp8(O[i][4 * g4] * rs, O[i][4 * g4 + 1] * rs, O[i][4 * g4 + 2] * rs, O[i][4 * g4 + 3] * rs);
            } else { bf16_t* orow = HB + mq * D + hh * 128 + 4 * hi;
#pragma unroll
                for (int i = 0; i < 4; ++i)
#pragma unroll
                    for (int g4 = 0; g4 < 4; ++g4) { u32x2 wv; wv.x = cvt_pk_bf16(O[i][4 * g4] * rl, O[i][4 * g4 + 1] * rl); wv.y = cvt_pk_bf16(O[i][4 * g4 + 2] * rl, O[i][4 * g4 + 3] * rl);
                        *(u32x2*)(orow + 32 * i + 8 * g4) = wv; } }
#undef A8_ISSUE
        }
    }
    const int lane2 = (int)__builtin_amdgcn_mbcnt_hi(~0u, __builtin_amdgcn_mbcnt_lo(~0u, 0u));
    for (;;) { if (cvh) { asm volatile("s_waitcnt vmcnt(0)" ::: "memory"); const int cvl_ = cvq >= CV_PER_LAYER ? 1 : 0, cvr = cvq - cvl_ * CV_PER_LAYER; const CvItem ci = cv_decode(F, cv_layer + cvl_, cvr, lane2); cv_finish(ci, cvb, cvr, lane2); cvh = false; }
        if (cvn >= CV_TOTAL) break; { const int cvl_ = cvn >= CV_PER_LAYER ? 1 : 0, cvr = cvn - cvl_ * CV_PER_LAYER; const CvItem ci = cv_decode(F, cv_layer + cvl_, cvr, lane2); cv_issue(ci, cvb); } cvq = cvn; cvn += cv_stride; cvh = true; }
}
#ifndef DUP_L6
#define DUP_L6 0
#endif
#ifndef DUP_SYNC
#define DUP_SYNC 0
#endif
#ifndef DUP_L9
#define DUP_L9 0
#endif
#ifndef DUP_BAR
#define DUP_BAR 0
#endif
#ifndef DUP_P0
#define DUP_P0 0
#endif
#ifndef DUP_A4
#define DUP_A4 0
#endif
#ifndef DUP_G7
#define DUP_G7 0
#endif
#ifndef DUP_G8
#define DUP_G8 0
#endif
#ifndef DUP_M1
#define DUP_M1 0
#endif
#ifndef DUP_O5
#define DUP_O5 0
#endif
#ifndef DUP_M2
#define DUP_M2 0
#endif
#ifndef DUP_M3
#define DUP_M3 0
#endif
#ifndef DUP_M4
#define DUP_M4 0
#endif
#ifndef DUP_A1
#define DUP_A1 0
#endif
#ifndef DUP_A2
#define DUP_A2 0
#endif
#ifndef DUP_A3
#define DUP_A3 0
#endif
#ifndef EN_P0
#define EN_P0 1
#endif
#ifndef EN_M1
#define EN_M1 1
#endif
#ifndef EN_M2
#define EN_M2 1
#endif
#ifndef EN_M3
#define EN_M3 1
#endif
#ifndef EN_M4
#define EN_M4 1
#endif
#ifndef EN_A1
#define EN_A1 1
#endif
#ifndef EN_A2
#define EN_A2 1
#endif
#ifndef EN_A3
#define EN_A3 1
#endif
#ifndef EN_A4
#define EN_A4 1
#endif
#ifndef EN_O5
#define EN_O5 1
#endif
#ifndef EN_L6
#define EN_L6 1
#endif
#ifndef EN_G7
#define EN_G7 1
#endif
#ifndef EN_G8
#define EN_G8 1
#endif
#ifndef EN_L9
#define EN_L9 1
#endif
#ifndef STAG_G7
#define STAG_G7 0
#endif
#ifndef STAG_G8
#define STAG_G8 0
#endif
__device__ __forceinline__ void stagger_wait(const Frame& F, int step) {
    if (step > 0) { const unsigned long long t0 = wall_clock64(), d = (unsigned long long)((F.vcu & 3) * step);
        while (wall_clock64() - t0 < d) __builtin_amdgcn_s_sleep(8);
        __syncthreads(); }
}
constexpr int PH_PER_LAYER = 9, N_PHASES = 1 + DEPTH * PH_PER_LAYER;
constexpr float Q_SCALE = 0.07216878364870323f * 1.4426950408889634f;

__global__ void __launch_bounds__(NTHR, 2) fwd_kernel(Args args) {
    extern __shared__ __attribute__((aligned(16))) unsigned char lds_raw[];
    Frame F0; Frame& F = F0;
    F.lds = (LAS unsigned char*)lds_raw; F.MISC = (volatile LAS unsigned*)(F.lds + MISC_OFF);
    F.tid = threadIdx.x; F.lane = F.tid & 63; F.wave = __builtin_amdgcn_readfirstlane(F.tid >> 6);
    F.G = gridDim.x; { const int bx = blockIdx.x; F.vcu = (F.G % 8 == 0) ? (bx % 8) * (F.G / 8) + bx / 8 : bx; }
    if (F.tid < 128) F.MISC[F.tid] = 0u;
    if (F.tid == 128) {
#pragma unroll
        for (int i = 0; i < 20; ++i) { const unsigned long long p = (unsigned long long)args.in[i]; F.MISC[128 + 2 * i] = (unsigned)p; F.MISC[129 + 2 * i] = (unsigned)(p >> 32); }
        { const unsigned long long p = (unsigned long long)args.out; F.MISC[168] = (unsigned)p; F.MISC[169] = (unsigned)(p >> 32); }
        { const unsigned long long p = (unsigned long long)args.ws; F.MISC[170] = (unsigned)p; F.MISC[171] = (unsigned)(p >> 32); }
    }
    __syncthreads();
    XcdBarrier bar = xcd_barrier_post(F.ctl() + CW_BAR, F.MISC);
    const int lo = args.ph_lo, hi = args.ph_hi;
#define IN(k) (lo <= (k) && (k) < hi)
#define SEAM(k) do { if (IN(k) && IN((k) + 1)) { xcd_barrier(bar); if (DUP_BAR) xcd_barrier(bar); } else __syncthreads(); } while (0)

    if (EN_P0 && IN(0)) { for (int rep = 0; rep <= DUP_P0; ++rep) { const Frame F = refresh(F0); p0_prologue(F); __syncthreads(); } }
    SEAM(0);

    for (int l = 0; l < DEPTH; ++l) {
        const int pb = 1 + l * PH_PER_LAYER, j = l >> 1;
        if ((l & 1) == 0) {
            if (EN_M1 && IN(pb + 0)) for (int rep = 0; rep <= DUP_M1; ++rep) { const Frame F = refresh(F0); unsigned char* ws = F.ws(); const bf16_t* xres = (const bf16_t*)(ws + WS_XB);
                constexpr int EB = DF8_M1 ? 1 : 2;
                if constexpr (DF8_MV != 0) {
                    { pg8::DenseOrder S; S.init(ws + WS_XB, (bf16_t*)(ws + WS_WINM) + (size_t)j * 3072 * 1024, T, 1024, 1024, 1024, F.G, F.vcu, 2);
                      pg8::EpiBf16 E{(bf16_t*)(ws + WS_PROJ), 3072, 1.0f};
                      pg8::gemm_phase<pg8::EpiBf16, pg8::DenseOrder, false, false>(F.lds, F.tid, 1024, 1024, 1024, S, E); }
                    __syncthreads();
                    { const Frame F = refresh(F0); unsigned char* ws = F.ws();
                      pg8::DenseOrder S; S.init(ws + WS_XB8, (unsigned char*)(ws + WS_WINM8) + ((size_t)j * 2048 + 1024) * 1024, T, 1024, 1024, 1024, F.G, F.vcu, 1);
                      pg8::EpiBf16 E{(bf16_t*)(ws + WS_PROJ) + 2048, 3072, 1.0f / (F8_SX * F8_SWI)};
                      pg8::gemm_phase<pg8::EpiBf16, pg8::DenseOrder, false, true>(F.lds, F.tid, 1024, 1024, 1024, S, E); }
                    __syncthreads();
                    { const Frame F = refresh(F0); unsigned char* ws = F.ws();
                      pg8::DenseOrder S; S.init((unsigned char*)(ws + WS_WINM8) + (size_t)j * 2048 * 1024, ws + WS_XB8, 1024, T, 1024, 1024, F.G, F.vcu, 1);
                      pg8::EpiVT E{(bf16_t*)(ws + WS_VT), T, 1.0f / (F8_SX * F8_SWI)};
                      pg8::gemm_phase<pg8::EpiVT, pg8::DenseOrder, false, true>(F.lds, F.tid, 1024, 1024, 1024, S, E); }
                    __syncthreads();
                } else {
                { pg8::DenseOrder S; S.init(ws + (DF8_M1 ? WS_XB8 : WS_XB), (unsigned char*)(ws + WS_WINM) + (size_t)j * 3072 * 1024 * EB, T, MVT ? 2048 : 3072, 1024, 1024, F.G, F.vcu, EB);
                  if (MVT) { S.skip_at = 4; S.skip_n = 4; }
                  pg8::EpiBf16 E{(bf16_t*)(ws + WS_PROJ), 3072, DF8_M1 ? 1.0f / (F8_SX * F8_SWI) : 1.0f};
                  pg8::gemm_phase<pg8::EpiBf16, pg8::DenseOrder, false, DF8_M1 != 0>(F.lds, F.tid, 1024, 1024, 1024, S, E); }
                __syncthreads();
                if (MVT) { const Frame F = refresh(F0); unsigned char* ws = F.ws();
                  pg8::DenseOrder S; S.init((unsigned char*)(ws + WS_WINM) + ((size_t)j * 3072 + 1024) * 1024 * EB, ws + (DF8_M1 ? WS_XB8 : WS_XB), 1024, T, 1024, 1024, F.G, F.vcu, EB);
                  pg8::EpiVT E{(bf16_t*)(ws + WS_VT), T};
                  pg8::gemm_phase<pg8::EpiVT, pg8::DenseOrder, false, DF8_M1 != 0>(F.lds, F.tid, 1024, 1024, 1024, S, E);
                  __syncthreads(); }
                }
                const Frame F2 = refresh(F0);
                { const f32x4* src = (const f32x4*)(ws + WS_GIMG) + (size_t)j * (D * 16 / 4);
#pragma unroll 4
                  for (int it = 0; it < 8; ++it) ((LAS f32x4*)F2.lds)[F2.tid + NTHR * it] = src[F2.tid + NTHR * it];
                  __syncthreads(); }
                gates_phase(F2, xres, (const float*)F2.ptr(IN_MBG) + j * 16, (float*)(ws + WS_GATES));
            }
            SEAM(pb + 0);
            if (EN_M2 && IN(pb + 1)) for (int rep = 0; rep <= DUP_M2; ++rep) { const Frame F = refresh(F0); mlstm_local_phase(F); __syncthreads(); }
            SEAM(pb + 1);
            if (EN_M3 && IN(pb + 2)) for (int rep = 0; rep <= DUP_M3; ++rep) { const Frame F = refresh(F0); mlstm_scan_phase(F); __syncthreads(); }
            SEAM(pb + 2);
            if (EN_M4 && IN(pb + 3)) for (int rep = 0; rep <= DUP_M4; ++rep) { const Frame F = refresh(F0); __syncthreads(); mlstm_out_phase(F, (const float*)F.ptr(IN_MNG) + (size_t)j * 1024); }
            SEAM(pb + 3);
        } else {
            if (EN_A1 && IN(pb + 0)) for (int rep = 0; rep <= DUP_A1; ++rep) { const Frame F = refresh(F0); unsigned char* ws = F.ws();
                constexpr int EB = DF8_A1 ? 1 : 2;
                pg8::DenseOrder S; S.init(ws + (DF8_A1 ? WS_XB8 : WS_XB), (unsigned char*)(ws + WS_WINA) + (size_t)j * AINP * 1024 * EB, T, AINP, 1024, 1024, F.G, F.vcu, EB);
                pg8::EpiF32 E{(float*)(ws + WS_A32), AINP, DF8_A1 ? 1.0f / (F8_SX * F8_SWI) : 1.0f};
                pg8::gemm_phase<pg8::EpiF32, pg8::DenseOrder, false, DF8_A1 != 0>(F.lds, F.tid, 1024, 1024, 1024, S, E);
            }
            SEAM(pb + 0);
            if (EN_A2 && IN(pb + 1)) { const Frame F = refresh(F0); mla_norm_phase(F, j); }
            SEAM(pb + 1);
            if (EN_A3 && IN(pb + 2)) for (int rep = 0; rep <= DUP_A3; ++rep) { const Frame F = refresh(F0); unsigned char* ws = F.ws();
                { pg8::DenseOrder S; S.init(ws + WS_CQ, (bf16_t*)(ws + WS_WQB) + (size_t)j * 1536 * AQL, T, 1536, AQL, AQL, F.G, F.vcu);
                  pg8::EpiQRope E{(bf16_t*)(ws + WS_QB), 1536, (const float*)(ws + WS_COS), (const float*)(ws + WS_SIN), ATT_FP8 ? Q_SCALE * F8_SQ : Q_SCALE};
                  pg8::gemm_phase<pg8::EpiQRope, pg8::DenseOrder, false>(F.lds, F.tid, AQL, AQL, AQL, S, E); }
                __syncthreads();
                { const Frame F = refresh(F0); unsigned char* ws = F.ws();
                  pg8::DenseOrder S; S.init(ws + WS_CKV, (bf16_t*)(ws + WS_WKV) + (size_t)j * 2048 * AKL, T, 1024, AKL, AKL, F.G, F.vcu);
                  if constexpr (ATT_FP8 != 0) { pg8::EpiF8 E{(unsigned char*)(ws + WS_KN), 1024, F8_SK}; pg8::gemm_phase<pg8::EpiF8, pg8::DenseOrder, false>(F.lds, F.tid, AKL, AKL, AKL, S, E); }
                  else { pg8::EpiBf16 E{(bf16_t*)(ws + WS_KN), 1024, 1.0f}; pg8::gemm_phase<pg8::EpiBf16, pg8::DenseOrder, false>(F.lds, F.tid, AKL, AKL, AKL, S, E); } }
                __syncthreads();
                { const Frame F = refresh(F0); unsigned char* ws = F.ws();
                  pg8::DenseOrder S; S.init((bf16_t*)(ws + WS_WKV) + (size_t)j * 2048 * AKL + (size_t)1024 * AKL, ws + WS_CKV, 1024, T, AKL, AKL, F.G, F.vcu);
                  if constexpr (ATT_FP8 != 0) { pg8::EpiVT8 E{(unsigned char*)(ws + WS_VT), T, F8_SV}; pg8::gemm_phase<pg8::EpiVT8, pg8::DenseOrder, false>(F.lds, F.tid, AKL, AKL, AKL, S, E); }
                  else { pg8::EpiVT E{(bf16_t*)(ws + WS_VT), T}; pg8::gemm_phase<pg8::EpiVT, pg8::DenseOrder, false>(F.lds, F.tid, AKL, AKL, AKL, S, E); } }
            }
            SEAM(pb + 2);
            if (EN_A4 && IN(pb + 3)) { for (int rep = 0; rep <= DUP_A4; ++rep) { const Frame F = refresh(F0); if constexpr (ATT_FP8 != 0) attn8_phase(F, (CV_IN_ATTN && MOE_FP8 && rep == 0) ? l : -1, l == 1 ? 2 : 1);     else attn_phase(F); __syncthreads(); } }
            SEAM(pb + 3);
        }
        if (EN_O5 && IN(pb + 4)) for (int rep = 0; rep <= DUP_O5; ++rep) { const Frame F = refresh(F0); unsigned char* ws = F.ws(); const bf16_t* xres = (const bf16_t*)(ws + WS_XB);
            constexpr int EB = DF8_O5 ? 1 : 2;
            const unsigned char* wo = (l & 1) ? (const unsigned char*)(ws + WS_WOUTA) + (size_t)j * 1024 * 1024 * EB : (const unsigned char*)(ws + WS_WOUTM) + (size_t)j * 1024 * 1024 * EB;
            pg8::DenseOrder S; S.init(ws + WS_HB, wo, T, 1024, 1024, 1024, F.G, F.vcu, EB);
            pg8::EpiResid E{xres, (float*)(ws + WS_ZF), 1024, DN_ALPHA, DF8_O5 ? 1.0f / (F8_SHB * F8_SWO) : 1.0f};
            pg8::gemm_phase<pg8::EpiResid, pg8::DenseOrder, false, DF8_O5 != 0>(F.lds, F.tid, 1024, 1024, 1024, S, E);
        }
        SEAM(pb + 4);
        if (EN_L6 && IN(pb + 5)) { if (DUP_L6) { const Frame F = refresh(F0); ln_router_phase(F, l, l + 4); __syncthreads(); } const Frame F = refresh(F0); ln_router_phase(F, l, l); }
        SEAM(pb + 5);
        if (EN_G7 && IN(pb + 6)) for (int rep = 0; rep <= DUP_G7; ++rep) { if (DUP_SYNC && rep) xcd_barrier(bar); const Frame F = refresh(F0); unsigned char* ws = F.ws();
            moe_prefix(F, l);
            constexpr size_t EB = MOE_FP8 ? 1 : 2;
            const int nu = moe_units(F, l, 8);
            pg8::MoeOrder S{(const volatile LAS int*)(F.lds + pg8::MOE_UTAB_OFF), (const char*)(ws + (MOE_FP8 ? WS_XB8 : WS_XB)), (const char*)(ws + WS_WGU) + (size_t)l * 32 * 2048 * 1024 * EB, (const int*)(ws + WS_LIST),
                            nu, (size_t)2048 * 1024 * EB, (size_t)256 * 1024 * EB, true, 0};
            pg8::EpiSwiglu E{(unsigned char*)(ws + WS_HMOE), (const float*)F.ptr(IN_BGU) + (size_t)l * 32 * 2048, F.lds};
            pg8::gemm_phase<pg8::EpiSwiglu, pg8::MoeOrder, true, MOE_FP8 != 0>(F.lds, F.tid, 1024, 1024, 1024, S, E);
        }
        SEAM(pb + 6);
        if (EN_G8 && IN(pb + 7)) for (int rep = 0; rep <= DUP_G8; ++rep) { if (DUP_SYNC && rep) xcd_barrier(bar); const Frame F = refresh(F0); unsigned char* ws = F.ws();
            if (MK_PER_PHASE) moe_prefix(F, l);
            constexpr size_t EB = MOE_FP8 ? 1 : 2;
            const int nu = moe_units(F, l, 4);
            pg8::MoeOrder S{(const volatile LAS int*)(F.lds + pg8::MOE_UTAB_OFF), (const char*)(ws + WS_HMOE), (const char*)(ws + WS_WD) + (size_t)l * 32 * 1024 * 1024 * EB, (const int*)(ws + WS_LIST),
                            nu, (size_t)1024 * 1024 * EB, (size_t)256 * 1024 * EB, false, (size_t)256 * 1024 * EB};
            pg8::EpiDown E{(bf16_t*)(ws + WS_YMOE), (const float*)F.ptr(IN_BD) + (size_t)l * 32 * 1024, F.lds};
            pg8::gemm_phase<pg8::EpiDown, pg8::MoeOrder, false, MOE_FP8 != 0>(F.lds, F.tid, 1024, 1024, 1024, S, E);
        }
        SEAM(pb + 7);
        if (EN_L9 && IN(pb + 8)) { if (DUP_L9) { const Frame F = refresh(F0); moe_prefix(F, l); ln_combine_phase(F, l, false, true); __syncthreads(); } const Frame F = refresh(F0); if (MK_PER_PHASE) moe_prefix(F, l); else __syncthreads(); ln_combine_phase(F, l, l == DEPTH - 1, false); }
        SEAM(pb + 8);
    }
#undef IN
#undef SEAM
}

extern "C" void kernel_launch(void* const* d_in, const int* in_sizes, int n_in, void* d_out, int out_size, void* d_ws, size_t ws_size, hipStream_t stream) {
    static int grid = 0;
    if (grid == 0) {
        if (n_in != 20 || out_size != T * D || ws_size < WS_END) { fprintf(stderr, "kernel_launch: unexpected problem (n_in %d out %d ws %zu)\n", n_in, out_size, ws_size); grid = -1; return; }
        int dev = 0, cus = 0, per_cu = 0;
        if (hipGetDevice(&dev) != hipSuccess || hipDeviceGetAttribute(&cus, hipDeviceAttributeMultiprocessorCount, dev) != hipSuccess) { grid = -1; return; }
        if (hipFuncSetAttribute((const void*)fwd_kernel, hipFuncAttributeMaxDynamicSharedMemorySize, LDS_BYTES) != hipSuccess) { fprintf(stderr, "kernel_launch: hipFuncSetAttribute failed\n"); grid = -1; return; }
        if (hipOccupancyMaxActiveBlocksPerMultiprocessor(&per_cu, (const void*)fwd_kernel, NTHR, LDS_BYTES) != hipSuccess || per_cu < 1) fprintf(stderr, "kernel_launch: occupancy query reports %d\n", per_cu);
        (void)hipGetLastError();
        grid = cus;
    }
    if (grid < 0) return;
    (void)hipMemsetAsync((char*)d_ws + WS_CTL, 0, CTL_ZERO_BYTES, stream);
    Args a; memset(&a, 0, sizeof(a));
    for (int i = 0; i < 20; ++i) a.in[i] = d_in[i];
    a.out = (float*)d_out; a.ws = (unsigned char*)d_ws;
#if MK_PER_PHASE
    for (int p = 0; p < N_PHASES; ++p) { a.ph_lo = p; a.ph_hi = p + 1; hipLaunchKernelGGL(fwd_kernel, dim3(grid), dim3(NTHR), LDS_BYTES, stream, a); }
#else
    a.ph_lo = 0; a.ph_hi = N_PHASES;
    hipLaunchKernelGGL(fwd_kernel, dim3(grid), dim3(NTHR), LDS_BYTES, stream, a);
#endif
    const hipError_t le = hipPeekAtLastError();
    if (le != hipSuccess) fprintf(stderr, "kernel_launch: launch failed: %s\n", hipGetErrorName(le));
}
```

```cpp
#include <hip/hip_runtime.h>
#include <cstdio>
#include <cstdint>
#include <cstring>

#define LAS __attribute__((address_space(3)))
#define GAS __attribute__((address_space(1)))
typedef unsigned short bf16_t;
typedef short bf16x8 __attribute__((ext_vector_type(8)));
typedef short s16x4 __attribute__((ext_vector_type(4)));
typedef float f32x2 __attribute__((ext_vector_type(2)));
typedef float f32x4 __attribute__((ext_vector_type(4)));
typedef float f32x16 __attribute__((ext_vector_type(16)));
typedef unsigned u32x2 __attribute__((ext_vector_type(2)));
typedef unsigned u32x4 __attribute__((ext_vector_type(4)));
typedef int i32x4 __attribute__((ext_vector_type(4)));
typedef int i32x8 __attribute__((ext_vector_type(8)));

#ifndef MK_PER_PHASE
#define MK_PER_PHASE 0
#endif

constexpr int NB = 4, SEQ = 8192, T = NB * SEQ, D = 1024, DEPTH = 4;
constexpr int MH = 8, MDV = 128, MDK = 64, MCH = 64, MNC = SEQ / MCH, MIN_ = 3088, MUNITS = NB * MH * MNC;
constexpr int AH = 8, AQL = 384, AKL = 256, ANOPE = 128, AROPE = 64, AV = 128, AIN = 704, AINP = 768, AQD = 192;
constexpr int NE = 32, TOPK = 4, DFF = 1024;
constexpr float DN_ALPHA = 1.6817928305074290f;
constexpr float LN_EPS = 1e-5f, RMS_EPS = 1e-6f;
constexpr int MOE_ROWS = 139264;

constexpr size_t MiB = 1ull << 20;
constexpr size_t WS_CTL = 0, CTL_ZERO_BYTES = 128 * 1024;
constexpr size_t WS_COS = 1 * MiB, WS_SIN = 5 * MiB, WS_GATES = 9 * MiB, WS_TOKINFO = 11 * MiB, WS_TOKGATE = 11 * MiB + 512 * 1024, WS_LIST = 12 * MiB;
constexpr size_t WS_GIMG = 16 * MiB + 128 * 1024  , WS_RIMG = 16 * MiB + 256 * 1024  , WS_RCV = 16 * MiB + 768 * 1024  , WS_MSC = 16 * MiB, WS_NLOC = 17 * MiB, WS_NPREV = 18 * MiB, WS_LNST = 19 * MiB  ;
constexpr size_t WS_WINM = 20 * MiB, WS_WOUTM = 32 * MiB, WS_WINA = 36 * MiB, WS_WQB = 39 * MiB, WS_WKV = 42 * MiB, WS_WOUTA = 44 * MiB;
constexpr size_t WS_WINM8 = 48 * MiB  ;
constexpr size_t WS_WGU = 64 * MiB, WS_WD = 576 * MiB;
constexpr size_t WS_XM = 832 * MiB, WS_XF = 832 * MiB, WS_ZF = 960 * MiB, WS_XB = 1088 * MiB, WS_PROJ = 1152 * MiB;
constexpr size_t WS_A32 = WS_PROJ, WS_CQ = WS_PROJ + 96 * MiB, WS_CKV = WS_PROJ + 120 * MiB, WS_KR = WS_PROJ + 136 * MiB;
constexpr size_t WS_QB = 1344 * MiB, WS_CLOC = WS_QB, WS_KN = 1472 * MiB, WS_CPREV = WS_KN, WS_VT = 1536 * MiB, WS_HB = 1600 * MiB;
constexpr size_t WS_HMOE = 1664 * MiB, WS_YMOE = 1936 * MiB, WS_XB8 = 2208 * MiB, WS_END = 2240 * MiB;
constexpr int CW_BAR = 4096, CW_CNT = 16384;

constexpr int RING_BYTES = 147456;
constexpr int MISC_OFF = RING_BYTES;
constexpr int LDS_BYTES = RING_BYTES + 1024;
constexpr int NWAVES = 8, NTHR = 512;

__device__ __forceinline__ unsigned cvt_pk_bf16(float lo, float hi) { unsigned r; asm("v_cvt_pk_bf16_f32 %0, %1, %2" : "=v"(r) : "v"(lo), "v"(hi)); return r; }
__device__ __forceinline__ float bf_lo(unsigned w) { return __uint_as_float(w << 16); }
__device__ __forceinline__ float bf_hi(unsigned w) { return __uint_as_float(w & 0xffff0000u); }
template <int CTRL> __device__ __forceinline__ float dpp_mov(float v) { return __int_as_float(__builtin_amdgcn_update_dpp(0, __float_as_int(v), CTRL, 0xf, 0xf, true)); }
__device__ __forceinline__ float xor16(float v, float& other) { const u32x2 r = __builtin_amdgcn_permlane16_swap(__float_as_uint(v), __float_as_uint(v), false, false); other = __uint_as_float(r.y); return __uint_as_float(r.x); }
__device__ __forceinline__ float xor32(float v, float& other) { const u32x2 r = __builtin_amdgcn_permlane32_swap(__float_as_uint(v), __float_as_uint(v), false, false); other = __uint_as_float(r.y); return __uint_as_float(r.x); }
__device__ __forceinline__ float wave_sum(float v) {
    v += dpp_mov<0xB1>(v); v += dpp_mov<0x4E>(v); v += dpp_mov<0x141>(v); v += dpp_mov<0x140>(v);
    float o; v = xor16(v, o) + o; v = xor32(v, o) + o;
    return v;
}
__device__ __forceinline__ float wave_max(float v) {
    v = fmaxf(v, dpp_mov<0xB1>(v)); v = fmaxf(v, dpp_mov<0x4E>(v)); v = fmaxf(v, dpp_mov<0x141>(v)); v = fmaxf(v, dpp_mov<0x140>(v));
    float o; v = xor16(v, o); v = fmaxf(v, o); v = xor32(v, o); v = fmaxf(v, o);
    return v;
}
__device__ __forceinline__ float max_x32(float v) { float o; const float a = xor32(v, o); return fmaxf(a, o); }
__device__ __forceinline__ float sum_x32(float v) { float o; const float a = xor32(v, o); return a + o; }
#ifndef DUP_EPI
#define DUP_EPI 0
#endif
#ifndef PG8_SP2
#define PG8_SP2 0
#endif
#ifndef MOE_FP8
#define MOE_FP8 1
#endif
constexpr float F8_SX = 16.f, F8_SWG = 256.f, F8_SH = 4.f, F8_SWD = 512.f;
#ifndef DF8_M1
#define DF8_M1 0
#endif
#ifndef DF8_A1
#define DF8_A1 1
#endif
#ifndef DF8_O5
#define DF8_O5 1
#endif
#ifndef DF8_MV
#define DF8_MV 1
#endif
#ifndef DENSE_FP8
#define DENSE_FP8 (DF8_M1 || DF8_MV || DF8_A1)
#endif
constexpr float F8_SHB = 16.f, F8_SWI = 256.f, F8_SWO = 512.f;
#ifndef MVT
#define MVT 1
#endif
static_assert(!(DF8_MV && (DF8_M1 || !MVT)), "DF8_MV: the split in-projection needs MVT and a bf16 q/k part");
#ifndef XM_RECOMP
#define XM_RECOMP 1
#endif
#ifndef RT_BF16
#define RT_BF16 1
#endif
#ifndef ZF_BF16
#define ZF_BF16 1
#endif
static_assert(!(RT_BF16 && !ZF_BF16), "RT_BF16 reads z as bf16");
static_assert(!(XM_RECOMP && !ZF_BF16), "XM_RECOMP reads z as bf16");
#ifndef CV_IN_ATTN
#define CV_IN_ATTN 1
#endif
#ifndef ATT_FP8
#define ATT_FP8 1
#endif
#ifndef Y_FP8
#define Y_FP8 1
#endif
constexpr float F8_SY = 64.f;
constexpr float F8_SQ = 64.f, F8_SK = 16.f, F8_SV = 16.f, F8_SP = 128.f;
#ifndef F8_SWCVT
#define F8_SWCVT 0
#endif
__device__ __forceinline__ unsigned f32_to_e4m3_sw(float x) {
    const unsigned b = __float_as_uint(x), sgn = (b >> 24) & 0x80u; const float ax = fabsf(x);
    if (ax < 0.015625f) return sgn | (unsigned)__builtin_rintf(ax * 512.0f);
    unsigned u = b & 0x7fffffffu; u += 0x7ffffu + ((u >> 20) & 1u);
    const unsigned e8 = (u >> 23) - 120u, m = (u >> 20) & 7u; unsigned enc = (e8 << 3) | m; enc = enc > 0x7eu ? 0x7eu : enc;
    return sgn | enc;
}
__device__ __forceinline__ unsigned cvt4_fp8(float a, float b, float c, float d) {
#if F8_SWCVT
    return f32_to_e4m3_sw(a) | (f32_to_e4m3_sw(b) << 8) | (f32_to_e4m3_sw(c) << 16) | (f32_to_e4m3_sw(d) << 24);
#else
    int w = __float_as_int(a);
    w = __builtin_amdgcn_cvt_pk_fp8_f32(a, b, w, false); w = __builtin_amdgcn_cvt_pk_fp8_f32(c, d, w, true); return (unsigned)w;
#endif
}
#define LDS_WAIT() asm volatile("s_waitcnt lgkmcnt(0)" ::: "memory")
#define VM_WAIT() asm volatile("s_waitcnt vmcnt(0)" ::: "memory")

#define XB_TMO      128
#define XB_XCNT(j)  (256  + 64 * (j))
#define XB_XSUB(j)  (1280 + 64 * (j))
#define XB_XGEN(j)  (2304 + 64 * (j))
#define XB_TOP      3328
#define XB_TOPGEN   3392
#define XCD_BAR_WORDS 3456
#define XB_SPIN_CAP (1u << 18)
__device__ __forceinline__ unsigned xb_ld(unsigned* p)              { return __hip_atomic_load(p, __ATOMIC_RELAXED, __HIP_MEMORY_SCOPE_AGENT); }
__device__ __forceinline__ unsigned xb_add(unsigned* p, unsigned v) { return __hip_atomic_fetch_add(p, v, __ATOMIC_RELAXED, __HIP_MEMORY_SCOPE_AGENT); }
__device__ __forceinline__ unsigned xb_xcc_id() { return (unsigned)__builtin_amdgcn_s_getreg((3 << 11) | 20) & 0xFu; }
#define XB_SPIN(cond, bar) do { unsigned _sp = 0; while (cond) { __builtin_amdgcn_s_sleep(1); \
    if ((++_sp & 255u) == 0u) { if (xb_ld(&(bar)[XB_TMO])) break; if (_sp > XB_SPIN_CAP) { atomicAdd(&(bar)[XB_TMO], 1u); break; } } } } while (0)
struct XcdBarrier { unsigned* bar; unsigned x; volatile LAS unsigned* st; };
__device__ __forceinline__ XcdBarrier xcd_barrier_post(unsigned* bar, volatile LAS unsigned* st) {
    XcdBarrier b; b.bar = bar; b.x = xb_xcc_id(); b.st = st;
    if (threadIdx.x == 0) (void)xb_add(&bar[XB_XCNT(b.x)], 1u);
    return b;
}
__device__ __forceinline__ void xcd_barrier_complete(unsigned* bar, unsigned x, unsigned& nloc, unsigned& nx) {
    const unsigned G = gridDim.x * gridDim.y * gridDim.z;
    unsigned sum, cnt, mine, sp = 0u;
    for (;;) {
        sum = 0u; cnt = 0u; mine = 0u;
#pragma unroll
        for (unsigned j = 0; j < 16; ++j) { const unsigned c = xb_ld(&bar[XB_XCNT(j)]); sum += c; cnt += (c > 0u) ? 1u : 0u; mine = (j == x) ? c : mine; }
        if (sum == G) break;
        __builtin_amdgcn_s_sleep(1);
        if ((++sp & 255u) == 0u) { if (xb_ld(&bar[XB_TMO])) break; if (sp > XB_SPIN_CAP) { atomicAdd(&bar[XB_TMO], 1u); break; } }
    }
    nloc = mine > 0u ? mine : 1u; nx = cnt > 0u ? cnt : 1u;
}
__device__ __forceinline__ void xcd_barrier(const XcdBarrier& b) {
    asm volatile("s_waitcnt vmcnt(0)" ::: "memory");
    __syncthreads();
    if (threadIdx.x == 0) {
        unsigned* bar = b.bar;
        __builtin_amdgcn_s_waitcnt(0);
        unsigned nloc = b.st[0], nx = b.st[1];
        if (nloc == 0u) { xcd_barrier_complete(bar, b.x, nloc, nx); b.st[0] = nloc; b.st[1] = nx; }
        const unsigned old = xb_add(&bar[XB_XSUB(b.x)], 1u);
        const unsigned gen = old / nloc;
        if (old + 1u == (gen + 1u) * nloc) {
            __builtin_amdgcn_fence(__ATOMIC_RELEASE, "agent");
            asm volatile("s_waitcnt vmcnt(0)" ::: "memory");
            const unsigned og = xb_add(&bar[XB_TOP], 1u);
            const unsigned tg = og / nx;
            if (og + 1u == (tg + 1u) * nx) xb_add(&bar[XB_TOPGEN], 1u);
            else XB_SPIN(xb_ld(&bar[XB_TOPGEN]) == tg, bar);
            __builtin_amdgcn_fence(__ATOMIC_ACQUIRE, "agent");
            xb_add(&bar[XB_XGEN(b.x)], 1u);
            asm volatile("s_waitcnt vmcnt(0)" ::: "memory");
        } else {
            XB_SPIN(xb_ld(&bar[XB_XGEN(b.x)]) == gen, bar);
            __builtin_amdgcn_fence(__ATOMIC_ACQUIRE, "agent");
            asm volatile("s_waitcnt vmcnt(0)" ::: "memory");
        }
    }
    __syncthreads();
}

namespace pg8 {
constexpr int BM = 256, BK = 64, HALF = 128, HTB = HALF * BK * 2, STAGE_BYTES = 8 * HTB;
__host__ __device__ __forceinline__ int lds_byte(int r, int c) { const int st = (r >> 4) * 2 + (c >> 5), rr = r & 15, cc = c & 31, ob = rr * 64 + cc * 2; return st * 1024 + (ob ^ (((ob >> 9) & 1) << 5)); }
__host__ __device__ __forceinline__ void stage_rc(int b, int& R, int& C) { const int st = b / 1024, sb = b % 1024, swz = sb ^ (((sb >> 9) & 1) << 5); R = (st >> 1) * 16 + swz / 64; C = (st & 1) * 32 + (swz % 64) / 2; }
__host__ __device__ __forceinline__ int perm32(int rho) { const int n = rho >> 4, i = rho & 15; return 8 * (i >> 2) + 4 * n + (i & 3); }

constexpr int BIAS_LDS_OFF = 131072 + 2048;
struct Unit { int pm, pn, aux, nvalid; const char* A; const char* B; const int* rows; int par = 0; };

template <class Epi, class Sched, bool GATHER, bool FP8 = false, bool SP2 = (PG8_SP2 != 0)>
__device__ __forceinline__ void gemm_phase(LAS unsigned char* lds, const int tid, const int K, const int lda, const int ldb, const Sched& S, const Epi& E) {
    const int wid = __builtin_amdgcn_readfirstlane(tid >> 6), lane = tid & 63, wr = wid >> 2, wc = wid & 3, fr = lane & 15, fq = lane >> 4;
    constexpr int ESZ = FP8 ? 1 : 2;
    const int nt = K * ESZ / (BK * 2);
    int RC[2];
    unsigned offB[2], offA[2], gAc[2][2];
#pragma unroll
    for (int i = 0; i < 2; ++i) { int R, C; stage_rc(tid * 16 + i * 8192, R, C); RC[i] = (R << 8) | (2 * C); const int Rb = Epi::PERM ? ((R & ~31) + perm32(R & 31)) : R;
        offB[i] = (unsigned)(Rb * ldb * ESZ + C * 2); offA[i] = (unsigned)(R * lda * ESZ + C * 2);
#pragma unroll
        for (int h = 0; h < 2; ++h) gAc[h][i] = offA[i]; }
    const size_t hstepA = (size_t)HALF * lda * ESZ, hstepB = (size_t)HALF * ldb * ESZ;
    const size_t kstep = (size_t)(BK * 2);
    const unsigned ldsw = (unsigned)wid * 1024u;
    const int aoff = lds_byte(wr * 64 + fr, fq * 8), boff = lds_byte(wc * 32 + fr, fq * 8);
#define PG8_SA(b, h) (((b) * 2 + (h)) * HTB)
#define PG8_SB(b, h) ((4 + (b) * 2 + (h)) * HTB)
#define PG8_STAGE(bufoff, gbase, voff) do { _Pragma("unroll") for (int _i = 0; _i < 2; ++_i) \
        __builtin_amdgcn_global_load_lds((const unsigned*)((const char*)(gbase) + (voff)[_i]), (LAS unsigned*)(lds + (bufoff) + ldsw + _i * 8192), 16, 0, 0); } while (0)
#define PG8_STAGEA(bufoff, gbase, h, G) do { if constexpr (GATHER) { PG8_STAGE(bufoff, gbase, G[h]); } else { PG8_STAGE(bufoff, (gbase) + (h) * hstepA, offA); } } while (0)
#define PG8_STAGEA2(bufoff, gbase, h) PG8_STAGEA(bufoff, gbase, h, gAc)
#define PG8_LDA(dst, b, h) do { _Pragma("unroll") for (int m = 0; m < 4; ++m) { dst[m].lo = *(const LAS i32x4*)(lds + PG8_SA(b, h) + aoff + m * 2048); dst[m].hi = *(const LAS i32x4*)(lds + PG8_SA(b, h) + aoff + m * 2048 + 1024); } } while (0)
#define PG8_LDB(dst, b, h) do { _Pragma("unroll") for (int n = 0; n < 2; ++n) { dst[n].lo = *(const LAS i32x4*)(lds + PG8_SB(b, h) + boff + n * 2048); dst[n].hi = *(const LAS i32x4*)(lds + PG8_SB(b, h) + boff + n * 2048 + 1024); } } while (0)
#define PG8_MMA(ai, bj, At, Bt) do { __builtin_amdgcn_s_setprio(1); _Pragma("unroll") for (int m = 0; m < 4; ++m) _Pragma("unroll") for (int n = 0; n < 2; ++n) { \
        if constexpr (FP8) { asm volatile("v_mfma_f32_16x16x128_f8f6f4 %0, %1, %2, %0" : "+v"(acc[ai][bj][m][n]) : "v"(Bt[n]), "v"(At[m])); }     \
        else { const i32x4 _bl = Bt[n].lo, _bh = Bt[n].hi, _al = At[m].lo, _ah = At[m].hi;     \
               acc[ai][bj][m][n] = __builtin_amdgcn_mfma_f32_16x16x32_bf16(__builtin_bit_cast(bf16x8, _bl), __builtin_bit_cast(bf16x8, _al), acc[ai][bj][m][n], 0, 0, 0); \
               acc[ai][bj][m][n] = __builtin_amdgcn_mfma_f32_16x16x32_bf16(__builtin_bit_cast(bf16x8, _bh), __builtin_bit_cast(bf16x8, _ah), acc[ai][bj][m][n], 0, 0, 0); } } \
        __builtin_amdgcn_s_setprio(0); } while (0)
#define PG8_WAIT_V(n) asm volatile("s_waitcnt vmcnt(" #n ")" ::: "memory")
#define PG8_WAIT_L(n) asm volatile("s_waitcnt lgkmcnt(" #n ")" ::: "memory")
#define PG8_BAR __builtin_amdgcn_s_barrier()
#define PG8_SCHED __builtin_amdgcn_sched_barrier(0)
#define PG8_GATHER_LD(U, TOK) do { _Pragma("unroll") for (int _h = 0; _h < 2; ++_h) _Pragma("unroll") for (int _i = 0; _i < 2; ++_i) { const int _r = _h * HALF + (RC[_i] >> 8); \
        TOK[_h][_i] = ((const GAS int*)(U).rows)[_r < (U).nvalid ? _r : 0]; } } while (0)
#define PG8_GATHER_CV(TOK, OFF) do { _Pragma("unroll") for (int _h = 0; _h < 2; ++_h) _Pragma("unroll") for (int _i = 0; _i < 2; ++_i) OFF[_h][_i] = (unsigned)(TOK[_h][_i] * lda * ESZ + (RC[_i] & 0xff)); } while (0)
#define PG8_GATHER(U, OFF) do { _Pragma("unroll") for (int _h = 0; _h < 2; ++_h) _Pragma("unroll") for (int _i = 0; _i < 2; ++_i) { const int _r = _h * HALF + (RC[_i] >> 8); \
        const int _tok = ((const GAS int*)(U).rows)[_r < (U).nvalid ? _r : 0]; OFF[_h][_i] = (unsigned)(_tok * lda * ESZ + (RC[_i] & 0xff)); } } while (0)
    Unit cur, nxt; int ui = 0;
    if (!S.next(0, cur)) return;
    f32x4 acc[2][2][4][2];
#pragma unroll
    for (int a = 0; a < 2; ++a)
#pragma unroll
        for (int b = 0; b < 2; ++b)
#pragma unroll
            for (int m = 0; m < 4; ++m)
#pragma unroll
                for (int n = 0; n < 2; ++n) acc[a][b][m][n] = (f32x4){0.f, 0.f, 0.f, 0.f};
    i32x8 At[4], B0[2], B1[2];
    const char* cA = cur.A; const char* cB = cur.B;
    if constexpr (GATHER) { PG8_GATHER(cur, gAc); }
    if constexpr (SP2) {
        PG8_STAGE(PG8_SB(0, 0), cB, offB); PG8_STAGE(PG8_SB(0, 1), cB + hstepB, offB); PG8_STAGEA(PG8_SA(0, 0), cA, 0, gAc); PG8_STAGEA(PG8_SA(0, 1), cA, 1, gAc);
        if (wr == 1) PG8_BAR;
        PG8_WAIT_V(2); PG8_BAR;
        PG8_STAGE(PG8_SB(1, 0), cB + kstep, offB); PG8_STAGEA(PG8_SA(1, 0), cA + kstep, 0, gAc); PG8_STAGE(PG8_SB(1, 1), cB + kstep + hstepB, offB);
        PG8_WAIT_V(6); PG8_BAR;
    } else {
    PG8_STAGE(PG8_SB(0, 0), cB, offB); PG8_STAGEA(PG8_SA(0, 0), cA, 0, gAc); PG8_STAGE(PG8_SB(0, 1), cB + hstepB, offB); PG8_STAGEA(PG8_SA(0, 1), cA, 1, gAc);
    if (wr == 1) PG8_BAR;
    PG8_WAIT_V(4); PG8_BAR;
    PG8_STAGE(PG8_SB(1, 0), cB + kstep, offB); PG8_STAGEA(PG8_SA(1, 0), cA + kstep, 0, gAc); PG8_STAGE(PG8_SB(1, 1), cB + kstep + hstepB, offB);
    PG8_WAIT_V(6); PG8_BAR;
    }
    for (;;) {
        const bool has_next = S.next(ui + 1, nxt);
        cur.par = ui & 1;
        if constexpr (Epi::BIASLDS) { if (wid == 0) { int l2; asm volatile("v_mbcnt_lo_u32_b32 %0, -1, 0\n\tv_mbcnt_hi_u32_b32 %0, -1, %0" : "=v"(l2)); E.prefetch(cur, ui & 1, l2); } }
        const char* nA = has_next ? nxt.A : cA; const char* nB = has_next ? nxt.B : cB;
#pragma unroll 1
        for (int t = 0; t < nt; t += 2) {
            const bool last = (t == nt - 2);
            const char* a1 = cA + (size_t)(t + 1) * kstep;
            const char* a2 = last ? nA : cA + (size_t)(t + 2) * kstep; const char* b2 = last ? nB : cB + (size_t)(t + 2) * kstep;
            const char* a3 = a2 + kstep; const char* b3 = b2 + kstep;
            int tokn[2][2];
            if constexpr (GATHER) { if (last && has_next) { PG8_GATHER_LD(nxt, tokn); } }
            if constexpr (SP2) {
            PG8_LDB(B0, 0, 0); PG8_LDB(B1, 0, 1); PG8_SCHED; PG8_LDA(At, 0, 0); PG8_STAGEA(PG8_SA(1, 1), a1, 1, gAc);
            PG8_WAIT_V(8); PG8_WAIT_L(0); PG8_BAR; PG8_MMA(0, 0, At, B0); PG8_MMA(0, 1, At, B1); PG8_BAR; PG8_SCHED;
            if constexpr (GATHER) { if (last && has_next) { PG8_GATHER_CV(tokn, gAc); } }
            PG8_LDA(At, 0, 1); PG8_STAGE(PG8_SB(0, 0), b2, offB); PG8_STAGE(PG8_SB(0, 1), b2 + hstepB, offB); PG8_STAGEA2(PG8_SA(0, 0), a2, 0);
            PG8_WAIT_V(8); PG8_WAIT_L(0); PG8_BAR; PG8_MMA(1, 0, At, B0); PG8_MMA(1, 1, At, B1); PG8_BAR; PG8_SCHED;
            PG8_LDB(B0, 1, 0); PG8_LDB(B1, 1, 1); PG8_SCHED; PG8_LDA(At, 1, 0); PG8_STAGEA2(PG8_SA(0, 1), a2, 1);
            PG8_WAIT_V(8); PG8_WAIT_L(0); PG8_BAR; PG8_MMA(0, 0, At, B0); PG8_MMA(0, 1, At, B1); PG8_BAR; PG8_SCHED;
            PG8_LDA(At, 1, 1); PG8_STAGE(PG8_SB(1, 0), b3, offB); PG8_STAGE(PG8_SB(1, 1), b3 + hstepB, offB); PG8_STAGEA2(PG8_SA(1, 0), a3, 0);
            PG8_WAIT_V(8); PG8_WAIT_L(0); PG8_BAR; PG8_MMA(1, 0, At, B0); PG8_MMA(1, 1, At, B1); PG8_BAR; PG8_SCHED;
            } else {
            PG8_LDB(B0, 0, 0); PG8_SCHED; PG8_LDA(At, 0, 0); PG8_STAGEA(PG8_SA(1, 1), a1, 1, gAc);
            PG8_WAIT_L(8); PG8_BAR; PG8_WAIT_L(0); PG8_MMA(0, 0, At, B0); PG8_BAR; PG8_SCHED;
            if constexpr (GATHER) { if (last && has_next) { PG8_GATHER_CV(tokn, gAc); } }
            PG8_LDB(B1, 0, 1); PG8_STAGE(PG8_SB(0, 0), b2, offB);
            PG8_BAR; PG8_WAIT_L(0); PG8_MMA(0, 1, At, B1); PG8_BAR;
            PG8_LDA(At, 0, 1); PG8_STAGEA2(PG8_SA(0, 0), a2, 0);
            PG8_BAR; PG8_WAIT_L(0); PG8_MMA(1, 0, At, B0); PG8_BAR; PG8_SCHED;
            PG8_STAGE(PG8_SB(0, 1), b2 + hstepB, offB);
            PG8_WAIT_V(6); PG8_BAR; PG8_MMA(1, 1, At, B1); PG8_BAR;
            PG8_LDB(B0, 1, 0); PG8_SCHED; PG8_LDA(At, 1, 0); PG8_STAGEA2(PG8_SA(0, 1), a2, 1);
            PG8_WAIT_L(8); PG8_BAR; PG8_WAIT_L(0); PG8_MMA(0, 0, At, B0); PG8_BAR; PG8_SCHED;
            PG8_LDB(B1, 1, 1); PG8_STAGE(PG8_SB(1, 0), b3, offB);
            PG8_BAR; PG8_WAIT_L(0); PG8_MMA(0, 1, At, B1); PG8_BAR;
            PG8_LDA(At, 1, 1); PG8_STAGEA2(PG8_SA(1, 0), a3, 0);
            PG8_BAR; PG8_WAIT_L(0); PG8_MMA(1, 0, At, B0); PG8_BAR; PG8_SCHED;
            PG8_STAGE(PG8_SB(1, 1), b3 + hstepB, offB);
            PG8_WAIT_V(6); PG8_BAR; PG8_MMA(1, 1, At, B1); PG8_BAR;
            }
        }
        if constexpr (FP8) asm volatile("s_nop 15" ::: "memory");
        { int l2; asm volatile("v_mbcnt_lo_u32_b32 %0, -1, 0\n\tv_mbcnt_hi_u32_b32 %0, -1, %0" : "=v"(l2)); E(acc, cur, wr, wc, l2 & 15, l2 >> 4); if (DUP_EPI && FP8) { asm volatile("" ::: "memory"); E(acc, cur, wr, wc, l2 & 15, l2 >> 4); } }
        if (!has_next) break;
#pragma unroll
        for (int a = 0; a < 2; ++a)
#pragma unroll
            for (int b = 0; b < 2; ++b)
#pragma unroll
                for (int m = 0; m < 4; ++m)
#pragma unroll
                    for (int n = 0; n < 2; ++n) acc[a][b][m][n] = (f32x4){0.f, 0.f, 0.f, 0.f};
        cur = nxt; cA = nA; cB = nB; ++ui;
    }
    PG8_WAIT_V(0);
    if (wr == 0) PG8_BAR;
    PG8_BAR;
#undef PG8_SA
#undef PG8_SB
#undef PG8_STAGE
#undef PG8_LDA
#undef PG8_LDB
#undef PG8_MMA
#undef PG8_WAIT_V
#undef PG8_WAIT_L
#undef PG8_BAR
#undef PG8_SCHED
#undef PG8_GATHER
#undef PG8_GATHER_LD
#undef PG8_GATHER_CV
#undef PG8_STAGEA
#undef PG8_STAGEA2
}
}
namespace pg8 {
__device__ __forceinline__ u32x4 widen16(u32x2 we, u32x2 wo) {
    const u32x2 r0 = __builtin_amdgcn_permlane16_swap(we.x, wo.x, false, false), r1 = __builtin_amdgcn_permlane16_swap(we.y, wo.y, false, false);
    return (u32x4){r0.x, r1.x, r0.y, r1.y};
}
struct EpiBf16 {
    static constexpr bool PERM = true; static constexpr bool BIASLDS = false;
    bf16_t* O; int ldc; float scale;
    __device__ __forceinline__ void operator()(const f32x4 (&acc)[2][2][4][2], const Unit& u, int wr, int wc, int fr, int fq) const {
        const int row0 = u.pm * BM + wr * 64 + fr, col0 = u.pn * BM + wc * 32 + 8 * fq;
#pragma unroll
        for (int ai = 0; ai < 2; ++ai)
#pragma unroll
            for (int m = 0; m < 4; ++m) { bf16_t* rowp = O + (size_t)(row0 + ai * HALF + m * 16) * ldc + col0;
#pragma unroll
                for (int bj = 0; bj < 2; ++bj) { const f32x4 v0 = acc[ai][bj][m][0] * scale, v1 = acc[ai][bj][m][1] * scale;
                    u32x4 w; w.x = cvt_pk_bf16(v0[0], v0[1]); w.y = cvt_pk_bf16(v0[2], v0[3]); w.z = cvt_pk_bf16(v1[0], v1[1]); w.w = cvt_pk_bf16(v1[2], v1[3]);
                    *(u32x4*)(rowp + bj * HALF) = w; } }
    }
};
struct EpiVT {
    static constexpr bool PERM = true; static constexpr bool BIASLDS = false;
    bf16_t* O; int ldc; float scale = 1.0f;
    __device__ __forceinline__ void operator()(const f32x4 (&acc)[2][2][4][2], const Unit& u, int wr, int wc, int fr, int fq) const {
        const int row0 = u.pm * BM + wr * 64 + fr, col0 = u.pn * BM + wc * 32 + 8 * fq;
        const int cb = col0 & ~15, g = (col0 >> 2) & 3;
        const int s0 = cb + ((g == 0) ? 0 : 4), s1 = cb + ((g == 0) ? 8 : 12);
#pragma unroll
        for (int ai = 0; ai < 2; ++ai)
#pragma unroll
            for (int m = 0; m < 4; ++m) { bf16_t* rowp = O + (size_t)(row0 + ai * HALF + m * 16) * ldc;
#pragma unroll
                for (int bj = 0; bj < 2; ++bj) { const f32x4 v0 = acc[ai][bj][m][0] * scale, v1 = acc[ai][bj][m][1] * scale;
                    u32x2 w0, w1; w0.x = cvt_pk_bf16(v0[0], v0[1]); w0.y = cvt_pk_bf16(v0[2], v0[3]); w1.x = cvt_pk_bf16(v1[0], v1[1]); w1.y = cvt_pk_bf16(v1[2], v1[3]);
                    *(u32x2*)(rowp + bj * HALF + s0) = w0; *(u32x2*)(rowp + bj * HALF + s1) = w1; } }
    }
};
struct EpiF8 {
    static constexpr bool PERM = true; static constexpr bool BIASLDS = false;
    unsigned char* O; int ldc; float scale;
    __device__ __forceinline__ void operator()(const f32x4 (&acc)[2][2][4][2], const Unit& u, int wr, int wc, int fr, int fq) const {
        const int row0 = u.pm * BM + wr * 64 + fr, col0 = u.pn * BM + wc * 32 + 8 * fq;
#pragma unroll
        for (int ai = 0; ai < 2; ++ai)
#pragma unroll
            for (int m = 0; m < 4; ++m) { unsigned char* rowp = O + (size_t)(row0 + ai * HALF + m * 16) * ldc + col0;
#pragma unroll
                for (int bj = 0; bj < 2; ++bj) { const f32x4 v0 = acc[ai][bj][m][0] * scale, v1 = acc[ai][bj][m][1] * scale;
                    u32x2 w; w.x = cvt4_fp8(v0[0], v0[1], v0[2], v0[3]); w.y = cvt4_fp8(v1[0], v1[1], v1[2], v1[3]); *(u32x2*)(rowp + bj * HALF) = w; } }
    }
};
struct EpiVT8 {
    static constexpr bool PERM = true; static constexpr bool BIASLDS = false;
    unsigned char* O; int ldc; float scale;
    __device__ __forceinline__ void operator()(const f32x4 (&acc)[2][2][4][2], const Unit& u, int wr, int wc, int fr, int fq) const {
        const int row0 = u.pm * BM + wr * 64 + fr, col0 = u.pn * BM + wc * 32 + 8 * fq;
#pragma unroll
        for (int ai = 0; ai < 2; ++ai)
#pragma unroll
            for (int m = 0; m < 4; ++m) { unsigned char* rowp = O + (size_t)(row0 + ai * HALF + m * 16) * ldc;
#pragma unroll
                for (int bj = 0; bj < 2; ++bj) { const int c = col0 + bj * HALF, p0 = (c & ~63) + 16 * ((c >> 5) & 1) + 4 * ((c & 31) >> 3);
                    const f32x4 v0 = acc[ai][bj][m][0] * scale, v1 = acc[ai][bj][m][1] * scale;
                    *(unsigned*)(rowp + p0) = cvt4_fp8(v0[0], v0[1], v0[2], v0[3]); *(unsigned*)(rowp + p0 + 32) = cvt4_fp8(v1[0], v1[1], v1[2], v1[3]); } }
    }
};
struct EpiF32 {
    static constexpr bool PERM = false; static constexpr bool BIASLDS = false;
    float* C; int ldc; float scale;
    __device__ __forceinline__ void operator()(const f32x4 (&acc)[2][2][4][2], const Unit& u, int wr, int wc, int fr, int fq) const {
        const int row0 = u.pm * BM + wr * 64 + fr, col0 = u.pn * BM + wc * 32 + 4 * fq;
#pragma unroll
        for (int ai = 0; ai < 2; ++ai)
#pragma unroll
            for (int m = 0; m < 4; ++m) { float* rowp = C + (size_t)(row0 + ai * HALF + m * 16) * ldc + col0;
#pragma unroll
                for (int bj = 0; bj < 2; ++bj)
#pragma unroll
                    for (int n = 0; n < 2; ++n) *(f32x4*)(rowp + bj * HALF + n * 16) = acc[ai][bj][m][n] * scale; }
    }
};
struct EpiResid {
    static constexpr bool PERM = true; static constexpr bool BIASLDS = false;
    const bf16_t* X; float* Z; int ldc; float alpha, ascale;
    __device__ __forceinline__ void operator()(const f32x4 (&acc)[2][2][4][2], const Unit& u, int wr, int wc, int fr, int fq) const {
        const int row0 = u.pm * BM + wr * 64 + fr, col0 = u.pn * BM + wc * 32 + 8 * fq;
        u32x4 xw[2][2];
#define ER_LOAD(g) do { const size_t off_ = (size_t)(row0 + ((g) >> 2) * HALF + ((g) & 3) * 16) * ldc + col0; \
            _Pragma("unroll") for (int bj = 0; bj < 2; ++bj) xw[(g) & 1][bj] = *(const u32x4*)(X + off_ + bj * HALF); } while (0)
        ER_LOAD(0);
#pragma unroll
        for (int g = 0; g < 8; ++g) { const int ai = g >> 2, m = g & 3; const size_t off = (size_t)(row0 + ai * HALF + m * 16) * ldc + col0;
            if (g + 1 < 8) ER_LOAD(g + 1);
            __builtin_amdgcn_sched_barrier(0);
#pragma unroll
            for (int bj = 0; bj < 2; ++bj) { const u32x4 x = xw[g & 1][bj];
                const f32x4 x0 = {bf_lo(x.x), bf_hi(x.x), bf_lo(x.y), bf_hi(x.y)}, x1 = {bf_lo(x.z), bf_hi(x.z), bf_lo(x.w), bf_hi(x.w)};
                const f32x4 z0 = x0 * alpha + acc[ai][bj][m][0] * ascale, z1 = x1 * alpha + acc[ai][bj][m][1] * ascale;
                if (ZF_BF16) { u32x4 w; w.x = cvt_pk_bf16(z0[0], z0[1]); w.y = cvt_pk_bf16(z0[2], z0[3]); w.z = cvt_pk_bf16(z1[0], z1[1]); w.w = cvt_pk_bf16(z1[2], z1[3]); *(u32x4*)((bf16_t*)Z + off + bj * HALF) = w; }
                else { *(f32x4*)(Z + off + bj * HALF) = z0; *(f32x4*)(Z + off + bj * HALF + 4) = z1; } }
            __builtin_amdgcn_sched_barrier(0); }
#undef ER_LOAD
    }
};
struct EpiQRope {
    static constexpr bool PERM = true; static constexpr bool BIASLDS = false;
    bf16_t* O; int ldc; const float* cosT; const float* sinT; float scale;
    __device__ __forceinline__ void operator()(const f32x4 (&acc)[2][2][4][2], const Unit& u, int wr, int wc, int fr, int fq) const {
        const int row0 = u.pm * BM + wr * 64 + fr, col0 = u.pn * BM + wc * 32 + 8 * fq;
        f32x4 cc[2][2], ss[2][2];
        const int rr0 = col0 % AQD, rr1 = (col0 + HALF) % AQD;
#define QR_LOAD(g) do { const unsigned row_ = (unsigned)(row0 + ((g) >> 2) * HALF + ((g) & 3) * 16); \
            _Pragma("unroll") for (int bj = 0; bj < 2; ++bj) { const int rr_ = bj ? rr1 : rr0; \
                if (rr_ >= ANOPE) { const unsigned tb_ = (row_ * 32u + (unsigned)((rr_ - ANOPE) >> 1)) * 4u; cc[(g) & 1][bj] = *(const f32x4*)((const char*)cosT + tb_); ss[(g) & 1][bj] = *(const f32x4*)((const char*)sinT + tb_); } } } while (0)
        QR_LOAD(0);
#pragma unroll
        for (int g = 0; g < 8; ++g) { const int ai = g >> 2, m = g & 3; const unsigned row = (unsigned)(row0 + ai * HALF + m * 16);
            if (g + 1 < 8) QR_LOAD(g + 1);
            __builtin_amdgcn_sched_barrier(0);
#pragma unroll
            for (int bj = 0; bj < 2; ++bj) { f32x4 v0 = acc[ai][bj][m][0] * scale, v1 = acc[ai][bj][m][1] * scale;
                const int col = col0 + bj * HALF, rr = bj ? rr1 : rr0;
                if (rr >= ANOPE) { const f32x4 c = cc[g & 1][bj], s = ss[g & 1][bj];
                    const f32x4 a0 = v0, a1 = v1;
                    v0[0] = a0[0] * c[0] - a0[1] * s[0]; v0[1] = a0[1] * c[0] + a0[0] * s[0]; v0[2] = a0[2] * c[1] - a0[3] * s[1]; v0[3] = a0[3] * c[1] + a0[2] * s[1];
                    v1[0] = a1[0] * c[2] - a1[1] * s[2]; v1[1] = a1[1] * c[2] + a1[0] * s[2]; v1[2] = a1[2] * c[3] - a1[3] * s[3]; v1[3] = a1[3] * c[3] + a1[2] * s[3]; }
                if (ATT_FP8) { u32x2 w; w.x = cvt4_fp8(v0[0], v0[1], v0[2], v0[3]); w.y = cvt4_fp8(v1[0], v1[1], v1[2], v1[3]); *(u32x2*)((char*)O + ((size_t)row * (unsigned)ldc + (unsigned)col)) = w; }
                else { u32x4 w; w.x = cvt_pk_bf16(v0[0], v0[1]); w.y = cvt_pk_bf16(v0[2], v0[3]); w.z = cvt_pk_bf16(v1[0], v1[1]); w.w = cvt_pk_bf16(v1[2], v1[3]);
                    *(u32x4*)((char*)O + ((size_t)row * (unsigned)ldc + (unsigned)col) * 2u) = w; } }
            __builtin_amdgcn_sched_barrier(0); }
#undef QR_LOAD
    }
};
struct EpiSwiglu {
    static constexpr bool PERM = true; static constexpr bool BIASLDS = true;
    unsigned char* Hh; const float* bgu; LAS unsigned char* lds;
    __device__ __forceinline__ void prefetch(const Unit& u, int par, int lane) const {
        __builtin_amdgcn_global_load_lds((const unsigned*)(bgu + (size_t)u.aux * 2048 + 2 * (u.pn * HALF) + 4 * lane), (LAS unsigned*)(lds + BIAS_LDS_OFF + par * 1024), 16, 0, 0); }
    __device__ __forceinline__ void operator()(const f32x4 (&acc)[2][2][4][2], const Unit& u, int wr, int wc, int fr, int fq) const {
        const int row0 = u.pm * BM + wr * 64 + fr, j0 = u.pn * HALF + wc * 32 + 8 * fq;
        const LAS f32x4* bp = (const LAS f32x4*)(lds + BIAS_LDS_OFF + u.par * 1024 + (64 * wc + 16 * fq) * 4);
        const f32x4 b0 = bp[0], b1 = bp[1], b2 = bp[2], b3 = bp[3];
        const float bg[8] = {b0[0], b0[2], b1[0], b1[2], b2[0], b2[2], b3[0], b3[2]}, bl[8] = {b0[1], b0[3], b1[1], b1[3], b2[1], b2[3], b3[1], b3[3]};
        constexpr float inv = MOE_FP8 ? 1.0f / (F8_SX * F8_SWG) : 1.0f;
#pragma unroll
        for (int ai = 0; ai < 2; ++ai)
#pragma unroll
            for (int mp = 0; mp < 2; ++mp) { u32x2 w8[2];
#pragma unroll
                for (int mo = 0; mo < 2; ++mo) { const int m = 2 * mp + mo; unsigned char* rowp = Hh + ((size_t)(row0 + ai * HALF + m * 16) * DFF + j0) * (MOE_FP8 ? 1 : 2);
                float o[8];
#pragma unroll
                for (int q = 0; q < 8; ++q) { float g = acc[ai][0][m][q >> 2][q & 3] * inv + bg[q], l = acc[ai][1][m][q >> 2][q & 3] * inv + bl[q];
                    g = fminf(g, 7.0f); l = fminf(fmaxf(l, -7.0f), 7.0f);
                    const float sg = __builtin_amdgcn_rcpf(1.0f + __builtin_amdgcn_exp2f(-1.702f * 1.4426950408889634f * g));
                    o[q] = (l + 1.0f) * g * sg * (MOE_FP8 ? F8_SH : 1.0f); }
                if (MOE_FP8) { w8[mo].x = cvt4_fp8(o[0], o[1], o[2], o[3]); w8[mo].y = cvt4_fp8(o[4], o[5], o[6], o[7]); }
                else { u32x4 w; w.x = cvt_pk_bf16(o[0], o[1]); w.y = cvt_pk_bf16(o[2], o[3]); w.z = cvt_pk_bf16(o[4], o[5]); w.w = cvt_pk_bf16(o[6], o[7]); *(u32x4*)rowp = w; } }
                if (MOE_FP8) { const u32x4 w16 = widen16(w8[0], w8[1]);
                    *(u32x4*)(Hh + (size_t)(row0 + ai * HALF + (2 * mp + (fq & 1)) * 16) * DFF + (j0 - 8 * fq) + 16 * (fq >> 1)) = w16; } }
    }
};
struct EpiDown {
    static constexpr bool PERM = true; static constexpr bool BIASLDS = true;
    bf16_t* Y; const float* bd; LAS unsigned char* lds;
    __device__ __forceinline__ void prefetch(const Unit& u, int par, int lane) const {
        __builtin_amdgcn_global_load_lds((const unsigned*)(bd + (size_t)u.aux * D + u.pn * BM + 4 * lane), (LAS unsigned*)(lds + BIAS_LDS_OFF + par * 1024), 16, 0, 0); }
    __device__ __forceinline__ void operator()(const f32x4 (&acc)[2][2][4][2], const Unit& u, int wr, int wc, int fr, int fq) const {
        const int row0 = u.pm * BM + wr * 64 + fr, col0 = u.pn * BM + wc * 32 + 8 * fq;
        const LAS f32x4* bp = (const LAS f32x4*)(lds + BIAS_LDS_OFF + u.par * 1024 + (wc * 32 + 8 * fq) * 4);
        constexpr float inv = MOE_FP8 ? 1.0f / (F8_SH * F8_SWD) : 1.0f;
#pragma unroll
        for (int bj = 0; bj < 2; ++bj) {
            const f32x4 b0 = bp[bj * (HALF / 4)], b1 = bp[bj * (HALF / 4) + 1];
#pragma unroll
            for (int ai = 0; ai < 2; ++ai)
#pragma unroll
                for (int mp = 0; mp < 2; ++mp) { u32x2 w8[2];
#pragma unroll
                    for (int mo = 0; mo < 2; ++mo) { const int m = 2 * mp + mo; const f32x4 v0 = acc[ai][bj][m][0] * inv + b0, v1 = acc[ai][bj][m][1] * inv + b1;
                    if (Y_FP8) { w8[mo].x = cvt4_fp8(v0[0] * F8_SY, v0[1] * F8_SY, v0[2] * F8_SY, v0[3] * F8_SY); w8[mo].y = cvt4_fp8(v1[0] * F8_SY, v1[1] * F8_SY, v1[2] * F8_SY, v1[3] * F8_SY); }
                    else { u32x4 w; w.x = cvt_pk_bf16(v0[0], v0[1]); w.y = cvt_pk_bf16(v0[2], v0[3]); w.z = cvt_pk_bf16(v1[0], v1[1]); w.w = cvt_pk_bf16(v1[2], v1[3]);
                        *(u32x4*)((char*)Y + ((size_t)(unsigned)(row0 + ai * HALF + m * 16) * D + (unsigned)(col0 + bj * HALF)) * 2u) = w; } }
                    if (Y_FP8) { const u32x4 w16 = widen16(w8[0], w8[1]);
                        *(u32x4*)((char*)Y + ((size_t)(unsigned)(row0 + ai * HALF + (2 * mp + (fq & 1)) * 16) * D + (unsigned)(col0 - 8 * fq + 16 * (fq >> 1) + bj * HALF))) = w16; } }
            asm volatile("" ::: "memory"); }
    }
};

struct DenseOrder {
    const char* A; const char* Bt; int nM, nN, G, c; size_t astep, bstep;
    int skip_at = 1 << 30, skip_n = 0;
    __device__ __forceinline__ void init(const void* A_, const void* Bt_, int M, int N, int lda, int ldb, int G_, int c_, int esz = 2) { A = (const char*)A_; Bt = (const char*)Bt_; nM = M / BM; nN = N / BM; G = G_; c = c_; astep = (size_t)BM * lda * esz; bstep = (size_t)BM * ldb * esz; }
    __device__ __forceinline__ bool next(int i, Unit& u) const {
        const int L = i * G + c; if (L >= nM * nN) return false;
        u.pm = L / nN; u.pn = L - u.pm * nN; if (u.pn >= skip_at) u.pn += skip_n;
        u.aux = 0; u.nvalid = 256; u.A = A + (size_t)u.pm * astep; u.B = Bt + (size_t)u.pn * bstep; u.rows = nullptr; return true;
    }
};
constexpr int MOE_UTAB_OFF = 131072;
struct MoeOrder {
    const volatile LAS int* utab; const char* A; const char* W; const int* list; int nunits; size_t wstep_e, astep;
    bool gather; size_t arow_step;
    __device__ __forceinline__ bool next(int i, Unit& u) const {
        if (i >= nunits) return false;
        const i32x4 ut = *(const LAS i32x4*)((const LAS int*)utab + 4 * i);
        const int rt = __builtin_amdgcn_readfirstlane(ut.x), pn = __builtin_amdgcn_readfirstlane(ut.y), er = __builtin_amdgcn_readfirstlane(ut.z), nv = __builtin_amdgcn_readfirstlane(ut.w);
        const int e = er & 0xff, rtl = er >> 8;
        u.pm = rt; u.pn = pn; u.aux = e; u.nvalid = nv; u.B = W + (size_t)e * wstep_e + (size_t)pn * astep;
        if (gather) { u.A = A; u.rows = list + (size_t)e * T + (size_t)rtl * 256; } else { u.A = A + (size_t)rt * arow_step; u.rows = nullptr; }
        return true;
    }
};
}
struct Args { const void* in[20]; float* out; unsigned char* ws; int ph_lo, ph_hi; };
struct Frame {
    LAS unsigned char* lds; volatile LAS unsigned* MISC;
    int tid, lane, wave, vcu, G;
    __device__ __forceinline__ const void* ptr(int i) const { const unsigned lo = __builtin_amdgcn_readfirstlane(MISC[128 + 2 * i]), hi = __builtin_amdgcn_readfirstlane(MISC[129 + 2 * i]);
        return (const void*)(const GAS char*)(((unsigned long long)hi << 32) | lo); }
    __device__ __forceinline__ unsigned char* ws() const { return (unsigned char*)ptr(21); }
    __device__ __forceinline__ float* out() const { return (float*)ptr(20); }
    __device__ __forceinline__ unsigned* ctl() const { return (unsigned*)ptr(21); }
};
__device__ __forceinline__ Frame refresh(const Frame& F) {
    Frame R = F; int ln, w = F.wave, v = F.vcu, g = F.G;
    asm volatile("v_mbcnt_lo_u32_b32 %0, -1, 0\n\tv_mbcnt_hi_u32_b32 %0, -1, %0" : "=v"(ln));
    asm volatile("" : "+s"(w), "+s"(v), "+s"(g));
    R.tid = w * 64 + ln; R.lane = ln; R.wave = w; R.vcu = v; R.G = g; return R;
}
enum { IN_X = 0, IN_POS, IN_LNG, IN_LNB, IN_MWIN, IN_MBG, IN_MNG, IN_MWOUT, IN_AWIN, IN_AQN, IN_AKVN, IN_AWQB, IN_AWKVB, IN_AWOUT, IN_RW, IN_RB, IN_WGU, IN_BGU, IN_WD, IN_BD };

template <class RowMap>
__device__ __forceinline__ void transpose_item(const float* __restrict__ W, int ldw, int K, bf16_t* __restrict__ WT, LAS float*, int kb, int nb, int lane, RowMap rm) {
    const int n4 = lane & 7, kg = lane >> 3, k0 = 64 * kb + 8 * kg, n0 = 32 * nb + 4 * n4;
    f32x4 v[8];
#pragma unroll
    for (int i = 0; i < 8; ++i) v[i] = *(const f32x4*)(W + (size_t)(k0 + i) * ldw + n0);
#pragma unroll
    for (int jn = 0; jn < 4; ++jn) { u32x4 o; o.x = cvt_pk_bf16(v[0][jn], v[1][jn]); o.y = cvt_pk_bf16(v[2][jn], v[3][jn]); o.z = cvt_pk_bf16(v[4][jn], v[5][jn]); o.w = cvt_pk_bf16(v[6][jn], v[7][jn]);
        *(u32x4*)(WT + (size_t)rm(n0 + jn) * K + k0) = o; }
}
template <class RowMap>
__device__ __forceinline__ void transpose_item_f8(const float* __restrict__ W, int ldw, int K, unsigned char* __restrict__ WT, LAS float*, int kb, int nb, int lane, RowMap rm, float scale) {
    const int n4 = lane & 7, kg = lane >> 3, k0 = 64 * kb + 8 * kg, n0 = 32 * nb + 4 * n4;
    f32x4 v[8];
#pragma unroll
    for (int i = 0; i < 8; ++i) v[i] = *(const f32x4*)(W + (size_t)(k0 + i) * ldw + n0) * scale;
#pragma unroll
    for (int jn = 0; jn < 4; ++jn) { u32x2 o; o.x = cvt4_fp8(v[0][jn], v[1][jn], v[2][jn], v[3][jn]); o.y = cvt4_fp8(v[4][jn], v[5][jn], v[6][jn], v[7][jn]);
        *(u32x2*)(WT + (size_t)rm(n0 + jn) * K + k0) = o; }
}
template <class RowMap>
__device__ __forceinline__ void transpose_item_f8w(const float* __restrict__ W, int ldw, int K, unsigned char* __restrict__ WT, int kb, int nb, int lane, RowMap rm, float scale) {
    const int n4 = lane & 15, kg = lane >> 4, k0 = 64 * kb + 16 * kg, n0 = 64 * nb + 4 * n4;
    f32x4 v[16];
#pragma unroll
    for (int i = 0; i < 16; ++i) v[i] = *(const f32x4*)(W + (size_t)(k0 + i) * ldw + n0) * scale;
#pragma unroll
    for (int jn = 0; jn < 4; ++jn) { u32x4 o; o.x = cvt4_fp8(v[0][jn], v[1][jn], v[2][jn], v[3][jn]); o.y = cvt4_fp8(v[4][jn], v[5][jn], v[6][jn], v[7][jn]);
        o.z = cvt4_fp8(v[8][jn], v[9][jn], v[10][jn], v[11][jn]); o.w = cvt4_fp8(v[12][jn], v[13][jn], v[14][jn], v[15][jn]);
        *(u32x4*)(WT + (size_t)rm(n0 + jn) * K + k0) = o; }
}
struct RmId { __device__ __forceinline__ int operator()(int n) const { return n; } };
struct RmQb { __device__ __forceinline__ int operator()(int n) const { const int hh = n / AQD, r = n - hh * AQD; if (r < ANOPE) return n; const int i = r - ANOPE; return hh * AQD + ANOPE + ((i < 32) ? 2 * i : 2 * (i - 32) + 1); } };
struct RmKv { __device__ __forceinline__ int operator()(int n) const { const int hh = n >> 8, r = n & 255; return (r < 128) ? hh * 128 + r : 1024 + hh * 128 + (r - 128); } };
struct RmGu { __device__ __forceinline__ int operator()(int n) const { const int j = n >> 1, l = n & 1; return (j >> 7) * 256 + l * 128 + (j & 127); } };

__device__ __forceinline__ void p0_prologue(const Frame& F) {
    LAS float* scr = (LAS float*)(F.lds + F.wave * 8704);
    const int gw = F.vcu * NWAVES + F.wave, NGW = F.G * NWAVES, lane = F.lane;
    unsigned char* ws = F.ws();
    constexpr int I_MWIN = 16 * 96, I_SQ = 16 * 32, I_AWIN = 16 * 22, I_QB = 6 * 48, I_KV = 4 * 64, I_GU = MOE_FP8 ? 16 * 32 : 16 * 64, I_D = MOE_FP8 ? 16 * 16 : 16 * 32;
    constexpr int N_SMALL = 2 * (I_MWIN + I_SQ + I_AWIN + I_QB + I_KV + I_SQ);
    constexpr int P0_LAYERS = (CV_IN_ATTN && MOE_FP8 && ATT_FP8) ? 1 : 4;
    constexpr int NITEMS = N_SMALL + P0_LAYERS * 32 * (I_GU + I_D);
    constexpr int N_LAYER = 32 * (I_GU + I_D);
    for (int it = gw; it < NITEMS; it += NGW) {
        int r = it;
        if (r < P0_LAYERS * N_LAYER) {
            const int l = (P0_LAYERS - 1) - r / N_LAYER; r -= (P0_LAYERS - 1 - l) * N_LAYER;
            if (r < 32 * I_GU) { const int mtx = l * 32 + r / I_GU, q = r % I_GU;
                if (MOE_FP8) transpose_item_f8w((const float*)F.ptr(IN_WGU) + (size_t)mtx * 1024 * 2048, 2048, 1024, (unsigned char*)(ws + WS_WGU) + (size_t)mtx * 2048 * 1024, q >> 5, q & 31, lane, RmGu(), F8_SWG);
                else transpose_item((const float*)F.ptr(IN_WGU) + (size_t)mtx * 1024 * 2048, 2048, 1024, (bf16_t*)(ws + WS_WGU) + (size_t)mtx * 2048 * 1024, scr, q >> 6, q & 63, lane, RmGu()); }
            else { r -= 32 * I_GU; const int mtx = l * 32 + r / I_D, q = r % I_D;
                if (MOE_FP8) transpose_item_f8w((const float*)F.ptr(IN_WD) + (size_t)mtx * 1024 * 1024, 1024, 1024, (unsigned char*)(ws + WS_WD) + (size_t)mtx * 1024 * 1024, q >> 4, q & 15, lane, RmId(), F8_SWD);
                else transpose_item((const float*)F.ptr(IN_WD) + (size_t)mtx * 1024 * 1024, 1024, 1024, (bf16_t*)(ws + WS_WD) + (size_t)mtx * 1024 * 1024, scr, q >> 5, q & 31, lane, RmId()); }
            continue;
        }
        r -= P0_LAYERS * N_LAYER;
        const int j = (r >= N_SMALL / 2) ? 1 : 0; r -= j * (N_SMALL / 2);
        if (r < I_MWIN) { if (DF8_MV && (r % 96) >= 32) transpose_item_f8((const float*)F.ptr(IN_MWIN) + (size_t)j * 1024 * MIN_, MIN_, 1024, (unsigned char*)(ws + WS_WINM8) + (size_t)j * 2048 * 1024 - (size_t)1024 * 1024, scr, r / 96, r % 96, lane, RmId(), F8_SWI);
            else if (DF8_M1) transpose_item_f8((const float*)F.ptr(IN_MWIN) + (size_t)j * 1024 * MIN_, MIN_, 1024, (unsigned char*)(ws + WS_WINM) + (size_t)j * 3072 * 1024, scr, r / 96, r % 96, lane, RmId(), F8_SWI);
            else transpose_item((const float*)F.ptr(IN_MWIN) + (size_t)j * 1024 * MIN_, MIN_, 1024, (bf16_t*)(ws + WS_WINM) + (size_t)j * 3072 * 1024, scr, r / 96, r % 96, lane, RmId()); continue; } r -= I_MWIN;
        if (r < I_SQ) { if (DF8_O5) transpose_item_f8((const float*)F.ptr(IN_MWOUT) + (size_t)j * 1024 * 1024, 1024, 1024, (unsigned char*)(ws + WS_WOUTM) + (size_t)j * 1024 * 1024, scr, r >> 5, r & 31, lane, RmId(), F8_SWO);
            else transpose_item((const float*)F.ptr(IN_MWOUT) + (size_t)j * 1024 * 1024, 1024, 1024, (bf16_t*)(ws + WS_WOUTM) + (size_t)j * 1024 * 1024, scr, r >> 5, r & 31, lane, RmId()); continue; } r -= I_SQ;
        if (r < I_AWIN) { if (DF8_A1) transpose_item_f8((const float*)F.ptr(IN_AWIN) + (size_t)j * 1024 * AIN, AIN, 1024, (unsigned char*)(ws + WS_WINA) + (size_t)j * AINP * 1024, scr, r / 22, r % 22, lane, RmId(), F8_SWI);
            else transpose_item((const float*)F.ptr(IN_AWIN) + (size_t)j * 1024 * AIN, AIN, 1024, (bf16_t*)(ws + WS_WINA) + (size_t)j * AINP * 1024, scr, r / 22, r % 22, lane, RmId()); continue; } r -= I_AWIN;
        if (r < I_QB) { transpose_item((const float*)F.ptr(IN_AWQB) + (size_t)j * AQL * 1536, 1536, AQL, (bf16_t*)(ws + WS_WQB) + (size_t)j * 1536 * AQL, scr, r / 48, r % 48, lane, RmQb()); continue; } r -= I_QB;
        if (r < I_KV) { transpose_item((const float*)F.ptr(IN_AWKVB) + (size_t)j * AKL * 2048, 2048, AKL, (bf16_t*)(ws + WS_WKV) + (size_t)j * 2048 * AKL, scr, r >> 6, r & 63, lane, RmKv()); continue; } r -= I_KV;
        if (DF8_O5) transpose_item_f8((const float*)F.ptr(IN_AWOUT) + (size_t)j * 1024 * 1024, 1024, 1024, (unsigned char*)(ws + WS_WOUTA) + (size_t)j * 1024 * 1024, scr, r >> 5, r & 31, lane, RmId(), F8_SWO);
        else transpose_item((const float*)F.ptr(IN_AWOUT) + (size_t)j * 1024 * 1024, 1024, 1024, (bf16_t*)(ws + WS_WOUTA) + (size_t)j * 1024 * 1024, scr, r >> 5, r & 31, lane, RmId());
    }
    { const int gt = F.vcu * NTHR + F.tid, NGT = F.G * NTHR;
      for (int i = gt; i < 2 * 64 * 1024 / 8; i += NGT) { const int j = i / (64 * 1024 / 8), q = i - j * (64 * 1024 / 8);
          if (DF8_A1) { if (q < 64 * 1024 / 16) *(u32x4*)((unsigned char*)(ws + WS_WINA) + (size_t)j * AINP * 1024 + (size_t)AIN * 1024 + (size_t)q * 16) = (u32x4){0u, 0u, 0u, 0u}; }
          else *(u32x4*)((bf16_t*)(ws + WS_WINA) + (size_t)j * AINP * 1024 + (size_t)AIN * 1024 + (size_t)q * 8) = (u32x4){0u, 0u, 0u, 0u}; }
      const float* x = (const float*)F.ptr(IN_X); bf16_t* xb = (bf16_t*)(ws + WS_XB);
      for (size_t i = gt; i < (size_t)T * D / 8; i += NGT) { const f32x4 v0 = *(const f32x4*)(x + i * 8), v1 = *(const f32x4*)(x + i * 8 + 4);
          u32x4 w; w.x = cvt_pk_bf16(v0[0], v0[1]); w.y = cvt_pk_bf16(v0[2], v0[3]); w.z = cvt_pk_bf16(v1[0], v1[1]); w.w = cvt_pk_bf16(v1[2], v1[3]); *(u32x4*)(xb + i * 8) = w;
          if (DF8_M1 || DF8_MV) { u32x2 w8; w8.x = cvt4_fp8(v0[0] * F8_SX, v0[1] * F8_SX, v0[2] * F8_SX, v0[3] * F8_SX); w8.y = cvt4_fp8(v1[0] * F8_SX, v1[1] * F8_SX, v1[2] * F8_SX, v1[3] * F8_SX); *(u32x2*)((unsigned char*)(ws + WS_XB8) + i * 8) = w8; } }
      { float* gimg = (float*)(ws + WS_GIMG); const float* Wi = (const float*)F.ptr(IN_MWIN);
        for (int i = gt; i < 2 * D * 16; i += NGT) { const int j = i >> 14, r = i & 16383, k = r >> 4, e = r & 15; gimg[(size_t)j * (D * 16) + ((k >> 2) * 16 + e) * 4 + (k & 3)] = Wi[(size_t)j * D * MIN_ + (size_t)k * MIN_ + 3072 + e]; } }
      { float* rimg = (float*)(ws + WS_RIMG); const float* Wr = (const float*)F.ptr(IN_RW); const float* lg = (const float*)F.ptr(IN_LNG);
        for (int i = gt; i < DEPTH * D * NE; i += NGT) { const int l = i >> 15, r = i & 32767, k = r >> 5, e = r & 31; const float wv = Wr[i] * lg[(size_t)(l * 2) * D + k];
            if (RT_BF16) ((bf16_t*)rimg)[(size_t)l * (D * NE) + ((((k >> 5) * 2 + (e >> 4)) * 64 + (((k >> 3) & 3) * 16 + (e & 15))) * 8 + (k & 7))] = (bf16_t)(cvt_pk_bf16(wv, 0.f) & 0xffffu);
            else rimg[(size_t)l * (D * NE) + ((k >> 2) * 32 + e) * 4 + (k & 3)] = wv; }
        const int gwv = F.vcu * NWAVES + F.wave;
        if (gwv < DEPTH * NE) { const int l = gwv >> 5, e = gwv & 31; const float* lb = (const float*)F.ptr(IN_LNB) + (size_t)(l * 2) * D; float c = 0.f;
            float cs = 0.f;
            for (int k = lane; k < D; k += 64) { const float wr = Wr[(size_t)l * D * NE + (size_t)k * NE + e]; c += wr * lb[k]; cs += bf_lo(cvt_pk_bf16(wr * lg[(size_t)(l * 2) * D + k], 0.f)); }
            c = wave_sum(c); cs = wave_sum(cs); if (lane == 0) { ((float*)(ws + WS_RCV))[gwv] = c + ((const float*)F.ptr(IN_RB))[gwv]; ((float*)(ws + WS_RCV))[DEPTH * NE + gwv] = cs; } } }
      const int* pos = (const int*)F.ptr(IN_POS); float* ct = (float*)(ws + WS_COS); float* st = (float*)(ws + WS_SIN);
      for (int i = gt; i < T * 32; i += NGT) { const int m = i >> 5, k = i & 31;
          const float inv = exp2f(-(float)(2 * k) * (13.287712379549449f / 64.0f));
          const float ang = (float)pos[m] * inv;
          const double rev = (double)ang * 0.15915494309189535; const float fr = (float)(rev - floor(rev));
          ct[i] = __builtin_amdgcn_cosf(fr); st[i] = __builtin_amdgcn_sinf(fr); }
    }
}

constexpr int CV_PER_LAYER = 32 * (16 * 64 + 16 * 32);
struct CvItem { const float* src; unsigned char* dst; int ldw, gu; };
__device__ __forceinline__ CvItem cv_decode(const Frame& F, int l, int r, int lane) {
    int q = r; CvItem c;
    const int n4 = lane & 7, kg = lane >> 3;
    if (q < 32 * 1024) { const int mtx = l * 32 + (q >> 10), kb = (q >> 6) & 15, nb = q & 63; c.gu = 1; c.ldw = 2048;
        c.src = (const float*)F.ptr(IN_WGU) + (size_t)mtx * 1024 * 2048 + (size_t)(64 * kb + 8 * kg) * 2048 + 32 * nb + 4 * n4;
        c.dst = (unsigned char*)(F.ws() + WS_WGU) + (size_t)mtx * 2048 * 1024 + 64 * kb + 8 * kg; }
    else { q -= 32 * 1024; const int mtx = l * 32 + (q >> 9), kb = (q >> 5) & 15, nb = q & 31; c.gu = 0; c.ldw = 1024;
        c.src = (const float*)F.ptr(IN_WD) + (size_t)mtx * 1024 * 1024 + (size_t)(64 * kb + 8 * kg) * 1024 + 32 * nb + 4 * n4;
        c.dst = (unsigned char*)(F.ws() + WS_WD) + (size_t)mtx * 1024 * 1024 + 64 * kb + 8 * kg; }
    return c;
}
__device__ __forceinline__ void cv_issue(const CvItem& c, LAS unsigned char* buf) {
#pragma unroll
    for (int i = 0; i < 8; ++i) __builtin_amdgcn_global_load_lds((const unsigned*)(c.src + (size_t)i * c.ldw), (LAS unsigned*)(buf + i * 1024), 16, 0, 2);
}
__device__ __forceinline__ void cv_finish(const CvItem& c, const LAS unsigned char* buf, int r, int lane) {
    f32x4 v[8];
#pragma unroll
    for (int i = 0; i < 8; ++i) v[i] = *(const LAS f32x4*)(buf + i * 1024 + lane * 16);
    int q = r; const int n4 = lane & 7; const int nb = c.gu ? (q & 63) : ((q - 32 * 1024) & 31); const int n0 = 32 * nb + 4 * n4; const float sc = c.gu ? F8_SWG : F8_SWD;
#pragma unroll
    for (int jn = 0; jn < 4; ++jn) { u32x2 o; o.x = cvt4_fp8(v[0][jn] * sc, v[1][jn] * sc, v[2][jn] * sc, v[3][jn] * sc); o.y = cvt4_fp8(v[4][jn] * sc, v[5][jn] * sc, v[6][jn] * sc, v[7][jn] * sc);
        const int n = n0 + jn, row = c.gu ? RmGu()(n) : n;
        __builtin_nontemporal_store(o, (u32x2*)(c.dst + (size_t)row * 1024)); }
}

template <int NEX>
__device__ __forceinline__ void skinny_fill(const Frame& F, const float* __restrict__ W, int ldw) {
    LAS float* wl = (LAS float*)F.lds;
    for (int idx = F.tid; idx < 1024 * NEX; idx += NTHR) { const int k = idx / NEX, e = idx % NEX; wl[((k >> 2) * NEX + e) * 4 + (k & 3)] = W[(size_t)k * ldw + e]; }
    __syncthreads();
}
__device__ __forceinline__ void gates_phase(const Frame& F, const bf16_t* __restrict__ X, const float* __restrict__ bg, float* __restrict__ Gt) {
    const LAS f32x4* wl = (const LAS f32x4*)F.lds;
    const int tok = F.lane & 15, kq = F.lane >> 4;
    const f32x4 bias = *(const f32x4*)(bg + 4 * kq);
    for (int grp = F.vcu * NWAVES + F.wave; grp < T / 16; grp += F.G * NWAVES) {
        const int m0 = grp * 16; const bf16_t* xr = X + (size_t)(m0 + tok) * D + 4 * kq;
        f32x4 acc0 = {0.f, 0.f, 0.f, 0.f}, acc1 = {0.f, 0.f, 0.f, 0.f};
        u32x2 xa[16], xb[16];
#define GP_LOAD(dst, q) do { _Pragma("unroll") for (int t = 0; t < 16; ++t) dst[t] = *(const u32x2*)(xr + 16 * (16 * (q) + t)); } while (0)
#define GP_MMA(src, q) do { _Pragma("unroll") for (int t = 0; t < 16; t += 2) { const int i = 16 * (q) + t; const u32x2 r0 = src[t], r1 = src[t + 1]; \
            const f32x4 x0 = {bf_lo(r0.x), bf_hi(r0.x), bf_lo(r0.y), bf_hi(r0.y)}, x1 = {bf_lo(r1.x), bf_hi(r1.x), bf_lo(r1.y), bf_hi(r1.y)}; \
            const f32x4 w0 = wl[(i * 4 + kq) * 16 + tok], w1 = wl[((i + 1) * 4 + kq) * 16 + tok]; \
            _Pragma("unroll") for (int j = 0; j < 4; ++j) { acc0 = __builtin_amdgcn_mfma_f32_16x16x4f32(w0[j], x0[j], acc0, 0, 0, 0); acc1 = __builtin_amdgcn_mfma_f32_16x16x4f32(w1[j], x1[j], acc1, 0, 0, 0); } } } while (0)
        GP_LOAD(xa, 0);
#pragma unroll 1
        for (int p = 0; p < 2; ++p) {
            GP_LOAD(xb, 2 * p + 1); __builtin_amdgcn_sched_barrier(0);
            GP_MMA(xa, 2 * p); __builtin_amdgcn_sched_barrier(0);
            if (p == 0) GP_LOAD(xa, 2);
            __builtin_amdgcn_sched_barrier(0);
            GP_MMA(xb, 2 * p + 1); __builtin_amdgcn_sched_barrier(0);
        }
#undef GP_LOAD
#undef GP_MMA
        *(f32x4*)(Gt + (size_t)(m0 + tok) * 16 + 4 * kq) = acc0 + acc1 + bias;
    }
}

__device__ __forceinline__ void ln_router_phase(const Frame& F, int layer, int cnt_layer) {
    unsigned char* ws = F.ws();
    const float* __restrict__ ZF = (const float*)(ws + WS_ZF); bf16_t* __restrict__ XM = (bf16_t*)(ws + WS_XM); unsigned char* __restrict__ XB8 = (unsigned char*)(ws + WS_XB8);
    const float* lng = (const float*)F.ptr(IN_LNG) + (size_t)(layer * 2) * D; const float* lnb = (const float*)F.ptr(IN_LNB) + (size_t)(layer * 2) * D;
    const int lane = F.lane, tok = lane & 15, kq = lane >> 4;
    unsigned* cnt = F.ctl() + CW_CNT + cnt_layer * 32 * 64;
    volatile LAS unsigned* hist = F.MISC + 64; volatile LAS unsigned* hbase = F.MISC + 96; volatile LAS float* cvec = (volatile LAS float*)(F.MISC + 192); volatile LAS float* scol = (volatile LAS float*)(F.MISC + 224);
    LAS float* wl = (LAS float*)F.lds; LAS float* part = (LAS float*)(F.lds + 131072);
    {
        const f32x4* src = (const f32x4*)((const char*)(ws + WS_RIMG) + (size_t)layer * (D * NE) * (RT_BF16 ? 2 : 4));
#pragma unroll 4
        for (int it = 0; it < (RT_BF16 ? 8 : 16); ++it) ((LAS f32x4*)wl)[F.tid + NTHR * it] = src[F.tid + NTHR * it];
        if (F.tid < 32) { hist[F.tid] = 0u; cvec[F.tid] = ((const float*)(ws + WS_RCV))[layer * NE + F.tid]; scol[F.tid] = ((const float*)(ws + WS_RCV))[DEPTH * NE + layer * NE + F.tid]; }
        __syncthreads();
    }
    f32x4 gv[4], bv[4];
#pragma unroll
    for (int j = 0; j < 4; ++j) { gv[j] = *(const f32x4*)(lng + 4 * lane + 256 * j); bv[j] = *(const f32x4*)(lnb + 4 * lane + 256 * j); }
#define LZ4(idx) (ZF_BF16 ? ({ const u32x2 w_ = *(const u32x2*)((const bf16_t*)ZF + (idx)); (f32x4){bf_lo(w_.x), bf_hi(w_.x), bf_lo(w_.y), bf_hi(w_.y)}; }) : *(const f32x4*)(ZF + (idx)))
    for (int grp = F.vcu; grp < T / 128; grp += F.G) {
        const int m0 = grp * 128 + F.wave * 16;
        float mu_l = 0.f, rs_l = 0.f;
        f32x4 nx[4];
#pragma unroll
        for (int j = 0; j < 4; ++j) nx[j] = LZ4((size_t)m0 * D + 4 * lane + 256 * j);
#pragma unroll 2
        for (int r = 0; r < 16; ++r) {
            const int m = m0 + r; f32x4 v[4];
#pragma unroll
            for (int j = 0; j < 4; ++j) v[j] = nx[j];
            if (r < 15) {
#pragma unroll
                for (int j = 0; j < 4; ++j) nx[j] = LZ4((size_t)(m + 1) * D + 4 * lane + 256 * j); }
            float s = 0.f;
#pragma unroll
            for (int j = 0; j < 4; ++j) s += (v[j][0] + v[j][1]) + (v[j][2] + v[j][3]);
            const float mean = wave_sum(s) * (1.f / D); float s2 = 0.f;
#pragma unroll
            for (int j = 0; j < 4; ++j) { v[j] = v[j] - mean; s2 += (v[j][0] * v[j][0] + v[j][1] * v[j][1]) + (v[j][2] * v[j][2] + v[j][3] * v[j][3]); }
            const float rstd = 1.f / sqrtf(wave_sum(s2) * (1.f / D) + LN_EPS);
            if (tok == r) { mu_l = mean; rs_l = rstd; }
#pragma unroll
            for (int j = 0; j < 4; ++j) { const f32x4 y = v[j] * rstd * gv[j] + bv[j];
                if (!XM_RECOMP) { u32x2 w; w.x = cvt_pk_bf16(y[0], y[1]); w.y = cvt_pk_bf16(y[2], y[3]); *(u32x2*)(XM + (size_t)m * D + 4 * lane + 256 * j) = w; }
                if (MOE_FP8) *(unsigned*)(XB8 + (size_t)m * D + 4 * lane + 256 * j) = cvt4_fp8(y[0] * F8_SX, y[1] * F8_SX, y[2] * F8_SX, y[3] * F8_SX);
                else { u32x2 w; w.x = cvt_pk_bf16(y[0], y[1]); w.y = cvt_pk_bf16(y[2], y[3]); *(u32x2*)((bf16_t*)(ws + WS_XB) + (size_t)m * D + 4 * lane + 256 * j) = w; } }
        }
        if (XM_RECOMP && kq == 0) *(f32x2*)((float*)(ws + WS_LNST) + 2 * (size_t)(m0 + tok)) = (f32x2){mu_l, rs_l};
        f32x4 acc0 = {0.f, 0.f, 0.f, 0.f}, acc1 = {0.f, 0.f, 0.f, 0.f};
        float lv[8]; int used = 0;
        if constexpr (RT_BF16 != 0) {
            const LAS bf16x8* wl8 = (const LAS bf16x8*)F.lds;
            const bf16_t* zq = (const bf16_t*)ZF + (size_t)(m0 + tok) * D + 8 * kq;
            bf16x8 za[16], zc[16];
#pragma unroll
            for (int i = 0; i < 16; ++i) za[i] = *(const bf16x8*)(zq + 32 * i);
#pragma unroll
            for (int i = 0; i < 16; ++i) zc[i] = *(const bf16x8*)(zq + 32 * (16 + i));
            __builtin_amdgcn_sched_barrier(0);
#pragma unroll
            for (int i = 0; i < 16; ++i) { acc0 = __builtin_amdgcn_mfma_f32_16x16x32_bf16(wl8[(i * 2) * 64 + lane], za[i], acc0, 0, 0, 0); acc1 = __builtin_amdgcn_mfma_f32_16x16x32_bf16(wl8[(i * 2 + 1) * 64 + lane], za[i], acc1, 0, 0, 0); }
#pragma unroll
            for (int i = 0; i < 16; ++i) { acc0 = __builtin_amdgcn_mfma_f32_16x16x32_bf16(wl8[((16 + i) * 2) * 64 + lane], zc[i], acc0, 0, 0, 0); acc1 = __builtin_amdgcn_mfma_f32_16x16x32_bf16(wl8[((16 + i) * 2 + 1) * 64 + lane], zc[i], acc1, 0, 0, 0); }
#pragma unroll
            for (int r = 0; r < 4; ++r) { lv[r] = (acc0[r] - mu_l * scol[4 * kq + r]) * rs_l + cvec[4 * kq + r]; lv[4 + r] = (acc1[r] - mu_l * scol[16 + 4 * kq + r]) * rs_l + cvec[16 + 4 * kq + r]; }
        } else {
        const LAS f32x4* wl4 = (const LAS f32x4*)F.lds;
        const size_t zr = (size_t)(m0 + tok) * D + 4 * kq;
        f32x4 za[16], zc[16];
#define LR_LOAD(dst, c) do { _Pragma("unroll") for (int i = 0; i < 16; ++i) dst[i] = LZ4(zr + 16 * (16 * (c) + i)); } while (0)
#define LR_MMA(src, c) do { _Pragma("unroll") for (int i = 0; i < 16; ++i) { const f32x4 xn = src[i] - mu_l; const int ii = 16 * (c) + i; \
                const f32x4 w0 = wl4[(ii * 4 + kq) * 32 + tok], w1 = wl4[(ii * 4 + kq) * 32 + 16 + tok]; \
                _Pragma("unroll") for (int j = 0; j < 4; ++j) { acc0 = __builtin_amdgcn_mfma_f32_16x16x4f32(w0[j], xn[j], acc0, 0, 0, 0); acc1 = __builtin_amdgcn_mfma_f32_16x16x4f32(w1[j], xn[j], acc1, 0, 0, 0); } } } while (0)
        LR_LOAD(za, 0);
#pragma unroll 1
        for (int p = 0; p < 2; ++p) {
            LR_LOAD(zc, 2 * p + 1); __builtin_amdgcn_sched_barrier(0);
            LR_MMA(za, 2 * p); __builtin_amdgcn_sched_barrier(0);
            if (p == 0) LR_LOAD(za, 2);
            __builtin_amdgcn_sched_barrier(0);
            LR_MMA(zc, 2 * p + 1); __builtin_amdgcn_sched_barrier(0);
        }
#undef LR_LOAD
#undef LR_MMA
#pragma unroll
        for (int r = 0; r < 4; ++r) { lv[r] = acc0[r] * rs_l + cvec[4 * kq + r]; lv[4 + r] = acc1[r] * rs_l + cvec[16 + 4 * kq + r]; }
        }
        float tv[4]; int ti[4];
#pragma unroll
        for (int k = 0; k < 4; ++k) {
            float bvv = -3.0e38f; int bi = 64, bslot = -1;
#pragma unroll
            for (int q = 0; q < 8; ++q) { const int idx = (q < 4) ? 4 * kq + q : 16 + 4 * kq + (q - 4); const bool ok = !((used >> q) & 1) && (lv[q] > bvv || (lv[q] == bvv && idx < bi)); if (ok) { bvv = lv[q]; bi = idx; bslot = q; } }
            float gvv = bvv; int gi = bi;
#pragma unroll
            for (int o = 16; o <= 32; o <<= 1) { const float ov = __shfl_xor(gvv, o); const int oi = __shfl_xor(gi, o); if (ov > gvv || (ov == gvv && oi < gi)) { gvv = ov; gi = oi; } }
            if (gi == bi && bslot >= 0) used |= (1 << bslot);
            tv[k] = gvv; ti[k] = gi;
        }
        const float e1 = __expf(tv[1] - tv[0]), e2 = __expf(tv[2] - tv[0]), e3 = __expf(tv[3] - tv[0]); const float inv = 1.f / (1.f + e1 + e2 + e3);
        const float myg = (kq == 0 ? 1.f : kq == 1 ? e1 : kq == 2 ? e2 : e3) * inv; const int mye = (kq == 0 ? ti[0] : kq == 1 ? ti[1] : kq == 2 ? ti[2] : ti[3]);
        const unsigned rank = __hip_atomic_fetch_add((LAS unsigned*)(hist + mye), 1u, __ATOMIC_RELAXED, __HIP_MEMORY_SCOPE_WORKGROUP);
        __syncthreads();
        if (F.tid < 32) { const unsigned c = hist[F.tid]; hbase[F.tid] = __hip_atomic_fetch_add(cnt + F.tid * 64, c, __ATOMIC_RELAXED, __HIP_MEMORY_SCOPE_AGENT); hist[F.tid] = 0u; }
        __syncthreads();
        const unsigned pos = hbase[mye] + rank; const int m = m0 + tok;
        ((int*)(ws + WS_TOKINFO))[m * 4 + kq] = (mye << 20) | (int)pos; ((float*)(ws + WS_TOKGATE))[m * 4 + kq] = myg;
        ((int*)(ws + WS_LIST))[(size_t)mye * T + pos] = m;
    }
}

__device__ __forceinline__ void ln_combine_phase(const Frame& F, int layer, bool is_last, bool dummy) {
    unsigned char* ws = F.ws();
    const bf16_t* __restrict__ XM = (const bf16_t*)(ws + WS_XM); bf16_t* __restrict__ XB = (bf16_t*)(ws + WS_XB); const bf16_t* __restrict__ YM = (const bf16_t*)(ws + WS_YMOE);
    const float* lng = (const float*)F.ptr(IN_LNG) + (size_t)(layer * 2 + 1) * D; const float* lnb = (const float*)F.ptr(IN_LNB) + (size_t)(layer * 2 + 1) * D;
    const int lane = F.lane;
    const int* tokinfo = (const int*)(ws + WS_TOKINFO); const float* tokgate = (const float*)(ws + WS_TOKGATE);
    volatile LAS int* ntp = (volatile LAS int*)(F.MISC + 16);
    f32x4 gv[4], bv[4];
#pragma unroll
    for (int j = 0; j < 4; ++j) { gv[j] = *(const f32x4*)(lng + 4 * lane + 256 * j); bv[j] = *(const f32x4*)(lnb + 4 * lane + 256 * j); }
    f32x4 ga[4], ba[4];
    if (XM_RECOMP) { const float* lng1 = (const float*)F.ptr(IN_LNG) + (size_t)(layer * 2) * D; const float* lnb1 = (const float*)F.ptr(IN_LNB) + (size_t)(layer * 2) * D;
#pragma unroll
        for (int j = 0; j < 4; ++j) { ga[j] = *(const f32x4*)(lng1 + 4 * lane + 256 * j) * DN_ALPHA; ba[j] = *(const f32x4*)(lnb1 + 4 * lane + 256 * j) * DN_ALPHA; } }
    const bf16_t* __restrict__ XS = XM_RECOMP ? (const bf16_t*)(ws + WS_ZF) : XM;
    float* OUT = F.out();
    bf16_t* XBo = XB; if (dummy) { OUT = (float*)(ws + WS_ZF); XBo = (bf16_t*)(ws + WS_HB); }
    for (int grp = F.vcu * NWAVES + F.wave; grp < T / 16; grp += F.G * NWAVES) {
        const int m0 = grp * 16;
        const int inf = tokinfo[m0 * 4 + lane]; const float gl = tokgate[m0 * 4 + lane];
        const unsigned prl = (unsigned)(ntp[inf >> 20] * 256 + (inf & 0xfffff));
        f32x2 stl = {0.f, 1.f}; if (XM_RECOMP) stl = *(const f32x2*)((const float*)(ws + WS_LNST) + 2 * (size_t)(m0 + (lane >> 2)));
        u32x2 nx[4]; u32x2 ny[4][4]; float ng[4];
#define LNC_LOAD(r) do { _Pragma("unroll") for (int j = 0; j < 4; ++j) nx[j] = *(const u32x2*)(XS + (size_t)(m0 + (r)) * D + 4 * lane + 256 * j); \
            _Pragma("unroll") for (int k = 0; k < 4; ++k) { const unsigned pr = (unsigned)__builtin_amdgcn_readlane((int)prl, 4 * (r) + k); ng[k] = __uint_as_float((unsigned)__builtin_amdgcn_readlane((int)__float_as_uint(gl), 4 * (r) + k)); \
                if (Y_FP8) { const unsigned char* yr = (const unsigned char*)YM + (size_t)pr * D + 4 * lane; _Pragma("unroll") for (int j = 0; j < 4; ++j) { ny[k][j].x = *(const unsigned*)(yr + 256 * j); ny[k][j].y = 0u; } } \
                else { const bf16_t* yr = YM + (size_t)pr * D + 4 * lane; _Pragma("unroll") for (int j = 0; j < 4; ++j) ny[k][j] = *(const u32x2*)(yr + 256 * j); } } } while (0)
        LNC_LOAD(0);
#pragma unroll 1
        for (int r = 0; r < 16; ++r) {
            const int m = m0 + r; f32x4 v[4];
#pragma unroll
            for (int j = 0; j < 4; ++j) v[j] = (f32x4){bf_lo(nx[j].x), bf_hi(nx[j].x), bf_lo(nx[j].y), bf_hi(nx[j].y)} * DN_ALPHA;
            if (XM_RECOMP) { const float mu1 = __uint_as_float((unsigned)__builtin_amdgcn_readlane((int)__float_as_uint(stl[0]), 4 * r)), rs1 = __uint_as_float((unsigned)__builtin_amdgcn_readlane((int)__float_as_uint(stl[1]), 4 * r));
#pragma unroll
                for (int j = 0; j < 4; ++j) { const f32x4 z = (f32x4){bf_lo(nx[j].x), bf_hi(nx[j].x), bf_lo(nx[j].y), bf_hi(nx[j].y)}; v[j] = (z - mu1) * rs1 * ga[j] + ba[j]; } }
#pragma unroll
            for (int k = 0; k < 4; ++k) { const float g = Y_FP8 ? ng[k] * (1.0f / F8_SY) : ng[k];
#pragma unroll
                for (int j = 0; j < 4; ++j) { const u32x2 w = ny[k][j];
                    if (Y_FP8) { const f32x2 lo2 = __builtin_amdgcn_cvt_pk_f32_fp8((int)w.x, false), hi2 = __builtin_amdgcn_cvt_pk_f32_fp8((int)w.x, true); v[j][0] += g * lo2[0]; v[j][1] += g * lo2[1]; v[j][2] += g * hi2[0]; v[j][3] += g * hi2[1]; }
                    else { v[j][0] += g * bf_lo(w.x); v[j][1] += g * bf_hi(w.x); v[j][2] += g * bf_lo(w.y); v[j][3] += g * bf_hi(w.y); } } }
            if (r < 15) LNC_LOAD(r + 1);
            float s = 0.f;
#pragma unroll
            for (int j = 0; j < 4; ++j) s += (v[j][0] + v[j][1]) + (v[j][2] + v[j][3]);
            const float mean = wave_sum(s) * (1.f / D); float s2 = 0.f;
#pragma unroll
            for (int j = 0; j < 4; ++j) { v[j] = v[j] - mean; s2 += (v[j][0] * v[j][0] + v[j][1] * v[j][1]) + (v[j][2] * v[j][2] + v[j][3] * v[j][3]); }
            const float rstd = 1.f / sqrtf(wave_sum(s2) * (1.f / D) + LN_EPS);
#pragma unroll
            for (int j = 0; j < 4; ++j) { const f32x4 y = v[j] * rstd * gv[j] + bv[j];
                if (is_last || dummy) *(f32x4*)(OUT + (size_t)m * D + 4 * lane + 256 * j) = y;
                if (!is_last) { u32x2 w; w.x = cvt_pk_bf16(y[0], y[1]); w.y = cvt_pk_bf16(y[2], y[3]); *(u32x2*)(XBo + (size_t)m * D + 4 * lane + 256 * j) = w;
                    if (DF8_M1 || DF8_MV || (DF8_A1 && (layer & 1) == 0)) *(unsigned*)((unsigned char*)(ws + WS_XB8) + (size_t)m * D + 4 * lane + 256 * j) = cvt4_fp8(y[0] * F8_SX, y[1] * F8_SX, y[2] * F8_SX, y[3] * F8_SX); } }
        }
#undef LNC_LOAD
    }
}

__device__ __forceinline__ void moe_prefix(const Frame& F, int layer) {
    volatile LAS int* ntp = (volatile LAS int*)(F.MISC + 16); volatile LAS int* cnte = (volatile LAS int*)(F.MISC + 224);
    __syncthreads();
    if (F.tid < 64) { const int ln = F.tid; unsigned* cnt = F.ctl() + CW_CNT + layer * 32 * 64;
        const int c = ln < 32 ? (int)__hip_atomic_load(cnt + ln * 64, __ATOMIC_RELAXED, __HIP_MEMORY_SCOPE_AGENT) : 0; const int tiles = (c + 255) >> 8;
        int incl = tiles;
#pragma unroll
        for (int o = 1; o < 32; o <<= 1) { const int t = __shfl_up(incl, o); if (ln >= o) incl += t; }
        if (ln < 32) { ntp[ln] = incl - tiles; cnte[ln] = c; }
        if (ln == 31) ntp[32] = incl; }
    __syncthreads();
}

__device__ __forceinline__ int moe_units(const Frame& F, int layer, int NC) {
    volatile LAS int* ntp = (volatile LAS int*)(F.MISC + 16); volatile LAS int* utab = (volatile LAS int*)(F.lds + pg8::MOE_UTAB_OFF);
    const int total = ntp[32] * NC;
    if (F.tid < 32) { const int L = F.tid * F.G + F.vcu;
        if (L < total) { const int rt = L / NC, pn = L - rt * NC; int e = 0;
            { const LAS int* ntq = (const LAS int*)(F.MISC + 16);
#pragma unroll
              for (int k = 1; k < 32; ++k) e += (rt >= ntq[k]) ? 1 : 0; }
            const int rtl = rt - ntp[e]; const int c_e = ((volatile LAS int*)(F.MISC + 224))[e];
            int nv = c_e - rtl * 256; nv = nv > 256 ? 256 : nv;
            utab[4 * F.tid] = rt; utab[4 * F.tid + 1] = pn; utab[4 * F.tid + 2] = e | (rtl << 8); utab[4 * F.tid + 3] = nv; } }
    __syncthreads();
    const int mine = (total - F.vcu + F.G - 1) / F.G;
    return total > F.vcu ? (mine > 32 ? 32 : mine) : 0;
}

__device__ __forceinline__ void mla_norm_phase(const Frame& F, int j) {
    unsigned char* ws = F.ws(); const float* A32 = (const float*)(ws + WS_A32);
    bf16_t* CQ = (bf16_t*)(ws + WS_CQ); bf16_t* CKV = (bf16_t*)(ws + WS_CKV); bf16_t* KR = (bf16_t*)(ws + WS_KR);
    const float* qn = (const float*)F.ptr(IN_AQN) + j * AQL; const float* kvn = (const float*)F.ptr(IN_AKVN) + j * AKL;
    const float* ct = (const float*)(ws + WS_COS); const float* st = (const float*)(ws + WS_SIN);
    const int lane = F.lane;
    f32x4 gq0 = {0.f, 0.f, 0.f, 0.f}, gq1 = gq0, gk0 = gq0, gk1 = gq0;
    if (lane < 48) { gq0 = *(const f32x4*)(qn + 8 * lane); gq1 = *(const f32x4*)(qn + 8 * lane + 4); }
    if (lane < 32) { gk0 = *(const f32x4*)(kvn + 8 * lane); gk1 = *(const f32x4*)(kvn + 8 * lane + 4); }
    const int mstep = F.G * NWAVES;
    f32x4 nq0 = {0.f, 0.f, 0.f, 0.f}, nq1 = nq0, nk0 = nq0, nk1 = nq0; float nx1 = 0.f, nx2 = 0.f, nc = 0.f, ns = 0.f;
#define MN_LOAD(mm) do { const float* ar_ = A32 + (size_t)(mm) * AINP; \
        if (lane < 48) { nq0 = *(const f32x4*)(ar_ + 8 * lane); nq1 = *(const f32x4*)(ar_ + 8 * lane + 4); } \
        if (lane < 32) { nk0 = *(const f32x4*)(ar_ + AQL + 8 * lane); nk1 = *(const f32x4*)(ar_ + AQL + 8 * lane + 4); nx1 = ar_[AQL + AKL + lane]; nx2 = ar_[AQL + AKL + 32 + lane]; nc = ct[(size_t)(mm) * 32 + lane]; ns = st[(size_t)(mm) * 32 + lane]; } } while (0)
    int m = F.vcu * NWAVES + F.wave;
    if (m < T) MN_LOAD(m);
    for (; m < T; m += mstep) {
        const f32x4 q0 = nq0, q1 = nq1, k0 = nk0, k1 = nk1; const float x1 = nx1, x2 = nx2, c = nc, s = ns;
        if (m + mstep < T) MN_LOAD(m + mstep);
        float sq = 0.f, sk = 0.f;
        if (lane < 48) sq = (q0[0] * q0[0] + q0[1] * q0[1]) + (q0[2] * q0[2] + q0[3] * q0[3]) + (q1[0] * q1[0] + q1[1] * q1[1]) + (q1[2] * q1[2] + q1[3] * q1[3]);
        if (lane < 32) sk = (k0[0] * k0[0] + k0[1] * k0[1]) + (k0[2] * k0[2] + k0[3] * k0[3]) + (k1[0] * k1[0] + k1[1] * k1[1]) + (k1[2] * k1[2] + k1[3] * k1[3]);
        const float rq = 1.f / sqrtf(wave_sum(sq) * (1.f / AQL) + RMS_EPS), rk = 1.f / sqrtf(wave_sum(sk) * (1.f / AKL) + RMS_EPS);
        if (lane < 48) { const f32x4 y0 = q0 * rq * gq0, y1 = q1 * rq * gq1;
            u32x4 w; w.x = cvt_pk_bf16(y0[0], y0[1]); w.y = cvt_pk_bf16(y0[2], y0[3]); w.z = cvt_pk_bf16(y1[0], y1[1]); w.w = cvt_pk_bf16(y1[2], y1[3]); *(u32x4*)(CQ + (size_t)m * AQL + 8 * lane) = w; }
        if (lane < 32) { const f32x4 y0 = k0 * rk * gk0, y1 = k1 * rk * gk1;
            u32x4 w; w.x = cvt_pk_bf16(y0[0], y0[1]); w.y = cvt_pk_bf16(y0[2], y0[3]); w.z = cvt_pk_bf16(y1[0], y1[1]); w.w = cvt_pk_bf16(y1[2], y1[3]); *(u32x4*)(CKV + (size_t)m * AKL + 8 * lane) = w;
            const float r1 = x1 * c - x2 * s, r2 = x2 * c + x1 * s;
            if (ATT_FP8) *(unsigned short*)((unsigned char*)KR + (size_t)m * AROPE + 2 * lane) = (unsigned short)(cvt4_fp8(r1 * F8_SK, r2 * F8_SK, 0.f, 0.f) & 0xffffu);
            else *(unsigned*)(KR + (size_t)m * AROPE + 2 * lane) = cvt_pk_bf16(r1, r2); }
    }
#undef MN_LOAD
}
constexpr int MT_STRIDE = 144;
__device__ __forceinline__ float log_sigmoid(float x) { return fminf(x, 0.f) - __logf(1.f + __expf(-fabsf(x))); }
__device__ __forceinline__ float wave_incl_scan_add(float v, int lane) {
#pragma unroll
    for (int o = 1; o < 64; o <<= 1) { const float t = __shfl_up(v, o); if (lane >= o) v += t; }
    return v;
}
__device__ __forceinline__ float wave_incl_scan_max(float v, int lane) {
#pragma unroll
    for (int o = 1; o < 64; o <<= 1) { const float t = __shfl_up(v, o); if (lane >= o) v = fmaxf(v, t); }
    return v;
}
template <int NCH>
__device__ __forceinline__ void stage_transposed(LAS unsigned char* tile, const bf16_t* __restrict__ src, int lane, float scale, bool do_scale) {
#pragma unroll
    for (int c = 0; c < NCH; ++c) { const u32x4 w = *(const u32x4*)(src + 8 * c); const unsigned ww[4] = {w.x, w.y, w.z, w.w};
#pragma unroll
        for (int p = 0; p < 4; ++p) { unsigned lo = ww[p] & 0xffffu, hi = ww[p] >> 16;
            if (do_scale) { const unsigned pk = cvt_pk_bf16(bf_lo(ww[p]) * scale, bf_hi(ww[p]) * scale); lo = pk & 0xffffu; hi = pk >> 16; }
            *(LAS bf16_t*)(tile + (8 * c + 2 * p) * MT_STRIDE + 2 * lane) = (bf16_t)lo; *(LAS bf16_t*)(tile + (8 * c + 2 * p + 1) * MT_STRIDE + 2 * lane) = (bf16_t)hi; } }
}

__device__ __forceinline__ void mlstm_local_phase(const Frame& F) {
    unsigned char* ws = F.ws(); const bf16_t* PROJ = (const bf16_t*)(ws + WS_PROJ); const float* Gt = (const float*)(ws + WS_GATES);
    bf16_t* CLOC = (bf16_t*)(ws + WS_CLOC); float* NLOC = (float*)(ws + WS_NLOC); float* GMAX = (float*)(ws + WS_MSC); float* BL = GMAX + MUNITS;
    const bf16_t* VTg = (const bf16_t*)(ws + WS_VT);
    const int lane = F.lane, c32 = lane & 31, hi = lane >> 5;
    const int plane = (lane & ~12) | ((lane & 4) << 1) | ((lane & 8) >> 1);
    LAS unsigned char* kt = F.lds + F.wave * (2 * 64 * MT_STRIDE); LAS unsigned char* vt = kt + 64 * MT_STRIDE;
    for (int it = F.vcu * NWAVES + F.wave; it < MUNITS * 2; it += F.G * NWAVES) {
        const int u = it >> 1, half = it & 1, c = u & (MNC - 1), bh = u >> 7, h = bh & 7, b = bh >> 3, m0 = b * SEQ + c * MCH;
        const int m = m0 + lane;
        const float ig = Gt[(size_t)m * 16 + h], lf = log_sigmoid(Gt[(size_t)m * 16 + 8 + h]);
        const float bc = wave_incl_scan_add(lf, lane), bl = __shfl(bc, 63);
        const float g = bl - bc + ig, gmax = wave_max(g), w = __expf(g - gmax);
        stage_transposed<8>(kt, PROJ + (size_t)m * 3072 + 512 + h * 64, MVT ? plane : lane, w, true);
        if (!MVT) stage_transposed<8>(vt, PROJ + (size_t)m * 3072 + 1024 + h * 128 + half * 64, lane, 1.f, false);
        const bf16_t* vg = VTg + (size_t)(h * 128 + half * 64 + c32) * T + m0 + 8 * hi;
        bf16x8 vgf[4][2];
        if (MVT) {
#pragma unroll
            for (int ks = 0; ks < 4; ++ks)
#pragma unroll
                for (int i = 0; i < 2; ++i) vgf[ks][i] = *(const bf16x8*)(vg + (size_t)(32 * i) * T + 16 * ks);
        }
        LDS_WAIT();
        f32x16 acc[2][2];
#pragma unroll
        for (int i = 0; i < 2; ++i)
#pragma unroll
            for (int j = 0; j < 2; ++j)
#pragma unroll
                for (int r = 0; r < 16; ++r) acc[i][j][r] = 0.f;
#pragma unroll
        for (int ks = 0; ks < 4; ++ks) {
            bf16x8 af[2], bfr[2];
#pragma unroll
            for (int i = 0; i < 2; ++i) { if (MVT) af[i] = vgf[ks][i]; else af[i] = *(const LAS bf16x8*)(vt + (32 * i + c32) * MT_STRIDE + (16 * ks + 8 * hi) * 2); bfr[i] = *(const LAS bf16x8*)(kt + (32 * i + c32) * MT_STRIDE + (16 * ks + 8 * hi) * 2); }
#pragma unroll
            for (int i = 0; i < 2; ++i)
#pragma unroll
                for (int j = 0; j < 2; ++j) acc[i][j] = __builtin_amdgcn_mfma_f32_32x32x16_bf16(bfr[j], af[i], acc[i][j], 0, 0, 0);
        }
        asm volatile("s_nop 15\n\ts_nop 3" : "+v"(acc[0][0]), "+v"(acc[0][1]), "+v"(acc[1][0]), "+v"(acc[1][1]));
        bf16_t* cl = CLOC + (size_t)u * (MDV * MDK) + (size_t)(half * 64 + c32) * MDK + 4 * hi;
#pragma unroll
        for (int i = 0; i < 2; ++i)
#pragma unroll
            for (int j = 0; j < 2; ++j)
#pragma unroll
                for (int g = 0; g < 4; ++g) { u32x2 w; w.x = cvt_pk_bf16(acc[i][j][4 * g], acc[i][j][4 * g + 1]); w.y = cvt_pk_bf16(acc[i][j][4 * g + 2], acc[i][j][4 * g + 3]);
                    *(u32x2*)(cl + (size_t)(32 * i) * MDK + 32 * j + 8 * g) = w; }
        if (half == 0) {
            float s = 0.f;
#pragma unroll
            for (int q = 0; q < 8; ++q) { const u32x4 w4 = *(const LAS u32x4*)(kt + lane * MT_STRIDE + 16 * q); s += (bf_lo(w4.x) + bf_hi(w4.x)) + (bf_lo(w4.y) + bf_hi(w4.y)) + (bf_lo(w4.z) + bf_hi(w4.z)) + (bf_lo(w4.w) + bf_hi(w4.w)); }
            NLOC[(size_t)u * MDK + lane] = s;
            if (lane == 0) { GMAX[u] = gmax; BL[u] = bl; }
        }
        LDS_WAIT();
    }
}

__device__ __forceinline__ void mlstm_scan_phase(const Frame& F) {
    unsigned char* ws = F.ws(); const bf16_t* __restrict__ CLOC = (const bf16_t*)(ws + WS_CLOC); const float* __restrict__ NLOC = (const float*)(ws + WS_NLOC);
    const float* __restrict__ GMAX = (const float*)(ws + WS_MSC); const float* __restrict__ BL = GMAX + MUNITS; float* __restrict__ MPREV = (float*)(ws + WS_MSC) + 2 * MUNITS;
    bf16_t* __restrict__ CPREV = (bf16_t*)(ws + WS_CPREV); float* __restrict__ NPREV = (float*)(ws + WS_NPREV);
    constexpr int PER = MDV * MDK / 2;
    for (int it = F.vcu * NTHR + F.tid; it < NB * MH * PER; it += F.G * NTHR) {
        const int bh = it / PER, e = it - bh * PER; const bool hasn = e < 32; const int eo = e * 2;
        float c0 = 0.f, c1 = 0.f, n0 = 0.f, n1 = 0.f, mm = 0.f;
        for (int cb = 0; cb < MNC; cb += 16) {
            f32x2 loc[16], nl[16]; float gm[16], bl[16];
#pragma unroll
            for (int k = 0; k < 16; ++k) { const int u = bh * MNC + cb + k; { const unsigned cw = *(const unsigned*)(CLOC + (size_t)u * (MDV * MDK) + eo); loc[k] = (f32x2){bf_lo(cw), bf_hi(cw)}; } gm[k] = GMAX[u]; bl[k] = BL[u];
                nl[k] = hasn ? *(const f32x2*)(NLOC + (size_t)u * MDK + eo) : (f32x2){0.f, 0.f}; }
#pragma unroll
            for (int k = 0; k < 16; ++k) { const int u = bh * MNC + cb + k;
                const float mnew = fmaxf(bl[k] + mm, gm[k]), dec = __expf(bl[k] + mm - mnew), sc = __expf(gm[k] - mnew);
                *(unsigned*)(CPREV + (size_t)u * (MDV * MDK) + eo) = cvt_pk_bf16(c0, c1);
                if (hasn) { *(f32x2*)(NPREV + (size_t)u * MDK + eo) = (f32x2){n0, n1}; if (e == 0) MPREV[u] = mm; }
                c0 = dec * c0 + sc * loc[k].x; c1 = dec * c1 + sc * loc[k].y; n0 = dec * n0 + sc * nl[k].x; n1 = dec * n1 + sc * nl[k].y; mm = mnew; }
        }
    }
}

static_assert(MVT, "mlstm_out_phase reads V^T from WS_VT");
#ifndef DUP_M4I
#define DUP_M4I 0
#endif
__device__ __forceinline__ void mlstm_out_phase(const Frame& F, const float* __restrict__ gain) {
    unsigned char* ws = F.ws(); const bf16_t* PROJ = (const bf16_t*)(ws + WS_PROJ); const float* Gt = (const float*)(ws + WS_GATES);
    const bf16_t* CPREV = (const bf16_t*)(ws + WS_CPREV); const float* NPREV = (const float*)(ws + WS_NPREV); const float* MPREV = (const float*)(ws + WS_MSC) + 2 * MUNITS;
    bf16_t* HB = (bf16_t*)(ws + WS_HB); const bf16_t* VTg = (const bf16_t*)(ws + WS_VT);
    const int lane = F.lane, c32 = lane & 31, hi = lane >> 5;
    LAS unsigned char* cpl = F.lds + F.wave * 18432; LAS unsigned char* stg = cpl + 16384;
    const int ckey = (c32 >> 1) & 7, row8 = lane >> 3, sl8 = lane & 7;
    const unsigned cpoff = (unsigned)(row8 * 128 + ((sl8 ^ (row8 >> 1)) * 16));
    for (int u0 = F.vcu * NWAVES + F.wave; u0 < MUNITS * (1 + DUP_M4I); u0 += F.G * NWAVES) {
        const int u = u0 & (MUNITS - 1), c = u & (MNC - 1), bh = u >> 7, h = bh & 7, b = bh >> 3, m0 = b * SEQ + c * MCH;
        { const unsigned char* cg = (const unsigned char*)(CPREV + (size_t)u * (MDV * MDK));
          asm volatile("" ::: "memory");
#pragma unroll
          for (int n = 0; n < 16; ++n) __builtin_amdgcn_global_load_lds((const unsigned*)(cg + n * 1024 + ((n & 1) ? (cpoff ^ 64u) : cpoff)), (LAS unsigned*)(cpl + n * 1024), 16, 0, 0); }
        const int mg = m0 + lane;
        const float ig = Gt[(size_t)mg * 16 + h], lf = log_sigmoid(Gt[(size_t)mg * 16 + 8 + h]);
        const bf16_t* vg = VTg + (size_t)(h * 128 + c32) * T + m0 + 8 * hi;
        const float bc = wave_incl_scan_add(lf, lane), av = ig - bc, pm = wave_incl_scan_max(av, lane);
        const float mprev = MPREV[u];
        f32x4 gn[4];
#pragma unroll
        for (int q = 0; q < 4; ++q) gn[q] = *(const f32x4*)(gain + h * 128 + 64 * (q >> 1) + 8 * sl8 + 4 * (q & 1));
        asm volatile("s_waitcnt vmcnt(0)" ::: "memory");
#pragma unroll 1
        for (int tb = 0; tb < 2; ++tb) {
        const int tl = 32 * tb + c32;
        int hi16 = 16 * hi; asm volatile("" : "+v"(hi16));
        const float Mt = fmaxf(mprev, __shfl(pm, tl)), bt = __shfl(bc, tl);
        const float winter = __expf(mprev - Mt) * 0.125f;
        bf16x8 qf[4];
        const bf16_t* qrow = PROJ + (size_t)(m0 + tl) * 3072 + h * 64 + 8 * hi;
#pragma unroll
        for (int ks = 0; ks < 4; ++ks) qf[ks] = *(const bf16x8*)(qrow + 16 * ks);
        float qn = 0.f;
        { const float* np = NPREV + (size_t)u * MDK + 8 * hi;
#pragma unroll
          for (int ks = 0; ks < 4; ++ks) { const f32x4 n0 = *(const f32x4*)(np + 16 * ks), n1 = *(const f32x4*)(np + 16 * ks + 4); const u32x4 qw = __builtin_bit_cast(u32x4, qf[ks]);
              qn += bf_lo(qw.x) * n0[0] + bf_hi(qw.x) * n0[1] + bf_lo(qw.y) * n0[2] + bf_hi(qw.y) * n0[3] + bf_lo(qw.z) * n1[0] + bf_hi(qw.z) * n1[1] + bf_lo(qw.w) * n1[2] + bf_hi(qw.w) * n1[3]; } }
        qn = sum_x32(qn);
        f32x16 acc[4];
#pragma unroll
        for (int i = 0; i < 4; ++i)
#pragma unroll
            for (int r = 0; r < 16; ++r) acc[i][r] = 0.f;
#pragma unroll
        for (int i = 0; i < 4; ++i)
#pragma unroll
            for (int ks = 0; ks < 4; ++ks) { const bf16x8 af = *(const LAS bf16x8*)(cpl + (32 * i + c32) * 128 + (((2 * ks + hi) ^ ckey) * 16)); acc[i] = __builtin_amdgcn_mfma_f32_32x32x16_bf16(af, qf[ks], acc[i], 0, 0, 0); }
#pragma unroll
        for (int i = 0; i < 4; ++i)
#pragma unroll
            for (int r = 0; r < 16; ++r) acc[i][r] *= winter;
        float den = 0.f;
#pragma unroll
        for (int sb = 0; sb < 2; ++sb) {
            if (sb <= tb) {
                f32x16 st;
#pragma unroll
                for (int r = 0; r < 16; ++r) st[r] = 0.f;
                const bf16_t* krow = PROJ + (size_t)(m0 + 32 * sb + c32) * 3072 + 512 + h * 64 + 8 * hi;
#pragma unroll
                for (int ks = 0; ks < 4; ++ks) { const bf16x8 kf = *(const bf16x8*)(krow + 16 * ks); st = __builtin_amdgcn_mfma_f32_32x32x16_bf16(kf, qf[ks], st, 0, 0, 0); }
                unsigned pk[8];
#pragma unroll
                for (int r = 0; r < 16; r += 2) {
                    const int s0 = 32 * sb + (r & 3) + 8 * (r >> 2) + 4 * hi, s1 = s0 + 1;
                    const float a0 = __int_as_float(__builtin_amdgcn_ds_bpermute(hi16 + 4 * (32 * sb + (r & 3) + 8 * (r >> 2)), __float_as_int(av))),
                                a1 = __int_as_float(__builtin_amdgcn_ds_bpermute(hi16 + 4 * (32 * sb + (r & 3) + 8 * (r >> 2) + 1), __float_as_int(av)));
                    float p0 = st[r] * 0.125f * __expf(a0 - Mt), p1 = st[r + 1] * 0.125f * __expf(a1 - Mt);
                    if (s0 > tl) p0 = 0.f; if (s1 > tl) p1 = 0.f;
                    den += p0 + p1; pk[r >> 1] = cvt_pk_bf16(p0, p1);
                }
#pragma unroll
                for (int s2 = 0; s2 < 2; ++s2) {
                    const bf16x8 pf = __builtin_bit_cast(bf16x8, (u32x4){pk[4 * s2], pk[4 * s2 + 1], pk[4 * s2 + 2], pk[4 * s2 + 3]});
#pragma unroll
                    for (int i = 0; i < 4; ++i) { const bf16x8 vf = *(const bf16x8*)(vg + (size_t)(32 * i) * T + 16 * (2 * sb + s2));
                        acc[i] = __builtin_amdgcn_mfma_f32_32x32x16_bf16(vf, pf, acc[i], 0, 0, 0); }
                }
            }
        }
        den = sum_x32(den);
        den += winter * qn;
        const float mrow = bt + Mt, dnm = fmaxf(fabsf(den), __expf(-mrow)), rinv = 1.f / dnm;
        float ss = 0.f;
#pragma unroll
        for (int i = 0; i < 4; ++i)
#pragma unroll
            for (int r = 0; r < 16; ++r) { acc[i][r] *= rinv; ss += acc[i][r] * acc[i][r]; }
        ss = sum_x32(ss);
        const float rn = 1.f / sqrtf(ss * (1.f / MDV) + RMS_EPS);
        u32x4 ow[4][2];
        { const bf16_t* orow = PROJ + (size_t)(m0 + 32 * tb + row8) * 3072 + 2048 + h * 128 + 8 * sl8;
#pragma unroll
          for (int rr = 0; rr < 4; ++rr) { ow[rr][0] = *(const u32x4*)(orow + (size_t)(8 * rr) * 3072); ow[rr][1] = *(const u32x4*)(orow + (size_t)(8 * rr) * 3072 + 64); } }
#pragma unroll
        for (int rr = 0; rr < 4; ++rr) {
            if ((c32 >> 3) == rr) {
#pragma unroll
                for (int i = 0; i < 4; ++i)
#pragma unroll
                    for (int g = 0; g < 4; ++g) { u32x2 w; w.x = cvt_pk_bf16(acc[i][4 * g] * rn, acc[i][4 * g + 1] * rn); w.y = cvt_pk_bf16(acc[i][4 * g + 2] * rn, acc[i][4 * g + 3] * rn);
                        *(LAS u32x2*)(stg + (c32 & 7) * 256 + (((4 * i + g) ^ (c32 & 7)) * 16) + 8 * hi) = w; }
            }
            asm volatile("" ::: "memory");
            const u32x4 y0 = *(const LAS u32x4*)(stg + row8 * 256 + ((sl8 ^ row8) * 16)), y1 = *(const LAS u32x4*)(stg + row8 * 256 + (((8 + sl8) ^ row8) * 16));
            asm volatile("" ::: "memory");
            const size_t mrowi = (size_t)(m0 + 32 * tb + 8 * rr + row8);
#pragma unroll
            for (int hf = 0; hf < 2; ++hf) { const u32x4 yw = hf ? y1 : y0, o4 = ow[rr][hf]; const unsigned yv[4] = {yw.x, yw.y, yw.z, yw.w}, ov[4] = {o4.x, o4.y, o4.z, o4.w};
                float z[8];
#pragma unroll
                for (int e = 0; e < 4; ++e) { const f32x4 gg = gn[2 * hf + (e >> 1)];
                    z[2 * e] = bf_lo(yv[e]) * gg[2 * (e & 1)] * __builtin_amdgcn_rcpf(1.f + __expf(-bf_lo(ov[e]))); z[2 * e + 1] = bf_hi(yv[e]) * gg[2 * (e & 1) + 1] * __builtin_amdgcn_rcpf(1.f + __expf(-bf_hi(ov[e]))); }
                if (DF8_O5) { u32x2 w; w.x = cvt4_fp8(z[0] * F8_SHB, z[1] * F8_SHB, z[2] * F8_SHB, z[3] * F8_SHB); w.y = cvt4_fp8(z[4] * F8_SHB, z[5] * F8_SHB, z[6] * F8_SHB, z[7] * F8_SHB);
                    *(u32x2*)((unsigned char*)HB + mrowi * D + h * 128 + 64 * hf + 8 * sl8) = w; }
                else { u32x4 w; w.x = cvt_pk_bf16(z[0], z[1]); w.y = cvt_pk_bf16(z[2], z[3]); w.z = cvt_pk_bf16(z[4], z[5]); w.w = cvt_pk_bf16(z[6], z[7]); *(u32x4*)(HB + mrowi * D + h * 128 + 64 * hf + 8 * sl8) = w; } }
        }
        }
        LDS_WAIT();
    }
}
__device__ __forceinline__ float max3f(float a, float b, float c) { return fmaxf(fmaxf(a, b), c); }
constexpr int AT_KB = 64 * 384, AT_VB = 128 * 128, AT_STAGE = AT_KB + AT_VB;
__device__ __forceinline__ void attn_phase(const Frame& F) {
    unsigned char* ws = F.ws(); const bf16_t* QB = (const bf16_t*)(ws + WS_QB); const bf16_t* KN = (const bf16_t*)(ws + WS_KN); const bf16_t* KR = (const bf16_t*)(ws + WS_KR); const bf16_t* VT = (const bf16_t*)(ws + WS_VT);
    bf16_t* HB = (bf16_t*)(ws + WS_HB);
    LAS unsigned char* lds = F.lds;
    const int lane = F.lane, w = F.wave, c32 = lane & 31, hi = lane >> 5;
    int k_isr[3]; unsigned k_off[3], v_off[2];
#pragma unroll
    for (int n = 0; n < 3; ++n) { const int P = (n * 8 + w) * 64 + lane, row = P / 24, q = P - row * 24, p = (q & ~7) | ((q & 7) ^ ((row >> 1) & 7));
        k_isr[n] = p >= 16; k_off[n] = (p >= 16) ? (unsigned)(row * AROPE + (p - 16) * 8) * 2u : (unsigned)(row * 1024 + p * 8) * 2u; }
#pragma unroll
    for (int n = 0; n < 2; ++n) { const int P = (n * 8 + w) * 64 + lane, row = P >> 3, q = P & 7, p = q ^ ((row >> 1) & 7); v_off[n] = (unsigned)row * (unsigned)(T * 2) + (unsigned)(p * 16); }
    const int sw = (c32 >> 1) & 7;
    unsigned ko[4];
#pragma unroll
    for (int i = 0; i < 4; ++i) ko[i] = (unsigned)(c32 * 384 + (((2 * i + hi) ^ sw) * 16));
    const unsigned vrow = (unsigned)(c32 * 128);

    for (int item = F.vcu; item < NB * AH * 16; item += F.G) {
        const int bh = item >> 4, x = item & 15, b = bh >> 3, hh = bh & 7;
#pragma unroll 1
        for (int sub = 0; sub < 2; ++sub) {
            const int qb = sub ? 31 - x : x, nt = 4 * qb + 4, jmax = 4 * qb + (w >> 1);
            const int qrow = 256 * qb + 32 * w + c32;
            const size_t mq = (size_t)b * SEQ + qrow;
            __syncthreads();
            const bf16_t* knb = KN + (size_t)b * SEQ * 1024 + hh * 128; const bf16_t* krb = KR + (size_t)b * SEQ * AROPE; const bf16_t* vtb = VT + (size_t)(hh * 128) * T + (size_t)b * SEQ;
#define AT_ISSUE(j, stg) do { _Pragma("unroll") for (int _n = 0; _n < 3; ++_n) { \
                const char* _g = k_isr[_n] ? (const char*)(krb + (size_t)(j) * 64 * AROPE) + k_off[_n] : (const char*)(knb + (size_t)(j) * 64 * 1024) + k_off[_n]; \
                __builtin_amdgcn_global_load_lds((const unsigned*)_g, (LAS unsigned*)(lds + (stg) * AT_STAGE + (_n * 8 + w) * 1024), 16, 0, 0); } \
            _Pragma("unroll") for (int _n = 0; _n < 2; ++_n) { const char* _g = (const char*)(vtb + (size_t)(j) * 64) + v_off[_n]; \
                __builtin_amdgcn_global_load_lds((const unsigned*)_g, (LAS unsigned*)(lds + (stg) * AT_STAGE + AT_KB + (_n * 8 + w) * 1024), 16, 0, 0); } } while (0)
            AT_ISSUE(0, 0);
            bf16x8 qf[12];
            { const bf16_t* qr = QB + mq * 1536 + hh * AQD + 8 * hi;
#pragma unroll
              for (int ks = 0; ks < 12; ++ks) qf[ks] = *(const bf16x8*)(qr + 16 * ks); }
            f32x16 O[4];
#pragma unroll
            for (int i = 0; i < 4; ++i)
#pragma unroll
                for (int r = 0; r < 16; ++r) O[i][r] = 0.f;
            float m_run = -1.0e30f, l_run = 0.f;
            unsigned pk[16];
#pragma unroll
            for (int r = 0; r < 16; ++r) pk[r] = 0u;
#define AT_QK_SM(jj, sg) do { const LAS unsigned char* kb_ = lds + (sg) * AT_STAGE; \
                f32x16 s0, s1; _Pragma("unroll") for (int r = 0; r < 16; ++r) { s0[r] = 0.f; s1[r] = 0.f; } \
                bf16x8 kf[2][4]; \
                _Pragma("unroll") for (int _q = 0; _q < 2; ++_q) { kf[0][2 * _q] = *(const LAS bf16x8*)(kb_ + ko[_q & 3]); kf[0][2 * _q + 1] = *(const LAS bf16x8*)(kb_ + ko[_q & 3] + 32 * 384); } \
                _Pragma("unroll") for (int g = 0; g < 6; ++g) { \
                    if (g + 1 < 6) { _Pragma("unroll") for (int _q = 0; _q < 2; ++_q) { const int _ks = 2 * (g + 1) + _q; \
                        kf[(g + 1) & 1][2 * _q] = *(const LAS bf16x8*)(kb_ + ko[_ks & 3] + (_ks >> 2) * 128); kf[(g + 1) & 1][2 * _q + 1] = *(const LAS bf16x8*)(kb_ + ko[_ks & 3] + (_ks >> 2) * 128 + 32 * 384); } } \
                    __builtin_amdgcn_sched_barrier(0); \
                    _Pragma("unroll") for (int q = 0; q < 2; ++q) { s0 = __builtin_amdgcn_mfma_f32_32x32x16_bf16(kf[g & 1][2 * q], qf[2 * g + q], s0, 0, 0, 0); s1 = __builtin_amdgcn_mfma_f32_32x32x16_bf16(kf[g & 1][2 * q + 1], qf[2 * g + q], s1, 0, 0, 0); } \
                    __builtin_amdgcn_sched_barrier(0); } \
                if ((jj) == jmax) { const int kbase = 64 * (jj) + 4 * hi; \
                    _Pragma("unroll") for (int r = 0; r < 16; ++r) { const int key = kbase + (r & 3) + 8 * (r >> 2); if (key > qrow) s0[r] = -__builtin_inff(); if (key + 32 > qrow) s1[r] = -__builtin_inff(); } } \
                float mx = max3f(s0[0], s1[0], s0[1]); \
                _Pragma("unroll") for (int r = 2; r < 16; r += 2) mx = max3f(mx, s0[r], s0[r + 1]); \
                _Pragma("unroll") for (int r = 1; r < 15; r += 2) mx = max3f(mx, s1[r], s1[r + 1]); \
                mx = fmaxf(mx, s1[15]); mx = fmaxf(mx, __shfl_xor(mx, 32)); \
                const bool grow = mx > m_run + 8.0f;                   \
                const float mnew = grow ? mx : m_run, alpha = __builtin_amdgcn_exp2f(m_run - mnew); m_run = mnew; \
                float ls = 0.f; \
                _Pragma("unroll") for (int r = 0; r < 16; r += 2) { const float p0 = __builtin_amdgcn_exp2f(s0[r] - mnew), p1 = __builtin_amdgcn_exp2f(s0[r + 1] - mnew), p2 = __builtin_amdgcn_exp2f(s1[r] - mnew), p3 = __builtin_amdgcn_exp2f(s1[r + 1] - mnew); \
                    ls += (p0 + p1) + (p2 + p3); pk[r >> 1] = cvt_pk_bf16(p0, p1); pk[8 + (r >> 1)] = cvt_pk_bf16(p2, p3); } \
                l_run = l_run * alpha + ls; \
                if (__builtin_amdgcn_ballot_w64(grow) != 0ull) { _Pragma("unroll") for (int i = 0; i < 4; ++i) _Pragma("unroll") for (int r = 0; r < 16; ++r) O[i][r] *= alpha; } } while (0)
#define AT_PV(sg) do { const LAS unsigned char* vb_ = lds + (sg) * AT_STAGE + AT_KB + vrow; \
                bf16x8 vfr[2][4]; \
                { const unsigned po = (unsigned)((hi ^ sw) * 16); _Pragma("unroll") for (int i = 0; i < 4; ++i) vfr[0][i] = *(const LAS bf16x8*)(vb_ + i * (32 * 128) + po); } \
                _Pragma("unroll") for (int st = 0; st < 4; ++st) { \
                    if (st + 1 < 4) { const unsigned po = (unsigned)(((2 * (st + 1) + hi) ^ sw) * 16); _Pragma("unroll") for (int i = 0; i < 4; ++i) vfr[(st + 1) & 1][i] = *(const LAS bf16x8*)(vb_ + i * (32 * 128) + po); } \
                    __builtin_amdgcn_sched_barrier(0); \
                    const bf16x8 pf = __builtin_bit_cast(bf16x8, (u32x4){pk[4 * st], pk[4 * st + 1], pk[4 * st + 2], pk[4 * st + 3]}); \
                    _Pragma("unroll") for (int i = 0; i < 4; ++i) O[i] = __builtin_amdgcn_mfma_f32_32x32x16_bf16(vfr[st & 1][i], pf, O[i], 0, 0, 0); \
                    __builtin_amdgcn_sched_barrier(0); } } while (0)
            const bool grpB = w >= 4;
            int sj = 0; bool pending = false;
#pragma unroll 1
            for (int j = 0; j <= nt; ++j) {
                const int sn = (sj == 2) ? 0 : sj + 1, sp = (sj == 0) ? 2 : sj - 1;
                if (grpB) { asm volatile("s_waitcnt vmcnt(0)" ::: "memory"); __syncthreads(); if (j + 1 < nt) AT_ISSUE(j + 1, sn); }
                if (pending) AT_PV(sp);
                if (!grpB) { asm volatile("s_waitcnt vmcnt(0)" ::: "memory"); __syncthreads(); if (j + 1 < nt) AT_ISSUE(j + 1, sn); }
                pending = (j < nt && j <= jmax);
                if (pending) AT_QK_SM(j, sj);
                sj = sn;
            }
#undef AT_QK_SM
#undef AT_PV
            const float lt = l_run + __shfl_xor(l_run, 32), rl = 1.f / lt;
            if (DF8_O5) { unsigned char* orow = (unsigned char*)HB + mq * D + hh * 128 + 4 * hi; const float rs = rl * F8_SHB;
#pragma unroll
                for (int i = 0; i < 4; ++i)
#pragma unroll
                    for (int g4 = 0; g4 < 4; ++g4) *(unsigned*)(orow + 32 * i + 8 * g4) = cvt4_fp8(O[i][4 * g4] * rs, O[i][4 * g4 + 1] * rs, O[i][4 * g4 + 2] * rs, O[i][4 * g4 + 3] * rs);
            } else { bf16_t* orow = HB + mq * D + hh * 128 + 4 * hi;
#pragma unroll
                for (int i = 0; i < 4; ++i)
#pragma unroll
                    for (int g4 = 0; g4 < 4; ++g4) { u32x2 wv; wv.x = cvt_pk_bf16(O[i][4 * g4] * rl, O[i][4 * g4 + 1] * rl); wv.y = cvt_pk_bf16(O[i][4 * g4 + 2] * rl, O[i][4 * g4 + 3] * rl);
                        *(u32x2*)(orow + 32 * i + 8 * g4) = wv; } }
#undef AT_ISSUE
        }
    }
}

constexpr int A8_KB = 64 * 192, A8_VB = 128 * 64, A8_STAGE = A8_KB + A8_VB;
__device__ __forceinline__ void attn8_phase(const Frame& F, const int cv_layer, const int cv_count) {
    unsigned char* ws = F.ws(); const unsigned char* Q8 = (const unsigned char*)(ws + WS_QB); const unsigned char* KN8 = (const unsigned char*)(ws + WS_KN); const unsigned char* KR8 = (const unsigned char*)(ws + WS_KR);
    const unsigned char* VT8 = (const unsigned char*)(ws + WS_VT); bf16_t* HB = (bf16_t*)(ws + WS_HB);
    LAS unsigned char* lds = F.lds;
    const int lane = F.lane, w = F.wave, c32 = lane & 31, hi = lane >> 5;
    const int sw = (c32 >> 2) & 3;
    const unsigned koA = (unsigned)(c32 * 192 + ((2 * hi) ^ sw) * 16), koB = (unsigned)(c32 * 192 + ((2 * hi + 1) ^ sw) * 16);
    const unsigned voA = (unsigned)(c32 * 64 + ((2 * hi) ^ sw) * 16), voB = (unsigned)(c32 * 64 + ((2 * hi + 1) ^ sw) * 16);
    constexpr float CS = 1.0f / (F8_SQ * F8_SK);
    const int cv_stride = F.G * NWAVES; const int CV_TOTAL = cv_count * CV_PER_LAYER; int cvn = cv_layer >= 0 ? F.vcu * NWAVES + w : CV_TOTAL, cvq = 0; bool cvh = false, cvj = false;
    LAS unsigned char* cvb = lds + 3 * A8_STAGE + w * 8192;

    for (int item = F.vcu; item < NB * AH * 16; item += F.G) {
        const int bh = item >> 4, x = item & 15, b = bh >> 3, hh = bh & 7;
#pragma unroll 1
        for (int sub = 0; sub < 2; ++sub) {
            const int qb = sub ? 31 - x : x, nt = 4 * qb + 4, jmax = 4 * qb + (w >> 1);
            const int qrow = 256 * qb + 32 * w + c32;
            const size_t mq = (size_t)b * SEQ + qrow;
            __syncthreads();
            const GAS unsigned char* wsg = (const GAS unsigned char*)ws;
            int hl_ = hi; asm volatile("" : "+v"(hl_));
            int k_isr[2]; unsigned k_off[2], v_off;
            { int ln_ = lane; asm volatile("" : "+v"(ln_));
#pragma unroll
              for (int t = 0; t < 2; ++t) { const int P = (w + 8 * t) * 64 + ln_, row = P / 12, q = P - row * 12, p = (q & ~3) | ((q & 3) ^ ((row >> 2) & 3));
                  k_isr[t] = p >= 8; k_off[t] = (p >= 8) ? (unsigned)(row * AROPE + (p - 8) * 16) : (unsigned)(row * 1024 + p * 16); }
              { const int P = w * 64 + ln_, row = P >> 2, q = P & 3, p = q ^ ((row >> 2) & 3); v_off = (unsigned)row * (unsigned)T + (unsigned)(p * 16); } }
            unsigned kb32[2], ks32[2];
#pragma unroll
            for (int t = 0; t < 2; ++t) { kb32[t] = k_isr[t] ? (unsigned)(WS_KR + (size_t)b * SEQ * AROPE) + k_off[t] : (unsigned)(WS_KN + (size_t)b * SEQ * 1024 + hh * 128) + k_off[t]; ks32[t] = k_isr[t] ? 64u * AROPE : 64u * 1024u; }
            const unsigned vb32 = (unsigned)(WS_VT + (size_t)(hh * 128) * T + (size_t)b * SEQ) + v_off;
#define A8_ISSUE(j, stg) do { _Pragma("unroll") for (int _t = 0; _t < 2; ++_t) { if (_t == 0 || w < 4) { \
                const GAS unsigned char* _g = wsg + (size_t)(kb32[_t] + (unsigned)(j) * ks32[_t]); \
                __builtin_amdgcn_global_load_lds((const GAS unsigned*)_g, (LAS unsigned*)(lds + (stg) * A8_STAGE + (w + 8 * _t) * 1024), 16, 0, 0); } } \
            { const GAS unsigned char* _g = wsg + (size_t)(vb32 + (unsigned)(j) * 64u); \
                __builtin_amdgcn_global_load_lds((const GAS unsigned*)_g, (LAS unsigned*)(lds + (stg) * A8_STAGE + A8_KB + w * 1024), 16, 0, 0); } } while (0)
            A8_ISSUE(0, 0);
            i32x8 qf[3];
            { const GAS unsigned char* qr = wsg + (size_t)((unsigned)WS_QB + (unsigned)mq * 1536u + (unsigned)(hh * AQD + 32 * hl_));
#pragma unroll
              for (int ks = 0; ks < 3; ++ks) { qf[ks].lo = *(const GAS i32x4*)(qr + 64 * ks); qf[ks].hi = *(const GAS i32x4*)(qr + 64 * ks + 16); } }
            f32x16 O[4];
#pragma unroll
            for (int i = 0; i < 4; ++i)
#pragma unroll
                for (int r = 0; r < 16; ++r) O[i][r] = 0.f;
            float m_run = -1.0e30f, l_run = 0.f, l_pa = 1.f, l_ps = 0.f;
            i32x8 pk, ones8;
            int one4 = 0x38383838; asm volatile("" : "+v"(one4));
#pragma unroll
            for (int r = 0; r < 8; ++r) { pk[r] = 0; ones8[r] = one4; }
#define A8_QK_SM(jj, sg) do { const LAS unsigned char* kb_ = lds + (sg) * A8_STAGE; \
                f32x16 s0, s1; _Pragma("unroll") for (int r = 0; r < 16; ++r) { s0[r] = 0.f; s1[r] = 0.f; } \
                i32x8 kf[2][2]; \
                kf[0][0].lo = *(const LAS i32x4*)(kb_ + koA); kf[0][0].hi = *(const LAS i32x4*)(kb_ + koB); kf[0][1].lo = *(const LAS i32x4*)(kb_ + koA + 32 * 192); kf[0][1].hi = *(const LAS i32x4*)(kb_ + koB + 32 * 192); \
                _Pragma("unroll") for (int ks = 0; ks < 3; ++ks) { \
                    if (ks + 1 < 3) { kf[(ks + 1) & 1][0].lo = *(const LAS i32x4*)(kb_ + koA + 64 * (ks + 1)); kf[(ks + 1) & 1][0].hi = *(const LAS i32x4*)(kb_ + koB + 64 * (ks + 1)); \
                        kf[(ks + 1) & 1][1].lo = *(const LAS i32x4*)(kb_ + koA + 64 * (ks + 1) + 32 * 192); kf[(ks + 1) & 1][1].hi = *(const LAS i32x4*)(kb_ + koB + 64 * (ks + 1) + 32 * 192); } \
                    __builtin_amdgcn_sched_barrier(0); __builtin_amdgcn_s_setprio(1); \
                    s0 = __builtin_amdgcn_mfma_scale_f32_32x32x64_f8f6f4(kf[ks & 1][0], qf[ks], s0, 0, 0, 0, 0, 0, 0); s1 = __builtin_amdgcn_mfma_scale_f32_32x32x64_f8f6f4(kf[ks & 1][1], qf[ks], s1, 0, 0, 0, 0, 0, 0); \
                    __builtin_amdgcn_s_setprio(0); __builtin_amdgcn_sched_barrier(0); } \
                if ((jj) == jmax) { const int kbase = 64 * (jj) + 4 * hi; \
                    _Pragma("unroll") for (int r = 0; r < 16; ++r) { const int key = kbase + (r & 3) + 8 * (r >> 2); if (key > qrow) s0[r] = -__builtin_inff(); if (key + 32 > qrow) s1[r] = -__builtin_inff(); } } \
                l_run = l_run * l_pa + l_ps; l_pa = 1.f; l_ps = 0.f; \
                float mx = max3f(s0[0], s1[0], s0[1]); \
                _Pragma("unroll") for (int r = 2; r < 16; r += 2) mx = max3f(mx, s0[r], s0[r + 1]); \
                _Pragma("unroll") for (int r = 1; r < 15; r += 2) mx = max3f(mx, s1[r], s1[r + 1]); \
                mx = fmaxf(mx, s1[15]); mx = max_x32(mx) * CS; \
                const bool grow = mx > m_run + 1.0f; \
                const float mnew = grow ? mx : m_run, alpha = __builtin_amdgcn_exp2f(m_run - mnew), eb = 7.0f - mnew; m_run = mnew;     \
                _Pragma("unroll") for (int g = 0; g < 4; ++g) { \
                    const float a0 = __builtin_amdgcn_exp2f(__builtin_fmaf(s0[4 * g], CS, eb)), a1 = __builtin_amdgcn_exp2f(__builtin_fmaf(s0[4 * g + 1], CS, eb)), a2 = __builtin_amdgcn_exp2f(__builtin_fmaf(s0[4 * g + 2], CS, eb)), a3 = __builtin_amdgcn_exp2f(__builtin_fmaf(s0[4 * g + 3], CS, eb)); \
                    const float c0 = __builtin_amdgcn_exp2f(__builtin_fmaf(s1[4 * g], CS, eb)), c1 = __builtin_amdgcn_exp2f(__builtin_fmaf(s1[4 * g + 1], CS, eb)), c2 = __builtin_amdgcn_exp2f(__builtin_fmaf(s1[4 * g + 2], CS, eb)), c3 = __builtin_amdgcn_exp2f(__builtin_fmaf(s1[4 * g + 3], CS, eb)); \
                    pk[g] = (int)cvt4_fp8(a0, a1, a2, a3); pk[4 + g] = (int)cvt4_fp8(c0, c1, c2, c3); } \
                { f32x16 lz; _Pragma("unroll") for (int r = 0; r < 16; ++r) lz[r] = 0.f;                    \
                  lz = __builtin_amdgcn_mfma_scale_f32_32x32x64_f8f6f4(ones8, pk, lz, 0, 0, 0, 0, 0, 0); l_pa = alpha; l_ps = lz[0]; }     \
                if (__builtin_amdgcn_ballot_w64(grow) != 0ull) { _Pragma("unroll") for (int i = 0; i < 4; ++i) _Pragma("unroll") for (int r = 0; r < 16; ++r) O[i][r] *= alpha; } } while (0)
#define A8_PV(sg) do { const LAS unsigned char* vb_ = lds + (sg) * A8_STAGE + A8_KB; \
                i32x8 vf[4]; _Pragma("unroll") for (int i = 0; i < 4; ++i) { vf[i].lo = *(const LAS i32x4*)(vb_ + voA + i * 2048); vf[i].hi = *(const LAS i32x4*)(vb_ + voB + i * 2048); } \
                __builtin_amdgcn_sched_barrier(0); __builtin_amdgcn_s_setprio(1); \
                _Pragma("unroll") for (int i = 0; i < 4; ++i) O[i] = __builtin_amdgcn_mfma_scale_f32_32x32x64_f8f6f4(vf[i], pk, O[i], 0, 0, 0, 0, 0, 0); \
                __builtin_amdgcn_s_setprio(0); __builtin_amdgcn_sched_barrier(0); } while (0)
            const bool grpB = w >= 4;
            int sj = 0; bool pending = false;
#pragma unroll 1
            for (int j = 0; j <= nt; ++j) {
                const int sn = (sj == 2) ? 0 : sj + 1, sp = (sj == 0) ? 2 : sj - 1;
#define A8_WAITBAR() do { if (cvj) { asm volatile("s_waitcnt vmcnt(8) lgkmcnt(0)" ::: "memory"); cvj = false; } else { asm volatile("s_waitcnt vmcnt(0) lgkmcnt(0)" ::: "memory"); } \
                    __builtin_amdgcn_s_barrier(); asm volatile("" ::: "memory"); } while (0)
                if (grpB) { A8_WAITBAR(); if (j + 1 < nt) A8_ISSUE(j + 1, sn); }
                if (pending) A8_PV(sp);
                if (!grpB) { A8_WAITBAR(); if (j + 1 < nt) A8_ISSUE(j + 1, sn); }
#undef A8_WAITBAR
                pending = (j < nt && j <= jmax);
                if (pending) A8_QK_SM(j, sj);
                sj = sn;
                if ((j & 3) == 3 && (cvh || cvn < CV_TOTAL)) {
                    if (cvh) { const int cvl_ = cvq >= CV_PER_LAYER ? 1 : 0, cvr = cvq - cvl_ * CV_PER_LAYER; const CvItem ci = cv_decode(F, cv_layer + cvl_, cvr, lane); cv_finish(ci, cvb, cvr, lane); cvh = false; }
                    if (cvn < CV_TOTAL) { { const int cvl_ = cvn >= CV_PER_LAYER ? 1 : 0, cvr = cvn - cvl_ * CV_PER_LAYER; const CvItem ci = cv_decode(F, cv_layer + cvl_, cvr, lane); cv_issue(ci, cvb); } cvq = cvn; cvn += cv_stride; cvh = true; cvj = (j < nt); }
                }
            }
#undef A8_QK_SM
#undef A8_PV
            const float lt = l_run * l_pa + l_ps, rl = 1.f / (lt * F8_SV);
            if (DF8_O5) { GAS unsigned char* orow = (GAS unsigned char*)wsg + (size_t)((unsigned)WS_HB + (unsigned)mq * (unsigned)D + (unsigned)(hh * 128 + 4 * hl_)); const float rs = rl * F8_SHB;
#pragma unroll
                for (int i = 0; i < 4; ++i)
#pragma unroll
                    for (int g4 = 0; g4 < 4; ++g4) *(GAS unsigned*)(orow + 32 * i + 8 * g4) = cvt4_fp8(O[i][4 * g4] * rs, O[i][4 * g4 + 1] * rs, O[i][4 * g4 + 2] * rs, O[i][4 * g4 + 3] * rs);
            } else { bf16_t* orow = HB + mq * D + hh * 128 + 4 * hi;
#pragma unroll
                for (int i = 0; i < 4; ++i)
#pragma unroll
                    for (int g4 = 0; g4 < 4; ++g4) { u32x2 wv; wv.x = cvt_pk_bf16(O[i][4 * g4] * rl, O[i][4 * g4 + 1] * rl); wv.y = cvt_pk_bf16(O[i][4 * g4 + 2] * rl, O[i][4 * g4 + 3] * rl);
                        *(u32x2*)(orow + 32 * i + 8 * g4) = wv; } }
#undef A8_ISSUE
        }
    }
    const int lane2 = (int)__builtin_amdgcn_mbcnt_hi(~0u, __builtin_amdgcn_mbcnt_lo(~0u, 0u));
    for (;;) { if (cvh) { asm volatile("s_waitcnt vmcnt(0)" ::: "memory"); const int cvl_ = cvq >= CV_PER_LAYER ? 1 : 0, cvr = cvq - cvl_ * CV_PER_LAYER; const CvItem ci = cv_decode(F, cv_layer + cvl_, cvr, lane2); cv_finish(ci, cvb, cvr, lane2); cvh = false; }
        if (cvn >= CV_TOTAL) break; { const int cvl_ = cvn >= CV_PER_LAYER ? 1 : 0, cvr = cvn - cvl_ * CV_PER_LAYER; const CvItem ci = cv_decode(F, cv_layer + cvl_, cvr, lane2); cv_issue(ci, cvb); } cvq = cvn; cvn += cv_stride; cvh = true; }
}
#ifndef DUP_L6
#define DUP_L6 0
#endif
#ifndef DUP_SYNC
#define DUP_SYNC 0
#endif
#ifndef DUP_L9
#define DUP_L9 0
#endif
#ifndef DUP_BAR
#define DUP_BAR 0
#endif
#ifndef DUP_P0
#define DUP_P0 0
#endif
#ifndef DUP_A4
#define DUP_A4 0
#endif
#ifndef DUP_G7
#define DUP_G7 0
#endif
#ifndef DUP_G8
#define DUP_G8 0
#endif
#ifndef DUP_M1
#define DUP_M1 0
#endif
#ifndef DUP_O5
#define DUP_O5 0
#endif
#ifndef DUP_M2
#define DUP_M2 0
#endif
#ifndef DUP_M3
#define DUP_M3 0
#endif
#ifndef DUP_M4
#define DUP_M4 0
#endif
#ifndef DUP_A1
#define DUP_A1 0
#endif
#ifndef DUP_A2
#define DUP_A2 0
#endif
#ifndef DUP_A3
#define DUP_A3 0
#endif
#ifndef EN_P0
#define EN_P0 1
#endif
#ifndef EN_M1
#define EN_M1 1
#endif
#ifndef EN_M2
#define EN_M2 1
#endif
#ifndef EN_M3
#define EN_M3 1
#endif
#ifndef EN_M4
#define EN_M4 1
#endif
#ifndef EN_A1
#define EN_A1 1
#endif
#ifndef EN_A2
#define EN_A2 1
#endif
#ifndef EN_A3
#define EN_A3 1
#endif
#ifndef EN_A4
#define EN_A4 1
#endif
#ifndef EN_O5
#define EN_O5 1
#endif
#ifndef EN_L6
#define EN_L6 1
#endif
#ifndef EN_G7
#define EN_G7 1
#endif
#ifndef EN_G8
#define EN_G8 1
#endif
#ifndef EN_L9
#define EN_L9 1
#endif
#ifndef STAG_G7
#define STAG_G7 0
#endif
#ifndef STAG_G8
#define STAG_G8 0
#endif
__device__ __forceinline__ void stagger_wait(const Frame& F, int step) {
    if (step > 0) { const unsigned long long t0 = wall_clock64(), d = (unsigned long long)((F.vcu & 3) * step);
        while (wall_clock64() - t0 < d) __builtin_amdgcn_s_sleep(8);
        __syncthreads(); }
}
constexpr int PH_PER_LAYER = 9, N_PHASES = 1 + DEPTH * PH_PER_LAYER;
constexpr float Q_SCALE = 0.07216878364870323f * 1.4426950408889634f;

__global__ void __launch_bounds__(NTHR, 2) fwd_kernel(Args args) {
    extern __shared__ __attribute__((aligned(16))) unsigned char lds_raw[];
    Frame F0; Frame& F = F0;
    F.lds = (LAS unsigned char*)lds_raw; F.MISC = (volatile LAS unsigned*)(F.lds + MISC_OFF);
    F.tid = threadIdx.x; F.lane = F.tid & 63; F.wave = __builtin_amdgcn_readfirstlane(F.tid >> 6);
    F.G = gridDim.x; { const int bx = blockIdx.x; F.vcu = (F.G % 8 == 0) ? (bx % 8) * (F.G / 8) + bx / 8 : bx; }
    if (F.tid < 128) F.MISC[F.tid] = 0u;
    if (F.tid == 128) {
#pragma unroll
        for (int i = 0; i < 20; ++i) { const unsigned long long p = (unsigned long long)args.in[i]; F.MISC[128 + 2 * i] = (unsigned)p; F.MISC[129 + 2 * i] = (unsigned)(p >> 32); }
        { const unsigned long long p = (unsigned long long)args.out; F.MISC[168] = (unsigned)p; F.MISC[169] = (unsigned)(p >> 32); }
        { const unsigned long long p = (unsigned long long)args.ws; F.MISC[170] = (unsigned)p; F.MISC[171] = (unsigned)(p >> 32); }
    }
    __syncthreads();
    XcdBarrier bar = xcd_barrier_post(F.ctl() + CW_BAR, F.MISC);
    const int lo = args.ph_lo, hi = args.ph_hi;
#define IN(k) (lo <= (k) && (k) < hi)
#define SEAM(k) do { if (IN(k) && IN((k) + 1)) { xcd_barrier(bar); if (DUP_BAR) xcd_barrier(bar); } else __syncthreads(); } while (0)

    if (EN_P0 && IN(0)) { for (int rep = 0; rep <= DUP_P0; ++rep) { const Frame F = refresh(F0); p0_prologue(F); __syncthreads(); } }
    SEAM(0);

    for (int l = 0; l < DEPTH; ++l) {
        const int pb = 1 + l * PH_PER_LAYER, j = l >> 1;
        if ((l & 1) == 0) {
            if (EN_M1 && IN(pb + 0)) for (int rep = 0; rep <= DUP_M1; ++rep) { const Frame F = refresh(F0); unsigned char* ws = F.ws(); const bf16_t* xres = (const bf16_t*)(ws + WS_XB);
                constexpr int EB = DF8_M1 ? 1 : 2;
                if constexpr (DF8_MV != 0) {
                    { pg8::DenseOrder S; S.init(ws + WS_XB, (bf16_t*)(ws + WS_WINM) + (size_t)j * 3072 * 1024, T, 1024, 1024, 1024, F.G, F.vcu, 2);
                      pg8::EpiBf16 E{(bf16_t*)(ws + WS_PROJ), 3072, 1.0f};
                      pg8::gemm_phase<pg8::EpiBf16, pg8::DenseOrder, false, false>(F.lds, F.tid, 1024, 1024, 1024, S, E); }
                    __syncthreads();
                    { const Frame F = refresh(F0); unsigned char* ws = F.ws();
                      pg8::DenseOrder S; S.init(ws + WS_XB8, (unsigned char*)(ws + WS_WINM8) + ((size_t)j * 2048 + 1024) * 1024, T, 1024, 1024, 1024, F.G, F.vcu, 1);
                      pg8::EpiBf16 E{(bf16_t*)(ws + WS_PROJ) + 2048, 3072, 1.0f / (F8_SX * F8_SWI)};
                      pg8::gemm_phase<pg8::EpiBf16, pg8::DenseOrder, false, true>(F.lds, F.tid, 1024, 1024, 1024, S, E); }
                    __syncthreads();
                    { const Frame F = refresh(F0); unsigned char* ws = F.ws();
                      pg8::DenseOrder S; S.init((unsigned char*)(ws + WS_WINM8) + (size_t)j * 2048 * 1024, ws + WS_XB8, 1024, T, 1024, 1024, F.G, F.vcu, 1);
                      pg8::EpiVT E{(bf16_t*)(ws + WS_VT), T, 1.0f / (F8_SX * F8_SWI)};
                      pg8::gemm_phase<pg8::EpiVT, pg8::DenseOrder, false, true>(F.lds, F.tid, 1024, 1024, 1024, S, E); }
                    __syncthreads();
                } else {
                { pg8::DenseOrder S; S.init(ws + (DF8_M1 ? WS_XB8 : WS_XB), (unsigned char*)(ws + WS_WINM) + (size_t)j * 3072 * 1024 * EB, T, MVT ? 2048 : 3072, 1024, 1024, F.G, F.vcu, EB);
                  if (MVT) { S.skip_at = 4; S.skip_n = 4; }
                  pg8::EpiBf16 E{(bf16_t*)(ws + WS_PROJ), 3072, DF8_M1 ? 1.0f / (F8_SX * F8_SWI) : 1.0f};
                  pg8::gemm_phase<pg8::EpiBf16, pg8::DenseOrder, false, DF8_M1 != 0>(F.lds, F.tid, 1024, 1024, 1024, S, E); }
                __syncthreads();
                if (MVT) { const Frame F = refresh(F0); unsigned char* ws = F.ws();
                  pg8::DenseOrder S; S.init((unsigned char*)(ws + WS_WINM) + ((size_t)j * 3072 + 1024) * 1024 * EB, ws + (DF8_M1 ? WS_XB8 : WS_XB), 1024, T, 1024, 1024, F.G, F.vcu, EB);
                  pg8::EpiVT E{(bf16_t*)(ws + WS_VT), T};
                  pg8::gemm_phase<pg8::EpiVT, pg8::DenseOrder, false, DF8_M1 != 0>(F.lds, F.tid, 1024, 1024, 1024, S, E);
                  __syncthreads(); }
                }
                const Frame F2 = refresh(F0);
                { const f32x4* src = (const f32x4*)(ws + WS_GIMG) + (size_t)j * (D * 16 / 4);
#pragma unroll 4
                  for (int it = 0; it < 8; ++it) ((LAS f32x4*)F2.lds)[F2.tid + NTHR * it] = src[F2.tid + NTHR * it];
                  __syncthreads(); }
                gates_phase(F2, xres, (const float*)F2.ptr(IN_MBG) + j * 16, (float*)(ws + WS_GATES));
            }
            SEAM(pb + 0);
            if (EN_M2 && IN(pb + 1)) for (int rep = 0; rep <= DUP_M2; ++rep) { const Frame F = refresh(F0); mlstm_local_phase(F); __syncthreads(); }
            SEAM(pb + 1);
            if (EN_M3 && IN(pb + 2)) for (int rep = 0; rep <= DUP_M3; ++rep) { const Frame F = refresh(F0); mlstm_scan_phase(F); __syncthreads(); }
            SEAM(pb + 2);
            if (EN_M4 && IN(pb + 3)) for (int rep = 0; rep <= DUP_M4; ++rep) { const Frame F = refresh(F0); __syncthreads(); mlstm_out_phase(F, (const float*)F.ptr(IN_MNG) + (size_t)j * 1024); }
            SEAM(pb + 3);
        } else {
            if (EN_A1 && IN(pb + 0)) for (int rep = 0; rep <= DUP_A1; ++rep) { const Frame F = refresh(F0); unsigned char* ws = F.ws();
                constexpr int EB = DF8_A1 ? 1 : 2;
                pg8::DenseOrder S; S.init(ws + (DF8_A1 ? WS_XB8 : WS_XB), (unsigned char*)(ws + WS_WINA) + (size_t)j * AINP * 1024 * EB, T, AINP, 1024, 1024, F.G, F.vcu, EB);
                pg8::EpiF32 E{(float*)(ws + WS_A32), AINP, DF8_A1 ? 1.0f / (F8_SX * F8_SWI) : 1.0f};
                pg8::gemm_phase<pg8::EpiF32, pg8::DenseOrder, false, DF8_A1 != 0>(F.lds, F.tid, 1024, 1024, 1024, S, E);
            }
            SEAM(pb + 0);
            if (EN_A2 && IN(pb + 1)) { const Frame F = refresh(F0); mla_norm_phase(F, j); }
            SEAM(pb + 1);
            if (EN_A3 && IN(pb + 2)) for (int rep = 0; rep <= DUP_A3; ++rep) { const Frame F = refresh(F0); unsigned char* ws = F.ws();
                { pg8::DenseOrder S; S.init(ws + WS_CQ, (bf16_t*)(ws + WS_WQB) + (size_t)j * 1536 * AQL, T, 1536, AQL, AQL, F.G, F.vcu);
                  pg8::EpiQRope E{(bf16_t*)(ws + WS_QB), 1536, (const float*)(ws + WS_COS), (const float*)(ws + WS_SIN), ATT_FP8 ? Q_SCALE * F8_SQ : Q_SCALE};
                  pg8::gemm_phase<pg8::EpiQRope, pg8::DenseOrder, false>(F.lds, F.tid, AQL, AQL, AQL, S, E); }
                __syncthreads();
                { const Frame F = refresh(F0); unsigned char* ws = F.ws();
                  pg8::DenseOrder S; S.init(ws + WS_CKV, (bf16_t*)(ws + WS_WKV) + (size_t)j * 2048 * AKL, T, 1024, AKL, AKL, F.G, F.vcu);
                  if constexpr (ATT_FP8 != 0) { pg8::EpiF8 E{(unsigned char*)(ws + WS_KN), 1024, F8_SK}; pg8::gemm_phase<pg8::EpiF8, pg8::DenseOrder, false>(F.lds, F.tid, AKL, AKL, AKL, S, E); }
                  else { pg8::EpiBf16 E{(bf16_t*)(ws + WS_KN), 1024, 1.0f}; pg8::gemm_phase<pg8::EpiBf16, pg8::DenseOrder, false>(F.lds, F.tid, AKL, AKL, AKL, S, E); } }
                __syncthreads();
                { const Frame F = refresh(F0); unsigned char* ws = F.ws();
                  pg8::DenseOrder S; S.init((bf16_t*)(ws + WS_WKV) + (size_t)j * 2048 * AKL + (size_t)1024 * AKL, ws + WS_CKV, 1024, T, AKL, AKL, F.G, F.vcu);
                  if constexpr (ATT_FP8 != 0) { pg8::EpiVT8 E{(unsigned char*)(ws + WS_VT), T, F8_SV}; pg8::gemm_phase<pg8::EpiVT8, pg8::DenseOrder, false>(F.lds, F.tid, AKL, AKL, AKL, S, E); }
                  else { pg8::EpiVT E{(bf16_t*)(ws + WS_VT), T}; pg8::gemm_phase<pg8::EpiVT, pg8::DenseOrder, false>(F.lds, F.tid, AKL, AKL, AKL, S, E); } }
            }
            SEAM(pb + 2);
            if (EN_A4 && IN(pb + 3)) { for (int rep = 0; rep <= DUP_A4; ++rep) { const Frame F = refresh(F0); if constexpr (ATT_FP8 != 0) attn8_phase(F, (CV_IN_ATTN && MOE_FP8 && rep == 0) ? l : -1, l == 1 ? 2 : 1);     else attn_phase(F); __syncthreads(); } }
            SEAM(pb + 3);
        }
        if (EN_O5 && IN(pb + 4)) for (int rep = 0; rep <= DUP_O5; ++rep) { const Frame F = refresh(F0); unsigned char* ws = F.ws(); const bf16_t* xres = (const bf16_t*)(ws + WS_XB);
            constexpr int EB = DF8_O5 ? 1 : 2;
            const unsigned char* wo = (l & 1) ? (const unsigned char*)(ws + WS_WOUTA) + (size_t)j * 1024 * 1024 * EB : (const unsigned char*)(ws + WS_WOUTM) + (size_t)j * 1024 * 1024 * EB;
            pg8::DenseOrder S; S.init(ws + WS_HB, wo, T, 1024, 1024, 1024, F.G, F.vcu, EB);
            pg8::EpiResid E{xres, (float*)(ws + WS_ZF), 1024, DN_ALPHA, DF8_O5 ? 1.0f / (F8_SHB * F8_SWO) : 1.0f};
            pg8::gemm_phase<pg8::EpiResid, pg8::DenseOrder, false, DF8_O5 != 0>(F.lds, F.tid, 1024, 1024, 1024, S, E);
        }
        SEAM(pb + 4);
        if (EN_L6 && IN(pb + 5)) { if (DUP_L6) { const Frame F = refresh(F0); ln_router_phase(F, l, l + 4); __syncthreads(); } const Frame F = refresh(F0); ln_router_phase(F, l, l); }
        SEAM(pb + 5);
        if (EN_G7 && IN(pb + 6)) for (int rep = 0; rep <= DUP_G7; ++rep) { if (DUP_SYNC && rep) xcd_barrier(bar); const Frame F = refresh(F0); unsigned char* ws = F.ws();
            moe_prefix(F, l);
            constexpr size_t EB = MOE_FP8 ? 1 : 2;
            const int nu = moe_units(F, l, 8);
            pg8::MoeOrder S{(const volatile LAS int*)(F.lds + pg8::MOE_UTAB_OFF), (const char*)(ws + (MOE_FP8 ? WS_XB8 : WS_XB)), (const char*)(ws + WS_WGU) + (size_t)l * 32 * 2048 * 1024 * EB, (const int*)(ws + WS_LIST),
                            nu, (size_t)2048 * 1024 * EB, (size_t)256 * 1024 * EB, true, 0};
            pg8::EpiSwiglu E{(unsigned char*)(ws + WS_HMOE), (const float*)F.ptr(IN_BGU) + (size_t)l * 32 * 2048, F.lds};
            pg8::gemm_phase<pg8::EpiSwiglu, pg8::MoeOrder, true, MOE_FP8 != 0>(F.lds, F.tid, 1024, 1024, 1024, S, E);
        }
        SEAM(pb + 6);
        if (EN_G8 && IN(pb + 7)) for (int rep = 0; rep <= DUP_G8; ++rep) { if (DUP_SYNC && rep) xcd_barrier(bar); const Frame F = refresh(F0); unsigned char* ws = F.ws();
            if (MK_PER_PHASE) moe_prefix(F, l);
            constexpr size_t EB = MOE_FP8 ? 1 : 2;
            const int nu = moe_units(F, l, 4);
            pg8::MoeOrder S{(const volatile LAS int*)(F.lds + pg8::MOE_UTAB_OFF), (const char*)(ws + WS_HMOE), (const char*)(ws + WS_WD) + (size_t)l * 32 * 1024 * 1024 * EB, (const int*)(ws + WS_LIST),
                            nu, (size_t)1024 * 1024 * EB, (size_t)256 * 1024 * EB, false, (size_t)256 * 1024 * EB};
            pg8::EpiDown E{(bf16_t*)(ws + WS_YMOE), (const float*)F.ptr(IN_BD) + (size_t)l * 32 * 1024, F.lds};
            pg8::gemm_phase<pg8::EpiDown, pg8::MoeOrder, false, MOE_FP8 != 0>(F.lds, F.tid, 1024, 1024, 1024, S, E);
        }
        SEAM(pb + 7);
        if (EN_L9 && IN(pb + 8)) { if (DUP_L9) { const Frame F = refresh(F0); moe_prefix(F, l); ln_combine_phase(F, l, false, true); __syncthreads(); } const Frame F = refresh(F0); if (MK_PER_PHASE) moe_prefix(F, l); else __syncthreads(); ln_combine_phase(F, l, l == DEPTH - 1, false); }
        SEAM(pb + 8);
    }
#undef IN
#undef SEAM
}

extern "C" void kernel_launch(void* const* d_in, const int* in_sizes, int n_in, void* d_out, int out_size, void* d_ws, size_t ws_size, hipStream_t stream) {
    static int grid = 0;
    if (grid == 0) {
        if (n_in != 20 || out_size != T * D || ws_size < WS_END) { fprintf(stderr, "kernel_launch: unexpected problem (n_in %d out %d ws %zu)\n", n_in, out_size, ws_size); grid = -1; return; }
        int dev = 0, cus = 0, per_cu = 0;
        if (hipGetDevice(&dev) != hipSuccess || hipDeviceGetAttribute(&cus, hipDeviceAttributeMultiprocessorCount, dev) != hipSuccess) { grid = -1; return; }
        if (hipFuncSetAttribute((const void*)fwd_kernel, hipFuncAttributeMaxDynamicSharedMemorySize, LDS_BYTES) != hipSuccess) { fprintf(stderr, "kernel_launch: hipFuncSetAttribute failed\n"); grid = -1; return; }
        if (hipOccupancyMaxActiveBlocksPerMultiprocessor(&per_cu, (const void*)fwd_kernel, NTHR, LDS_BYTES) != hipSuccess || per_cu < 1) fprintf(stderr, "kernel_launch: occupancy query reports %d\n", per_cu);
        (void)hipGetLastError();
        grid = cus;
    }
    if (grid < 0) return;
    (void)hipMemsetAsync((char*)d_ws + WS_CTL, 0, CTL_ZERO_BYTES, stream);
    Args a; memset(&a, 0, sizeof(a));
    for (int i = 0; i < 20; ++i) a.in[i] = d_in[i];
    a.out = (float*)d_out; a.ws = (unsigned char*)d_ws;
#if MK_PER_PHASE
    for (int p = 0; p < N_PHASES; ++p) { a.ph_lo = p; a.ph_hi = p + 1; hipLaunchKernelGGL(fwd_kernel, dim3(grid), dim3(NTHR), LDS_BYTES, stream, a); }
#else
    a.ph_lo = 0; a.ph_hi = N_PHASES;
    hipLaunchKernelGGL(fwd_kernel, dim3(grid), dim3(NTHR), LDS_BYTES, stream, a);
#endif
    const hipError_t le = hipPeekAtLastError();
    if (le != hipSuccess) fprintf(stderr, "kernel_launch: launch failed: %s\n", hipGetErrorName(le));
}
```
